# Optimizing an MI355X kernel written in HIP

```python
import jax, jax.numpy as jnp
from jax import lax
import numpy as np

D_MODEL = 1024
BATCH = 8
SEQ = 2048
DEPTH = 2
DEC_BATCH = 32
DEC_SEQ = 8
PAST_LEN = 8192
PAGE_SIZE = 128

HEAD_DIM = 64
POOL_WIDTH = D_MODEL // 4
POOL_WINDOWS = (2, 4, 8, 16)
POOL_GROUP = POOL_WIDTH // len(POOL_WINDOWS)
POOL_HIST = max(POOL_WINDOWS) - 1
ATTN_WIDTH = 3 * D_MODEL // 8
DIL_PAIRS = ((128, 1), (512, 4), (2048, 16))
N_DIL = len(DIL_PAIRS)
ATTN_HEADS = ATTN_WIDTH // HEAD_DIM
HEADS_PER_DIL = ATTN_HEADS // N_DIL
ATTN_OUT = HEADS_PER_DIL * HEAD_DIM
CONV_WIDTH = D_MODEL - POOL_WIDTH - ATTN_WIDTH
CONV_K = 3
ROPE_DIM = HEAD_DIM // 4
ROPE_THETA = 500000.0
D_FF = 4 * D_MODEL
IN_COLS = POOL_WIDTH + 3 * ATTN_WIDTH + 3 * CONV_WIDTH
MIX_OUT = POOL_WIDTH + ATTN_OUT + CONV_WIDTH
EPS = 1e-6
NEG_INF = -1e30

kernel_name = "hybrid_pool_dilattn_shortconv_decode_step"


def rmsnorm(x, g):
    xf = x.astype(jnp.float32)
    y = xf * lax.rsqrt(jnp.mean(xf * xf, axis=-1, keepdims=True) + EPS)
    return (y * g.astype(jnp.float32)).astype(x.dtype)


def partial_rope(x, pos):
    half = ROPE_DIM // 2
    inv = jnp.power(jnp.float32(ROPE_THETA), -jnp.arange(half, dtype=jnp.float32) / half)
    ang = pos.astype(jnp.float32)[:, None] * inv[None, :]
    cos = jnp.cos(ang)[:, None, :]
    sin = jnp.sin(ang)[:, None, :]
    xf = x.astype(jnp.float32)
    x1 = xf[..., :half]
    x2 = xf[..., half:ROPE_DIM]
    out = jnp.concatenate([x1 * cos - x2 * sin, x2 * cos + x1 * sin, xf[..., ROPE_DIM:]], axis=-1)
    return out.astype(x.dtype)


def softmax_stats(s):
    m = jnp.max(s, axis=-1, keepdims=True)
    p = jnp.exp(s - m)
    den = jnp.sum(p, axis=-1, keepdims=True)
    return p / den, (m + jnp.log(den))[..., 0]


def pool_mix(u_hist, u_new, pos, pool_w, pool_scale):
    n, t, c = u_new.shape
    u_ext = jnp.concatenate([u_hist, u_new], axis=1).astype(jnp.float32)
    cs = jnp.concatenate([jnp.zeros((n, 1, c), jnp.float32), jnp.cumsum(u_ext, axis=1)], axis=1)
    end = cs[:, POOL_HIST + 1:]
    uf = u_new.astype(jnp.float32)
    outs = []
    for j, w in enumerate(POOL_WINDOWS):
        sl = slice(j * POOL_GROUP, (j + 1) * POOL_GROUP)
        win_sum = end[..., sl] - cs[:, POOL_HIST + 1 - w:POOL_HIST + 1 - w + t, sl]
        cnt = jnp.minimum(pos + 1, w).astype(jnp.float32)[None, :, None]
        outs.append(win_sum / cnt - uf[..., sl])
    d = jnp.stack(outs, axis=2).astype(u_new.dtype)
    y = jnp.einsum("ntgc,gcd->ntgd", d, pool_w).reshape(n, t, POOL_WIDTH)
    return y * pool_scale


def conv_mix(z_hist, z_new, conv_w):
    t = z_new.shape[1]
    z_ext = jnp.concatenate([z_hist, z_new], axis=1)
    return sum(conv_w[i] * z_ext[:, i:i + t] for i in range(CONV_K))


def band_attn(q, k, v, n_back):
    n, l, h, dh = q.shape
    qb_len = n_back
    nb = -(-l // qb_len)
    lp = nb * qb_len
    pad = ((0, 0), (0, lp - l), (0, 0), (0, 0))

    def blocks(a):
        return jnp.pad(a, pad).reshape(n, nb, qb_len, h, dh)

    def with_prev(a):
        prev = jnp.concatenate([jnp.zeros_like(a[:, :1]), a[:, :-1]], axis=1)
        return jnp.concatenate([prev, a], axis=2)

    qb = blocks(q)
    kk = with_prev(blocks(k))
    vv = with_prev(blocks(v))
    s = jnp.einsum("nbqhd,nbkhd->nbhqk", qb, kk, preferred_element_type=jnp.float32) * (HEAD_DIM ** -0.5)
    qi = jnp.arange(qb_len)[:, None]
    ki = jnp.arange(2 * qb_len)[None, :]
    dist = qi + qb_len - ki
    blk = jnp.arange(nb)[:, None, None]
    valid = (dist >= 0) & (dist <= n_back) & (blk * qb_len - qb_len + ki >= 0)
    s = jnp.where(valid[None, :, None], s, NEG_INF)
    p, lse = softmax_stats(s)
    o = jnp.einsum("nbhqk,nbkhd->nbqhd", p, vv.astype(jnp.float32)).reshape(n, lp, h, dh)[:, :l]
    lse = lse.transpose(0, 1, 3, 2).reshape(n, lp, h)[:, :l]
    return o, lse


def dilated_prompt(q, k, v, window, dil):
    b, s, h, dh = q.shape
    m = s // dil

    def to_res(a):
        return a.reshape(b, m, dil, h, dh).transpose(0, 2, 1, 3, 4).reshape(b * dil, m, h, dh)

    o, lse = band_attn(to_res(q), to_res(k), to_res(v), window // dil)
    o = o.reshape(b, dil, m, h, dh).transpose(0, 2, 1, 3, 4).reshape(b, s, h, dh)
    lse = lse.reshape(b, dil, m, h).transpose(0, 2, 1, 3).reshape(b, s, h)
    return o, lse


def dilated_sample(q, k_ext, v_ext, start_pos, window, dil):
    t = q.shape[1]
    n_keys = window // dil + 1
    idx = window + jnp.arange(t)[:, None] - dil * jnp.arange(n_keys)[None, :]
    kg = k_ext[:, idx]
    vg = v_ext[:, idx]
    s = jnp.einsum("nthd,ntjhd->nthj", q, kg, preferred_element_type=jnp.float32) * (HEAD_DIM ** -0.5)
    valid = (start_pos - window + idx) >= 0
    s = jnp.where(valid[None, :, None, :], s, NEG_INF)
    p, lse = softmax_stats(s)
    o = jnp.einsum("nthj,ntjhd->nthd", p, vg.astype(jnp.float32))
    return o, lse


def trunk_layer(x, pos, is_prompt, pool_hist, conv_hist, kv_bufs,
                norm1_g, w_in, q_norm_g, k_norm_g, pool_w, pool_scale, conv_w,
                w_out, norm2_g, w_up, w_down):
    n, t, _ = x.shape
    h = rmsnorm(x, norm1_g)
    proj = jnp.einsum("ntd,dc->ntc", h, w_in)
    cuts = [POOL_WIDTH, POOL_WIDTH + ATTN_WIDTH, POOL_WIDTH + 2 * ATTN_WIDTH, POOL_WIDTH + 3 * ATTN_WIDTH,
            POOL_WIDTH + 3 * ATTN_WIDTH + CONV_WIDTH, POOL_WIDTH + 3 * ATTN_WIDTH + 2 * CONV_WIDTH]
    u, q, k, v, gb, gc, gh = jnp.split(proj, cuts, axis=-1)

    y_pool = pool_mix(pool_hist, u, pos, pool_w, pool_scale)
    new_pool = jnp.concatenate([pool_hist, u], axis=1)[:, -POOL_HIST:]

    q = partial_rope(rmsnorm(q.reshape(n, t, ATTN_HEADS, HEAD_DIM), q_norm_g), pos)
    k = partial_rope(rmsnorm(k.reshape(n, t, ATTN_HEADS, HEAD_DIM), k_norm_g), pos)
    v = v.reshape(n, t, ATTN_HEADS, HEAD_DIM)
    outs, lses, new_kv = [], [], []
    for g, (window, dil) in enumerate(DIL_PAIRS):
        hs = slice(g * HEADS_PER_DIL, (g + 1) * HEADS_PER_DIL)
        qg, kg, vg = q[:, :, hs], k[:, :, hs], v[:, :, hs]
        kv_ext = jnp.concatenate([kv_bufs[g], jnp.stack([kg, vg], axis=2)], axis=1)
        if is_prompt:
            o, lse = dilated_prompt(qg, kg, vg, window, dil)
        else:
            o, lse = dilated_sample(qg, kv_ext[:, :, 0], kv_ext[:, :, 1], pos[0], window, dil)
        outs.append(o)
        lses.append(lse)
        new_kv.append(kv_ext[:, -window:])
    wts = jax.nn.softmax(jnp.stack(lses, axis=0), axis=0)
    y_attn = jnp.sum(wts[..., None] * jnp.stack(outs, axis=0), axis=0)
    y_attn = y_attn.reshape(n, t, ATTN_OUT).astype(x.dtype)

    z = gc * gh
    y_conv = gb * conv_mix(conv_hist, z, conv_w)
    new_conv = jnp.concatenate([conv_hist, z], axis=1)[:, -(CONV_K - 1):]

    mixed = jnp.concatenate([y_pool, y_attn, y_conv], axis=-1)
    x = x + jnp.einsum("ntc,cd->ntd", mixed, w_out)

    hf = jnp.einsum("ntd,df->ntf", rmsnorm(x, norm2_g), w_up)
    x = x + jnp.einsum("ntf,fd->ntd", jnp.square(jax.nn.relu(hf)), w_down)
    return x, new_pool, new_conv, new_kv


def setup_inputs(seed: int = 0) -> dict:
    key = jax.random.key(seed)
    ks = jax.random.split(key, 24)
    f32 = jnp.float32

    def nrm(k, shape, scale):
        return jax.random.normal(k, shape, f32) * scale

    kv_shape = lambda w: (DEPTH, DEC_BATCH, w, 2, HEADS_PER_DIL, HEAD_DIM)
    return {
        "x_prompt": nrm(ks[0], (BATCH, SEQ, D_MODEL), 1.0),
        "x_sample": nrm(ks[1], (DEC_BATCH, DEC_SEQ, D_MODEL), 1.0),
        "state_pool": nrm(ks[2], (DEPTH, DEC_BATCH, POOL_HIST, POOL_WIDTH), 1.0),
        "state_conv": nrm(ks[3], (DEPTH, DEC_BATCH, CONV_K - 1, CONV_WIDTH), 1.0),
        "cache_kv_w128": nrm(ks[4], kv_shape(DIL_PAIRS[0][0]), 1.0),
        "cache_kv_w512": nrm(ks[5], kv_shape(DIL_PAIRS[1][0]), 1.0),
        "cache_kv_w2048": nrm(ks[6], kv_shape(DIL_PAIRS[2][0]), 1.0),
        "norm1_g": 1.0 + nrm(ks[7], (DEPTH, D_MODEL), 0.02),
        "w_in": nrm(ks[8], (DEPTH, D_MODEL, IN_COLS), D_MODEL ** -0.5),
        "q_norm_g": 1.0 + nrm(ks[9], (DEPTH, HEAD_DIM), 0.02),
        "k_norm_g": 1.0 + nrm(ks[10], (DEPTH, HEAD_DIM), 0.02),
        "pool_w": nrm(ks[11], (DEPTH, len(POOL_WINDOWS), POOL_GROUP, POOL_GROUP), POOL_GROUP ** -0.5),
        "pool_scale": 1.0 + nrm(ks[12], (DEPTH, POOL_WIDTH), 0.02),
        "conv_w": nrm(ks[13], (DEPTH, CONV_K, CONV_WIDTH), CONV_K ** -0.5),
        "w_out": nrm(ks[14], (DEPTH, MIX_OUT, D_MODEL), MIX_OUT ** -0.5),
        "norm2_g": 1.0 + nrm(ks[15], (DEPTH, D_MODEL), 0.02),
        "w_up": nrm(ks[16], (DEPTH, D_MODEL, D_FF), D_MODEL ** -0.5),
        "w_down": nrm(ks[17], (DEPTH, D_FF, D_MODEL), D_FF ** -0.5),
    }


def reference(x_prompt, x_sample, state_pool, state_conv, cache_kv_w128, cache_kv_w512, cache_kv_w2048,
              norm1_g, w_in, q_norm_g, k_norm_g, pool_w, pool_scale, conv_w, w_out, norm2_g, w_up, w_down):
    b, s, _ = x_prompt.shape
    pos_p = jnp.arange(s, dtype=jnp.int32)
    pos_s = PAST_LEN + jnp.arange(x_sample.shape[1], dtype=jnp.int32)
    caches = (cache_kv_w128, cache_kv_w512, cache_kv_w2048)
    xp, xs = x_prompt, x_sample
    pool_p, conv_p, kv_p = [], [], [[] for _ in DIL_PAIRS]
    pool_s, conv_s, kv_s = [], [], [[] for _ in DIL_PAIRS]
    for layer in range(DEPTH):
        wts = (norm1_g[layer], w_in[layer], q_norm_g[layer], k_norm_g[layer], pool_w[layer], pool_scale[layer],
               conv_w[layer], w_out[layer], norm2_g[layer], w_up[layer], w_down[layer])
        zero_kv = [jnp.zeros((b, w, 2, HEADS_PER_DIL, HEAD_DIM), xp.dtype) for (w, _) in DIL_PAIRS]
        xp, np_pool, np_conv, np_kv = trunk_layer(
            xp, pos_p, True,
            jnp.zeros((b, POOL_HIST, POOL_WIDTH), xp.dtype),
            jnp.zeros((b, CONV_K - 1, CONV_WIDTH), xp.dtype),
            zero_kv, *wts)
        xs, ns_pool, ns_conv, ns_kv = trunk_layer(
            xs, pos_s, False, state_pool[layer], state_conv[layer],
            [c[layer] for c in caches], *wts)
        pool_p.append(np_pool)
        conv_p.append(np_conv)
        pool_s.append(ns_pool)
        conv_s.append(ns_conv)
        for g in range(N_DIL):
            kv_p[g].append(np_kv[g])
            kv_s[g].append(ns_kv[g])
    return (xp, xs,
            jnp.stack(pool_p), jnp.stack(conv_p),
            jnp.stack(kv_p[0]), jnp.stack(kv_p[1]), jnp.stack(kv_p[2]),
            jnp.stack(pool_s), jnp.stack(conv_s),
            jnp.stack(kv_s[0]), jnp.stack(kv_s[1]), jnp.stack(kv_s[2]))
```

```cpp
#include <hip/hip_runtime.h>
#include <hip/hip_cooperative_groups.h>
#include <cstdio>
namespace cg = cooperative_groups;

typedef unsigned short u16;
using bf16x8 = __attribute__((ext_vector_type(8))) short;
using f32x4 = __attribute__((ext_vector_type(4))) float;
using f32x16 = __attribute__((ext_vector_type(16))) float;

constexpr int NP = 16384, NS = 256, MT = NP + NS;
constexpr int D = 1024, IC = 2560, MC = 768, FF = 4096;
constexpr float EPS = 1e-6f;
constexpr int C_U = 0, C_Q = 256, C_K = 640, C_V = 1024, C_GB = 1408, C_GC = 1792, C_GH = 2176;
constexpr size_t O_YP = 0;
constexpr size_t O_YS = O_YP + (size_t)NP * D;
constexpr size_t O_POOLP = O_YS + (size_t)NS * D;
constexpr size_t O_CONVP = O_POOLP + 2 * 8 * 15 * 256;
constexpr size_t O_KV128P = O_CONVP + 2 * 8 * 2 * 384;
constexpr size_t O_KV512P = O_KV128P + (size_t)2 * 8 * 128 * 256;
constexpr size_t O_KV2048P = O_KV512P + (size_t)2 * 8 * 512 * 256;
constexpr size_t O_POOLS = O_KV2048P + (size_t)2 * 8 * 2048 * 256;
constexpr size_t O_CONVS = O_POOLS + 2 * 32 * 15 * 256;
constexpr size_t O_KV128S = O_CONVS + 2 * 32 * 2 * 384;
constexpr size_t O_KV512S = O_KV128S + (size_t)2 * 32 * 128 * 256;
constexpr size_t O_KV2048S = O_KV512S + (size_t)2 * 32 * 512 * 256;

struct Params {
  const float *x_prompt, *x_sample, *state_pool, *state_conv, *kv_in[3];
  const float *norm1_g, *w_in, *q_norm_g, *k_norm_g, *pool_w, *pool_scale, *conv_w, *w_out, *norm2_g, *w_up, *w_down;
  float* out;
  u16 *wt_in, *wt_out, *wt_up, *wt_down, *pwT;
  u16 *xg, *proj, *mixed, *hf;
  float *xa, *xb, *sumsq, *opart, *lse, *rope;
  unsigned* bar;
};

extern __shared__ __attribute__((aligned(16))) unsigned char smem[];
typedef __attribute__((address_space(3))) void* LDSP;

__device__ __forceinline__ u16 f2bf(float f) { unsigned u = __float_as_uint(f); u += 0x7fffu + ((u >> 16) & 1u); return (u16)(u >> 16); }
__device__ __forceinline__ float bf2f(u16 h) { return __uint_as_float(((unsigned)h) << 16); }
__device__ __forceinline__ float bfs2f(short h) { return __uint_as_float(((unsigned)(u16)h) << 16); }
__device__ __forceinline__ unsigned pack2(float a, float b) { return (unsigned)f2bf(a) | ((unsigned)f2bf(b) << 16); }
__device__ __forceinline__ int opaque_tid(const int wave_s) {
  int l; asm volatile("v_mbcnt_lo_u32_b32 %0, -1, 0\n\tv_mbcnt_hi_u32_b32 %0, -1, %0" : "=v"(l));
  return wave_s * 64 + l;
}
__device__ __forceinline__ void grid_bar(unsigned* cnt, const unsigned target, const int wave_s) {
  __builtin_amdgcn_fence(__ATOMIC_RELEASE, "agent");
  __syncthreads();
  if (opaque_tid(wave_s) == 0) {
    __hip_atomic_fetch_add(cnt, 1u, __ATOMIC_RELEASE, __HIP_MEMORY_SCOPE_AGENT);
    while (__hip_atomic_load(cnt, __ATOMIC_ACQUIRE, __HIP_MEMORY_SCOPE_AGENT) < target) __builtin_amdgcn_s_sleep(2);
  }
  __syncthreads();
  __builtin_amdgcn_fence(__ATOMIC_ACQUIRE, "agent");
}
__device__ __forceinline__ float wave_sum(float v) { for (int o = 32; o; o >>= 1) v += __shfl_xor(v, o); return v; }
__device__ __forceinline__ float wave_max(float v) { for (int o = 32; o; o >>= 1) v = fmaxf(v, __shfl_xor(v, o)); return v; }

constexpr int BM = 256, BK = 64, HALF = 128, NXCD = 8, WGM = 8, HT = HALF * BK;
constexpr int GEMM_LDS = 8 * HT * 2;

__device__ __forceinline__ int lds_byte(int r, int c) {
  int st = (r >> 4) * 2 + (c >> 5), rr = r & 15, cc = c & 31, ob = rr * 64 + cc * 2;
  return st * 1024 + (ob ^ (((ob >> 9) & 1) << 5));
}
__device__ __forceinline__ void stage_rc(int b, int& R, int& C) {
  int st = b / 1024, sb = b % 1024, swz = sb ^ (((sb >> 9) & 1) << 5);
  R = (st >> 1) * 16 + swz / 64; C = (st & 1) * 32 + (swz % 64) / 2;
}

struct GemmEpi {
  const float* sumsq_in;
  u16* out_bf; int ldo;
  const float *resid_p, *resid_s;
  float *out_p, *out_s;
  u16* out_xg; const float* gnext; float* sumsq_out;
};

template <int MODE>
__device__ __forceinline__ void gemm_phase(const u16* __restrict__ A, const u16* __restrict__ Bt, const int M, const int N, const int K, const GemmEpi e, const int wave_s) {
  u16* shm = (u16*)smem;
#define SA(b, h) (shm + ((b) * 2 + (h)) * HT)
#define SB(b, h) (shm + (4 + (b) * 2 + (h)) * HT)
#define STAGE(P, RS, br, kt) do { const unsigned _so = (unsigned)(((br) * K + (kt) * BK) * 2); \
    __builtin_amdgcn_raw_ptr_buffer_load_lds(RS, (LDSP)((char*)(P) + tid0 * 16), 16, toff0, _so, 0, 0); \
    __builtin_amdgcn_raw_ptr_buffer_load_lds(RS, (LDSP)((char*)(P) + tid0 * 16 + 8192), 16, toff1, _so, 0, 0); } while (0)
#define LDA(dst, b, h) for (int m = 0; m < 4; ++m) for (int k = 0; k < 2; ++k) \
    dst[m][k] = *reinterpret_cast<const bf16x8*>((char*)SA(b, h) + lds_byte(wr * 64 + m * 16 + fr, k * 32 + fq * 8))
#define LDB(dst, b, h) for (int n = 0; n < 2; ++n) for (int k = 0; k < 2; ++k) \
    dst[n][k] = *reinterpret_cast<const bf16x8*>((char*)SB(b, h) + lds_byte(wc * 32 + n * 16 + fr, k * 32 + fq * 8))
#define MMA(ai, bj, At, Bt_) do { __builtin_amdgcn_s_setprio(1); \
    for (int m = 0; m < 4; ++m) for (int n = 0; n < 2; ++n) for (int k = 0; k < 2; ++k) \
      acc[ai][bj][m][n] = __builtin_amdgcn_mfma_f32_16x16x32_bf16(At[m][k], Bt_[n][k], acc[ai][bj][m][n], 0, 0, 0); \
    __builtin_amdgcn_s_setprio(0); } while (0)
#define WAIT_V(n) asm volatile("s_waitcnt vmcnt(" #n ")" ::: "memory")
#define WAIT_L(n) asm volatile("s_waitcnt lgkmcnt(" #n ")" ::: "memory")
#define BAR __builtin_amdgcn_s_barrier()
#define SCHED __builtin_amdgcn_sched_barrier(0)

  const int nM = M / BM, nN = N / BM, nwg = nM * nN;
  const int nt = K / BK;
  unsigned toff0, toff1;
  const int tid0 = opaque_tid(wave_s);
  const int wr = (tid0 >> 6) >> 2, wc = (tid0 >> 6) & 3, fr = tid0 & 15, fq = (tid0 & 63) >> 4;
  { int r_, c_; stage_rc(tid0 * 16, r_, c_); toff0 = (unsigned)(r_ * K + c_) * 2u; stage_rc(tid0 * 16 + 8192, r_, c_); toff1 = (unsigned)(r_ * K + c_) * 2u; }
  const __amdgpu_buffer_rsrc_t rsA = __builtin_amdgcn_make_buffer_rsrc((void*)A, 0, -1, 0x00020000);
  const __amdgpu_buffer_rsrc_t rsB = __builtin_amdgcn_make_buffer_rsrc((void*)Bt, 0, -1, 0x00020000);
  for (int tt = blockIdx.x; tt < nwg; tt += gridDim.x) {
    int wgid = tt;
    { int q = nwg / NXCD, r = nwg % NXCD, xcd = wgid % NXCD, off = wgid / NXCD;
      wgid = (xcd < r ? xcd * (q + 1) : r * (q + 1) + (xcd - r) * q) + off; }
    int nig = WGM * nN, gid = wgid / nig, fm = gid * WGM, gsz = min(nM - fm, WGM);
    int pm = fm + ((wgid % nig) % gsz), pn = (wgid % nig) / gsz, brow = pm * BM, bcol = pn * BM;
    f32x4 acc[2][2][4][2] = {};
    bf16x8 At[4][2], B0[2][2], B1[2][2];
    STAGE(SB(0, 0), rsB, bcol, 0); STAGE(SA(0, 0), rsA, brow, 0);
    STAGE(SB(0, 1), rsB, bcol + HALF, 0); STAGE(SA(0, 1), rsA, brow + HALF, 0);
    if (wr == 1) BAR;
    WAIT_V(4); BAR;
    STAGE(SB(1, 0), rsB, bcol, 1); STAGE(SA(1, 0), rsA, brow, 1); STAGE(SB(1, 1), rsB, bcol + HALF, 1);
    WAIT_V(6); BAR;
    for (int t = 0; t < nt - 2; t += 2) {
      LDB(B0, 0, 0); SCHED; LDA(At, 0, 0); STAGE(SA(1, 1), rsA, brow + HALF, t + 1);
      WAIT_L(8); BAR; WAIT_L(0); MMA(0, 0, At, B0); BAR; SCHED;
      LDB(B1, 0, 1); STAGE(SB(0, 0), rsB, bcol, t + 2);
      BAR; WAIT_L(0); MMA(0, 1, At, B1); BAR;
      LDA(At, 0, 1); STAGE(SA(0, 0), rsA, brow, t + 2);
      BAR; WAIT_L(0); MMA(1, 0, At, B0); BAR; SCHED;
      STAGE(SB(0, 1), rsB, bcol + HALF, t + 2);
      WAIT_V(6); BAR; MMA(1, 1, At, B1); BAR;
      LDB(B0, 1, 0); SCHED; LDA(At, 1, 0); STAGE(SA(0, 1), rsA, brow + HALF, t + 2);
      WAIT_L(8); BAR; WAIT_L(0); MMA(0, 0, At, B0); BAR; SCHED;
      LDB(B1, 1, 1); STAGE(SB(1, 0), rsB, bcol, t + 3);
      BAR; WAIT_L(0); MMA(0, 1, At, B1); BAR;
      LDA(At, 1, 1); STAGE(SA(1, 0), rsA, brow, t + 3);
      BAR; WAIT_L(0); MMA(1, 0, At, B0); BAR; SCHED;
      STAGE(SB(1, 1), rsB, bcol + HALF, t + 3);
      WAIT_V(6); BAR; MMA(1, 1, At, B1); BAR;
    }
    { LDB(B0, 0, 0); LDA(At, 0, 0); STAGE(SA(1, 1), rsA, brow + HALF, nt - 1);
      BAR; WAIT_L(0); MMA(0, 0, At, B0); BAR;
      LDB(B1, 0, 1); BAR; WAIT_L(0); MMA(0, 1, At, B1); BAR;
      LDA(At, 0, 1); WAIT_V(4); BAR; WAIT_L(0); MMA(1, 0, At, B0); MMA(1, 1, At, B1); BAR; }
    { LDB(B0, 1, 0); LDA(At, 1, 0); WAIT_V(2); BAR; WAIT_L(0); MMA(0, 0, At, B0); BAR;
      LDB(B1, 1, 1); WAIT_V(0); BAR; WAIT_L(0); MMA(0, 1, At, B1); BAR;
      LDA(At, 1, 1); BAR; WAIT_L(0); MMA(1, 0, At, B0); MMA(1, 1, At, B1); BAR; }
    if (wr == 0) BAR;
    {
      const int tid1 = opaque_tid(wave_s);
      const int wid = tid1 >> 6, lane = tid1 & 63, wr = wid >> 2, wc = wid & 3, fr = lane & 15, fq = lane >> 4;
      float* stg = (float*)smem;
      const float* rp = nullptr; float* outp = nullptr;
      if (MODE == 2) {
        rp = (brow < NP) ? e.resid_p + (size_t)brow * D : e.resid_s + (size_t)(brow - NP) * D;
        outp = (brow < NP) ? e.out_p + (size_t)brow * D : e.out_s + (size_t)(brow - NP) * D;
      }
      const int gcol = bcol + lane * 4;
      float4 gn = make_float4(0.f, 0.f, 0.f, 0.f);
      if (MODE == 2 && e.out_xg) gn = *(const float4*)(e.gnext + gcol);
#pragma unroll
      for (int ai = 0; ai < 2; ++ai) {
        {
          float* wb = stg + (wr * 64 + fq * 4) * 256 + wc * 32 + fr;
          const int sw = (fq & 1) << 4;
#pragma unroll
          for (int bj = 0; bj < 2; ++bj)
#pragma unroll
            for (int m = 0; m < 4; ++m)
#pragma unroll
              for (int n = 0; n < 2; ++n)
#pragma unroll
                for (int j = 0; j < 4; ++j)
                  wb[(m * 16 + j) * 256 + bj * 128 + ((n * 16) ^ sw)] = acc[ai][bj][m][n][j];
        }
        __syncthreads();
#pragma unroll 4
        for (int i = 0; i < 16; ++i) {
          const int r = wid * 16 + i;
          const float4 a = *(const float4*)(stg + r * 256 + ((lane * 4) ^ (((r >> 2) & 1) << 4)));
          const int lrow = ai * HALF + r;
          if (MODE == 1 || MODE == 3) {
            const float rs = rsqrtf(e.sumsq_in[brow + lrow] * (1.0f / 1024.0f) + EPS);
            float v0 = a.x * rs, v1 = a.y * rs, v2 = a.z * rs, v3 = a.w * rs;
            if (MODE == 3) { v0 = fmaxf(v0, 0.f); v1 = fmaxf(v1, 0.f); v2 = fmaxf(v2, 0.f); v3 = fmaxf(v3, 0.f); v0 *= v0; v1 *= v1; v2 *= v2; v3 *= v3; }
            uint2 o; o.x = pack2(v0, v1); o.y = pack2(v2, v3);
            *(uint2*)(e.out_bf + (size_t)(brow + lrow) * e.ldo + gcol) = o;
          } else {
            const size_t o = (size_t)lrow * D + gcol;
            const float4 x0 = *(const float4*)(rp + o);
            float4 x; x.x = x0.x + a.x; x.y = x0.y + a.y; x.z = x0.z + a.z; x.w = x0.w + a.w;
            *(float4*)(outp + o) = x;
            if (e.out_xg) {
              uint2 ob; ob.x = pack2(x.x * gn.x, x.y * gn.y); ob.y = pack2(x.z * gn.z, x.w * gn.w);
              *(uint2*)(e.out_xg + (size_t)brow * D + o) = ob;
            }
            if (e.sumsq_out) {
              const float ssq = wave_sum(x.x * x.x + x.y * x.y + x.z * x.z + x.w * x.w);
              if (lane == 0) atomicAdd(e.sumsq_out + brow + lrow, ssq);
            }
          }
        }
        __syncthreads();
      }
    }
    WAIT_V(0);
    __syncthreads();
  }
#undef SA
#undef SB
#undef STAGE
#undef LDA
#undef LDB
#undef MMA
}

__device__ __forceinline__ void tr_tile(const float* __restrict__ src, u16* __restrict__ dst, int K, int N, int k0, int n0, const int tid) {
  float* lt = (float*)smem;
  { const int kk = tid >> 4, n4 = tid & 15;
#pragma unroll
    for (int i = 0; i < 2; ++i) {
      const int k = kk + i * 32;
      const float4 v = *(const float4*)(src + (size_t)(k0 + k) * N + n0 + n4 * 4);
      float* d = lt + k * 65 + n4 * 4;
      d[0] = v.x; d[1] = v.y; d[2] = v.z; d[3] = v.w;
    } }
  __syncthreads();
  { const int n = tid >> 3, k8 = tid & 7;
    float f[8];
#pragma unroll
    for (int i = 0; i < 8; ++i) f[i] = lt[(k8 * 8 + i) * 65 + n];
    uint4 o; o.x = pack2(f[0], f[1]); o.y = pack2(f[2], f[3]); o.z = pack2(f[4], f[5]); o.w = pack2(f[6], f[7]);
    *(uint4*)(dst + (size_t)(n0 + n) * K + k0 + k8 * 8) = o; }
  __syncthreads();
}

__device__ void phase0(const Params& p, const int wave_s) {
  const int tid = opaque_tid(wave_s), lane = tid & 63, wid = tid >> 6;
  const int gw = blockIdx.x * 8 + wid, nw = gridDim.x * 8;
  const size_t gt = (size_t)blockIdx.x * 512 + tid, ntd = (size_t)gridDim.x * 512;
  for (int row = gw; row < MT; row += nw) {
    const float4* xr = (const float4*)(row < NP ? p.x_prompt + (size_t)row * D : p.x_sample + (size_t)(row - NP) * D);
    const float4* g4 = (const float4*)p.norm1_g;
    float ss = 0.f;
#pragma unroll
    for (int i = 0; i < 4; ++i) {
      const float4 v = xr[lane + 64 * i], g = g4[lane + 64 * i];
      ss += v.x * v.x + v.y * v.y + v.z * v.z + v.w * v.w;
      uint2 o; o.x = pack2(v.x * g.x, v.y * g.y); o.y = pack2(v.z * g.z, v.w * g.w);
      *(uint2*)(p.xg + (size_t)row * D + (lane + 64 * i) * 4) = o;
    }
    ss = wave_sum(ss);
    if (lane == 0) p.sumsq[row] = ss;
  }
  for (size_t i = gt; i < (size_t)3 * MT; i += ntd) p.sumsq[MT + i] = 0.f;
  for (size_t i = gt; i < (size_t)2056 * 8; i += ntd) {
    const int pi = (int)(i >> 3), fi = (int)(i & 7);
    const int pos = pi < 2048 ? pi : 8192 + (pi - 2048);
    float inv;
    switch (fi) { case 0: inv = 1.0f; break; case 1: inv = 0.1939227432012558f; break; case 2: inv = 0.03760603070259094f; break;
      case 3: inv = 0.007292664609849453f; break; case 4: inv = 0.0014142135623842478f; break; case 5: inv = 0.00027424818836152554f; break;
      case 6: inv = 5.318296098266728e-05f; break; default: inv = 1.0313386155758053e-05f; break; }
    const float ang = (float)pos * inv;
    p.rope[pi * 16 + fi] = cosf(ang);
    p.rope[pi * 16 + 8 + fi] = sinf(ang);
  }
  {
    const size_t n4[3] = {(size_t)2 * 32 * 128 * 64, (size_t)2 * 32 * 512 * 64, (size_t)2 * 32 * 2048 * 64};
    const size_t oo[3] = {O_KV128S, O_KV512S, O_KV2048S};
#pragma unroll
    for (int g = 0; g < 3; ++g) {
      const int W = 128 << (2 * g);
      const float4* src = (const float4*)p.kv_in[g];
      float4* dst = (float4*)(p.out + oo[g]);
      const size_t per = (size_t)W * 64, lim = (size_t)(W - 8) * 64;
      for (size_t i = gt; i < n4[g]; i += ntd) {
        if ((i % per) < lim) dst[i] = src[i + 512];
      }
    }
  }
  constexpr int TL = 640 + 192 + 1024 + 1024 + 4;
  for (int t = blockIdx.x; t < 2 * TL; t += gridDim.x) {
    const int l = t / TL; int r = t % TL;
    const float* src; u16* dst; int K, N;
    if (r < 640) { src = p.w_in + (size_t)l * D * IC; dst = p.wt_in + (size_t)l * IC * D; K = D; N = IC; }
    else if (r < 832) { r -= 640; src = p.w_out + (size_t)l * MC * D; dst = p.wt_out + (size_t)l * D * MC; K = MC; N = D; }
    else if (r < 1856) { r -= 832; src = p.w_up + (size_t)l * D * FF; dst = p.wt_up + (size_t)l * FF * D; K = D; N = FF; }
    else if (r < 2880) { r -= 1856; src = p.w_down + (size_t)l * FF * D; dst = p.wt_down + (size_t)l * D * FF; K = FF; N = D; }
    else { r -= 2880; src = p.pool_w + (size_t)(l * 4 + r) * 4096; dst = p.pwT + (size_t)(l * 4 + r) * 4096; K = 64; N = 64; r = 0; }
    const int ntn = N / 64;
    tr_tile(src, dst, K, N, (r / ntn) * 64, (r % ntn) * 64, tid);
  }
}

#define MFMA32(a, b, c) __builtin_amdgcn_mfma_f32_32x32x16_bf16((a), (b), (c), 0, 0, 0)

__device__ __forceinline__ void load_qk(const u16* __restrict__ rowp, const float* __restrict__ ropep, const float* __restrict__ gain,
                                        const float scale, bf16x8 out[4], const int h) {
  float f[4][8];
  float ss = 0.f;
#pragma unroll
  for (int s = 0; s < 4; ++s) {
    const bf16x8 raw = *(const bf16x8*)(rowp + 16 * s + 8 * h);
#pragma unroll
    for (int j = 0; j < 8; ++j) { f[s][j] = bfs2f(raw[j]); ss += f[s][j] * f[s][j]; }
  }
  ss += __shfl_xor(ss, 32);
  const float inv = rsqrtf(ss * (1.0f / 64.0f) + EPS);
#pragma unroll
  for (int s = 0; s < 4; ++s) {
    const float4 g0 = *(const float4*)(gain + 16 * s + 8 * h), g1 = *(const float4*)(gain + 16 * s + 8 * h + 4);
    f[s][0] *= inv * g0.x; f[s][1] *= inv * g0.y; f[s][2] *= inv * g0.z; f[s][3] *= inv * g0.w;
    f[s][4] *= inv * g1.x; f[s][5] *= inv * g1.y; f[s][6] *= inv * g1.z; f[s][7] *= inv * g1.w;
  }
  {
    const float4 c0 = *(const float4*)(ropep), c1 = *(const float4*)(ropep + 4), s0 = *(const float4*)(ropep + 8), s1 = *(const float4*)(ropep + 12);
    const float cs[8] = {c0.x, c0.y, c0.z, c0.w, c1.x, c1.y, c1.z, c1.w};
    const float sn[8] = {s0.x, s0.y, s0.z, s0.w, s1.x, s1.y, s1.z, s1.w};
#pragma unroll
    for (int j = 0; j < 8; ++j) {
      const float other = __shfl_xor(f[0][j], 32);
      f[0][j] = (h == 0) ? (f[0][j] * cs[j] - other * sn[j]) : (f[0][j] * cs[j] + other * sn[j]);
    }
  }
#pragma unroll
  for (int s = 0; s < 4; ++s)
#pragma unroll
    for (int j = 0; j < 8; ++j) out[s][j] = (short)f2bf(f[s][j] * scale);
}

__device__ __forceinline__ void attn_prompt_task(const Params& p, const int layer, const int task, const int lane) {
  const int c = task & 63; int tmp = task >> 6; const int g = tmp % 3; tmp /= 3; const int hslot = tmp & 1; const int b = tmp >> 1;
  const int dl = 1 << (2 * g);
  const int tpc = 64 >> (2 * g);
  const int r = c / tpc, tile = c % tpc;
  const int m0 = tile * 32;
  const int head = 2 * g + hslot;
  const u16* projb = p.proj + (size_t)b * 2048 * IC;
  const int qi = lane & 31, h = lane >> 5;
  bf16x8 qf[4];
  { const int tq = (m0 + qi) * dl + r;
    load_qk(projb + (size_t)tq * IC + C_Q + head * 64, p.rope + tq * 16, p.q_norm_g + layer * 64, 0.125f, qf, h); }
  const int kt_lo = max(0, 4 - tile);
  f32x16 sacc[5];
#pragma unroll
  for (int kt = 0; kt < 5; ++kt) {
#pragma unroll
    for (int i = 0; i < 16; ++i) sacc[kt][i] = 0.f;
    if (kt >= kt_lo) {
      const int mk = m0 - 128 + 32 * kt + qi;
      const int tk = mk * dl + r;
      bf16x8 kf[4];
      load_qk(projb + (size_t)tk * IC + C_K + head * 64, p.rope + tk * 16, p.k_norm_g + layer * 64, 1.0f, kf, h);
#pragma unroll
      for (int s = 0; s < 4; ++s) sacc[kt] = MFMA32(kf[s], qf[s], sacc[kt]);
    }
  }
  float mx = -1e30f;
#pragma unroll
  for (int kt = 0; kt < 5; ++kt)
#pragma unroll
    for (int rr = 0; rr < 16; ++rr) {
      const int keyrow = (rr & 3) + 8 * (rr >> 2) + 4 * h;
      const int dist = 128 - 32 * kt + qi - keyrow;
      const bool valid = (kt >= kt_lo) && dist >= 0 && dist <= 128;
      const float s = valid ? sacc[kt][rr] : -1e30f;
      sacc[kt][rr] = s;
      mx = fmaxf(mx, s);
    }
  mx = fmaxf(mx, __shfl_xor(mx, 32));
  float sum = 0.f;
#pragma unroll
  for (int kt = 0; kt < 5; ++kt)
#pragma unroll
    for (int rr = 0; rr < 16; ++rr) {
      const float s = sacc[kt][rr];
      const float e = (s > -1e29f) ? __expf(s - mx) : 0.f;
      sacc[kt][rr] = e;
      sum += e;
    }
  sum += __shfl_xor(sum, 32);
  f32x16 oacc[2];
#pragma unroll
  for (int i = 0; i < 16; ++i) { oacc[0][i] = 0.f; oacc[1][i] = 0.f; }
#pragma unroll
  for (int kt = 0; kt < 5; ++kt) {
    if (kt >= kt_lo) {
#pragma unroll
      for (int s2 = 0; s2 < 2; ++s2) {
        bf16x8 pf;
#pragma unroll
        for (int j = 0; j < 8; ++j) pf[j] = (short)f2bf(sacc[kt][8 * s2 + j]);
        bf16x8 v0, v1;
#pragma unroll
        for (int j = 0; j < 8; ++j) {
          const int kr = 16 * s2 + 8 * (j >> 2) + 4 * h + (j & 3);
          const int tk = (m0 - 128 + 32 * kt + kr) * dl + r;
          const u16* vp = projb + (size_t)tk * IC + C_V + head * 64 + qi;
          v0[j] = (short)vp[0]; v1[j] = (short)vp[32];
        }
        oacc[0] = MFMA32(v0, pf, oacc[0]);
        oacc[1] = MFMA32(v1, pf, oacc[1]);
      }
    }
  }
  const float isum = 1.0f / sum;
  const int tq = (m0 + qi) * dl + r;
  const size_t rowq = (size_t)b * 2048 + tq;
  float* op = p.opart + ((size_t)g * MT + rowq) * 128 + hslot * 64;
#pragma unroll
  for (int db = 0; db < 2; ++db)
#pragma unroll
    for (int i4 = 0; i4 < 4; ++i4) {
      float4 o; o.x = oacc[db][4 * i4] * isum; o.y = oacc[db][4 * i4 + 1] * isum; o.z = oacc[db][4 * i4 + 2] * isum; o.w = oacc[db][4 * i4 + 3] * isum;
      *(float4*)(op + db * 32 + 8 * i4 + 4 * h) = o;
    }
  if (h == 0) p.lse[((size_t)g * MT + rowq) * 2 + hslot] = mx + __logf(sum);
}

__device__ __forceinline__ void kv_row_task(const Params& p, const int l, const int row, const int lane) {
  const int hl = lane < 48 ? lane : 47;
  const int head = hl >> 3, c8 = hl & 7;
  int b, t, ridx;
  const bool prompt = row < NP;
  if (prompt) { b = row >> 11; t = row & 2047; ridx = t; } else { b = (row - NP) >> 3; t = (row - NP) & 7; ridx = 2048 + t; }
  const u16* pr = p.proj + (size_t)row * IC;
  const bf16x8 kr = *(const bf16x8*)(pr + C_K + hl * 8);
  const bf16x8 vr = *(const bf16x8*)(pr + C_V + hl * 8);
  float f[8]; float ss = 0.f;
#pragma unroll
  for (int j = 0; j < 8; ++j) { f[j] = bfs2f(kr[j]); ss += f[j] * f[j]; }
  ss += __shfl_xor(ss, 1); ss += __shfl_xor(ss, 2); ss += __shfl_xor(ss, 4);
  const float inv = rsqrtf(ss * (1.0f / 64.0f) + EPS);
  const float* gk = p.k_norm_g + l * 64 + c8 * 8;
#pragma unroll
  for (int j = 0; j < 8; ++j) f[j] *= inv * gk[j];
  const float* rp = p.rope + ridx * 16;
#pragma unroll
  for (int j = 0; j < 8; ++j) {
    const float other = __shfl_xor(f[j], 1);
    const float cs = rp[j], sn = rp[8 + j];
    if (c8 == 0) f[j] = f[j] * cs - other * sn;
    else if (c8 == 1) f[j] = f[j] * cs + other * sn;
  }
  const int g = head >> 1, hh = head & 1;
  const int W = 128 << (2 * g);
  float* dst = nullptr;
  if (prompt) {
    const int r = t - (2048 - W);
    const size_t base = (g == 0) ? O_KV128P : (g == 1) ? O_KV512P : O_KV2048P;
    if (r >= 0) dst = p.out + base + ((size_t)(l * 8 + b) * W + r) * 256 + hh * 64 + c8 * 8;
  } else {
    const int r = W - 8 + t;
    const size_t base = (g == 0) ? O_KV128S : (g == 1) ? O_KV512S : O_KV2048S;
    dst = p.out + base + ((size_t)(l * 32 + b) * W + r) * 256 + hh * 64 + c8 * 8;
  }
  if (dst && lane < 48) {
    *(float4*)(dst) = make_float4(f[0], f[1], f[2], f[3]);
    *(float4*)(dst + 4) = make_float4(f[4], f[5], f[6], f[7]);
    *(float4*)(dst + 128) = make_float4(bfs2f(vr[0]), bfs2f(vr[1]), bfs2f(vr[2]), bfs2f(vr[3]));
    *(float4*)(dst + 132) = make_float4(bfs2f(vr[4]), bfs2f(vr[5]), bfs2f(vr[6]), bfs2f(vr[7]));
  }
}

__device__ void phaseA(const Params& p, const int l, const int wave_s) {
  const int tid = opaque_tid(wave_s);
  const int lane = tid & 63, wid = tid >> 6;
  const int gw = blockIdx.x * 8 + wid, nw = gridDim.x * 8;
  for (int task = gw; task < 3072; task += nw) attn_prompt_task(p, l, task, lane);
  for (int row = nw - 1 - gw; row < MT; row += nw) kv_row_task(p, l, row, lane);
}

__device__ __forceinline__ void pool_task(const Params& p, const int l, const int task, const int lane) {
  const int tile = task >> 2, grp = task & 3;
  const int qi = lane & 31, h = lane >> 5;
  const int row = tile * 32 + qi;
  const int w = 2 << grp;
  const bool prompt = row < NP;
  int n, t; float cnt;
  if (prompt) { n = row >> 11; t = row & 2047; cnt = (float)min(t + 1, w); } else { n = (row - NP) >> 3; t = (row - NP) & 7; cnt = (float)w; }
  const float icnt = 1.0f / cnt;
  f32x16 acc[2];
#pragma unroll
  for (int i = 0; i < 16; ++i) { acc[0][i] = 0.f; acc[1][i] = 0.f; }
  const u16* pw = p.pwT + (size_t)(l * 4 + grp) * 4096;
#pragma unroll
  for (int s = 0; s < 4; ++s) {
    const int c0 = grp * 64 + 16 * s + 8 * h;
    float sum[8], own[8];
#pragma unroll
    for (int j = 0; j < 8; ++j) { sum[j] = 0.f; own[j] = 0.f; }
    for (int i = 0; i < w; ++i) {
      const int tt = t - i;
      float v[8];
      if (tt >= 0) {
        const bf16x8 raw = *(const bf16x8*)(p.proj + (size_t)(row - i) * IC + C_U + c0);
#pragma unroll
        for (int j = 0; j < 8; ++j) v[j] = bfs2f(raw[j]);
      } else if (!prompt) {
        const float* sp = p.state_pool + ((size_t)(l * 32 + n) * 15 + 15 + tt) * 256 + c0;
        const float4 a = *(const float4*)sp, bb = *(const float4*)(sp + 4);
        v[0] = a.x; v[1] = a.y; v[2] = a.z; v[3] = a.w; v[4] = bb.x; v[5] = bb.y; v[6] = bb.z; v[7] = bb.w;
      } else {
#pragma unroll
        for (int j = 0; j < 8; ++j) v[j] = 0.f;
      }
#pragma unroll
      for (int j = 0; j < 8; ++j) sum[j] += v[j];
      if (i == 0) {
#pragma unroll
        for (int j = 0; j < 8; ++j) own[j] = v[j];
      }
    }
    bf16x8 df;
#pragma unroll
    for (int j = 0; j < 8; ++j) df[j] = (short)f2bf(sum[j] * icnt - own[j]);
    const bf16x8 a0 = *(const bf16x8*)(pw + (size_t)qi * 64 + 16 * s + 8 * h);
    const bf16x8 a1 = *(const bf16x8*)(pw + (size_t)(qi + 32) * 64 + 16 * s + 8 * h);
    acc[0] = MFMA32(a0, df, acc[0]);
    acc[1] = MFMA32(a1, df, acc[1]);
  }
  const float* ps = p.pool_scale + l * 256 + grp * 64;
  u16* mp = p.mixed + (size_t)row * MC + grp * 64;
#pragma unroll
  for (int db = 0; db < 2; ++db)
#pragma unroll
    for (int i4 = 0; i4 < 4; ++i4) {
      const int dd0 = db * 32 + 8 * i4 + 4 * h;
      const float4 sc = *(const float4*)(ps + dd0);
      uint2 o; o.x = pack2(acc[db][4 * i4] * sc.x, acc[db][4 * i4 + 1] * sc.y); o.y = pack2(acc[db][4 * i4 + 2] * sc.z, acc[db][4 * i4 + 3] * sc.w);
      *(uint2*)(mp + dd0) = o;
    }
}

__device__ __forceinline__ void sample_attn_task(const Params& p, const int l, const int id, const int lane) {
  const int n = id >> 4, t = (id >> 1) & 7, hslot = id & 1;
  const int row = NP + n * 8 + t;
  float og[3], lg[3];
#pragma unroll
  for (int g = 0; g < 3; ++g) {
    const int head = 2 * g + hslot;
    const int W = 128 << (2 * g), dl = 1 << (2 * g);
    float qv = bf2f(p.proj[(size_t)row * IC + C_Q + head * 64 + lane]);
    const float ss = wave_sum(qv * qv);
    qv = qv * rsqrtf(ss * (1.0f / 64.0f) + EPS) * p.q_norm_g[l * 64 + lane];
    {
      const float other = __shfl_xor(qv, 8);
      if (lane < 16) {
        const int i = lane & 7;
        const float cs = p.rope[(2048 + t) * 16 + i], sn = p.rope[(2048 + t) * 16 + 8 + i];
        qv = (lane < 8) ? (qv * cs - other * sn) : (qv * cs + other * sn);
      }
    }
    qv *= 0.125f;
    const size_t oo = (g == 0) ? O_KV128S : (g == 1) ? O_KV512S : O_KV2048S;
    const float* cache = p.kv_in[g] + (size_t)(l * 32 + n) * W * 256 + hslot * 64;
    const float* outkv = p.out + oo + (size_t)(l * 32 + n) * W * 256 + hslot * 64;
    const int idx_a = W + t - dl * lane, idx_b = W + t - dl * (lane + 64), idx_c = t;
    const float* ka = (idx_a < W) ? cache + (size_t)idx_a * 256 : outkv + (size_t)(idx_a - 8) * 256;
    const float* kb = cache + (size_t)idx_b * 256;
    const float* kc = cache + (size_t)idx_c * 256;
    float sa = 0.f, sb = 0.f, sc = 0.f;
#pragma unroll
    for (int d4 = 0; d4 < 16; ++d4) {
      const float4 xa = *(const float4*)(ka + d4 * 4), xb = *(const float4*)(kb + d4 * 4), xc = *(const float4*)(kc + d4 * 4);
      const float q0 = __int_as_float(__builtin_amdgcn_readlane(__float_as_int(qv), d4 * 4 + 0));
      const float q1 = __int_as_float(__builtin_amdgcn_readlane(__float_as_int(qv), d4 * 4 + 1));
      const float q2 = __int_as_float(__builtin_amdgcn_readlane(__float_as_int(qv), d4 * 4 + 2));
      const float q3 = __int_as_float(__builtin_amdgcn_readlane(__float_as_int(qv), d4 * 4 + 3));
      sa += q0 * xa.x + q1 * xa.y + q2 * xa.z + q3 * xa.w;
      sb += q0 * xb.x + q1 * xb.y + q2 * xb.z + q3 * xb.w;
      sc += q0 * xc.x + q1 * xc.y + q2 * xc.z + q3 * xc.w;
    }
    float mx = wave_max(fmaxf(sa, sb)); mx = fmaxf(mx, sc);
    const float pa = __expf(sa - mx), pb = __expf(sb - mx), pc = __expf(sc - mx);
    const float sum = wave_sum(pa + pb) + pc;
    float o = 0.f;
    for (int j = 0; j < 64; ++j) {
      const float pj = __shfl(pa, j);
      const int idx = W + t - dl * j;
      const float* vp = (idx < W) ? cache + (size_t)idx * 256 : outkv + (size_t)(idx - 8) * 256;
      o += pj * vp[128 + lane];
    }
    for (int j = 0; j < 64; ++j) {
      const float pj = __shfl(pb, j);
      const int idx = W + t - dl * (j + 64);
      o += pj * cache[(size_t)idx * 256 + 128 + lane];
    }
    o += pc * cache[(size_t)idx_c * 256 + 128 + lane];
    og[g] = o / sum;
    lg[g] = mx + __logf(sum);
  }
  const float m = fmaxf(lg[0], fmaxf(lg[1], lg[2]));
  const float w0 = __expf(lg[0] - m), w1 = __expf(lg[1] - m), w2 = __expf(lg[2] - m);
  const float y = (w0 * og[0] + w1 * og[1] + w2 * og[2]) / (w0 + w1 + w2);
  p.mixed[(size_t)row * MC + 256 + hslot * 64 + lane] = f2bf(y);
}

__device__ void phaseB(const Params& p, const int l, const int wave_s) {
  const int tid = opaque_tid(wave_s), lane = tid & 63, wid = tid >> 6;
  const int gw = blockIdx.x * 8 + wid, nw = gridDim.x * 8;
  const size_t gt = (size_t)blockIdx.x * 512 + tid, ntd = (size_t)gridDim.x * 512;
  for (int task = gw; task < 520 * 4; task += nw) pool_task(p, l, task, lane);
  for (int id = nw - 1 - gw; id < 512; id += nw) sample_attn_task(p, l, id, lane);
  for (size_t idx = gt; idx < (size_t)MT * 48; idx += ntd) {
    const int row = (int)(idx / 48), ch = (int)(idx % 48) * 8;
    const bool prompt = row < NP;
    int n, t;
    if (prompt) { n = row >> 11; t = row & 2047; } else { n = (row - NP) >> 3; t = (row - NP) & 7; }
    float z[3][8];
#pragma unroll
    for (int i = 0; i < 3; ++i) {
      const int tt = t - 2 + i;
      if (tt >= 0) {
        const u16* pr = p.proj + (size_t)(row - 2 + i) * IC;
        const bf16x8 gc = *(const bf16x8*)(pr + C_GC + ch), gh = *(const bf16x8*)(pr + C_GH + ch);
#pragma unroll
        for (int j = 0; j < 8; ++j) z[i][j] = bfs2f(gc[j]) * bfs2f(gh[j]);
      } else if (!prompt) {
        const float* sp = p.state_conv + ((size_t)(l * 32 + n) * 2 + 2 + tt) * 384 + ch;
        const float4 a = *(const float4*)sp, bb = *(const float4*)(sp + 4);
        z[i][0] = a.x; z[i][1] = a.y; z[i][2] = a.z; z[i][3] = a.w; z[i][4] = bb.x; z[i][5] = bb.y; z[i][6] = bb.z; z[i][7] = bb.w;
      } else {
#pragma unroll
        for (int j = 0; j < 8; ++j) z[i][j] = 0.f;
      }
    }
    const bf16x8 gb = *(const bf16x8*)(p.proj + (size_t)row * IC + C_GB + ch);
    const float* cw = p.conv_w + (size_t)l * 3 * 384 + ch;
    float y[8];
#pragma unroll
    for (int j = 0; j < 8; ++j) y[j] = bfs2f(gb[j]) * (cw[j] * z[0][j] + cw[384 + j] * z[1][j] + cw[768 + j] * z[2][j]);
    uint4 o; o.x = pack2(y[0], y[1]); o.y = pack2(y[2], y[3]); o.z = pack2(y[4], y[5]); o.w = pack2(y[6], y[7]);
    *(uint4*)(p.mixed + (size_t)row * MC + 384 + ch) = o;
    float* so = nullptr;
    if (prompt) { if (t >= 2046) so = p.out + O_CONVP + ((size_t)(l * 8 + n) * 2 + (t - 2046)) * 384 + ch; }
    else { if (t >= 6) so = p.out + O_CONVS + ((size_t)(l * 32 + n) * 2 + (t - 6)) * 384 + ch; }
    if (so) { *(float4*)so = make_float4(z[2][0], z[2][1], z[2][2], z[2][3]); *(float4*)(so + 4) = make_float4(z[2][4], z[2][5], z[2][6], z[2][7]); }
  }
  for (size_t idx = gt; idx < (size_t)NP * 16; idx += ntd) {
    const int row = (int)(idx >> 4), chunk = (int)(idx & 15);
    const int hslot = chunk >> 3, d0 = (chunk & 7) * 8;
    float lg[3];
#pragma unroll
    for (int g = 0; g < 3; ++g) lg[g] = p.lse[((size_t)g * MT + row) * 2 + hslot];
    const float m = fmaxf(lg[0], fmaxf(lg[1], lg[2]));
    float wg[3]; wg[0] = __expf(lg[0] - m); wg[1] = __expf(lg[1] - m); wg[2] = __expf(lg[2] - m);
    const float iw = 1.0f / (wg[0] + wg[1] + wg[2]);
    float y[8];
#pragma unroll
    for (int j = 0; j < 8; ++j) y[j] = 0.f;
#pragma unroll
    for (int g = 0; g < 3; ++g) {
      const float* op = p.opart + ((size_t)g * MT + row) * 128 + hslot * 64 + d0;
      const float4 a = *(const float4*)op, bb = *(const float4*)(op + 4);
      const float ww = wg[g] * iw;
      y[0] += ww * a.x; y[1] += ww * a.y; y[2] += ww * a.z; y[3] += ww * a.w; y[4] += ww * bb.x; y[5] += ww * bb.y; y[6] += ww * bb.z; y[7] += ww * bb.w;
    }
    uint4 o; o.x = pack2(y[0], y[1]); o.y = pack2(y[2], y[3]); o.z = pack2(y[4], y[5]); o.w = pack2(y[6], y[7]);
    *(uint4*)(p.mixed + (size_t)row * MC + 256 + hslot * 64 + d0) = o;
  }
  for (size_t idx = gt; idx < (size_t)8 * 15 * 256; idx += ntd) {
    const int c = (int)(idx & 255); const int bi = (int)(idx >> 8); const int i = bi % 15, b = bi / 15;
    p.out[O_POOLP + (size_t)l * 8 * 15 * 256 + idx] = bf2f(p.proj[((size_t)b * 2048 + 2033 + i) * IC + C_U + c]);
  }
  for (size_t idx = gt; idx < (size_t)32 * 15 * 256; idx += ntd) {
    const int c = (int)(idx & 255); const int bi = (int)(idx >> 8); const int i = bi % 15, n = bi / 15;
    float v;
    if (i < 7) v = p.state_pool[((size_t)(l * 32 + n) * 15 + 8 + i) * 256 + c];
    else v = bf2f(p.proj[((size_t)NP + n * 8 + (i - 7)) * IC + C_U + c]);
    p.out[O_POOLS + (size_t)l * 32 * 15 * 256 + idx] = v;
  }
}

typedef const __attribute__((address_space(4))) Params* CP;
#if defined(__HIP_DEVICE_COMPILE__)
#define LOAD_PARAMS() CP pp_ = (CP)__builtin_amdgcn_kernarg_segment_ptr(); asm volatile("" : "+s"(pp_)); const Params p = *pp_
#else
#define LOAD_PARAMS() const Params& p = p_unused
#endif
__global__ void __launch_bounds__(512, 2) mega(const Params p_unused, const int ph_lo, const int ph_hi) {
  const int wave_s = __builtin_amdgcn_readfirstlane((int)(threadIdx.x >> 6));
  if (ph_hi - ph_lo > 1) cg::this_grid().sync();
  int ph = 0;
#define IN_PH() (ph_lo <= ph && ph < ph_hi)
#define SEAM() do { if (ph_lo <= ph && ph + 1 < ph_hi) { LOAD_PARAMS(); grid_bar(p.bar, (unsigned)(ph - ph_lo + 1) * gridDim.x, wave_s); } ++ph; } while (0)
  if (IN_PH()) { LOAD_PARAMS(); phase0(p, wave_s); }
  SEAM();
#pragma unroll 1
  for (int l = 0; l < 2; ++l) {
    if (IN_PH()) {
      LOAD_PARAMS();
      GemmEpi e{}; e.sumsq_in = p.sumsq + (size_t)(2 * l) * MT; e.out_bf = p.proj; e.ldo = IC;
      gemm_phase<1>(p.xg, p.wt_in + (size_t)l * IC * D, MT, IC, D, e, wave_s);
    }
    SEAM();
    if (IN_PH()) { LOAD_PARAMS(); phaseA(p, l, wave_s); }
    SEAM();
    if (IN_PH()) { LOAD_PARAMS(); phaseB(p, l, wave_s); }
    SEAM();
    if (IN_PH()) {
      LOAD_PARAMS();
      GemmEpi e{};
      if (l == 0) { e.resid_p = p.x_prompt; e.resid_s = p.x_sample; } else { e.resid_p = p.xb; e.resid_s = p.xb + (size_t)NP * D; }
      e.out_p = p.xa; e.out_s = p.xa + (size_t)NP * D;
      e.out_xg = p.xg; e.gnext = p.norm2_g + l * D; e.sumsq_out = p.sumsq + (size_t)(2 * l + 1) * MT;
      gemm_phase<2>(p.mixed, p.wt_out + (size_t)l * D * MC, MT, D, MC, e, wave_s);
    }
    SEAM();
    if (IN_PH()) {
      LOAD_PARAMS();
      GemmEpi e{}; e.sumsq_in = p.sumsq + (size_t)(2 * l + 1) * MT; e.out_bf = p.hf; e.ldo = FF;
      gemm_phase<3>(p.xg, p.wt_up + (size_t)l * FF * D, MT, FF, D, e, wave_s);
    }
    SEAM();
    if (IN_PH()) {
      LOAD_PARAMS();
      GemmEpi e{};
      e.resid_p = p.xa; e.resid_s = p.xa + (size_t)NP * D;
      if (l == 0) { e.out_p = p.xb; e.out_s = p.xb + (size_t)NP * D; e.out_xg = p.xg; e.gnext = p.norm1_g + D; e.sumsq_out = p.sumsq + (size_t)2 * MT; }
      else { e.out_p = p.out + O_YP; e.out_s = p.out + O_YS; e.out_xg = nullptr; e.gnext = nullptr; e.sumsq_out = nullptr; }
      gemm_phase<2>(p.hf, p.wt_down + (size_t)l * D * FF, MT, D, FF, e, wave_s);
    }
    SEAM();
  }
}

extern "C" void kernel_launch(void* const* d_in, const int* in_sizes, int n_in, void* d_out, int out_size, void* d_ws, size_t ws_size, hipStream_t stream) {
  static int grid_blocks = 0;
  if (!grid_blocks) {
    int dev = 0, cus = 0, per_cu = 0;
    hipGetDevice(&dev);
    hipDeviceGetAttribute(&cus, hipDeviceAttributeMultiprocessorCount, dev);
    hipFuncSetAttribute((const void*)mega, hipFuncAttributeMaxDynamicSharedMemorySize, GEMM_LDS);
    hipOccupancyMaxActiveBlocksPerMultiprocessor(&per_cu, (const void*)mega, 512, GEMM_LDS);
    if (per_cu < 1) { fprintf(stderr, "occupancy query returned %d\n", per_cu); per_cu = 1; }
    grid_blocks = cus * 1;
  }
  Params p{};
  p.x_prompt = (const float*)d_in[0]; p.x_sample = (const float*)d_in[1]; p.state_pool = (const float*)d_in[2]; p.state_conv = (const float*)d_in[3];
  p.kv_in[0] = (const float*)d_in[4]; p.kv_in[1] = (const float*)d_in[5]; p.kv_in[2] = (const float*)d_in[6];
  p.norm1_g = (const float*)d_in[7]; p.w_in = (const float*)d_in[8]; p.q_norm_g = (const float*)d_in[9]; p.k_norm_g = (const float*)d_in[10];
  p.pool_w = (const float*)d_in[11]; p.pool_scale = (const float*)d_in[12]; p.conv_w = (const float*)d_in[13]; p.w_out = (const float*)d_in[14];
  p.norm2_g = (const float*)d_in[15]; p.w_up = (const float*)d_in[16]; p.w_down = (const float*)d_in[17];
  p.out = (float*)d_out;
  unsigned char* w = (unsigned char*)d_ws; size_t off = 0;
  auto carve = [&](size_t bytes) { unsigned char* r = w + off; off += (bytes + 255) & ~(size_t)255; return r; };
  p.bar = (unsigned*)carve(256);
  p.wt_in = (u16*)carve((size_t)2 * IC * D * 2);
  p.wt_out = (u16*)carve((size_t)2 * D * MC * 2);
  p.wt_up = (u16*)carve((size_t)2 * FF * D * 2);
  p.wt_down = (u16*)carve((size_t)2 * D * FF * 2);
  p.pwT = (u16*)carve((size_t)2 * 4 * 4096 * 2);
  p.xg = (u16*)carve((size_t)MT * D * 2);
  p.mixed = (u16*)carve((size_t)MT * MC * 2);
  p.xa = (float*)carve((size_t)MT * D * 4);
  p.xb = (float*)carve((size_t)MT * D * 4);
  p.sumsq = (float*)carve((size_t)4 * MT * 4);
  p.lse = (float*)carve((size_t)3 * MT * 2 * 4);
  p.rope = (float*)carve((size_t)2056 * 16 * 4);
  p.hf = (u16*)carve((size_t)MT * FF * 2);
  p.proj = p.hf;
  p.opart = (float*)((unsigned char*)p.hf + (((size_t)MT * IC * 2 + 255) & ~(size_t)255));
  if (off > ws_size) { fprintf(stderr, "workspace too small: need %zu have %zu\n", off, ws_size); return; }
  (void)hipMemsetAsync(p.bar, 0, 256, stream);
  int lo = 0, hi = 13;
  void* args[] = {(void*)&p, (void*)&lo, (void*)&hi};
  hipError_t e = hipLaunchCooperativeKernel((const void*)mega, dim3(grid_blocks), dim3(512), args, GEMM_LDS, stream);
  if (e != hipSuccess) fprintf(stderr, "cooperative launch failed: %s (grid %d)\n", hipGetErrorString(e), grid_blocks);
}
```

```cpp
#include <hip/hip_runtime.h>
#include <hip/hip_cooperative_groups.h>
#include <cstdio>
namespace cg = cooperative_groups;

typedef unsigned short u16;
using bf16x8 = __attribute__((ext_vector_type(8))) short;
using f32x4 = __attribute__((ext_vector_type(4))) float;
using f32x16 = __attribute__((ext_vector_type(16))) float;

constexpr int NP = 16384, NS = 256, MT = NP + NS;
constexpr int D = 1024, IC = 2560, MC = 768, FF = 4096;
constexpr float EPS = 1e-6f;
constexpr int C_U = 0, C_Q = 256, C_K = 640, C_V = 1024, C_GB = 1408, C_GC = 1792, C_GH = 2176;
constexpr size_t O_YP = 0;
constexpr size_t O_YS = O_YP + (size_t)NP * D;
constexpr size_t O_POOLP = O_YS + (size_t)NS * D;
constexpr size_t O_CONVP = O_POOLP + 2 * 8 * 15 * 256;
constexpr size_t O_KV128P = O_CONVP + 2 * 8 * 2 * 384;
constexpr size_t O_KV512P = O_KV128P + (size_t)2 * 8 * 128 * 256;
constexpr size_t O_KV2048P = O_KV512P + (size_t)2 * 8 * 512 * 256;
constexpr size_t O_POOLS = O_KV2048P + (size_t)2 * 8 * 2048 * 256;
constexpr size_t O_CONVS = O_POOLS + 2 * 32 * 15 * 256;
constexpr size_t O_KV128S = O_CONVS + 2 * 32 * 2 * 384;
constexpr size_t O_KV512S = O_KV128S + (size_t)2 * 32 * 128 * 256;
constexpr size_t O_KV2048S = O_KV512S + (size_t)2 * 32 * 512 * 256;

struct Params {
  const float *x_prompt, *x_sample, *state_pool, *state_conv, *kv_in[3];
  const float *norm1_g, *w_in, *q_norm_g, *k_norm_g, *pool_w, *pool_scale, *conv_w, *w_out, *norm2_g, *w_up, *w_down;
  float* out;
  u16 *wt_in, *wt_out, *wt_up, *wt_down, *pwT;
  u16 *xg, *proj, *mixed, *hf;
  float *xa, *xb, *sumsq, *opart, *lse, *rope;
  unsigned* bar;
};

extern __shared__ __attribute__((aligned(16))) unsigned char smem[];
typedef __attribute__((address_space(3))) void* LDSP;

__device__ __forceinline__ u16 f2bf(float f) { unsigned u = __float_as_uint(f); u += 0x7fffu + ((u >> 16) & 1u); return (u16)(u >> 16); }
__device__ __forceinline__ float bf2f(u16 h) { return __uint_as_float(((unsigned)h) << 16); }
__device__ __forceinline__ float bfs2f(short h) { return __uint_as_float(((unsigned)(u16)h) << 16); }
__device__ __forceinline__ unsigned pack2(float a, float b) { return (unsigned)f2bf(a) | ((unsigned)f2bf(b) << 16); }
__device__ __forceinline__ int opaque_tid(const int wave_s) {
  int l; asm volatile("v_mbcnt_lo_u32_b32 %0, -1, 0\n\tv_mbcnt_hi_u32_b32 %0, -1, %0" : "=v"(l));
  return wave_s * 64 + l;
}
__device__ __forceinline__ int opaque_lane() {
  int l; asm volatile("v_mbcnt_lo_u32_b32 %0, -1, 0\n\tv_mbcnt_hi_u32_b32 %0, -1, %0" : "=v"(l));
  return l;
}
__device__ __forceinline__ void grid_bar(unsigned* cnt, const unsigned target, const int wave_s) {
  __builtin_amdgcn_fence(__ATOMIC_RELEASE, "agent");
  __syncthreads();
  if (opaque_tid(wave_s) == 0) {
    __hip_atomic_fetch_add(cnt, 1u, __ATOMIC_RELEASE, __HIP_MEMORY_SCOPE_AGENT);
    while (__hip_atomic_load(cnt, __ATOMIC_ACQUIRE, __HIP_MEMORY_SCOPE_AGENT) < target) __builtin_amdgcn_s_sleep(2);
  }
  __syncthreads();
  __builtin_amdgcn_fence(__ATOMIC_ACQUIRE, "agent");
}
__device__ __forceinline__ float wave_sum(float v) { for (int o = 32; o; o >>= 1) v += __shfl_xor(v, o); return v; }
__device__ __forceinline__ float wave_max(float v) { for (int o = 32; o; o >>= 1) v = fmaxf(v, __shfl_xor(v, o)); return v; }

constexpr int BM = 256, BK = 64, HALF = 128, NXCD = 8, WGM = 8, HT = HALF * BK;
constexpr int GEMM_LDS = 8 * HT * 2;

__device__ __forceinline__ int lds_byte(int r, int c) {
  int st = (r >> 4) * 2 + (c >> 5), rr = r & 15, cc = c & 31, ob = rr * 64 + cc * 2;
  return st * 1024 + (ob ^ (((ob >> 9) & 1) << 5));
}
__device__ __forceinline__ void stage_rc(int b, int& R, int& C) {
  int st = b / 1024, sb = b % 1024, swz = sb ^ (((sb >> 9) & 1) << 5);
  R = (st >> 1) * 16 + swz / 64; C = (st & 1) * 32 + (swz % 64) / 2;
}

struct GemmEpi {
  const float* sumsq_in;
  u16* out_bf; int ldo;
  const float *resid_p, *resid_s;
  float *out_p, *out_s;
  u16* out_xg; const float* gnext; float* sumsq_out;
};

template <int MODE>
__device__ __forceinline__ void epi4(const GemmEpi& e, const f32x4 a, const float rs, const float* __restrict__ rp, float* __restrict__ outp,
                                     const size_t grow, const size_t lro, const int col0, const float4 gn, float& ssq) {
  if (MODE == 1 || MODE == 3) {
    float v0 = a[0] * rs, v1 = a[1] * rs, v2 = a[2] * rs, v3 = a[3] * rs;
    if (MODE == 3) { v0 = fmaxf(v0, 0.f); v1 = fmaxf(v1, 0.f); v2 = fmaxf(v2, 0.f); v3 = fmaxf(v3, 0.f); v0 *= v0; v1 *= v1; v2 *= v2; v3 *= v3; }
    uint2 o; o.x = pack2(v0, v1); o.y = pack2(v2, v3);
    *(uint2*)(e.out_bf + grow * e.ldo + col0) = o;
  } else {
    const size_t o = lro + col0;
    const float4 x0 = *(const float4*)(rp + o);
    float4 x; x.x = x0.x + a[0]; x.y = x0.y + a[1]; x.z = x0.z + a[2]; x.w = x0.w + a[3];
    *(float4*)(outp + o) = x;
    if (e.out_xg) {
      uint2 ob; ob.x = pack2(x.x * gn.x, x.y * gn.y); ob.y = pack2(x.z * gn.z, x.w * gn.w);
      *(uint2*)(e.out_xg + grow * D + col0) = ob;
    }
    ssq += x.x * x.x + x.y * x.y + x.z * x.z + x.w * x.w;
  }
}

template <int MODE>
__device__ __forceinline__ void gemm_phase(const u16* __restrict__ A, const u16* __restrict__ Bt, const int M, const int N, const int K, const GemmEpi e, const int wave_s) {
  u16* shm = (u16*)smem;
#define SA(b, h) (shm + ((b) * 2 + (h)) * HT)
#define SB(b, h) (shm + (4 + (b) * 2 + (h)) * HT)
#define STAGE(P, RS, br, kt) do { const unsigned _so = (unsigned)(((br) * K + (kt) * BK) * 2); \
    __builtin_amdgcn_raw_ptr_buffer_load_lds(RS, (LDSP)((char*)(P) + tid0 * 16), 16, toff0, _so, 0, 0); \
    __builtin_amdgcn_raw_ptr_buffer_load_lds(RS, (LDSP)((char*)(P) + tid0 * 16 + 8192), 16, toff1, _so, 0, 0); } while (0)
#define LDA(dst, b, h) for (int m = 0; m < 4; ++m) for (int k = 0; k < 2; ++k) \
    dst[m][k] = *reinterpret_cast<const bf16x8*>((char*)SA(b, h) + lds_byte(wr * 64 + m * 16 + fr, k * 32 + fq * 8))
#define LDB(dst, b, h) for (int n = 0; n < 2; ++n) for (int k = 0; k < 2; ++k) \
    dst[n][k] = *reinterpret_cast<const bf16x8*>((char*)SB(b, h) + lds_byte(wc * 32 + n * 16 + fr, k * 32 + fq * 8))
#define MMA(ai, bj, At, Bt_) do { __builtin_amdgcn_s_setprio(1); \
    for (int m = 0; m < 4; ++m) for (int n = 0; n < 2; ++n) for (int k = 0; k < 2; ++k) \
      acc[ai][bj][m][n] = __builtin_amdgcn_mfma_f32_16x16x32_bf16(Bt_[n][k], At[m][k], acc[ai][bj][m][n], 0, 0, 0); \
    __builtin_amdgcn_s_setprio(0); } while (0)
#define WAIT_V(n) asm volatile("s_waitcnt vmcnt(" #n ")" ::: "memory")
#define WAIT_L(n) asm volatile("s_waitcnt lgkmcnt(" #n ")" ::: "memory")
#define BAR __builtin_amdgcn_s_barrier()
#define SCHED __builtin_amdgcn_sched_barrier(0)
#define DECODE(tt_, brow_, bcol_) do { int wgid = (tt_); \
    { int q = nwg / NXCD, r = nwg % NXCD, xcd = wgid % NXCD, off = wgid / NXCD; \
      wgid = (xcd < r ? xcd * (q + 1) : r * (q + 1) + (xcd - r) * q) + off; } \
    int nig = WGM * nN, gid = wgid / nig, fm = gid * WGM, gsz = min(nM - fm, WGM); \
    brow_ = (fm + ((wgid % nig) % gsz)) * BM; bcol_ = ((wgid % nig) / gsz) * BM; } while (0)
#define STAGE7(brow_, bcol_) do { \
    STAGE(SB(0, 0), rsB, bcol_, 0); STAGE(SA(0, 0), rsA, brow_, 0); \
    STAGE(SB(0, 1), rsB, bcol_ + HALF, 0); STAGE(SA(0, 1), rsA, brow_ + HALF, 0); \
    STAGE(SB(1, 0), rsB, bcol_, 1); STAGE(SA(1, 0), rsA, brow_, 1); STAGE(SB(1, 1), rsB, bcol_ + HALF, 1); } while (0)

  const int nM = M / BM, nN = N / BM, nwg = nM * nN;
  const int nt = K / BK;
  unsigned toff0, toff1;
  const int tid0 = opaque_tid(wave_s);
  const int wr = (tid0 >> 6) >> 2, wc = (tid0 >> 6) & 3, fr = tid0 & 15, fq = (tid0 & 63) >> 4;
  { int r_, c_; stage_rc(tid0 * 16, r_, c_); toff0 = (unsigned)(r_ * K + c_) * 2u; stage_rc(tid0 * 16 + 8192, r_, c_); toff1 = (unsigned)(r_ * K + c_) * 2u; }
  const __amdgpu_buffer_rsrc_t rsA = __builtin_amdgcn_make_buffer_rsrc((void*)A, 0, -1, 0x00020000);
  const __amdgpu_buffer_rsrc_t rsB = __builtin_amdgcn_make_buffer_rsrc((void*)Bt, 0, -1, 0x00020000);
  int tt = blockIdx.x;
  int brow = 0, bcol = 0;
  if (tt < nwg) { DECODE(tt, brow, bcol); STAGE7(brow, bcol); WAIT_V(0); }
  while (tt < nwg) {
    f32x4 acc[2][2][4][2] = {};
    bf16x8 At[4][2], B0[2][2], B1[2][2];
    if (wr == 1) BAR;
    BAR;
    for (int t = 0; t < nt - 2; t += 2) {
      LDB(B0, 0, 0); SCHED; LDA(At, 0, 0); STAGE(SA(1, 1), rsA, brow + HALF, t + 1);
      WAIT_L(8); BAR; WAIT_L(0); MMA(0, 0, At, B0); BAR; SCHED;
      LDB(B1, 0, 1); STAGE(SB(0, 0), rsB, bcol, t + 2);
      BAR; WAIT_L(0); MMA(0, 1, At, B1); BAR;
      LDA(At, 0, 1); STAGE(SA(0, 0), rsA, brow, t + 2);
      BAR; WAIT_L(0); MMA(1, 0, At, B0); BAR; SCHED;
      STAGE(SB(0, 1), rsB, bcol + HALF, t + 2);
      WAIT_V(6); BAR; MMA(1, 1, At, B1); BAR;
      LDB(B0, 1, 0); SCHED; LDA(At, 1, 0); STAGE(SA(0, 1), rsA, brow + HALF, t + 2);
      WAIT_L(8); BAR; WAIT_L(0); MMA(0, 0, At, B0); BAR; SCHED;
      LDB(B1, 1, 1); STAGE(SB(1, 0), rsB, bcol, t + 3);
      BAR; WAIT_L(0); MMA(0, 1, At, B1); BAR;
      LDA(At, 1, 1); STAGE(SA(1, 0), rsA, brow, t + 3);
      BAR; WAIT_L(0); MMA(1, 0, At, B0); BAR; SCHED;
      STAGE(SB(1, 1), rsB, bcol + HALF, t + 3);
      WAIT_V(6); BAR; MMA(1, 1, At, B1); BAR;
    }
    { LDB(B0, 0, 0); LDA(At, 0, 0); STAGE(SA(1, 1), rsA, brow + HALF, nt - 1);
      BAR; WAIT_L(0); MMA(0, 0, At, B0); BAR;
      LDB(B1, 0, 1); BAR; WAIT_L(0); MMA(0, 1, At, B1); BAR;
      LDA(At, 0, 1); WAIT_V(4); BAR; WAIT_L(0); MMA(1, 0, At, B0); MMA(1, 1, At, B1); BAR; }
    { LDB(B0, 1, 0); LDA(At, 1, 0); WAIT_V(2); BAR; WAIT_L(0); MMA(0, 0, At, B0); BAR;
      LDB(B1, 1, 1); WAIT_V(0); BAR; WAIT_L(0); MMA(0, 1, At, B1); BAR;
      LDA(At, 1, 1); BAR; WAIT_L(0); MMA(1, 0, At, B0); MMA(1, 1, At, B1); BAR; }
    if (wr == 0) BAR;
    const int erow = brow, ecol = bcol;
    tt += gridDim.x;
    if (tt < nwg) { DECODE(tt, brow, bcol); STAGE7(brow, bcol); }
    SCHED;
    {
      const int tid1 = opaque_tid(wave_s);
      const int wr = (tid1 >> 6) >> 2, wc = (tid1 >> 6) & 3, fr = tid1 & 15, fq = (tid1 & 63) >> 4;
      const float* rp = (MODE == 2) ? e.resid_p + (size_t)erow * D : nullptr;
      float* outp = (MODE == 2) ? e.out_p + (size_t)erow * D : nullptr;
      float4 gn[2][2];
#pragma unroll
      for (int bj = 0; bj < 2; ++bj)
#pragma unroll
        for (int n = 0; n < 2; ++n) {
          gn[bj][n] = make_float4(0.f, 0.f, 0.f, 0.f);
          if (MODE == 2 && e.out_xg) gn[bj][n] = *(const float4*)(e.gnext + ecol + bj * HALF + wc * 32 + n * 16 + fq * 4);
        }
#pragma unroll
      for (int ai = 0; ai < 2; ++ai)
#pragma unroll
        for (int m = 0; m < 4; ++m) {
          const int lrow = ai * HALF + wr * 64 + m * 16 + fr;
          const size_t grow = (size_t)erow + lrow;
          float rs = 0.f, ssq = 0.f;
          if (MODE == 1 || MODE == 3) rs = rsqrtf(e.sumsq_in[grow] * (1.0f / 1024.0f) + EPS);
#pragma unroll
          for (int bj = 0; bj < 2; ++bj)
#pragma unroll
            for (int n = 0; n < 2; ++n)
              epi4<MODE>(e, acc[ai][bj][m][n], rs, rp, outp, grow, (size_t)lrow * D, ecol + bj * HALF + wc * 32 + n * 16 + fq * 4, gn[bj][n], ssq);
          if (MODE == 2 && e.sumsq_out) {
            ssq += __shfl_xor(ssq, 16); ssq += __shfl_xor(ssq, 32);
            if (fq == 0) atomicAdd(e.sumsq_out + grow, ssq);
          }
          SCHED;
        }
    }
    WAIT_V(16);
  }
  WAIT_V(0);
#undef SA
#undef SB
#undef STAGE
#undef LDA
#undef LDB
#undef MMA
}

#define MFMA32(a, b, c) __builtin_amdgcn_mfma_f32_32x32x16_bf16((a), (b), (c), 0, 0, 0)

template <int MODE>
__device__ __forceinline__ void sample_gemm(const u16* __restrict__ A, const u16* __restrict__ Bt, const int N, const int K, const GemmEpi e, const int wave_s) {
  const int tid = opaque_tid(wave_s);
  const int lane = tid & 63, wid = tid >> 6;
  const int i = lane & 31, h = lane >> 5;
  const int ntask = 8 * (N / 32);
  for (int id = wid * gridDim.x + blockIdx.x; id < ntask; id += 8 * gridDim.x) {
    const int r0 = (id & 7) * 32, c0 = (id >> 3) * 32;
    const u16* ap = A + (size_t)(NP + r0 + i) * K + 8 * h;
    const u16* bp = Bt + (size_t)(c0 + i) * K + 8 * h;
    f32x16 acc;
#pragma unroll
    for (int q = 0; q < 16; ++q) acc[q] = 0.f;
#pragma unroll 8
    for (int k = 0; k < K; k += 16) {
      const bf16x8 a = *(const bf16x8*)(ap + k);
      const bf16x8 b = *(const bf16x8*)(bp + k);
      acc = MFMA32(b, a, acc);
    }
    const int srow = r0 + i;
    const size_t grow = (size_t)NP + srow;
    float rs = 0.f, ssq = 0.f;
    if (MODE == 1 || MODE == 3) rs = rsqrtf(e.sumsq_in[grow] * (1.0f / 1024.0f) + EPS);
#pragma unroll
    for (int q = 0; q < 4; ++q) {
      const int col0 = c0 + 8 * q + 4 * h;
      f32x4 a4; a4[0] = acc[4 * q]; a4[1] = acc[4 * q + 1]; a4[2] = acc[4 * q + 2]; a4[3] = acc[4 * q + 3];
      float4 gn = make_float4(0.f, 0.f, 0.f, 0.f);
      if (MODE == 2 && e.out_xg) gn = *(const float4*)(e.gnext + col0);
      epi4<MODE>(e, a4, rs, e.resid_s, e.out_s, grow, (size_t)srow * D, col0, gn, ssq);
    }
    if (MODE == 2 && e.sumsq_out) {
      ssq += __shfl_xor(ssq, 32);
      if (h == 0) atomicAdd(e.sumsq_out + grow, ssq);
    }
  }
}

__device__ __forceinline__ void tr_tile(const float* __restrict__ src, u16* __restrict__ dst, int K, int N, int k0, int n0, const int tid) {
  float* lt = (float*)smem;
  { const int kk = tid >> 4, n4 = tid & 15;
#pragma unroll
    for (int i = 0; i < 2; ++i) {
      const int k = kk + i * 32;
      const float4 v = *(const float4*)(src + (size_t)(k0 + k) * N + n0 + n4 * 4);
      float* d = lt + k * 65 + n4 * 4;
      d[0] = v.x; d[1] = v.y; d[2] = v.z; d[3] = v.w;
    } }
  __syncthreads();
  { const int n = tid >> 3, k8 = tid & 7;
    float f[8];
#pragma unroll
    for (int i = 0; i < 8; ++i) f[i] = lt[(k8 * 8 + i) * 65 + n];
    uint4 o; o.x = pack2(f[0], f[1]); o.y = pack2(f[2], f[3]); o.z = pack2(f[4], f[5]); o.w = pack2(f[6], f[7]);
    *(uint4*)(dst + (size_t)(n0 + n) * K + k0 + k8 * 8) = o; }
  __syncthreads();
}

__device__ void phase0(const Params& p, const int wave_s) {
  const int tid = opaque_tid(wave_s), lane = tid & 63, wid = tid >> 6;
  const int gw = blockIdx.x * 8 + wid, nw = gridDim.x * 8;
  const size_t gt = (size_t)blockIdx.x * 512 + tid, ntd = (size_t)gridDim.x * 512;
  for (int row = gw; row < MT; row += nw) {
    const float4* xr = (const float4*)(row < NP ? p.x_prompt + (size_t)row * D : p.x_sample + (size_t)(row - NP) * D);
    const float4* g4 = (const float4*)p.norm1_g;
    float ss = 0.f;
#pragma unroll
    for (int i = 0; i < 4; ++i) {
      const float4 v = xr[lane + 64 * i], g = g4[lane + 64 * i];
      ss += v.x * v.x + v.y * v.y + v.z * v.z + v.w * v.w;
      uint2 o; o.x = pack2(v.x * g.x, v.y * g.y); o.y = pack2(v.z * g.z, v.w * g.w);
      *(uint2*)(p.xg + (size_t)row * D + (lane + 64 * i) * 4) = o;
    }
    ss = wave_sum(ss);
    if (lane == 0) p.sumsq[row] = ss;
  }
  for (size_t i = gt; i < (size_t)3 * MT; i += ntd) p.sumsq[MT + i] = 0.f;
  for (size_t i = gt; i < (size_t)2056 * 8; i += ntd) {
    const int pi = (int)(i >> 3), fi = (int)(i & 7);
    const int pos = pi < 2048 ? pi : 8192 + (pi - 2048);
    float inv;
    switch (fi) { case 0: inv = 1.0f; break; case 1: inv = 0.1939227432012558f; break; case 2: inv = 0.03760603070259094f; break;
      case 3: inv = 0.007292664609849453f; break; case 4: inv = 0.0014142135623842478f; break; case 5: inv = 0.00027424818836152554f; break;
      case 6: inv = 5.318296098266728e-05f; break; default: inv = 1.0313386155758053e-05f; break; }
    const float ang = (float)pos * inv;
    p.rope[pi * 16 + fi] = cosf(ang);
    p.rope[pi * 16 + 8 + fi] = sinf(ang);
  }
  {
    const size_t n4[3] = {(size_t)2 * 32 * 128 * 64, (size_t)2 * 32 * 512 * 64, (size_t)2 * 32 * 2048 * 64};
    const size_t oo[3] = {O_KV128S, O_KV512S, O_KV2048S};
#pragma unroll
    for (int g = 0; g < 3; ++g) {
      const int W = 128 << (2 * g);
      const float4* src = (const float4*)p.kv_in[g];
      float4* dst = (float4*)(p.out + oo[g]);
      const size_t per = (size_t)W * 64, lim = (size_t)(W - 8) * 64;
      for (size_t i = gt; i < n4[g]; i += ntd) {
        if ((i % per) < lim) dst[i] = src[i + 512];
      }
    }
  }
  constexpr int TL = 640 + 192 + 1024 + 1024 + 4;
  for (int t = blockIdx.x; t < 2 * TL; t += gridDim.x) {
    const int l = t / TL; int r = t % TL;
    const float* src; u16* dst; int K, N;
    if (r < 640) { src = p.w_in + (size_t)l * D * IC; dst = p.wt_in + (size_t)l * IC * D; K = D; N = IC; }
    else if (r < 832) { r -= 640; src = p.w_out + (size_t)l * MC * D; dst = p.wt_out + (size_t)l * D * MC; K = MC; N = D; }
    else if (r < 1856) { r -= 832; src = p.w_up + (size_t)l * D * FF; dst = p.wt_up + (size_t)l * FF * D; K = D; N = FF; }
    else if (r < 2880) { r -= 1856; src = p.w_down + (size_t)l * FF * D; dst = p.wt_down + (size_t)l * D * FF; K = FF; N = D; }
    else { r -= 2880; src = p.pool_w + (size_t)(l * 4 + r) * 4096; dst = p.pwT + (size_t)(l * 4 + r) * 4096; K = 64; N = 64; r = 0; }
    const int ntn = N / 64;
    tr_tile(src, dst, K, N, (r / ntn) * 64, (r % ntn) * 64, tid);
  }
}


__device__ __forceinline__ void load_qk(const u16* __restrict__ rowp, const float* __restrict__ ropep, const float* __restrict__ gain,
                                        const float scale, bf16x8 out[4], const int h) {
  float f[4][8];
  float ss = 0.f;
#pragma unroll
  for (int s = 0; s < 4; ++s) {
    const bf16x8 raw = *(const bf16x8*)(rowp + 16 * s + 8 * h);
#pragma unroll
    for (int j = 0; j < 8; ++j) { f[s][j] = bfs2f(raw[j]); ss += f[s][j] * f[s][j]; }
  }
  ss += __shfl_xor(ss, 32);
  const float inv = rsqrtf(ss * (1.0f / 64.0f) + EPS);
#pragma unroll
  for (int s = 0; s < 4; ++s) {
    const float4 g0 = *(const float4*)(gain + 16 * s + 8 * h), g1 = *(const float4*)(gain + 16 * s + 8 * h + 4);
    f[s][0] *= inv * g0.x; f[s][1] *= inv * g0.y; f[s][2] *= inv * g0.z; f[s][3] *= inv * g0.w;
    f[s][4] *= inv * g1.x; f[s][5] *= inv * g1.y; f[s][6] *= inv * g1.z; f[s][7] *= inv * g1.w;
  }
  {
    const float4 c0 = *(const float4*)(ropep), c1 = *(const float4*)(ropep + 4), s0 = *(const float4*)(ropep + 8), s1 = *(const float4*)(ropep + 12);
    const float cs[8] = {c0.x, c0.y, c0.z, c0.w, c1.x, c1.y, c1.z, c1.w};
    const float sn[8] = {s0.x, s0.y, s0.z, s0.w, s1.x, s1.y, s1.z, s1.w};
#pragma unroll
    for (int j = 0; j < 8; ++j) {
      const float other = __shfl_xor(f[0][j], 32);
      f[0][j] = (h == 0) ? (f[0][j] * cs[j] - other * sn[j]) : (f[0][j] * cs[j] + other * sn[j]);
    }
  }
#pragma unroll
  for (int s = 0; s < 4; ++s)
#pragma unroll
    for (int j = 0; j < 8; ++j) out[s][j] = (short)f2bf(f[s][j] * scale);
}

template <bool SAMPLE>
__device__ __forceinline__ void attn_task(const Params& p, const int layer, const int task, const int lane_unused) {
  const int lane = opaque_lane();
  int g, hslot, b, r, tile, nq;
  if (!SAMPLE) {
    const int c = task & 63; int tmp = task >> 6; g = tmp % 3; tmp /= 3; hslot = tmp & 1; b = tmp >> 1;
    const int tpc = 64 >> (2 * g);
    r = c / tpc; tile = c % tpc; nq = 32;
  } else {
    b = task / 26; const int rem = task % 26; hslot = rem / 13; const int c = rem % 13;
    if (c == 0) { g = 0; r = 0; nq = 8; } else if (c < 5) { g = 1; r = c - 1; nq = 2; } else { g = 2; r = c - 5; nq = 1; }
    tile = 4;
  }
  const int dl = 1 << (2 * g);
  const int W = 128 << (2 * g);
  const int m0 = tile * 32;
  const int head = 2 * g + hslot;
  const u16* projb = SAMPLE ? p.proj + (size_t)(NP + b * 8) * IC : p.proj + (size_t)b * 2048 * IC;
  const int ropeb = SAMPLE ? 2048 : 0;
  const float* cache = SAMPLE ? ((g == 0) ? p.kv_in[0] : (g == 1) ? p.kv_in[1] : p.kv_in[2]) + (size_t)(layer * 32 + b) * W * 256 + hslot * 64 : nullptr;
  const int qi = lane & 31, h = lane >> 5;
  int tq;
  if (SAMPLE) tq = r + dl * (qi < nq ? qi : 0); else tq = (m0 + qi) * dl + r;
  bf16x8 qf[4];
  load_qk(projb + (size_t)tq * IC + C_Q + head * 64, p.rope + (ropeb + tq) * 16, p.q_norm_g + layer * 64, 0.125f, qf, h);
  const int kt_lo = SAMPLE ? 0 : max(0, 4 - tile);
  f32x16 sacc[5];
#pragma unroll
  for (int kt = 0; kt < 5; ++kt) {
#pragma unroll
    for (int i = 0; i < 16; ++i) sacc[kt][i] = 0.f;
    if (kt >= kt_lo) {
      bf16x8 kf[4];
      if (SAMPLE && kt < 4) {
        const float* kp = cache + (size_t)(r + dl * (32 * kt + qi)) * 256 + 8 * h;
#pragma unroll
        for (int s = 0; s < 4; ++s) {
          const float4 x0 = *(const float4*)(kp + 16 * s), x1 = *(const float4*)(kp + 16 * s + 4);
          kf[s][0] = (short)f2bf(x0.x); kf[s][1] = (short)f2bf(x0.y); kf[s][2] = (short)f2bf(x0.z); kf[s][3] = (short)f2bf(x0.w);
          kf[s][4] = (short)f2bf(x1.x); kf[s][5] = (short)f2bf(x1.y); kf[s][6] = (short)f2bf(x1.z); kf[s][7] = (short)f2bf(x1.w);
        }
      } else {
        int tk;
        if (SAMPLE) tk = r + dl * (qi < nq ? qi : 0); else tk = (m0 - 128 + 32 * kt + qi) * dl + r;
        load_qk(projb + (size_t)tk * IC + C_K + head * 64, p.rope + (ropeb + tk) * 16, p.k_norm_g + layer * 64, 1.0f, kf, h);
      }
#pragma unroll
      for (int s = 0; s < 4; ++s) sacc[kt] = MFMA32(kf[s], qf[s], sacc[kt]);
    }
  }
  float mx = -1e30f;
#pragma unroll
  for (int kt = 0; kt < 5; ++kt)
#pragma unroll
    for (int rr = 0; rr < 16; ++rr) {
      const int keyrow = (rr & 3) + 8 * (rr >> 2) + 4 * h;
      const int dist = 128 - 32 * kt + qi - keyrow;
      const bool valid = (kt >= kt_lo) && dist >= 0 && dist <= 128;
      const float s = valid ? sacc[kt][rr] : -1e30f;
      sacc[kt][rr] = s;
      mx = fmaxf(mx, s);
    }
  mx = fmaxf(mx, __shfl_xor(mx, 32));
  float sum = 0.f;
#pragma unroll
  for (int kt = 0; kt < 5; ++kt)
#pragma unroll
    for (int rr = 0; rr < 16; ++rr) {
      const float s = sacc[kt][rr];
      const float ex = (s > -1e29f) ? __expf(s - mx) : 0.f;
      sacc[kt][rr] = ex;
      sum += ex;
    }
  sum += __shfl_xor(sum, 32);
  f32x16 oacc[2];
#pragma unroll
  for (int i = 0; i < 16; ++i) { oacc[0][i] = 0.f; oacc[1][i] = 0.f; }
#pragma unroll
  for (int kt = 0; kt < 5; ++kt) {
    if (kt >= kt_lo) {
#pragma unroll
      for (int s2 = 0; s2 < 2; ++s2) {
        bf16x8 pf;
#pragma unroll
        for (int j = 0; j < 8; ++j) pf[j] = (short)f2bf(sacc[kt][8 * s2 + j]);
        bf16x8 v0, v1;
#pragma unroll
        for (int j = 0; j < 8; ++j) {
          const int kr = 16 * s2 + 8 * (j >> 2) + 4 * h + (j & 3);
          if (SAMPLE && kt < 4) {
            const float* vp = cache + (size_t)(r + dl * (32 * kt + kr)) * 256 + 128 + qi;
            v0[j] = (short)f2bf(vp[0]); v1[j] = (short)f2bf(vp[32]);
          } else {
            int tk;
            if (SAMPLE) tk = r + dl * (kr < nq ? kr : 0); else tk = (m0 - 128 + 32 * kt + kr) * dl + r;
            const u16* vp = projb + (size_t)tk * IC + C_V + head * 64 + qi;
            v0[j] = (short)vp[0]; v1[j] = (short)vp[32];
          }
        }
        oacc[0] = MFMA32(v0, pf, oacc[0]);
        oacc[1] = MFMA32(v1, pf, oacc[1]);
      }
    }
  }
  const float isum = 1.0f / sum;
  const size_t rowq = SAMPLE ? (size_t)NP + b * 8 + tq : (size_t)b * 2048 + tq;
  if (!SAMPLE || qi < nq) {
    float* op = p.opart + ((size_t)g * MT + rowq) * 128 + hslot * 64;
#pragma unroll
    for (int db = 0; db < 2; ++db)
#pragma unroll
      for (int i4 = 0; i4 < 4; ++i4) {
        float4 o; o.x = oacc[db][4 * i4] * isum; o.y = oacc[db][4 * i4 + 1] * isum; o.z = oacc[db][4 * i4 + 2] * isum; o.w = oacc[db][4 * i4 + 3] * isum;
        *(float4*)(op + db * 32 + 8 * i4 + 4 * h) = o;
      }
    if (h == 0) p.lse[((size_t)g * MT + rowq) * 2 + hslot] = mx + __logf(sum);
  }
}

__device__ __forceinline__ void kv_row_task(const Params& p, const int l, const int row, const int lane) {
  const int hl = lane < 48 ? lane : 47;
  const int head = hl >> 3, c8 = hl & 7;
  int b, t, ridx;
  const bool prompt = row < NP;
  if (prompt) { b = row >> 11; t = row & 2047; ridx = t; } else { b = (row - NP) >> 3; t = (row - NP) & 7; ridx = 2048 + t; }
  const u16* pr = p.proj + (size_t)row * IC;
  const bf16x8 kr = *(const bf16x8*)(pr + C_K + hl * 8);
  const bf16x8 vr = *(const bf16x8*)(pr + C_V + hl * 8);
  float f[8]; float ss = 0.f;
#pragma unroll
  for (int j = 0; j < 8; ++j) { f[j] = bfs2f(kr[j]); ss += f[j] * f[j]; }
  ss += __shfl_xor(ss, 1); ss += __shfl_xor(ss, 2); ss += __shfl_xor(ss, 4);
  const float inv = rsqrtf(ss * (1.0f / 64.0f) + EPS);
  const float* gk = p.k_norm_g + l * 64 + c8 * 8;
#pragma unroll
  for (int j = 0; j < 8; ++j) f[j] *= inv * gk[j];
  const float* rp = p.rope + ridx * 16;
#pragma unroll
  for (int j = 0; j < 8; ++j) {
    const float other = __shfl_xor(f[j], 1);
    const float cs = rp[j], sn = rp[8 + j];
    if (c8 == 0) f[j] = f[j] * cs - other * sn;
    else if (c8 == 1) f[j] = f[j] * cs + other * sn;
  }
  const int g = head >> 1, hh = head & 1;
  const int W = 128 << (2 * g);
  float* dst = nullptr;
  if (prompt) {
    const int r = t - (2048 - W);
    const size_t base = (g == 0) ? O_KV128P : (g == 1) ? O_KV512P : O_KV2048P;
    if (r >= 0) dst = p.out + base + ((size_t)(l * 8 + b) * W + r) * 256 + hh * 64 + c8 * 8;
  } else {
    const int r = W - 8 + t;
    const size_t base = (g == 0) ? O_KV128S : (g == 1) ? O_KV512S : O_KV2048S;
    dst = p.out + base + ((size_t)(l * 32 + b) * W + r) * 256 + hh * 64 + c8 * 8;
  }
  if (dst && lane < 48) {
    *(float4*)(dst) = make_float4(f[0], f[1], f[2], f[3]);
    *(float4*)(dst + 4) = make_float4(f[4], f[5], f[6], f[7]);
    *(float4*)(dst + 128) = make_float4(bfs2f(vr[0]), bfs2f(vr[1]), bfs2f(vr[2]), bfs2f(vr[3]));
    *(float4*)(dst + 132) = make_float4(bfs2f(vr[4]), bfs2f(vr[5]), bfs2f(vr[6]), bfs2f(vr[7]));
  }
}

__device__ void phaseA(const Params& p, const int l, const int wave_s) {
  const int tid = opaque_tid(wave_s);
  const int lane = tid & 63, wid = tid >> 6;
  const int gw = blockIdx.x * 8 + wid, nw = gridDim.x * 8;
  for (int task = gw; task < 832 + 3072; task += nw) { if (task < 832) attn_task<true>(p, l, task, lane); else attn_task<false>(p, l, task - 832, lane); }
  for (int row = nw - 1 - gw; row < MT; row += nw) kv_row_task(p, l, row, lane);
}

__device__ __forceinline__ void pool_task(const Params& p, const int l, const int task, const int lane) {
  const int tile = task >> 2, grp = task & 3;
  const int qi = lane & 31, h = lane >> 5;
  const int row = tile * 32 + qi;
  const int w = 2 << grp;
  const bool prompt = row < NP;
  int n, t; float cnt;
  if (prompt) { n = row >> 11; t = row & 2047; cnt = (float)min(t + 1, w); } else { n = (row - NP) >> 3; t = (row - NP) & 7; cnt = (float)w; }
  const float icnt = 1.0f / cnt;
  f32x16 acc[2];
#pragma unroll
  for (int i = 0; i < 16; ++i) { acc[0][i] = 0.f; acc[1][i] = 0.f; }
  const u16* pw = p.pwT + (size_t)(l * 4 + grp) * 4096;
#pragma unroll
  for (int s = 0; s < 4; ++s) {
    const int c0 = grp * 64 + 16 * s + 8 * h;
    float sum[8], own[8];
#pragma unroll
    for (int j = 0; j < 8; ++j) { sum[j] = 0.f; own[j] = 0.f; }
    for (int i = 0; i < w; ++i) {
      const int tt = t - i;
      float v[8];
      if (tt >= 0) {
        const bf16x8 raw = *(const bf16x8*)(p.proj + (size_t)(row - i) * IC + C_U + c0);
#pragma unroll
        for (int j = 0; j < 8; ++j) v[j] = bfs2f(raw[j]);
      } else if (!prompt) {
        const float* sp = p.state_pool + ((size_t)(l * 32 + n) * 15 + 15 + tt) * 256 + c0;
        const float4 a = *(const float4*)sp, bb = *(const float4*)(sp + 4);
        v[0] = a.x; v[1] = a.y; v[2] = a.z; v[3] = a.w; v[4] = bb.x; v[5] = bb.y; v[6] = bb.z; v[7] = bb.w;
      } else {
#pragma unroll
        for (int j = 0; j < 8; ++j) v[j] = 0.f;
      }
#pragma unroll
      for (int j = 0; j < 8; ++j) sum[j] += v[j];
      if (i == 0) {
#pragma unroll
        for (int j = 0; j < 8; ++j) own[j] = v[j];
      }
    }
    bf16x8 df;
#pragma unroll
    for (int j = 0; j < 8; ++j) df[j] = (short)f2bf(sum[j] * icnt - own[j]);
    const bf16x8 a0 = *(const bf16x8*)(pw + (size_t)qi * 64 + 16 * s + 8 * h);
    const bf16x8 a1 = *(const bf16x8*)(pw + (size_t)(qi + 32) * 64 + 16 * s + 8 * h);
    acc[0] = MFMA32(a0, df, acc[0]);
    acc[1] = MFMA32(a1, df, acc[1]);
  }
  const float* ps = p.pool_scale + l * 256 + grp * 64;
  u16* mp = p.mixed + (size_t)row * MC + grp * 64;
#pragma unroll
  for (int db = 0; db < 2; ++db)
#pragma unroll
    for (int i4 = 0; i4 < 4; ++i4) {
      const int dd0 = db * 32 + 8 * i4 + 4 * h;
      const float4 sc = *(const float4*)(ps + dd0);
      uint2 o; o.x = pack2(acc[db][4 * i4] * sc.x, acc[db][4 * i4 + 1] * sc.y); o.y = pack2(acc[db][4 * i4 + 2] * sc.z, acc[db][4 * i4 + 3] * sc.w);
      *(uint2*)(mp + dd0) = o;
    }
}

__device__ void phaseB(const Params& p, const int l, const int wave_s) {
  const int tid = opaque_tid(wave_s), lane = tid & 63, wid = tid >> 6;
  const int gw = blockIdx.x * 8 + wid, nw = gridDim.x * 8;
  const size_t gt = (size_t)blockIdx.x * 512 + tid, ntd = (size_t)gridDim.x * 512;
  for (int task = gw; task < 520 * 4; task += nw) pool_task(p, l, task, lane);
  for (size_t idx = gt; idx < (size_t)MT * 48; idx += ntd) {
    const int row = (int)(idx / 48), ch = (int)(idx % 48) * 8;
    const bool prompt = row < NP;
    int n, t;
    if (prompt) { n = row >> 11; t = row & 2047; } else { n = (row - NP) >> 3; t = (row - NP) & 7; }
    float z[3][8];
#pragma unroll
    for (int i = 0; i < 3; ++i) {
      const int tt = t - 2 + i;
      if (tt >= 0) {
        const u16* pr = p.proj + (size_t)(row - 2 + i) * IC;
        const bf16x8 gc = *(const bf16x8*)(pr + C_GC + ch), gh = *(const bf16x8*)(pr + C_GH + ch);
#pragma unroll
        for (int j = 0; j < 8; ++j) z[i][j] = bfs2f(gc[j]) * bfs2f(gh[j]);
      } else if (!prompt) {
        const float* sp = p.state_conv + ((size_t)(l * 32 + n) * 2 + 2 + tt) * 384 + ch;
        const float4 a = *(const float4*)sp, bb = *(const float4*)(sp + 4);
        z[i][0] = a.x; z[i][1] = a.y; z[i][2] = a.z; z[i][3] = a.w; z[i][4] = bb.x; z[i][5] = bb.y; z[i][6] = bb.z; z[i][7] = bb.w;
      } else {
#pragma unroll
        for (int j = 0; j < 8; ++j) z[i][j] = 0.f;
      }
    }
    const bf16x8 gb = *(const bf16x8*)(p.proj + (size_t)row * IC + C_GB + ch);
    const float* cw = p.conv_w + (size_t)l * 3 * 384 + ch;
    float y[8];
#pragma unroll
    for (int j = 0; j < 8; ++j) y[j] = bfs2f(gb[j]) * (cw[j] * z[0][j] + cw[384 + j] * z[1][j] + cw[768 + j] * z[2][j]);
    uint4 o; o.x = pack2(y[0], y[1]); o.y = pack2(y[2], y[3]); o.z = pack2(y[4], y[5]); o.w = pack2(y[6], y[7]);
    *(uint4*)(p.mixed + (size_t)row * MC + 384 + ch) = o;
    float* so = nullptr;
    if (prompt) { if (t >= 2046) so = p.out + O_CONVP + ((size_t)(l * 8 + n) * 2 + (t - 2046)) * 384 + ch; }
    else { if (t >= 6) so = p.out + O_CONVS + ((size_t)(l * 32 + n) * 2 + (t - 6)) * 384 + ch; }
    if (so) { *(float4*)so = make_float4(z[2][0], z[2][1], z[2][2], z[2][3]); *(float4*)(so + 4) = make_float4(z[2][4], z[2][5], z[2][6], z[2][7]); }
  }
  for (size_t idx = gt; idx < (size_t)MT * 16; idx += ntd) {
    const int row = (int)(idx >> 4), chunk = (int)(idx & 15);
    const int hslot = chunk >> 3, d0 = (chunk & 7) * 8;
    float lg[3];
#pragma unroll
    for (int g = 0; g < 3; ++g) lg[g] = p.lse[((size_t)g * MT + row) * 2 + hslot];
    const float m = fmaxf(lg[0], fmaxf(lg[1], lg[2]));
    float wg[3]; wg[0] = __expf(lg[0] - m); wg[1] = __expf(lg[1] - m); wg[2] = __expf(lg[2] - m);
    const float iw = 1.0f / (wg[0] + wg[1] + wg[2]);
    float y[8];
#pragma unroll
    for (int j = 0; j < 8; ++j) y[j] = 0.f;
#pragma unroll
    for (int g = 0; g < 3; ++g) {
      const float* op = p.opart + ((size_t)g * MT + row) * 128 + hslot * 64 + d0;
      const float4 a = *(const float4*)op, bb = *(const float4*)(op + 4);
      const float ww = wg[g] * iw;
      y[0] += ww * a.x; y[1] += ww * a.y; y[2] += ww * a.z; y[3] += ww * a.w; y[4] += ww * bb.x; y[5] += ww * bb.y; y[6] += ww * bb.z; y[7] += ww * bb.w;
    }
    uint4 o; o.x = pack2(y[0], y[1]); o.y = pack2(y[2], y[3]); o.z = pack2(y[4], y[5]); o.w = pack2(y[6], y[7]);
    *(uint4*)(p.mixed + (size_t)row * MC + 256 + hslot * 64 + d0) = o;
  }
  for (size_t idx = gt; idx < (size_t)8 * 15 * 256; idx += ntd) {
    const int c = (int)(idx & 255); const int bi = (int)(idx >> 8); const int i = bi % 15, b = bi / 15;
    p.out[O_POOLP + (size_t)l * 8 * 15 * 256 + idx] = bf2f(p.proj[((size_t)b * 2048 + 2033 + i) * IC + C_U + c]);
  }
  for (size_t idx = gt; idx < (size_t)32 * 15 * 256; idx += ntd) {
    const int c = (int)(idx & 255); const int bi = (int)(idx >> 8); const int i = bi % 15, n = bi / 15;
    float v;
    if (i < 7) v = p.state_pool[((size_t)(l * 32 + n) * 15 + 8 + i) * 256 + c];
    else v = bf2f(p.proj[((size_t)NP + n * 8 + (i - 7)) * IC + C_U + c]);
    p.out[O_POOLS + (size_t)l * 32 * 15 * 256 + idx] = v;
  }
}

#ifndef REPM
#define REPM 0
#endif
#define NREP(k) (1 + ((REPM >> (k)) & 1))
typedef const __attribute__((address_space(4))) Params* CP;
#if defined(__HIP_DEVICE_COMPILE__)
#define LOAD_PARAMS() CP pp_ = (CP)__builtin_amdgcn_kernarg_segment_ptr(); asm volatile("" : "+s"(pp_)); const Params p = *pp_
#else
#define LOAD_PARAMS() const Params& p = p_unused
#endif
__global__ void __launch_bounds__(512, 2) mega(const Params p_unused, const int ph_lo, const int ph_hi) {
  const int wave_s = __builtin_amdgcn_readfirstlane((int)(threadIdx.x >> 6));
  if (ph_hi - ph_lo > 1) cg::this_grid().sync();
  int ph = 0;
#define IN_PH() (ph_lo <= ph && ph < ph_hi)
#define SEAM() do { if (ph_lo <= ph && ph + 1 < ph_hi) { LOAD_PARAMS(); grid_bar(p.bar, (unsigned)(ph - ph_lo + 1) * gridDim.x, wave_s); } ++ph; } while (0)
  if (IN_PH()) for (int rep = 0; rep < NREP(0); ++rep) { LOAD_PARAMS(); phase0(p, wave_s); }
  SEAM();
#pragma unroll 1
  for (int l = 0; l < 2; ++l) {
    if (IN_PH()) for (int rep = 0; rep < NREP(1); ++rep) {
      LOAD_PARAMS();
      GemmEpi e{}; e.sumsq_in = p.sumsq + (size_t)(2 * l) * MT; e.out_bf = p.proj; e.ldo = IC;
      gemm_phase<1>(p.xg, p.wt_in + (size_t)l * IC * D, NP, IC, D, e, wave_s);
      sample_gemm<1>(p.xg, p.wt_in + (size_t)l * IC * D, IC, D, e, wave_s);
    }
    SEAM();
    if (IN_PH()) for (int rep = 0; rep < NREP(2); ++rep) { LOAD_PARAMS(); phaseA(p, l, wave_s); }
    SEAM();
    if (IN_PH()) for (int rep = 0; rep < NREP(3); ++rep) { LOAD_PARAMS(); phaseB(p, l, wave_s); }
    SEAM();
    if (IN_PH()) for (int rep = 0; rep < NREP(4); ++rep) {
      LOAD_PARAMS();
      GemmEpi e{};
      if (l == 0) { e.resid_p = p.x_prompt; e.resid_s = p.x_sample; } else { e.resid_p = p.xb; e.resid_s = p.xb + (size_t)NP * D; }
      e.out_p = p.xa; e.out_s = p.xa + (size_t)NP * D;
      e.out_xg = p.xg; e.gnext = p.norm2_g + l * D; e.sumsq_out = p.sumsq + (size_t)(2 * l + 1) * MT;
      if (rep) e.sumsq_out = nullptr;
      gemm_phase<2>(p.mixed, p.wt_out + (size_t)l * D * MC, NP, D, MC, e, wave_s);
      sample_gemm<2>(p.mixed, p.wt_out + (size_t)l * D * MC, D, MC, e, wave_s);
    }
    SEAM();
    if (IN_PH()) for (int rep = 0; rep < NREP(5); ++rep) {
      LOAD_PARAMS();
      GemmEpi e{}; e.sumsq_in = p.sumsq + (size_t)(2 * l + 1) * MT; e.out_bf = p.hf; e.ldo = FF;
      gemm_phase<3>(p.xg, p.wt_up + (size_t)l * FF * D, NP, FF, D, e, wave_s);
      sample_gemm<3>(p.xg, p.wt_up + (size_t)l * FF * D, FF, D, e, wave_s);
    }
    SEAM();
    if (IN_PH()) for (int rep = 0; rep < NREP(6); ++rep) {
      LOAD_PARAMS();
      GemmEpi e{};
      e.resid_p = p.xa; e.resid_s = p.xa + (size_t)NP * D;
      if (l == 0) { e.out_p = p.xb; e.out_s = p.xb + (size_t)NP * D; e.out_xg = p.xg; e.gnext = p.norm1_g + D; e.sumsq_out = p.sumsq + (size_t)2 * MT; }
      else { e.out_p = p.out + O_YP; e.out_s = p.out + O_YS; e.out_xg = nullptr; e.gnext = nullptr; e.sumsq_out = nullptr; }
      if (rep) e.sumsq_out = nullptr;
      gemm_phase<2>(p.hf, p.wt_down + (size_t)l * D * FF, NP, D, FF, e, wave_s);
      sample_gemm<2>(p.hf, p.wt_down + (size_t)l * D * FF, D, FF, e, wave_s);
    }
    SEAM();
  }
}

extern "C" void kernel_launch(void* const* d_in, const int* in_sizes, int n_in, void* d_out, int out_size, void* d_ws, size_t ws_size, hipStream_t stream) {
  static int grid_blocks = 0;
  if (!grid_blocks) {
    int dev = 0, cus = 0, per_cu = 0;
    hipGetDevice(&dev);
    hipDeviceGetAttribute(&cus, hipDeviceAttributeMultiprocessorCount, dev);
    hipFuncSetAttribute((const void*)mega, hipFuncAttributeMaxDynamicSharedMemorySize, GEMM_LDS);
    hipOccupancyMaxActiveBlocksPerMultiprocessor(&per_cu, (const void*)mega, 512, GEMM_LDS);
    if (per_cu < 1) { fprintf(stderr, "occupancy query returned %d\n", per_cu); per_cu = 1; }
    grid_blocks = cus * 1;
  }
  Params p{};
  p.x_prompt = (const float*)d_in[0]; p.x_sample = (const float*)d_in[1]; p.state_pool = (const float*)d_in[2]; p.state_conv = (const float*)d_in[3];
  p.kv_in[0] = (const float*)d_in[4]; p.kv_in[1] = (const float*)d_in[5]; p.kv_in[2] = (const float*)d_in[6];
  p.norm1_g = (const float*)d_in[7]; p.w_in = (const float*)d_in[8]; p.q_norm_g = (const float*)d_in[9]; p.k_norm_g = (const float*)d_in[10];
  p.pool_w = (const float*)d_in[11]; p.pool_scale = (const float*)d_in[12]; p.conv_w = (const float*)d_in[13]; p.w_out = (const float*)d_in[14];
  p.norm2_g = (const float*)d_in[15]; p.w_up = (const float*)d_in[16]; p.w_down = (const float*)d_in[17];
  p.out = (float*)d_out;
  unsigned char* w = (unsigned char*)d_ws; size_t off = 0;
  auto carve = [&](size_t bytes) { unsigned char* r = w + off; off += (bytes + 255) & ~(size_t)255; return r; };
  p.bar = (unsigned*)carve(256);
  p.wt_in = (u16*)carve((size_t)2 * IC * D * 2);
  p.wt_out = (u16*)carve((size_t)2 * D * MC * 2);
  p.wt_up = (u16*)carve((size_t)2 * FF * D * 2);
  p.wt_down = (u16*)carve((size_t)2 * D * FF * 2);
  p.pwT = (u16*)carve((size_t)2 * 4 * 4096 * 2);
  p.xg = (u16*)carve((size_t)MT * D * 2);
  p.mixed = (u16*)carve((size_t)MT * MC * 2);
  p.xa = (float*)carve((size_t)MT * D * 4);
  p.xb = (float*)carve((size_t)MT * D * 4);
  p.sumsq = (float*)carve((size_t)4 * MT * 4);
  p.lse = (float*)carve((size_t)3 * MT * 2 * 4);
  p.rope = (float*)carve((size_t)2056 * 16 * 4);
  p.hf = (u16*)carve((size_t)MT * FF * 2);
  p.proj = p.hf;
  p.opart = (float*)((unsigned char*)p.hf + (((size_t)MT * IC * 2 + 255) & ~(size_t)255));
  if (off > ws_size) { fprintf(stderr, "workspace too small: need %zu have %zu\n", off, ws_size); return; }
  (void)hipMemsetAsync(p.bar, 0, 256, stream);
  int lo = 0, hi = 13;
  void* args[] = {(void*)&p, (void*)&lo, (void*)&hi};
  hipError_t e = hipLaunchCooperativeKernel((const void*)mega, dim3(grid_blocks), dim3(512), args, GEMM_LDS, stream);
  if (e != hipSuccess) fprintf(stderr, "cooperative launch failed: %s (grid %d)\n", hipGetErrorString(e), grid_blocks);
}
```

```cpp
#include <hip/hip_runtime.h>
#include <hip/hip_cooperative_groups.h>
#include <cstdio>
namespace cg = cooperative_groups;

typedef unsigned short u16;
using bf16x8 = __attribute__((ext_vector_type(8))) short;
using f32x4 = __attribute__((ext_vector_type(4))) float;
using f32x16 = __attribute__((ext_vector_type(16))) float;

constexpr int NP = 16384, NS = 256, MT = NP + NS;
constexpr int D = 1024, IC = 2560, MC = 768, FF = 4096;
constexpr float EPS = 1e-6f;
constexpr int C_U = 0, C_Q = 256, C_K = 640, C_V = 1024, C_GB = 1408, C_GC = 1792, C_GH = 2176;
constexpr size_t O_YP = 0;
constexpr size_t O_YS = O_YP + (size_t)NP * D;
constexpr size_t O_POOLP = O_YS + (size_t)NS * D;
constexpr size_t O_CONVP = O_POOLP + 2 * 8 * 15 * 256;
constexpr size_t O_KV128P = O_CONVP + 2 * 8 * 2 * 384;
constexpr size_t O_KV512P = O_KV128P + (size_t)2 * 8 * 128 * 256;
constexpr size_t O_KV2048P = O_KV512P + (size_t)2 * 8 * 512 * 256;
constexpr size_t O_POOLS = O_KV2048P + (size_t)2 * 8 * 2048 * 256;
constexpr size_t O_CONVS = O_POOLS + 2 * 32 * 15 * 256;
constexpr size_t O_KV128S = O_CONVS + 2 * 32 * 2 * 384;
constexpr size_t O_KV512S = O_KV128S + (size_t)2 * 32 * 128 * 256;
constexpr size_t O_KV2048S = O_KV512S + (size_t)2 * 32 * 512 * 256;

struct Params {
  const float *x_prompt, *x_sample, *state_pool, *state_conv, *kv_in[3];
  const float *norm1_g, *w_in, *q_norm_g, *k_norm_g, *pool_w, *pool_scale, *conv_w, *w_out, *norm2_g, *w_up, *w_down;
  float* out;
  u16 *wt_in, *wt_out, *wt_up, *wt_down, *pwT;
  u16 *xg, *proj, *mixed, *hf;
  float *xa, *xb, *sumsq, *opart, *lse, *rope;
  unsigned* bar;
};

extern __shared__ __attribute__((aligned(16))) unsigned char smem[];
typedef __attribute__((address_space(3))) void* LDSP;

__device__ __forceinline__ u16 f2bf(float f) { unsigned u = __float_as_uint(f); u += 0x7fffu + ((u >> 16) & 1u); return (u16)(u >> 16); }
__device__ __forceinline__ float bf2f(u16 h) { return __uint_as_float(((unsigned)h) << 16); }
__device__ __forceinline__ float bfs2f(short h) { return __uint_as_float(((unsigned)(u16)h) << 16); }
__device__ __forceinline__ unsigned pack2(float a, float b) { return (unsigned)f2bf(a) | ((unsigned)f2bf(b) << 16); }
__device__ __forceinline__ int opaque_tid(const int wave_s) {
  int l; asm volatile("v_mbcnt_lo_u32_b32 %0, -1, 0\n\tv_mbcnt_hi_u32_b32 %0, -1, %0" : "=v"(l));
  return wave_s * 64 + l;
}
__device__ __forceinline__ int opaque_lane() {
  int l; asm volatile("v_mbcnt_lo_u32_b32 %0, -1, 0\n\tv_mbcnt_hi_u32_b32 %0, -1, %0" : "=v"(l));
  return l;
}
__device__ __forceinline__ void grid_bar(unsigned* cnt, const unsigned target, const int wave_s) {
  asm volatile("s_waitcnt vmcnt(0)" ::: "memory");
  __syncthreads();
  if (opaque_tid(wave_s) == 0) {
    __builtin_amdgcn_fence(__ATOMIC_RELEASE, "agent");
    asm volatile("s_waitcnt vmcnt(0)" ::: "memory");
    __hip_atomic_fetch_add(cnt, 1u, __ATOMIC_RELAXED, __HIP_MEMORY_SCOPE_AGENT);
    while (__hip_atomic_load(cnt, __ATOMIC_RELAXED, __HIP_MEMORY_SCOPE_AGENT) < target) __builtin_amdgcn_s_sleep(4);
    __builtin_amdgcn_fence(__ATOMIC_ACQUIRE, "agent");
    asm volatile("s_waitcnt vmcnt(0)" ::: "memory");
  }
  __syncthreads();
}
__device__ __forceinline__ float wave_sum(float v) { for (int o = 32; o; o >>= 1) v += __shfl_xor(v, o); return v; }
__device__ __forceinline__ float wave_max(float v) { for (int o = 32; o; o >>= 1) v = fmaxf(v, __shfl_xor(v, o)); return v; }

constexpr int BM = 256, BK = 64, HALF = 128, NXCD = 8, WGM = 8, HT = HALF * BK;
constexpr int GEMM_LDS = 8 * HT * 2;

__device__ __forceinline__ int lds_byte(int r, int c) {
  int st = (r >> 4) * 2 + (c >> 5), rr = r & 15, cc = c & 31, ob = rr * 64 + cc * 2;
  return st * 1024 + (ob ^ (((ob >> 9) & 1) << 5));
}
__device__ __forceinline__ void stage_rc(int b, int& R, int& C) {
  int st = b / 1024, sb = b % 1024, swz = sb ^ (((sb >> 9) & 1) << 5);
  R = (st >> 1) * 16 + swz / 64; C = (st & 1) * 32 + (swz % 64) / 2;
}

struct GemmEpi {
  const float* sumsq_in;
  u16* out_bf; int ldo;
  const float *resid_p, *resid_s;
  float *out_p, *out_s;
  u16* out_xg; const float* gnext; float* sumsq_out;
};

template <int MODE>
__device__ __forceinline__ void epi4(const GemmEpi& e, const f32x4 a, const float rs, const float* __restrict__ rp, float* __restrict__ outp,
                                     const size_t grow, const size_t lro, const int col0, const float4 gn, float& ssq) {
  if (MODE == 1 || MODE == 3) {
    float v0 = a[0] * rs, v1 = a[1] * rs, v2 = a[2] * rs, v3 = a[3] * rs;
    if (MODE == 3) { v0 = fmaxf(v0, 0.f); v1 = fmaxf(v1, 0.f); v2 = fmaxf(v2, 0.f); v3 = fmaxf(v3, 0.f); v0 *= v0; v1 *= v1; v2 *= v2; v3 *= v3; }
    uint2 o; o.x = pack2(v0, v1); o.y = pack2(v2, v3);
    *(uint2*)(e.out_bf + grow * e.ldo + col0) = o;
  } else {
    const size_t o = lro + col0;
    const float4 x0 = *(const float4*)(rp + o);
    float4 x; x.x = x0.x + a[0]; x.y = x0.y + a[1]; x.z = x0.z + a[2]; x.w = x0.w + a[3];
    *(float4*)(outp + o) = x;
    if (e.out_xg) {
      uint2 ob; ob.x = pack2(x.x * gn.x, x.y * gn.y); ob.y = pack2(x.z * gn.z, x.w * gn.w);
      *(uint2*)(e.out_xg + grow * D + col0) = ob;
    }
    ssq += x.x * x.x + x.y * x.y + x.z * x.z + x.w * x.w;
  }
}

template <int MODE>
__device__ __forceinline__ void gemm_phase(const u16* __restrict__ A, const u16* __restrict__ Bt, const int M, const int N, const int K, const GemmEpi e, const int wave_s) {
  u16* shm = (u16*)smem;
#define SA(b, h) (shm + ((b) * 2 + (h)) * HT)
#define SB(b, h) (shm + (4 + (b) * 2 + (h)) * HT)
#define STAGE(P, RS, br, kt) do { const unsigned _so = (unsigned)(((br) * K + (kt) * BK) * 2); \
    __builtin_amdgcn_raw_ptr_buffer_load_lds(RS, (LDSP)((char*)(P) + tid0 * 16), 16, toff0, _so, 0, 0); \
    __builtin_amdgcn_raw_ptr_buffer_load_lds(RS, (LDSP)((char*)(P) + tid0 * 16 + 8192), 16, toff1, _so, 0, 0); } while (0)
#define LDA(dst, b, h) for (int m = 0; m < 4; ++m) for (int k = 0; k < 2; ++k) \
    dst[m][k] = *reinterpret_cast<const bf16x8*>((char*)SA(b, h) + lds_byte(wr * 64 + m * 16 + fr, k * 32 + fq * 8))
#define LDB(dst, b, h) for (int n = 0; n < 2; ++n) for (int k = 0; k < 2; ++k) \
    dst[n][k] = *reinterpret_cast<const bf16x8*>((char*)SB(b, h) + lds_byte(wc * 32 + n * 16 + fr, k * 32 + fq * 8))
#define MMA(ai, bj, At, Bt_) do { __builtin_amdgcn_s_setprio(1); \
    for (int m = 0; m < 4; ++m) for (int n = 0; n < 2; ++n) for (int k = 0; k < 2; ++k) \
      acc[ai][bj][m][n] = __builtin_amdgcn_mfma_f32_16x16x32_bf16(Bt_[n][k], At[m][k], acc[ai][bj][m][n], 0, 0, 0); \
    __builtin_amdgcn_s_setprio(0); } while (0)
#define WAIT_V(n) asm volatile("s_waitcnt vmcnt(" #n ")" ::: "memory")
#define WAIT_L(n) asm volatile("s_waitcnt lgkmcnt(" #n ")" ::: "memory")
#define BAR __builtin_amdgcn_s_barrier()
#define SCHED __builtin_amdgcn_sched_barrier(0)
#define DECODE(tt_, brow_, bcol_) do { int wgid = (tt_); \
    { int q = nwg / NXCD, r = nwg % NXCD, xcd = wgid % NXCD, off = wgid / NXCD; \
      wgid = (xcd < r ? xcd * (q + 1) : r * (q + 1) + (xcd - r) * q) + off; } \
    int nig = WGM * nN, gid = wgid / nig, fm = gid * WGM, gsz = min(nM - fm, WGM); \
    brow_ = (fm + ((wgid % nig) % gsz)) * BM; bcol_ = ((wgid % nig) / gsz) * BM; } while (0)
#define STAGE7(brow_, bcol_) do { \
    STAGE(SB(0, 0), rsB, bcol_, 0); STAGE(SA(0, 0), rsA, brow_, 0); \
    STAGE(SB(0, 1), rsB, bcol_ + HALF, 0); STAGE(SA(0, 1), rsA, brow_ + HALF, 0); \
    STAGE(SB(1, 0), rsB, bcol_, 1); STAGE(SA(1, 0), rsA, brow_, 1); STAGE(SB(1, 1), rsB, bcol_ + HALF, 1); } while (0)

  const int nM = M / BM, nN = N / BM, nwg = nM * nN;
  const int nt = K / BK;
  unsigned toff0, toff1;
  const int tid0 = opaque_tid(wave_s);
  const int wr = (tid0 >> 6) >> 2, wc = (tid0 >> 6) & 3, fr = tid0 & 15, fq = (tid0 & 63) >> 4;
  { int r_, c_; stage_rc(tid0 * 16, r_, c_); toff0 = (unsigned)(r_ * K + c_) * 2u; stage_rc(tid0 * 16 + 8192, r_, c_); toff1 = (unsigned)(r_ * K + c_) * 2u; }
  const __amdgpu_buffer_rsrc_t rsA = __builtin_amdgcn_make_buffer_rsrc((void*)A, 0, -1, 0x00020000);
  const __amdgpu_buffer_rsrc_t rsB = __builtin_amdgcn_make_buffer_rsrc((void*)Bt, 0, -1, 0x00020000);
  int tt = blockIdx.x;
  int brow = 0, bcol = 0;
  if (tt < nwg) { DECODE(tt, brow, bcol); STAGE7(brow, bcol); WAIT_V(0); }
  while (tt < nwg) {
    f32x4 acc[2][2][4][2] = {};
    bf16x8 At[4][2], B0[2][2], B1[2][2];
    if (wr == 1) BAR;
    BAR;
    for (int t = 0; t < nt - 2; t += 2) {
      LDB(B0, 0, 0); SCHED; LDA(At, 0, 0); STAGE(SA(1, 1), rsA, brow + HALF, t + 1);
      WAIT_L(8); BAR; WAIT_L(0); MMA(0, 0, At, B0); BAR; SCHED;
      LDB(B1, 0, 1); STAGE(SB(0, 0), rsB, bcol, t + 2);
      BAR; WAIT_L(0); MMA(0, 1, At, B1); BAR;
      LDA(At, 0, 1); STAGE(SA(0, 0), rsA, brow, t + 2);
      BAR; WAIT_L(0); MMA(1, 0, At, B0); BAR; SCHED;
      STAGE(SB(0, 1), rsB, bcol + HALF, t + 2);
      WAIT_V(6); BAR; MMA(1, 1, At, B1); BAR;
      LDB(B0, 1, 0); SCHED; LDA(At, 1, 0); STAGE(SA(0, 1), rsA, brow + HALF, t + 2);
      WAIT_L(8); BAR; WAIT_L(0); MMA(0, 0, At, B0); BAR; SCHED;
      LDB(B1, 1, 1); STAGE(SB(1, 0), rsB, bcol, t + 3);
      BAR; WAIT_L(0); MMA(0, 1, At, B1); BAR;
      LDA(At, 1, 1); STAGE(SA(1, 0), rsA, brow, t + 3);
      BAR; WAIT_L(0); MMA(1, 0, At, B0); BAR; SCHED;
      STAGE(SB(1, 1), rsB, bcol + HALF, t + 3);
      WAIT_V(6); BAR; MMA(1, 1, At, B1); BAR;
    }
    { LDB(B0, 0, 0); LDA(At, 0, 0); STAGE(SA(1, 1), rsA, brow + HALF, nt - 1);
      BAR; WAIT_L(0); MMA(0, 0, At, B0); BAR;
      LDB(B1, 0, 1); BAR; WAIT_L(0); MMA(0, 1, At, B1); BAR;
      LDA(At, 0, 1); WAIT_V(4); BAR; WAIT_L(0); MMA(1, 0, At, B0); MMA(1, 1, At, B1); BAR; }
    { LDB(B0, 1, 0); LDA(At, 1, 0); WAIT_V(2); BAR; WAIT_L(0); MMA(0, 0, At, B0); BAR;
      LDB(B1, 1, 1); WAIT_V(0); BAR; WAIT_L(0); MMA(0, 1, At, B1); BAR;
      LDA(At, 1, 1); BAR; WAIT_L(0); MMA(1, 0, At, B0); MMA(1, 1, At, B1); BAR; }
    if (wr == 0) BAR;
    const int erow = brow, ecol = bcol;
    tt += gridDim.x;
    if (tt < nwg) { DECODE(tt, brow, bcol); STAGE7(brow, bcol); }
    SCHED;
    {
      const int tid1 = opaque_tid(wave_s);
      const int wr = (tid1 >> 6) >> 2, wc = (tid1 >> 6) & 3, fr = tid1 & 15, fq = (tid1 & 63) >> 4;
      const float* rp = (MODE == 2) ? e.resid_p + (size_t)erow * D : nullptr;
      float* outp = (MODE == 2) ? e.out_p + (size_t)erow * D : nullptr;
      float4 gn[2][2];
#pragma unroll
      for (int bj = 0; bj < 2; ++bj)
#pragma unroll
        for (int n = 0; n < 2; ++n) {
          gn[bj][n] = make_float4(0.f, 0.f, 0.f, 0.f);
          if (MODE == 2 && e.out_xg) gn[bj][n] = *(const float4*)(e.gnext + ecol + bj * HALF + wc * 32 + n * 16 + fq * 4);
        }
#pragma unroll
      for (int ai = 0; ai < 2; ++ai)
#pragma unroll
        for (int m = 0; m < 4; ++m) {
          const int lrow = ai * HALF + wr * 64 + m * 16 + fr;
          const size_t grow = (size_t)erow + lrow;
          float rs = 0.f, ssq = 0.f;
          if (MODE == 1 || MODE == 3) rs = rsqrtf(e.sumsq_in[grow] * (1.0f / 1024.0f) + EPS);
#pragma unroll
          for (int bj = 0; bj < 2; ++bj)
#pragma unroll
            for (int n = 0; n < 2; ++n)
              epi4<MODE>(e, acc[ai][bj][m][n], rs, rp, outp, grow, (size_t)lrow * D, ecol + bj * HALF + wc * 32 + n * 16 + fq * 4, gn[bj][n], ssq);
          if (MODE == 2 && e.sumsq_out) {
            ssq += __shfl_xor(ssq, 16); ssq += __shfl_xor(ssq, 32);
            if (fq == 0) atomicAdd(e.sumsq_out + grow, ssq);
          }
          SCHED;
        }
    }
    WAIT_V(16);
  }
  WAIT_V(0);
#undef SA
#undef SB
#undef STAGE
#undef LDA
#undef LDB
#undef MMA
}

#define MFMA32(a, b, c) __builtin_amdgcn_mfma_f32_32x32x16_bf16((a), (b), (c), 0, 0, 0)

template <int MODE>
__device__ __forceinline__ void sample_gemm(const u16* __restrict__ A, const u16* __restrict__ Bt, const int N, const int K, const GemmEpi e, const int wave_s) {
  const int tid = opaque_tid(wave_s);
  const int lane = tid & 63, wid = tid >> 6;
  const int i = lane & 31, h = lane >> 5;
  const int ntask = 8 * (N / 32);
  for (int id = wid * gridDim.x + blockIdx.x; id < ntask; id += 8 * gridDim.x) {
    const int r0 = (id & 7) * 32, c0 = (id >> 3) * 32;
    const u16* ap = A + (size_t)(NP + r0 + i) * K + 8 * h;
    const u16* bp = Bt + (size_t)(c0 + i) * K + 8 * h;
    f32x16 acc;
#pragma unroll
    for (int q = 0; q < 16; ++q) acc[q] = 0.f;
#pragma unroll 8
    for (int k = 0; k < K; k += 16) {
      const bf16x8 a = *(const bf16x8*)(ap + k);
      const bf16x8 b = *(const bf16x8*)(bp + k);
      acc = MFMA32(b, a, acc);
    }
    const int srow = r0 + i;
    const size_t grow = (size_t)NP + srow;
    float rs = 0.f, ssq = 0.f;
    if (MODE == 1 || MODE == 3) rs = rsqrtf(e.sumsq_in[grow] * (1.0f / 1024.0f) + EPS);
#pragma unroll
    for (int q = 0; q < 4; ++q) {
      const int col0 = c0 + 8 * q + 4 * h;
      f32x4 a4; a4[0] = acc[4 * q]; a4[1] = acc[4 * q + 1]; a4[2] = acc[4 * q + 2]; a4[3] = acc[4 * q + 3];
      float4 gn = make_float4(0.f, 0.f, 0.f, 0.f);
      if (MODE == 2 && e.out_xg) gn = *(const float4*)(e.gnext + col0);
      epi4<MODE>(e, a4, rs, e.resid_s, e.out_s, grow, (size_t)srow * D, col0, gn, ssq);
    }
    if (MODE == 2 && e.sumsq_out) {
      ssq += __shfl_xor(ssq, 32);
      if (h == 0) atomicAdd(e.sumsq_out + grow, ssq);
    }
  }
}

__device__ __forceinline__ void tr_tile(const float* __restrict__ src, u16* __restrict__ dst, int K, int N, int k0, int n0, const int tid) {
  float* lt = (float*)smem;
  { const int kk = tid >> 4, n4 = tid & 15;
#pragma unroll
    for (int i = 0; i < 2; ++i) {
      const int k = kk + i * 32;
      const float4 v = *(const float4*)(src + (size_t)(k0 + k) * N + n0 + n4 * 4);
      float* d = lt + k * 65 + n4 * 4;
      d[0] = v.x; d[1] = v.y; d[2] = v.z; d[3] = v.w;
    } }
  __syncthreads();
  { const int n = tid >> 3, k8 = tid & 7;
    float f[8];
#pragma unroll
    for (int i = 0; i < 8; ++i) f[i] = lt[(k8 * 8 + i) * 65 + n];
    uint4 o; o.x = pack2(f[0], f[1]); o.y = pack2(f[2], f[3]); o.z = pack2(f[4], f[5]); o.w = pack2(f[6], f[7]);
    *(uint4*)(dst + (size_t)(n0 + n) * K + k0 + k8 * 8) = o; }
  __syncthreads();
}

__device__ void phase0(const Params& p, const int wave_s) {
  const int tid = opaque_tid(wave_s), lane = tid & 63, wid = tid >> 6;
  const int gw = blockIdx.x * 8 + wid, nw = gridDim.x * 8;
  const size_t gt = (size_t)blockIdx.x * 512 + tid, ntd = (size_t)gridDim.x * 512;
  for (int row = gw; row < MT; row += nw) {
    const float4* xr = (const float4*)(row < NP ? p.x_prompt + (size_t)row * D : p.x_sample + (size_t)(row - NP) * D);
    const float4* g4 = (const float4*)p.norm1_g;
    float ss = 0.f;
#pragma unroll
    for (int i = 0; i < 4; ++i) {
      const float4 v = xr[lane + 64 * i], g = g4[lane + 64 * i];
      ss += v.x * v.x + v.y * v.y + v.z * v.z + v.w * v.w;
      uint2 o; o.x = pack2(v.x * g.x, v.y * g.y); o.y = pack2(v.z * g.z, v.w * g.w);
      *(uint2*)(p.xg + (size_t)row * D + (lane + 64 * i) * 4) = o;
    }
    ss = wave_sum(ss);
    if (lane == 0) p.sumsq[row] = ss;
  }
  for (size_t i = gt; i < (size_t)3 * MT; i += ntd) p.sumsq[MT + i] = 0.f;
  for (size_t i = gt; i < (size_t)2056 * 8; i += ntd) {
    const int pi = (int)(i >> 3), fi = (int)(i & 7);
    const int pos = pi < 2048 ? pi : 8192 + (pi - 2048);
    float inv;
    switch (fi) { case 0: inv = 1.0f; break; case 1: inv = 0.1939227432012558f; break; case 2: inv = 0.03760603070259094f; break;
      case 3: inv = 0.007292664609849453f; break; case 4: inv = 0.0014142135623842478f; break; case 5: inv = 0.00027424818836152554f; break;
      case 6: inv = 5.318296098266728e-05f; break; default: inv = 1.0313386155758053e-05f; break; }
    const float ang = (float)pos * inv;
    p.rope[pi * 16 + fi] = cosf(ang);
    p.rope[pi * 16 + 8 + fi] = sinf(ang);
  }
  {
    const size_t n4[3] = {(size_t)2 * 32 * 128 * 64, (size_t)2 * 32 * 512 * 64, (size_t)2 * 32 * 2048 * 64};
    const size_t oo[3] = {O_KV128S, O_KV512S, O_KV2048S};
#pragma unroll
    for (int g = 0; g < 3; ++g) {
      const int W = 128 << (2 * g);
      const float4* src = (const float4*)p.kv_in[g];
      float4* dst = (float4*)(p.out + oo[g]);
      const size_t per = (size_t)W * 64, lim = (size_t)(W - 8) * 64;
      for (size_t i = gt; i < n4[g]; i += ntd) {
        if ((i % per) < lim) dst[i] = src[i + 512];
      }
    }
  }
  constexpr int TL = 640 + 192 + 1024 + 1024 + 4;
  for (int t = blockIdx.x; t < 2 * TL; t += gridDim.x) {
    const int l = t / TL; int r = t % TL;
    const float* src; u16* dst; int K, N;
    if (r < 640) { src = p.w_in + (size_t)l * D * IC; dst = p.wt_in + (size_t)l * IC * D; K = D; N = IC; }
    else if (r < 832) { r -= 640; src = p.w_out + (size_t)l * MC * D; dst = p.wt_out + (size_t)l * D * MC; K = MC; N = D; }
    else if (r < 1856) { r -= 832; src = p.w_up + (size_t)l * D * FF; dst = p.wt_up + (size_t)l * FF * D; K = D; N = FF; }
    else if (r < 2880) { r -= 1856; src = p.w_down + (size_t)l * FF * D; dst = p.wt_down + (size_t)l * D * FF; K = FF; N = D; }
    else { r -= 2880; src = p.pool_w + (size_t)(l * 4 + r) * 4096; dst = p.pwT + (size_t)(l * 4 + r) * 4096; K = 64; N = 64; r = 0; }
    const int ntn = N / 64;
    tr_tile(src, dst, K, N, (r / ntn) * 64, (r % ntn) * 64, tid);
  }
}


__device__ __forceinline__ void load_qk(const u16* __restrict__ rowp, const float* __restrict__ ropep, const float* __restrict__ gain,
                                        const float scale, bf16x8 out[4], const int h) {
  float f[4][8];
  float ss = 0.f;
#pragma unroll
  for (int s = 0; s < 4; ++s) {
    const bf16x8 raw = *(const bf16x8*)(rowp + 16 * s + 8 * h);
#pragma unroll
    for (int j = 0; j < 8; ++j) { f[s][j] = bfs2f(raw[j]); ss += f[s][j] * f[s][j]; }
  }
  ss += __shfl_xor(ss, 32);
  const float inv = rsqrtf(ss * (1.0f / 64.0f) + EPS);
#pragma unroll
  for (int s = 0; s < 4; ++s) {
    const float4 g0 = *(const float4*)(gain + 16 * s + 8 * h), g1 = *(const float4*)(gain + 16 * s + 8 * h + 4);
    f[s][0] *= inv * g0.x; f[s][1] *= inv * g0.y; f[s][2] *= inv * g0.z; f[s][3] *= inv * g0.w;
    f[s][4] *= inv * g1.x; f[s][5] *= inv * g1.y; f[s][6] *= inv * g1.z; f[s][7] *= inv * g1.w;
  }
  {
    const float4 c0 = *(const float4*)(ropep), c1 = *(const float4*)(ropep + 4), s0 = *(const float4*)(ropep + 8), s1 = *(const float4*)(ropep + 12);
    const float cs[8] = {c0.x, c0.y, c0.z, c0.w, c1.x, c1.y, c1.z, c1.w};
    const float sn[8] = {s0.x, s0.y, s0.z, s0.w, s1.x, s1.y, s1.z, s1.w};
#pragma unroll
    for (int j = 0; j < 8; ++j) {
      const float other = __shfl_xor(f[0][j], 32);
      f[0][j] = (h == 0) ? (f[0][j] * cs[j] - other * sn[j]) : (f[0][j] * cs[j] + other * sn[j]);
    }
  }
#pragma unroll
  for (int s = 0; s < 4; ++s)
#pragma unroll
    for (int j = 0; j < 8; ++j) out[s][j] = (short)f2bf(f[s][j] * scale);
}

template <bool SAMPLE>
__device__ __forceinline__ void attn_task(const Params& p, const int layer, const int task, const int lane_unused) {
  const int lane = opaque_lane();
  int g, hslot, b, r, tile, nq;
  if (!SAMPLE) {
    const int c = task & 63; int tmp = task >> 6; g = tmp % 3; tmp /= 3; hslot = tmp & 1; b = tmp >> 1;
    const int tpc = 64 >> (2 * g);
    r = c / tpc; tile = c % tpc; nq = 32;
  } else {
    b = task / 26; const int rem = task % 26; hslot = rem / 13; const int c = rem % 13;
    if (c == 0) { g = 0; r = 0; nq = 8; } else if (c < 5) { g = 1; r = c - 1; nq = 2; } else { g = 2; r = c - 5; nq = 1; }
    tile = 4;
  }
  const int dl = 1 << (2 * g);
  const int W = 128 << (2 * g);
  const int m0 = tile * 32;
  const int head = 2 * g + hslot;
  const u16* projb = SAMPLE ? p.proj + (size_t)(NP + b * 8) * IC : p.proj + (size_t)b * 2048 * IC;
  const int ropeb = SAMPLE ? 2048 : 0;
  const float* cache = SAMPLE ? ((g == 0) ? p.kv_in[0] : (g == 1) ? p.kv_in[1] : p.kv_in[2]) + (size_t)(layer * 32 + b) * W * 256 + hslot * 64 : nullptr;
  const int qi = lane & 31, h = lane >> 5;
  int tq;
  if (SAMPLE) tq = r + dl * (qi < nq ? qi : 0); else tq = (m0 + qi) * dl + r;
  bf16x8 qf[4];
  load_qk(projb + (size_t)tq * IC + C_Q + head * 64, p.rope + (ropeb + tq) * 16, p.q_norm_g + layer * 64, 0.125f, qf, h);
  const int kt_lo = SAMPLE ? 0 : max(0, 4 - tile);
  f32x16 sacc[5];
#pragma unroll
  for (int kt = 0; kt < 5; ++kt) {
#pragma unroll
    for (int i = 0; i < 16; ++i) sacc[kt][i] = 0.f;
    if (kt >= kt_lo) {
      bf16x8 kf[4];
      if (SAMPLE && kt < 4) {
        const float* kp = cache + (size_t)(r + dl * (32 * kt + qi)) * 256 + 8 * h;
#pragma unroll
        for (int s = 0; s < 4; ++s) {
          const float4 x0 = *(const float4*)(kp + 16 * s), x1 = *(const float4*)(kp + 16 * s + 4);
          kf[s][0] = (short)f2bf(x0.x); kf[s][1] = (short)f2bf(x0.y); kf[s][2] = (short)f2bf(x0.z); kf[s][3] = (short)f2bf(x0.w);
          kf[s][4] = (short)f2bf(x1.x); kf[s][5] = (short)f2bf(x1.y); kf[s][6] = (short)f2bf(x1.z); kf[s][7] = (short)f2bf(x1.w);
        }
      } else {
        int tk;
        if (SAMPLE) tk = r + dl * (qi < nq ? qi : 0); else tk = (m0 - 128 + 32 * kt + qi) * dl + r;
        load_qk(projb + (size_t)tk * IC + C_K + head * 64, p.rope + (ropeb + tk) * 16, p.k_norm_g + layer * 64, 1.0f, kf, h);
      }
#pragma unroll
      for (int s = 0; s < 4; ++s) sacc[kt] = MFMA32(kf[s], qf[s], sacc[kt]);
    }
  }
  float mx = -1e30f;
#pragma unroll
  for (int kt = 0; kt < 5; ++kt)
#pragma unroll
    for (int rr = 0; rr < 16; ++rr) {
      const int keyrow = (rr & 3) + 8 * (rr >> 2) + 4 * h;
      const int dist = 128 - 32 * kt + qi - keyrow;
      const bool valid = (kt >= kt_lo) && dist >= 0 && dist <= 128;
      const float s = valid ? sacc[kt][rr] : -1e30f;
      sacc[kt][rr] = s;
      mx = fmaxf(mx, s);
    }
  mx = fmaxf(mx, __shfl_xor(mx, 32));
  float sum = 0.f;
#pragma unroll
  for (int kt = 0; kt < 5; ++kt)
#pragma unroll
    for (int rr = 0; rr < 16; ++rr) {
      const float s = sacc[kt][rr];
      const float ex = (s > -1e29f) ? __expf(s - mx) : 0.f;
      sacc[kt][rr] = ex;
      sum += ex;
    }
  sum += __shfl_xor(sum, 32);
  f32x16 oacc[2];
#pragma unroll
  for (int i = 0; i < 16; ++i) { oacc[0][i] = 0.f; oacc[1][i] = 0.f; }
#pragma unroll
  for (int kt = 0; kt < 5; ++kt) {
    if (kt >= kt_lo) {
#pragma unroll
      for (int s2 = 0; s2 < 2; ++s2) {
        bf16x8 pf;
#pragma unroll
        for (int j = 0; j < 8; ++j) pf[j] = (short)f2bf(sacc[kt][8 * s2 + j]);
        bf16x8 v0, v1;
#pragma unroll
        for (int j = 0; j < 8; ++j) {
          const int kr = 16 * s2 + 8 * (j >> 2) + 4 * h + (j & 3);
          if (SAMPLE && kt < 4) {
            const float* vp = cache + (size_t)(r + dl * (32 * kt + kr)) * 256 + 128 + qi;
            v0[j] = (short)f2bf(vp[0]); v1[j] = (short)f2bf(vp[32]);
          } else {
            int tk;
            if (SAMPLE) tk = r + dl * (kr < nq ? kr : 0); else tk = (m0 - 128 + 32 * kt + kr) * dl + r;
            const u16* vp = projb + (size_t)tk * IC + C_V + head * 64 + qi;
            v0[j] = (short)vp[0]; v1[j] = (short)vp[32];
          }
        }
        oacc[0] = MFMA32(v0, pf, oacc[0]);
        oacc[1] = MFMA32(v1, pf, oacc[1]);
      }
    }
  }
  const float isum = 1.0f / sum;
  const size_t rowq = SAMPLE ? (size_t)NP + b * 8 + tq : (size_t)b * 2048 + tq;
  if (!SAMPLE || qi < nq) {
    float* op = p.opart + ((size_t)g * MT + rowq) * 128 + hslot * 64;
#pragma unroll
    for (int db = 0; db < 2; ++db)
#pragma unroll
      for (int i4 = 0; i4 < 4; ++i4) {
        float4 o; o.x = oacc[db][4 * i4] * isum; o.y = oacc[db][4 * i4 + 1] * isum; o.z = oacc[db][4 * i4 + 2] * isum; o.w = oacc[db][4 * i4 + 3] * isum;
        *(float4*)(op + db * 32 + 8 * i4 + 4 * h) = o;
      }
    if (h == 0) p.lse[((size_t)g * MT + rowq) * 2 + hslot] = mx + __logf(sum);
  }
}

__device__ __forceinline__ void kv_row_task(const Params& p, const int l, const int row, const int lane) {
  const int hl = lane < 48 ? lane : 47;
  const int head = hl >> 3, c8 = hl & 7;
  int b, t, ridx;
  const bool prompt = row < NP;
  if (prompt) { b = row >> 11; t = row & 2047; ridx = t; } else { b = (row - NP) >> 3; t = (row - NP) & 7; ridx = 2048 + t; }
  const u16* pr = p.proj + (size_t)row * IC;
  const bf16x8 kr = *(const bf16x8*)(pr + C_K + hl * 8);
  const bf16x8 vr = *(const bf16x8*)(pr + C_V + hl * 8);
  float f[8]; float ss = 0.f;
#pragma unroll
  for (int j = 0; j < 8; ++j) { f[j] = bfs2f(kr[j]); ss += f[j] * f[j]; }
  ss += __shfl_xor(ss, 1); ss += __shfl_xor(ss, 2); ss += __shfl_xor(ss, 4);
  const float inv = rsqrtf(ss * (1.0f / 64.0f) + EPS);
  const float* gk = p.k_norm_g + l * 64 + c8 * 8;
#pragma unroll
  for (int j = 0; j < 8; ++j) f[j] *= inv * gk[j];
  const float* rp = p.rope + ridx * 16;
#pragma unroll
  for (int j = 0; j < 8; ++j) {
    const float other = __shfl_xor(f[j], 1);
    const float cs = rp[j], sn = rp[8 + j];
    if (c8 == 0) f[j] = f[j] * cs - other * sn;
    else if (c8 == 1) f[j] = f[j] * cs + other * sn;
  }
  const int g = head >> 1, hh = head & 1;
  const int W = 128 << (2 * g);
  float* dst = nullptr;
  if (prompt) {
    const int r = t - (2048 - W);
    const size_t base = (g == 0) ? O_KV128P : (g == 1) ? O_KV512P : O_KV2048P;
    if (r >= 0) dst = p.out + base + ((size_t)(l * 8 + b) * W + r) * 256 + hh * 64 + c8 * 8;
  } else {
    const int r = W - 8 + t;
    const size_t base = (g == 0) ? O_KV128S : (g == 1) ? O_KV512S : O_KV2048S;
    dst = p.out + base + ((size_t)(l * 32 + b) * W + r) * 256 + hh * 64 + c8 * 8;
  }
  if (dst && lane < 48) {
    *(float4*)(dst) = make_float4(f[0], f[1], f[2], f[3]);
    *(float4*)(dst + 4) = make_float4(f[4], f[5], f[6], f[7]);
    *(float4*)(dst + 128) = make_float4(bfs2f(vr[0]), bfs2f(vr[1]), bfs2f(vr[2]), bfs2f(vr[3]));
    *(float4*)(dst + 132) = make_float4(bfs2f(vr[4]), bfs2f(vr[5]), bfs2f(vr[6]), bfs2f(vr[7]));
  }
}

__device__ void phaseA(const Params& p, const int l, const int wave_s) {
  const int tid = opaque_tid(wave_s);
  const int lane = tid & 63, wid = tid >> 6;
  const int gw = blockIdx.x * 8 + wid, nw = gridDim.x * 8;
  for (int task = gw; task < 832 + 3072; task += nw) { if (task < 832) attn_task<true>(p, l, task, lane); else attn_task<false>(p, l, task - 832, lane); }
  for (int row = nw - 1 - gw; row < MT; row += nw) kv_row_task(p, l, row, lane);
}

__device__ __forceinline__ void pool_task(const Params& p, const int l, const int task, const int lane) {
  const int tile = task >> 2, grp = task & 3;
  const int qi = lane & 31, h = lane >> 5;
  const int row = tile * 32 + qi;
  const int w = 2 << grp;
  const bool prompt = row < NP;
  int n, t; float cnt;
  if (prompt) { n = row >> 11; t = row & 2047; cnt = (float)min(t + 1, w); } else { n = (row - NP) >> 3; t = (row - NP) & 7; cnt = (float)w; }
  const float icnt = 1.0f / cnt;
  f32x16 acc[2];
#pragma unroll
  for (int i = 0; i < 16; ++i) { acc[0][i] = 0.f; acc[1][i] = 0.f; }
  const u16* pw = p.pwT + (size_t)(l * 4 + grp) * 4096;
#pragma unroll
  for (int s = 0; s < 4; ++s) {
    const int c0 = grp * 64 + 16 * s + 8 * h;
    float sum[8], own[8];
#pragma unroll
    for (int j = 0; j < 8; ++j) { sum[j] = 0.f; own[j] = 0.f; }
    for (int i = 0; i < w; ++i) {
      const int tt = t - i;
      float v[8];
      if (tt >= 0) {
        const bf16x8 raw = *(const bf16x8*)(p.proj + (size_t)(row - i) * IC + C_U + c0);
#pragma unroll
        for (int j = 0; j < 8; ++j) v[j] = bfs2f(raw[j]);
      } else if (!prompt) {
        const float* sp = p.state_pool + ((size_t)(l * 32 + n) * 15 + 15 + tt) * 256 + c0;
        const float4 a = *(const float4*)sp, bb = *(const float4*)(sp + 4);
        v[0] = a.x; v[1] = a.y; v[2] = a.z; v[3] = a.w; v[4] = bb.x; v[5] = bb.y; v[6] = bb.z; v[7] = bb.w;
      } else {
#pragma unroll
        for (int j = 0; j < 8; ++j) v[j] = 0.f;
      }
#pragma unroll
      for (int j = 0; j < 8; ++j) sum[j] += v[j];
      if (i == 0) {
#pragma unroll
        for (int j = 0; j < 8; ++j) own[j] = v[j];
      }
    }
    bf16x8 df;
#pragma unroll
    for (int j = 0; j < 8; ++j) df[j] = (short)f2bf(sum[j] * icnt - own[j]);
    const bf16x8 a0 = *(const bf16x8*)(pw + (size_t)qi * 64 + 16 * s + 8 * h);
    const bf16x8 a1 = *(const bf16x8*)(pw + (size_t)(qi + 32) * 64 + 16 * s + 8 * h);
    acc[0] = MFMA32(a0, df, acc[0]);
    acc[1] = MFMA32(a1, df, acc[1]);
  }
  const float* ps = p.pool_scale + l * 256 + grp * 64;
  u16* mp = p.mixed + (size_t)row * MC + grp * 64;
#pragma unroll
  for (int db = 0; db < 2; ++db)
#pragma unroll
    for (int i4 = 0; i4 < 4; ++i4) {
      const int dd0 = db * 32 + 8 * i4 + 4 * h;
      const float4 sc = *(const float4*)(ps + dd0);
      uint2 o; o.x = pack2(acc[db][4 * i4] * sc.x, acc[db][4 * i4 + 1] * sc.y); o.y = pack2(acc[db][4 * i4 + 2] * sc.z, acc[db][4 * i4 + 3] * sc.w);
      *(uint2*)(mp + dd0) = o;
    }
}

__device__ void phaseB(const Params& p, const int l, const int wave_s) {
  const int tid = opaque_tid(wave_s), lane = tid & 63, wid = tid >> 6;
  const int gw = blockIdx.x * 8 + wid, nw = gridDim.x * 8;
  const size_t gt = (size_t)blockIdx.x * 512 + tid, ntd = (size_t)gridDim.x * 512;
  for (int task = gw; task < 520 * 4; task += nw) pool_task(p, l, task, lane);
  for (size_t idx = gt; idx < (size_t)MT * 48; idx += ntd) {
    const int row = (int)(idx / 48), ch = (int)(idx % 48) * 8;
    const bool prompt = row < NP;
    int n, t;
    if (prompt) { n = row >> 11; t = row & 2047; } else { n = (row - NP) >> 3; t = (row - NP) & 7; }
    float z[3][8];
#pragma unroll
    for (int i = 0; i < 3; ++i) {
      const int tt = t - 2 + i;
      if (tt >= 0) {
        const u16* pr = p.proj + (size_t)(row - 2 + i) * IC;
        const bf16x8 gc = *(const bf16x8*)(pr + C_GC + ch), gh = *(const bf16x8*)(pr + C_GH + ch);
#pragma unroll
        for (int j = 0; j < 8; ++j) z[i][j] = bfs2f(gc[j]) * bfs2f(gh[j]);
      } else if (!prompt) {
        const float* sp = p.state_conv + ((size_t)(l * 32 + n) * 2 + 2 + tt) * 384 + ch;
        const float4 a = *(const float4*)sp, bb = *(const float4*)(sp + 4);
        z[i][0] = a.x; z[i][1] = a.y; z[i][2] = a.z; z[i][3] = a.w; z[i][4] = bb.x; z[i][5] = bb.y; z[i][6] = bb.z; z[i][7] = bb.w;
      } else {
#pragma unroll
        for (int j = 0; j < 8; ++j) z[i][j] = 0.f;
      }
    }
    const bf16x8 gb = *(const bf16x8*)(p.proj + (size_t)row * IC + C_GB + ch);
    const float* cw = p.conv_w + (size_t)l * 3 * 384 + ch;
    float y[8];
#pragma unroll
    for (int j = 0; j < 8; ++j) y[j] = bfs2f(gb[j]) * (cw[j] * z[0][j] + cw[384 + j] * z[1][j] + cw[768 + j] * z[2][j]);
    uint4 o; o.x = pack2(y[0], y[1]); o.y = pack2(y[2], y[3]); o.z = pack2(y[4], y[5]); o.w = pack2(y[6], y[7]);
    *(uint4*)(p.mixed + (size_t)row * MC + 384 + ch) = o;
    float* so = nullptr;
    if (prompt) { if (t >= 2046) so = p.out + O_CONVP + ((size_t)(l * 8 + n) * 2 + (t - 2046)) * 384 + ch; }
    else { if (t >= 6) so = p.out + O_CONVS + ((size_t)(l * 32 + n) * 2 + (t - 6)) * 384 + ch; }
    if (so) { *(float4*)so = make_float4(z[2][0], z[2][1], z[2][2], z[2][3]); *(float4*)(so + 4) = make_float4(z[2][4], z[2][5], z[2][6], z[2][7]); }
  }
  for (size_t idx = gt; idx < (size_t)MT * 16; idx += ntd) {
    const int row = (int)(idx >> 4), chunk = (int)(idx & 15);
    const int hslot = chunk >> 3, d0 = (chunk & 7) * 8;
    float lg[3];
#pragma unroll
    for (int g = 0; g < 3; ++g) lg[g] = p.lse[((size_t)g * MT + row) * 2 + hslot];
    const float m = fmaxf(lg[0], fmaxf(lg[1], lg[2]));
    float wg[3]; wg[0] = __expf(lg[0] - m); wg[1] = __expf(lg[1] - m); wg[2] = __expf(lg[2] - m);
    const float iw = 1.0f / (wg[0] + wg[1] + wg[2]);
    float y[8];
#pragma unroll
    for (int j = 0; j < 8; ++j) y[j] = 0.f;
#pragma unroll
    for (int g = 0; g < 3; ++g) {
      const float* op = p.opart + ((size_t)g * MT + row) * 128 + hslot * 64 + d0;
      const float4 a = *(const float4*)op, bb = *(const float4*)(op + 4);
      const float ww = wg[g] * iw;
      y[0] += ww * a.x; y[1] += ww * a.y; y[2] += ww * a.z; y[3] += ww * a.w; y[4] += ww * bb.x; y[5] += ww * bb.y; y[6] += ww * bb.z; y[7] += ww * bb.w;
    }
    uint4 o; o.x = pack2(y[0], y[1]); o.y = pack2(y[2], y[3]); o.z = pack2(y[4], y[5]); o.w = pack2(y[6], y[7]);
    *(uint4*)(p.mixed + (size_t)row * MC + 256 + hslot * 64 + d0) = o;
  }
  for (size_t idx = gt; idx < (size_t)8 * 15 * 256; idx += ntd) {
    const int c = (int)(idx & 255); const int bi = (int)(idx >> 8); const int i = bi % 15, b = bi / 15;
    p.out[O_POOLP + (size_t)l * 8 * 15 * 256 + idx] = bf2f(p.proj[((size_t)b * 2048 + 2033 + i) * IC + C_U + c]);
  }
  for (size_t idx = gt; idx < (size_t)32 * 15 * 256; idx += ntd) {
    const int c = (int)(idx & 255); const int bi = (int)(idx >> 8); const int i = bi % 15, n = bi / 15;
    float v;
    if (i < 7) v = p.state_pool[((size_t)(l * 32 + n) * 15 + 8 + i) * 256 + c];
    else v = bf2f(p.proj[((size_t)NP + n * 8 + (i - 7)) * IC + C_U + c]);
    p.out[O_POOLS + (size_t)l * 32 * 15 * 256 + idx] = v;
  }
}

#ifndef REPM
#define REPM 0
#endif
#define NREP(k) (1 + ((REPM >> (k)) & 1))
typedef const __attribute__((address_space(4))) Params* CP;
#if defined(__HIP_DEVICE_COMPILE__)
#define LOAD_PARAMS() CP pp_ = (CP)__builtin_amdgcn_kernarg_segment_ptr(); asm volatile("" : "+s"(pp_)); const Params p = *pp_
#else
#define LOAD_PARAMS() const Params& p = p_unused
#endif
__global__ void __launch_bounds__(512, 2) mega(const Params p_unused, const int ph_lo, const int ph_hi) {
  const int wave_s = __builtin_amdgcn_readfirstlane((int)(threadIdx.x >> 6));
  if (ph_hi - ph_lo > 1) cg::this_grid().sync();
  int ph = 0;
#define IN_PH() (ph_lo <= ph && ph < ph_hi)
#define SEAM() do { if (ph_lo <= ph && ph + 1 < ph_hi) { LOAD_PARAMS(); grid_bar(p.bar, (unsigned)(ph - ph_lo + 1) * gridDim.x, wave_s); } ++ph; } while (0)
  if (IN_PH()) for (int rep = 0; rep < NREP(0); ++rep) { LOAD_PARAMS(); phase0(p, wave_s); }
  SEAM();
#pragma unroll 1
  for (int l = 0; l < 2; ++l) {
    if (IN_PH()) for (int rep = 0; rep < NREP(1); ++rep) {
      LOAD_PARAMS();
      GemmEpi e{}; e.sumsq_in = p.sumsq + (size_t)(2 * l) * MT; e.out_bf = p.proj; e.ldo = IC;
      gemm_phase<1>(p.xg, p.wt_in + (size_t)l * IC * D, NP, IC, D, e, wave_s);
      sample_gemm<1>(p.xg, p.wt_in + (size_t)l * IC * D, IC, D, e, wave_s);
    }
    SEAM();
    if (IN_PH()) for (int rep = 0; rep < NREP(2); ++rep) { LOAD_PARAMS(); phaseA(p, l, wave_s); }
    SEAM();
    if (IN_PH()) for (int rep = 0; rep < NREP(3); ++rep) { LOAD_PARAMS(); phaseB(p, l, wave_s); }
    SEAM();
    if (IN_PH()) for (int rep = 0; rep < NREP(4); ++rep) {
      LOAD_PARAMS();
      GemmEpi e{};
      if (l == 0) { e.resid_p = p.x_prompt; e.resid_s = p.x_sample; } else { e.resid_p = p.xb; e.resid_s = p.xb + (size_t)NP * D; }
      e.out_p = p.xa; e.out_s = p.xa + (size_t)NP * D;
      e.out_xg = p.xg; e.gnext = p.norm2_g + l * D; e.sumsq_out = p.sumsq + (size_t)(2 * l + 1) * MT;
      if (rep) e.sumsq_out = nullptr;
      gemm_phase<2>(p.mixed, p.wt_out + (size_t)l * D * MC, NP, D, MC, e, wave_s);
      sample_gemm<2>(p.mixed, p.wt_out + (size_t)l * D * MC, D, MC, e, wave_s);
    }
    SEAM();
    if (IN_PH()) for (int rep = 0; rep < NREP(5); ++rep) {
      LOAD_PARAMS();
      GemmEpi e{}; e.sumsq_in = p.sumsq + (size_t)(2 * l + 1) * MT; e.out_bf = p.hf; e.ldo = FF;
      gemm_phase<3>(p.xg, p.wt_up + (size_t)l * FF * D, NP, FF, D, e, wave_s);
      sample_gemm<3>(p.xg, p.wt_up + (size_t)l * FF * D, FF, D, e, wave_s);
    }
    SEAM();
    if (IN_PH()) for (int rep = 0; rep < NREP(6); ++rep) {
      LOAD_PARAMS();
      GemmEpi e{};
      e.resid_p = p.xa; e.resid_s = p.xa + (size_t)NP * D;
      if (l == 0) { e.out_p = p.xb; e.out_s = p.xb + (size_t)NP * D; e.out_xg = p.xg; e.gnext = p.norm1_g + D; e.sumsq_out = p.sumsq + (size_t)2 * MT; }
      else { e.out_p = p.out + O_YP; e.out_s = p.out + O_YS; e.out_xg = nullptr; e.gnext = nullptr; e.sumsq_out = nullptr; }
      if (rep) e.sumsq_out = nullptr;
      gemm_phase<2>(p.hf, p.wt_down + (size_t)l * D * FF, NP, D, FF, e, wave_s);
      sample_gemm<2>(p.hf, p.wt_down + (size_t)l * D * FF, D, FF, e, wave_s);
    }
    SEAM();
  }
}

extern "C" void kernel_launch(void* const* d_in, const int* in_sizes, int n_in, void* d_out, int out_size, void* d_ws, size_t ws_size, hipStream_t stream) {
  static int grid_blocks = 0;
  if (!grid_blocks) {
    int dev = 0, cus = 0, per_cu = 0;
    hipGetDevice(&dev);
    hipDeviceGetAttribute(&cus, hipDeviceAttributeMultiprocessorCount, dev);
    hipFuncSetAttribute((const void*)mega, hipFuncAttributeMaxDynamicSharedMemorySize, GEMM_LDS);
    hipOccupancyMaxActiveBlocksPerMultiprocessor(&per_cu, (const void*)mega, 512, GEMM_LDS);
    if (per_cu < 1) { fprintf(stderr, "occupancy query returned %d\n", per_cu); per_cu = 1; }
    grid_blocks = cus * 1;
  }
  Params p{};
  p.x_prompt = (const float*)d_in[0]; p.x_sample = (const float*)d_in[1]; p.state_pool = (const float*)d_in[2]; p.state_conv = (const float*)d_in[3];
  p.kv_in[0] = (const float*)d_in[4]; p.kv_in[1] = (const float*)d_in[5]; p.kv_in[2] = (const float*)d_in[6];
  p.norm1_g = (const float*)d_in[7]; p.w_in = (const float*)d_in[8]; p.q_norm_g = (const float*)d_in[9]; p.k_norm_g = (const float*)d_in[10];
  p.pool_w = (const float*)d_in[11]; p.pool_scale = (const float*)d_in[12]; p.conv_w = (const float*)d_in[13]; p.w_out = (const float*)d_in[14];
  p.norm2_g = (const float*)d_in[15]; p.w_up = (const float*)d_in[16]; p.w_down = (const float*)d_in[17];
  p.out = (float*)d_out;
  unsigned char* w = (unsigned char*)d_ws; size_t off = 0;
  auto carve = [&](size_t bytes) { unsigned char* r = w + off; off += (bytes + 255) & ~(size_t)255; return r; };
  p.bar = (unsigned*)carve(256);
  p.wt_in = (u16*)carve((size_t)2 * IC * D * 2);
  p.wt_out = (u16*)carve((size_t)2 * D * MC * 2);
  p.wt_up = (u16*)carve((size_t)2 * FF * D * 2);
  p.wt_down = (u16*)carve((size_t)2 * D * FF * 2);
  p.pwT = (u16*)carve((size_t)2 * 4 * 4096 * 2);
  p.xg = (u16*)carve((size_t)MT * D * 2);
  p.mixed = (u16*)carve((size_t)MT * MC * 2);
  p.xa = (float*)carve((size_t)MT * D * 4);
  p.xb = (float*)carve((size_t)MT * D * 4);
  p.sumsq = (float*)carve((size_t)4 * MT * 4);
  p.lse = (float*)carve((size_t)3 * MT * 2 * 4);
  p.rope = (float*)carve((size_t)2056 * 16 * 4);
  p.hf = (u16*)carve((size_t)MT * FF * 2);
  p.proj = p.hf;
  p.opart = (float*)((unsigned char*)p.hf + (((size_t)MT * IC * 2 + 255) & ~(size_t)255));
  if (off > ws_size) { fprintf(stderr, "workspace too small: need %zu have %zu\n", off, ws_size); return; }
  (void)hipMemsetAsync(p.bar, 0, 256, stream);
  int lo = 0, hi = 13;
  void* args[] = {(void*)&p, (void*)&lo, (void*)&hi};
  hipError_t e = hipLaunchCooperativeKernel((const void*)mega, dim3(grid_blocks), dim3(512), args, GEMM_LDS, stream);
  if (e != hipSuccess) fprintf(stderr, "cooperative launch failed: %s (grid %d)\n", hipGetErrorString(e), grid_blocks);
}
```

```cpp
#include <hip/hip_runtime.h>
#include <hip/hip_cooperative_groups.h>
#include <cstdio>
namespace cg = cooperative_groups;

typedef unsigned short u16;
using bf16x8 = __attribute__((ext_vector_type(8))) short;
using f32x4 = __attribute__((ext_vector_type(4))) float;
using f32x16 = __attribute__((ext_vector_type(16))) float;

constexpr int NP = 16384, NS = 256, MT = NP + NS;
constexpr int D = 1024, IC = 2560, MC = 768, FF = 4096;
constexpr float EPS = 1e-6f;
constexpr int C_U = 0, C_Q = 256, C_K = 640, C_V = 1024, C_GB = 1408, C_GC = 1792, C_GH = 2176;
constexpr size_t O_YP = 0;
constexpr size_t O_YS = O_YP + (size_t)NP * D;
constexpr size_t O_POOLP = O_YS + (size_t)NS * D;
constexpr size_t O_CONVP = O_POOLP + 2 * 8 * 15 * 256;
constexpr size_t O_KV128P = O_CONVP + 2 * 8 * 2 * 384;
constexpr size_t O_KV512P = O_KV128P + (size_t)2 * 8 * 128 * 256;
constexpr size_t O_KV2048P = O_KV512P + (size_t)2 * 8 * 512 * 256;
constexpr size_t O_POOLS = O_KV2048P + (size_t)2 * 8 * 2048 * 256;
constexpr size_t O_CONVS = O_POOLS + 2 * 32 * 15 * 256;
constexpr size_t O_KV128S = O_CONVS + 2 * 32 * 2 * 384;
constexpr size_t O_KV512S = O_KV128S + (size_t)2 * 32 * 128 * 256;
constexpr size_t O_KV2048S = O_KV512S + (size_t)2 * 32 * 512 * 256;

struct Params {
  const float *x_prompt, *x_sample, *state_pool, *state_conv, *kv_in[3];
  const float *norm1_g, *w_in, *q_norm_g, *k_norm_g, *pool_w, *pool_scale, *conv_w, *w_out, *norm2_g, *w_up, *w_down;
  float* out;
  u16 *wt_in, *wt_out, *wt_up, *wt_down, *pwT;
  u16 *xg, *proj, *mixed, *hf;
  float *xa, *xb, *sumsq, *opart, *lse, *rope;
  unsigned* bar;
};

extern __shared__ __attribute__((aligned(16))) unsigned char smem[];
typedef __attribute__((address_space(3))) void* LDSP;

__device__ __forceinline__ u16 f2bf(float f) { unsigned u = __float_as_uint(f); u += 0x7fffu + ((u >> 16) & 1u); return (u16)(u >> 16); }
__device__ __forceinline__ float bf2f(u16 h) { return __uint_as_float(((unsigned)h) << 16); }
__device__ __forceinline__ float bfs2f(short h) { return __uint_as_float(((unsigned)(u16)h) << 16); }
__device__ __forceinline__ unsigned pack2(float a, float b) { return (unsigned)f2bf(a) | ((unsigned)f2bf(b) << 16); }
__device__ __forceinline__ int opaque_tid(const int wave_s) {
  int l; asm volatile("v_mbcnt_lo_u32_b32 %0, -1, 0\n\tv_mbcnt_hi_u32_b32 %0, -1, %0" : "=v"(l));
  return wave_s * 64 + l;
}
__device__ __forceinline__ int opaque_lane() {
  int l; asm volatile("v_mbcnt_lo_u32_b32 %0, -1, 0\n\tv_mbcnt_hi_u32_b32 %0, -1, %0" : "=v"(l));
  return l;
}
__device__ __forceinline__ void grid_bar(unsigned* cnt, const unsigned target, const int wave_s) {
  asm volatile("s_waitcnt vmcnt(0)" ::: "memory");
  __syncthreads();
  if (opaque_tid(wave_s) == 0) {
    __builtin_amdgcn_fence(__ATOMIC_RELEASE, "agent");
    asm volatile("s_waitcnt vmcnt(0)" ::: "memory");
    __hip_atomic_fetch_add(cnt, 1u, __ATOMIC_RELAXED, __HIP_MEMORY_SCOPE_AGENT);
    while (__hip_atomic_load(cnt, __ATOMIC_RELAXED, __HIP_MEMORY_SCOPE_AGENT) < target) __builtin_amdgcn_s_sleep(4);
    __builtin_amdgcn_fence(__ATOMIC_ACQUIRE, "agent");
    asm volatile("s_waitcnt vmcnt(0)" ::: "memory");
  }
  __syncthreads();
}
__device__ __forceinline__ float wave_sum(float v) { for (int o = 32; o; o >>= 1) v += __shfl_xor(v, o); return v; }
__device__ __forceinline__ float wave_max(float v) { for (int o = 32; o; o >>= 1) v = fmaxf(v, __shfl_xor(v, o)); return v; }

constexpr int BM = 256, BK = 64, HALF = 128, NXCD = 8, WGM = 8, HT = HALF * BK;
constexpr int GEMM_LDS = 8 * HT * 2;

__device__ __forceinline__ int lds_byte(int r, int c) {
  int st = (r >> 4) * 2 + (c >> 5), rr = r & 15, cc = c & 31, ob = rr * 64 + cc * 2;
  return st * 1024 + (ob ^ (((ob >> 9) & 1) << 5));
}
__device__ __forceinline__ void stage_rc(int b, int& R, int& C) {
  int st = b / 1024, sb = b % 1024, swz = sb ^ (((sb >> 9) & 1) << 5);
  R = (st >> 1) * 16 + swz / 64; C = (st & 1) * 32 + (swz % 64) / 2;
}

struct GemmEpi {
  const float* sumsq_in;
  u16* out_bf; int ldo;
  const float *resid_p, *resid_s;
  float *out_p, *out_s;
  u16* out_xg; const float* gnext; float* sumsq_out;
};

template <int MODE>
__device__ __forceinline__ void epi4(const GemmEpi& e, const f32x4 a, const float rs, const float* __restrict__ rp, float* __restrict__ outp,
                                     const size_t grow, const size_t lro, const int col0, const float4 gn, float& ssq) {
  if (MODE == 1 || MODE == 3) {
    float v0 = a[0] * rs, v1 = a[1] * rs, v2 = a[2] * rs, v3 = a[3] * rs;
    if (MODE == 3) { v0 = fmaxf(v0, 0.f); v1 = fmaxf(v1, 0.f); v2 = fmaxf(v2, 0.f); v3 = fmaxf(v3, 0.f); v0 *= v0; v1 *= v1; v2 *= v2; v3 *= v3; }
    uint2 o; o.x = pack2(v0, v1); o.y = pack2(v2, v3);
    *(uint2*)(e.out_bf + grow * e.ldo + col0) = o;
  } else {
    const size_t o = lro + col0;
    float4 x; x.x = a[0]; x.y = a[1]; x.z = a[2]; x.w = a[3];
    if (rp) { const float4 x0 = *(const float4*)(rp + o); x.x += x0.x; x.y += x0.y; x.z += x0.z; x.w += x0.w; }
    *(float4*)(outp + o) = x;
    if (e.out_xg) {
      uint2 ob; ob.x = pack2(x.x * gn.x, x.y * gn.y); ob.y = pack2(x.z * gn.z, x.w * gn.w);
      *(uint2*)(e.out_xg + grow * D + col0) = ob;
    }
    ssq += x.x * x.x + x.y * x.y + x.z * x.z + x.w * x.w;
  }
}

template <int MODE>
__device__ __forceinline__ void gemm_phase(const u16* __restrict__ A, const u16* __restrict__ Bt, const int M, const int N, const int K, const GemmEpi e, const int wave_s) {
  u16* shm = (u16*)smem;
#define SA(b, h) (shm + ((b) * 2 + (h)) * HT)
#define SB(b, h) (shm + (4 + (b) * 2 + (h)) * HT)
#define STAGE(P, RS, br, kt) do { const unsigned _so = (unsigned)(((br) * K + (kt) * BK) * 2); \
    __builtin_amdgcn_raw_ptr_buffer_load_lds(RS, (LDSP)((char*)(P) + tid0 * 16), 16, toff0, _so, 0, 0); \
    __builtin_amdgcn_raw_ptr_buffer_load_lds(RS, (LDSP)((char*)(P) + tid0 * 16 + 8192), 16, toff1, _so, 0, 0); } while (0)
#define LDA(dst, b, h) for (int m = 0; m < 4; ++m) for (int k = 0; k < 2; ++k) \
    dst[m][k] = *reinterpret_cast<const bf16x8*>((char*)SA(b, h) + lds_byte(wr * 64 + m * 16 + fr, k * 32 + fq * 8))
#define LDB(dst, b, h) for (int n = 0; n < 2; ++n) for (int k = 0; k < 2; ++k) \
    dst[n][k] = *reinterpret_cast<const bf16x8*>((char*)SB(b, h) + lds_byte(wc * 32 + n * 16 + fr, k * 32 + fq * 8))
#define MMA(ai, bj, At, Bt_) do { __builtin_amdgcn_s_setprio(1); \
    for (int m = 0; m < 4; ++m) for (int n = 0; n < 2; ++n) for (int k = 0; k < 2; ++k) \
      acc[ai][bj][m][n] = __builtin_amdgcn_mfma_f32_16x16x32_bf16(Bt_[n][k], At[m][k], acc[ai][bj][m][n], 0, 0, 0); \
    __builtin_amdgcn_s_setprio(0); } while (0)
#define WAIT_V(n) asm volatile("s_waitcnt vmcnt(" #n ")" ::: "memory")
#define WAIT_L(n) asm volatile("s_waitcnt lgkmcnt(" #n ")" ::: "memory")
#define BAR __builtin_amdgcn_s_barrier()
#define SCHED __builtin_amdgcn_sched_barrier(0)
#define DECODE(tt_, brow_, bcol_) do { int wgid = (tt_); \
    { int q = nwg / NXCD, r = nwg % NXCD, xcd = wgid % NXCD, off = wgid / NXCD; \
      wgid = (xcd < r ? xcd * (q + 1) : r * (q + 1) + (xcd - r) * q) + off; } \
    int nig = WGM * nN, gid = wgid / nig, fm = gid * WGM, gsz = min(nM - fm, WGM); \
    brow_ = (fm + ((wgid % nig) % gsz)) * BM; bcol_ = ((wgid % nig) / gsz) * BM; } while (0)
#define STAGE7(brow_, bcol_) do { \
    STAGE(SB(0, 0), rsB, bcol_, 0); STAGE(SA(0, 0), rsA, brow_, 0); \
    STAGE(SB(0, 1), rsB, bcol_ + HALF, 0); STAGE(SA(0, 1), rsA, brow_ + HALF, 0); \
    STAGE(SB(1, 0), rsB, bcol_, 1); STAGE(SA(1, 0), rsA, brow_, 1); STAGE(SB(1, 1), rsB, bcol_ + HALF, 1); } while (0)

  const int nM = M / BM, nN = N / BM, nwg = nM * nN;
  const int nt = K / BK;
  unsigned toff0, toff1;
  const int tid0 = opaque_tid(wave_s);
  const int wr = (tid0 >> 6) >> 2, wc = (tid0 >> 6) & 3, fr = tid0 & 15, fq = (tid0 & 63) >> 4;
  { int r_, c_; stage_rc(tid0 * 16, r_, c_); toff0 = (unsigned)(r_ * K + c_) * 2u; stage_rc(tid0 * 16 + 8192, r_, c_); toff1 = (unsigned)(r_ * K + c_) * 2u; }
  const __amdgpu_buffer_rsrc_t rsA = __builtin_amdgcn_make_buffer_rsrc((void*)A, 0, -1, 0x00020000);
  const __amdgpu_buffer_rsrc_t rsB = __builtin_amdgcn_make_buffer_rsrc((void*)Bt, 0, -1, 0x00020000);
  int tt = blockIdx.x;
  int brow = 0, bcol = 0;
  if (tt < nwg) { DECODE(tt, brow, bcol); STAGE7(brow, bcol); WAIT_V(0); }
  f32x4 acc[2][2][4][2];
#define ACC_INIT(brow_, bcol_) do { \
    if (MODE == 2) { \
      const int t2 = opaque_tid(wave_s); const int wr_ = (t2 >> 6) >> 2, wc_ = (t2 >> 6) & 3, fr_ = t2 & 15, fq_ = (t2 & 63) >> 4; \
      const float* rp_ = e.resid_p + (size_t)(brow_ + wr_ * 64 + fr_) * D + bcol_ + wc_ * 32 + fq_ * 4; \
      _Pragma("unroll") for (int ai = 0; ai < 2; ++ai) _Pragma("unroll") for (int bj = 0; bj < 2; ++bj) \
      _Pragma("unroll") for (int m = 0; m < 4; ++m) _Pragma("unroll") for (int n = 0; n < 2; ++n) { \
        const float4 x0 = *(const float4*)(rp_ + (size_t)(ai * HALF + m * 16) * D + bj * HALF + n * 16); \
        acc[ai][bj][m][n][0] = x0.x; acc[ai][bj][m][n][1] = x0.y; acc[ai][bj][m][n][2] = x0.z; acc[ai][bj][m][n][3] = x0.w; } \
    } else { \
      _Pragma("unroll") for (int ai = 0; ai < 2; ++ai) _Pragma("unroll") for (int bj = 0; bj < 2; ++bj) \
      _Pragma("unroll") for (int m = 0; m < 4; ++m) _Pragma("unroll") for (int n = 0; n < 2; ++n) \
        acc[ai][bj][m][n] = (f32x4){0.f, 0.f, 0.f, 0.f}; \
    } } while (0)
  if (tt < nwg) ACC_INIT(brow, bcol);
  while (tt < nwg) {
    bf16x8 At[4][2], B0[2][2], B1[2][2];
    if (wr == 1) BAR;
    BAR;
    for (int t = 0; t < nt - 2; t += 2) {
      LDB(B0, 0, 0); SCHED; LDA(At, 0, 0); STAGE(SA(1, 1), rsA, brow + HALF, t + 1);
      WAIT_L(8); BAR; WAIT_L(0); MMA(0, 0, At, B0); BAR; SCHED;
      LDB(B1, 0, 1); STAGE(SB(0, 0), rsB, bcol, t + 2);
      BAR; WAIT_L(0); MMA(0, 1, At, B1); BAR;
      LDA(At, 0, 1); STAGE(SA(0, 0), rsA, brow, t + 2);
      BAR; WAIT_L(0); MMA(1, 0, At, B0); BAR; SCHED;
      STAGE(SB(0, 1), rsB, bcol + HALF, t + 2);
      WAIT_V(6); BAR; MMA(1, 1, At, B1); BAR;
      LDB(B0, 1, 0); SCHED; LDA(At, 1, 0); STAGE(SA(0, 1), rsA, brow + HALF, t + 2);
      WAIT_L(8); BAR; WAIT_L(0); MMA(0, 0, At, B0); BAR; SCHED;
      LDB(B1, 1, 1); STAGE(SB(1, 0), rsB, bcol, t + 3);
      BAR; WAIT_L(0); MMA(0, 1, At, B1); BAR;
      LDA(At, 1, 1); STAGE(SA(1, 0), rsA, brow, t + 3);
      BAR; WAIT_L(0); MMA(1, 0, At, B0); BAR; SCHED;
      STAGE(SB(1, 1), rsB, bcol + HALF, t + 3);
      WAIT_V(6); BAR; MMA(1, 1, At, B1); BAR;
    }
    { LDB(B0, 0, 0); LDA(At, 0, 0); STAGE(SA(1, 1), rsA, brow + HALF, nt - 1);
      BAR; WAIT_L(0); MMA(0, 0, At, B0); BAR;
      LDB(B1, 0, 1); BAR; WAIT_L(0); MMA(0, 1, At, B1); BAR;
      LDA(At, 0, 1); WAIT_V(4); BAR; WAIT_L(0); MMA(1, 0, At, B0); MMA(1, 1, At, B1); BAR; }
    { LDB(B0, 1, 0); LDA(At, 1, 0); WAIT_V(2); BAR; WAIT_L(0); MMA(0, 0, At, B0); BAR;
      LDB(B1, 1, 1); WAIT_V(0); BAR; WAIT_L(0); MMA(0, 1, At, B1); BAR;
      LDA(At, 1, 1); BAR; WAIT_L(0); MMA(1, 0, At, B0); MMA(1, 1, At, B1); BAR; }
    if (wr == 0) BAR;
    const int erow = brow, ecol = bcol;
    tt += gridDim.x;
    if (tt < nwg) { DECODE(tt, brow, bcol); STAGE7(brow, bcol); }
    SCHED;
    {
      const int tid1 = opaque_tid(wave_s);
      const int wr = (tid1 >> 6) >> 2, wc = (tid1 >> 6) & 3, fr = tid1 & 15, fq = (tid1 & 63) >> 4;
      const float* rp = nullptr;
      float* outp = (MODE == 2) ? e.out_p + (size_t)erow * D : nullptr;
      float rsv[2][4];
#pragma unroll
      for (int ai = 0; ai < 2; ++ai)
#pragma unroll
        for (int m = 0; m < 4; ++m) {
          rsv[ai][m] = 0.f;
          if (MODE == 1 || MODE == 3) rsv[ai][m] = e.sumsq_in[(size_t)erow + ai * HALF + wr * 64 + m * 16 + fr];
        }
      float4 gn[2][2];
#pragma unroll
      for (int bj = 0; bj < 2; ++bj)
#pragma unroll
        for (int n = 0; n < 2; ++n) {
          gn[bj][n] = make_float4(0.f, 0.f, 0.f, 0.f);
          if (MODE == 2 && e.out_xg) gn[bj][n] = *(const float4*)(e.gnext + ecol + bj * HALF + wc * 32 + n * 16 + fq * 4);
        }
#pragma unroll
      for (int ai = 0; ai < 2; ++ai)
#pragma unroll
        for (int m = 0; m < 4; ++m) {
          const int lrow = ai * HALF + wr * 64 + m * 16 + fr;
          const size_t grow = (size_t)erow + lrow;
          float rs = 0.f, ssq = 0.f;
          if (MODE == 1 || MODE == 3) rs = rsqrtf(rsv[ai][m] * (1.0f / 1024.0f) + EPS);
#pragma unroll
          for (int bj = 0; bj < 2; ++bj)
#pragma unroll
            for (int n = 0; n < 2; ++n)
              epi4<MODE>(e, acc[ai][bj][m][n], rs, rp, outp, grow, (size_t)lrow * D, ecol + bj * HALF + wc * 32 + n * 16 + fq * 4, gn[bj][n], ssq);
          if (MODE == 2 && e.sumsq_out) {
            ssq += __shfl_xor(ssq, 16); ssq += __shfl_xor(ssq, 32);
            if (fq == 0) atomicAdd(e.sumsq_out + grow, ssq);
          }
          SCHED;
        }
    }
    if (tt < nwg) ACC_INIT(brow, bcol);
    WAIT_V(16);
  }
  WAIT_V(0);
#undef SA
#undef SB
#undef STAGE
#undef LDA
#undef LDB
#undef MMA
}

#define MFMA32(a, b, c) __builtin_amdgcn_mfma_f32_32x32x16_bf16((a), (b), (c), 0, 0, 0)

template <int MODE>
__device__ __forceinline__ void sample_gemm(const u16* __restrict__ A, const u16* __restrict__ Bt, const int N, const int K, const GemmEpi e, const int wave_s, const int b0, const int nb) {
  const int bi = (int)blockIdx.x - b0;
  if (bi < 0 || bi >= nb) return;
  const int tid = opaque_tid(wave_s);
  const int lane = tid & 63, wid = tid >> 6;
  const int i = lane & 31, h = lane >> 5;
  const int ntask = 8 * (N / 32);
  const int ks = K / 8;
  float* red = (float*)smem;
  for (int id = bi; id < ntask; id += nb) {
    const int r0 = (id & 7) * 32, c0 = (id >> 3) * 32;
    const u16* ap = A + (size_t)(NP + r0 + i) * K + wid * ks + 8 * h;
    const u16* bp = Bt + (size_t)(c0 + i) * K + wid * ks + 8 * h;
    f32x16 acc;
#pragma unroll
    for (int q = 0; q < 16; ++q) acc[q] = 0.f;
#pragma unroll 8
    for (int k = 0; k < ks; k += 16) {
      const bf16x8 a = *(const bf16x8*)(ap + k);
      const bf16x8 b = *(const bf16x8*)(bp + k);
      acc = MFMA32(b, a, acc);
    }
#pragma unroll
    for (int q = 0; q < 4; ++q)
      *(float4*)(red + (wid * 32 + i) * 36 + 8 * q + 4 * h) = make_float4(acc[4 * q], acc[4 * q + 1], acc[4 * q + 2], acc[4 * q + 3]);
    __syncthreads();
    if (tid < 256) {
      const int row = tid >> 3, c4 = (tid & 7) * 4;
      f32x4 s4; s4[0] = 0.f; s4[1] = 0.f; s4[2] = 0.f; s4[3] = 0.f;
#pragma unroll
      for (int w = 0; w < 8; ++w) {
        const float4 v = *(const float4*)(red + (w * 32 + row) * 36 + c4);
        s4[0] += v.x; s4[1] += v.y; s4[2] += v.z; s4[3] += v.w;
      }
      const int srow = r0 + row, col0 = c0 + c4;
      const size_t grow = (size_t)NP + srow;
      float rs = 0.f, ssq = 0.f;
      if (MODE == 1 || MODE == 3) rs = rsqrtf(e.sumsq_in[grow] * (1.0f / 1024.0f) + EPS);
      float4 gn = make_float4(0.f, 0.f, 0.f, 0.f);
      if (MODE == 2 && e.out_xg) gn = *(const float4*)(e.gnext + col0);
      epi4<MODE>(e, s4, rs, e.resid_s, e.out_s, grow, (size_t)srow * D, col0, gn, ssq);
      if (MODE == 2 && e.sumsq_out) {
        ssq += __shfl_xor(ssq, 1); ssq += __shfl_xor(ssq, 2); ssq += __shfl_xor(ssq, 4);
        if ((tid & 7) == 0) atomicAdd(e.sumsq_out + grow, ssq);
      }
    }
    __syncthreads();
  }
}

__device__ __forceinline__ void kv_shift_copy(const Params& p, const int l, const int b0, const int nb, const int tid) {
  const int bi = (int)blockIdx.x - b0;
  if (bi < 0 || bi >= nb) return;
  const size_t gt = (size_t)bi * 512 + tid, ntd = (size_t)nb * 512;
#pragma unroll
  for (int g = 0; g < 3; ++g) {
    const int W = 128 << (2 * g);
    const size_t n4 = (size_t)32 * W * 64;
    const size_t oo = (g == 0) ? O_KV128S : (g == 1) ? O_KV512S : O_KV2048S;
    const f32x4* src = (const f32x4*)p.kv_in[g] + (size_t)l * n4;
    f32x4* dst = (f32x4*)(p.out + oo) + (size_t)l * n4;
    const unsigned per = (unsigned)W * 64u, lim = (unsigned)(W - 8) * 64u;
    for (size_t i = gt; i < n4; i += ntd) {
      if (((unsigned)i % per) < lim) __builtin_nontemporal_store(__builtin_nontemporal_load(src + i + 512), dst + i);
    }
  }
}

__device__ __forceinline__ void tr_tile(const float* __restrict__ src, u16* __restrict__ dst, int K, int N, int k0, int n0, const int tid) {
  float* lt = (float*)smem;
  { const int kk = tid >> 4, n4 = tid & 15;
#pragma unroll
    for (int i = 0; i < 2; ++i) {
      const int k = kk + i * 32;
      const float4 v = *(const float4*)(src + (size_t)(k0 + k) * N + n0 + n4 * 4);
      float* d = lt + k * 65 + n4 * 4;
      d[0] = v.x; d[1] = v.y; d[2] = v.z; d[3] = v.w;
    } }
  __syncthreads();
  { const int n = tid >> 3, k8 = tid & 7;
    float f[8];
#pragma unroll
    for (int i = 0; i < 8; ++i) f[i] = lt[(k8 * 8 + i) * 65 + n];
    uint4 o; o.x = pack2(f[0], f[1]); o.y = pack2(f[2], f[3]); o.z = pack2(f[4], f[5]); o.w = pack2(f[6], f[7]);
    *(uint4*)(dst + (size_t)(n0 + n) * K + k0 + k8 * 8) = o; }
  __syncthreads();
}

__device__ void phase0(const Params& p, const int wave_s) {
  const int tid = opaque_tid(wave_s), lane = tid & 63, wid = tid >> 6;
  const int gw = blockIdx.x * 8 + wid, nw = gridDim.x * 8;
  const size_t gt = (size_t)blockIdx.x * 512 + tid, ntd = (size_t)gridDim.x * 512;
  for (int row = gw; row < MT; row += nw) {
    const float4* xr = (const float4*)(row < NP ? p.x_prompt + (size_t)row * D : p.x_sample + (size_t)(row - NP) * D);
    const float4* g4 = (const float4*)p.norm1_g;
    float ss = 0.f;
#pragma unroll
    for (int i = 0; i < 4; ++i) {
      const float4 v = xr[lane + 64 * i], g = g4[lane + 64 * i];
      ss += v.x * v.x + v.y * v.y + v.z * v.z + v.w * v.w;
      uint2 o; o.x = pack2(v.x * g.x, v.y * g.y); o.y = pack2(v.z * g.z, v.w * g.w);
      *(uint2*)(p.xg + (size_t)row * D + (lane + 64 * i) * 4) = o;
    }
    ss = wave_sum(ss);
    if (lane == 0) p.sumsq[row] = ss;
  }
  for (size_t i = gt; i < (size_t)3 * MT; i += ntd) p.sumsq[MT + i] = 0.f;
  for (size_t i = gt; i < (size_t)2056 * 8; i += ntd) {
    const int pi = (int)(i >> 3), fi = (int)(i & 7);
    const int pos = pi < 2048 ? pi : 8192 + (pi - 2048);
    float inv;
    switch (fi) { case 0: inv = 1.0f; break; case 1: inv = 0.1939227432012558f; break; case 2: inv = 0.03760603070259094f; break;
      case 3: inv = 0.007292664609849453f; break; case 4: inv = 0.0014142135623842478f; break; case 5: inv = 0.00027424818836152554f; break;
      case 6: inv = 5.318296098266728e-05f; break; default: inv = 1.0313386155758053e-05f; break; }
    const float ang = (float)pos * inv;
    p.rope[pi * 16 + fi] = cosf(ang);
    p.rope[pi * 16 + 8 + fi] = sinf(ang);
  }
  constexpr int TL = 640 + 192 + 1024 + 1024 + 4;
  for (int t = blockIdx.x; t < 2 * TL; t += gridDim.x) {
    const int l = t / TL; int r = t % TL;
    const float* src; u16* dst; int K, N;
    if (r < 640) { src = p.w_in + (size_t)l * D * IC; dst = p.wt_in + (size_t)l * IC * D; K = D; N = IC; }
    else if (r < 832) { r -= 640; src = p.w_out + (size_t)l * MC * D; dst = p.wt_out + (size_t)l * D * MC; K = MC; N = D; }
    else if (r < 1856) { r -= 832; src = p.w_up + (size_t)l * D * FF; dst = p.wt_up + (size_t)l * FF * D; K = D; N = FF; }
    else if (r < 2880) { r -= 1856; src = p.w_down + (size_t)l * FF * D; dst = p.wt_down + (size_t)l * D * FF; K = FF; N = D; }
    else { r -= 2880; src = p.pool_w + (size_t)(l * 4 + r) * 4096; dst = p.pwT + (size_t)(l * 4 + r) * 4096; K = 64; N = 64; r = 0; }
    const int ntn = N / 64;
    tr_tile(src, dst, K, N, (r / ntn) * 64, (r % ntn) * 64, tid);
  }
}


__device__ __forceinline__ void load_qk(const u16* __restrict__ rowp, const float* __restrict__ ropep, const float* __restrict__ gain,
                                        const float scale, bf16x8 out[4], const int h) {
  float f[4][8];
  float ss = 0.f;
#pragma unroll
  for (int s = 0; s < 4; ++s) {
    const bf16x8 raw = *(const bf16x8*)(rowp + 16 * s + 8 * h);
#pragma unroll
    for (int j = 0; j < 8; ++j) { f[s][j] = bfs2f(raw[j]); ss += f[s][j] * f[s][j]; }
  }
  ss += __shfl_xor(ss, 32);
  const float inv = rsqrtf(ss * (1.0f / 64.0f) + EPS);
#pragma unroll
  for (int s = 0; s < 4; ++s) {
    const float4 g0 = *(const float4*)(gain + 16 * s + 8 * h), g1 = *(const float4*)(gain + 16 * s + 8 * h + 4);
    f[s][0] *= inv * g0.x; f[s][1] *= inv * g0.y; f[s][2] *= inv * g0.z; f[s][3] *= inv * g0.w;
    f[s][4] *= inv * g1.x; f[s][5] *= inv * g1.y; f[s][6] *= inv * g1.z; f[s][7] *= inv * g1.w;
  }
  {
    const float4 c0 = *(const float4*)(ropep), c1 = *(const float4*)(ropep + 4), s0 = *(const float4*)(ropep + 8), s1 = *(const float4*)(ropep + 12);
    const float cs[8] = {c0.x, c0.y, c0.z, c0.w, c1.x, c1.y, c1.z, c1.w};
    const float sn[8] = {s0.x, s0.y, s0.z, s0.w, s1.x, s1.y, s1.z, s1.w};
#pragma unroll
    for (int j = 0; j < 8; ++j) {
      const float other = __shfl_xor(f[0][j], 32);
      f[0][j] = (h == 0) ? (f[0][j] * cs[j] - other * sn[j]) : (f[0][j] * cs[j] + other * sn[j]);
    }
  }
#pragma unroll
  for (int s = 0; s < 4; ++s)
#pragma unroll
    for (int j = 0; j < 8; ++j) out[s][j] = (short)f2bf(f[s][j] * scale);
}

template <bool SAMPLE>
__device__ __forceinline__ void attn_task(const Params& p, const int layer, const int task, const int lane_unused) {
  const int lane = opaque_lane();
  int g, hslot, b, r, tile, nq;
  if (!SAMPLE) {
    const int c = task & 63; int tmp = task >> 6; g = tmp % 3; tmp /= 3; hslot = tmp & 1; b = tmp >> 1;
    const int tpc = 64 >> (2 * g);
    r = c / tpc; tile = c % tpc; nq = 32;
  } else {
    b = task / 26; const int rem = task % 26; hslot = rem / 13; const int c = rem % 13;
    if (c == 0) { g = 0; r = 0; nq = 8; } else if (c < 5) { g = 1; r = c - 1; nq = 2; } else { g = 2; r = c - 5; nq = 1; }
    tile = 4;
  }
  const int dl = 1 << (2 * g);
  const int W = 128 << (2 * g);
  const int m0 = tile * 32;
  const int head = 2 * g + hslot;
  const u16* projb = SAMPLE ? p.proj + (size_t)(NP + b * 8) * IC : p.proj + (size_t)b * 2048 * IC;
  const int ropeb = SAMPLE ? 2048 : 0;
  const float* cache = SAMPLE ? ((g == 0) ? p.kv_in[0] : (g == 1) ? p.kv_in[1] : p.kv_in[2]) + (size_t)(layer * 32 + b) * W * 256 + hslot * 64 : nullptr;
  const int qi = lane & 31, h = lane >> 5;
  int tq;
  if (SAMPLE) tq = r + dl * (qi < nq ? qi : 0); else tq = (m0 + qi) * dl + r;
  bf16x8 qf[4];
  load_qk(projb + (size_t)tq * IC + C_Q + head * 64, p.rope + (ropeb + tq) * 16, p.q_norm_g + layer * 64, 0.125f, qf, h);
  const int kt_lo = SAMPLE ? 0 : max(0, 4 - tile);
  f32x16 sacc[5];
#pragma unroll
  for (int kt = 0; kt < 5; ++kt) {
#pragma unroll
    for (int i = 0; i < 16; ++i) sacc[kt][i] = 0.f;
    if (kt >= kt_lo) {
      bf16x8 kf[4];
      if (SAMPLE && kt < 4) {
        const float* kp = cache + (size_t)(r + dl * (32 * kt + qi)) * 256 + 8 * h;
#pragma unroll
        for (int s = 0; s < 4; ++s) {
          const float4 x0 = *(const float4*)(kp + 16 * s), x1 = *(const float4*)(kp + 16 * s + 4);
          kf[s][0] = (short)f2bf(x0.x); kf[s][1] = (short)f2bf(x0.y); kf[s][2] = (short)f2bf(x0.z); kf[s][3] = (short)f2bf(x0.w);
          kf[s][4] = (short)f2bf(x1.x); kf[s][5] = (short)f2bf(x1.y); kf[s][6] = (short)f2bf(x1.z); kf[s][7] = (short)f2bf(x1.w);
        }
      } else {
        int tk;
        if (SAMPLE) tk = r + dl * (qi < nq ? qi : 0); else tk = (m0 - 128 + 32 * kt + qi) * dl + r;
        load_qk(projb + (size_t)tk * IC + C_K + head * 64, p.rope + (ropeb + tk) * 16, p.k_norm_g + layer * 64, 1.0f, kf, h);
      }
#pragma unroll
      for (int s = 0; s < 4; ++s) sacc[kt] = MFMA32(kf[s], qf[s], sacc[kt]);
    }
  }
  float mx = -1e30f;
#pragma unroll
  for (int kt = 0; kt < 5; ++kt)
#pragma unroll
    for (int rr = 0; rr < 16; ++rr) {
      const int keyrow = (rr & 3) + 8 * (rr >> 2) + 4 * h;
      const int dist = 128 - 32 * kt + qi - keyrow;
      const bool valid = (kt >= kt_lo) && dist >= 0 && dist <= 128;
      const float s = valid ? sacc[kt][rr] : -1e30f;
      sacc[kt][rr] = s;
      mx = fmaxf(mx, s);
    }
  mx = fmaxf(mx, __shfl_xor(mx, 32));
  float sum = 0.f;
#pragma unroll
  for (int kt = 0; kt < 5; ++kt)
#pragma unroll
    for (int rr = 0; rr < 16; ++rr) {
      const float s = sacc[kt][rr];
      const float ex = (s > -1e29f) ? __expf(s - mx) : 0.f;
      sacc[kt][rr] = ex;
      sum += ex;
    }
  sum += __shfl_xor(sum, 32);
  f32x16 oacc[2];
#pragma unroll
  for (int i = 0; i < 16; ++i) { oacc[0][i] = 0.f; oacc[1][i] = 0.f; }
#pragma unroll
  for (int kt = 0; kt < 5; ++kt) {
    if (kt >= kt_lo) {
#pragma unroll
      for (int s2 = 0; s2 < 2; ++s2) {
        bf16x8 pf;
#pragma unroll
        for (int j = 0; j < 8; ++j) pf[j] = (short)f2bf(sacc[kt][8 * s2 + j]);
        bf16x8 v0, v1;
#pragma unroll
        for (int j = 0; j < 8; ++j) {
          const int kr = 16 * s2 + 8 * (j >> 2) + 4 * h + (j & 3);
          if (SAMPLE && kt < 4) {
            const float* vp = cache + (size_t)(r + dl * (32 * kt + kr)) * 256 + 128 + qi;
            v0[j] = (short)f2bf(vp[0]); v1[j] = (short)f2bf(vp[32]);
          } else {
            int tk;
            if (SAMPLE) tk = r + dl * (kr < nq ? kr : 0); else tk = (m0 - 128 + 32 * kt + kr) * dl + r;
            const u16* vp = projb + (size_t)tk * IC + C_V + head * 64 + qi;
            v0[j] = (short)vp[0]; v1[j] = (short)vp[32];
          }
        }
        oacc[0] = MFMA32(v0, pf, oacc[0]);
        oacc[1] = MFMA32(v1, pf, oacc[1]);
      }
    }
  }
  const float isum = 1.0f / sum;
  const size_t rowq = SAMPLE ? (size_t)NP + b * 8 + tq : (size_t)b * 2048 + tq;
  if (!SAMPLE || qi < nq) {
    float* op = p.opart + ((size_t)g * MT + rowq) * 128 + hslot * 64;
#pragma unroll
    for (int db = 0; db < 2; ++db)
#pragma unroll
      for (int i4 = 0; i4 < 4; ++i4) {
        float4 o; o.x = oacc[db][4 * i4] * isum; o.y = oacc[db][4 * i4 + 1] * isum; o.z = oacc[db][4 * i4 + 2] * isum; o.w = oacc[db][4 * i4 + 3] * isum;
        *(float4*)(op + db * 32 + 8 * i4 + 4 * h) = o;
      }
    if (h == 0) p.lse[((size_t)g * MT + rowq) * 2 + hslot] = mx + __logf(sum);
  }
}

__device__ __forceinline__ void kv_row_task(const Params& p, const int l, const int row, const int lane) {
  const int hl = lane < 48 ? lane : 47;
  const int head = hl >> 3, c8 = hl & 7;
  int b, t, ridx;
  const bool prompt = row < NP;
  if (prompt) { b = row >> 11; t = row & 2047; ridx = t; } else { b = (row - NP) >> 3; t = (row - NP) & 7; ridx = 2048 + t; }
  const u16* pr = p.proj + (size_t)row * IC;
  const bf16x8 kr = *(const bf16x8*)(pr + C_K + hl * 8);
  const bf16x8 vr = *(const bf16x8*)(pr + C_V + hl * 8);
  float f[8]; float ss = 0.f;
#pragma unroll
  for (int j = 0; j < 8; ++j) { f[j] = bfs2f(kr[j]); ss += f[j] * f[j]; }
  ss += __shfl_xor(ss, 1); ss += __shfl_xor(ss, 2); ss += __shfl_xor(ss, 4);
  const float inv = rsqrtf(ss * (1.0f / 64.0f) + EPS);
  const float* gk = p.k_norm_g + l * 64 + c8 * 8;
#pragma unroll
  for (int j = 0; j < 8; ++j) f[j] *= inv * gk[j];
  const float* rp = p.rope + ridx * 16;
#pragma unroll
  for (int j = 0; j < 8; ++j) {
    const float other = __shfl_xor(f[j], 1);
    const float cs = rp[j], sn = rp[8 + j];
    if (c8 == 0) f[j] = f[j] * cs - other * sn;
    else if (c8 == 1) f[j] = f[j] * cs + other * sn;
  }
  const int g = head >> 1, hh = head & 1;
  const int W = 128 << (2 * g);
  float* dst = nullptr;
  if (prompt) {
    const int r = t - (2048 - W);
    const size_t base = (g == 0) ? O_KV128P : (g == 1) ? O_KV512P : O_KV2048P;
    if (r >= 0) dst = p.out + base + ((size_t)(l * 8 + b) * W + r) * 256 + hh * 64 + c8 * 8;
  } else {
    const int r = W - 8 + t;
    const size_t base = (g == 0) ? O_KV128S : (g == 1) ? O_KV512S : O_KV2048S;
    dst = p.out + base + ((size_t)(l * 32 + b) * W + r) * 256 + hh * 64 + c8 * 8;
  }
  if (dst && lane < 48) {
    *(float4*)(dst) = make_float4(f[0], f[1], f[2], f[3]);
    *(float4*)(dst + 4) = make_float4(f[4], f[5], f[6], f[7]);
    *(float4*)(dst + 128) = make_float4(bfs2f(vr[0]), bfs2f(vr[1]), bfs2f(vr[2]), bfs2f(vr[3]));
    *(float4*)(dst + 132) = make_float4(bfs2f(vr[4]), bfs2f(vr[5]), bfs2f(vr[6]), bfs2f(vr[7]));
  }
}

__device__ void phaseA(const Params& p, const int l, const int wave_s) {
  const int tid = opaque_tid(wave_s);
  const int lane = tid & 63, wid = tid >> 6;
  const int gw = blockIdx.x * 8 + wid, nw = gridDim.x * 8;
  for (int task = gw; task < 832 + 3072; task += nw) { if (task < 832) attn_task<true>(p, l, task, lane); else attn_task<false>(p, l, task - 832, lane); }
  for (int row = nw - 1 - gw; row < MT; row += nw) kv_row_task(p, l, row, lane);
}

template <int GRP>
__device__ __forceinline__ void pool_task(const Params& p, const int l, const int task, const int lane) {
  const int tile = task >> 2; constexpr int grp = GRP;
  const int qi = lane & 31, h = lane >> 5;
  const int row = tile * 32 + qi;
  constexpr int w = 2 << GRP;
  const bool prompt = row < NP;
  int n, t; float cnt;
  if (prompt) { n = row >> 11; t = row & 2047; cnt = (float)min(t + 1, w); } else { n = (row - NP) >> 3; t = (row - NP) & 7; cnt = (float)w; }
  const float icnt = 1.0f / cnt;
  f32x16 acc[2];
#pragma unroll
  for (int i = 0; i < 16; ++i) { acc[0][i] = 0.f; acc[1][i] = 0.f; }
  const u16* pw = p.pwT + (size_t)(l * 4 + grp) * 4096;
#pragma unroll
  for (int s = 0; s < 4; ++s) {
    const int c0 = grp * 64 + 16 * s + 8 * h;
    float sum[8], own[8];
#pragma unroll
    for (int j = 0; j < 8; ++j) { sum[j] = 0.f; own[j] = 0.f; }
#pragma unroll
    for (int i = 0; i < w; ++i) {
      const int tt = t - i;
      float v[8];
      if (tt >= 0) {
        const bf16x8 raw = *(const bf16x8*)(p.proj + (size_t)(row - i) * IC + C_U + c0);
#pragma unroll
        for (int j = 0; j < 8; ++j) v[j] = bfs2f(raw[j]);
      } else if (!prompt) {
        const float* sp = p.state_pool + ((size_t)(l * 32 + n) * 15 + 15 + tt) * 256 + c0;
        const float4 a = *(const float4*)sp, bb = *(const float4*)(sp + 4);
        v[0] = a.x; v[1] = a.y; v[2] = a.z; v[3] = a.w; v[4] = bb.x; v[5] = bb.y; v[6] = bb.z; v[7] = bb.w;
      } else {
#pragma unroll
        for (int j = 0; j < 8; ++j) v[j] = 0.f;
      }
#pragma unroll
      for (int j = 0; j < 8; ++j) sum[j] += v[j];
      if (i == 0) {
#pragma unroll
        for (int j = 0; j < 8; ++j) own[j] = v[j];
      }
    }
    bf16x8 df;
#pragma unroll
    for (int j = 0; j < 8; ++j) df[j] = (short)f2bf(sum[j] * icnt - own[j]);
    const bf16x8 a0 = *(const bf16x8*)(pw + (size_t)qi * 64 + 16 * s + 8 * h);
    const bf16x8 a1 = *(const bf16x8*)(pw + (size_t)(qi + 32) * 64 + 16 * s + 8 * h);
    acc[0] = MFMA32(a0, df, acc[0]);
    acc[1] = MFMA32(a1, df, acc[1]);
  }
  const float* ps = p.pool_scale + l * 256 + grp * 64;
  u16* mp = p.mixed + (size_t)row * MC + grp * 64;
#pragma unroll
  for (int db = 0; db < 2; ++db)
#pragma unroll
    for (int i4 = 0; i4 < 4; ++i4) {
      const int dd0 = db * 32 + 8 * i4 + 4 * h;
      const float4 sc = *(const float4*)(ps + dd0);
      uint2 o; o.x = pack2(acc[db][4 * i4] * sc.x, acc[db][4 * i4 + 1] * sc.y); o.y = pack2(acc[db][4 * i4 + 2] * sc.z, acc[db][4 * i4 + 3] * sc.w);
      *(uint2*)(mp + dd0) = o;
    }
}

__device__ void phaseB(const Params& p, const int l, const int wave_s) {
  const int tid = opaque_tid(wave_s), lane = tid & 63, wid = tid >> 6;
  const int gw = blockIdx.x * 8 + wid, nw = gridDim.x * 8;
  const size_t gt = (size_t)blockIdx.x * 512 + tid, ntd = (size_t)gridDim.x * 512;
  for (int task = gw; task < 520 * 4; task += nw) {
    switch (task & 3) { case 0: pool_task<0>(p, l, task, lane); break; case 1: pool_task<1>(p, l, task, lane); break;
                        case 2: pool_task<2>(p, l, task, lane); break; default: pool_task<3>(p, l, task, lane); break; }
  }
  for (size_t idx = gt; idx < (size_t)MT * 48; idx += ntd) {
    const int row = (int)(idx / 48), ch = (int)(idx % 48) * 8;
    const bool prompt = row < NP;
    int n, t;
    if (prompt) { n = row >> 11; t = row & 2047; } else { n = (row - NP) >> 3; t = (row - NP) & 7; }
    float z[3][8];
#pragma unroll
    for (int i = 0; i < 3; ++i) {
      const int tt = t - 2 + i;
      if (tt >= 0) {
        const u16* pr = p.proj + (size_t)(row - 2 + i) * IC;
        const bf16x8 gc = *(const bf16x8*)(pr + C_GC + ch), gh = *(const bf16x8*)(pr + C_GH + ch);
#pragma unroll
        for (int j = 0; j < 8; ++j) z[i][j] = bfs2f(gc[j]) * bfs2f(gh[j]);
      } else if (!prompt) {
        const float* sp = p.state_conv + ((size_t)(l * 32 + n) * 2 + 2 + tt) * 384 + ch;
        const float4 a = *(const float4*)sp, bb = *(const float4*)(sp + 4);
        z[i][0] = a.x; z[i][1] = a.y; z[i][2] = a.z; z[i][3] = a.w; z[i][4] = bb.x; z[i][5] = bb.y; z[i][6] = bb.z; z[i][7] = bb.w;
      } else {
#pragma unroll
        for (int j = 0; j < 8; ++j) z[i][j] = 0.f;
      }
    }
    const bf16x8 gb = *(const bf16x8*)(p.proj + (size_t)row * IC + C_GB + ch);
    const float* cw = p.conv_w + (size_t)l * 3 * 384 + ch;
    float y[8];
#pragma unroll
    for (int j = 0; j < 8; ++j) y[j] = bfs2f(gb[j]) * (cw[j] * z[0][j] + cw[384 + j] * z[1][j] + cw[768 + j] * z[2][j]);
    uint4 o; o.x = pack2(y[0], y[1]); o.y = pack2(y[2], y[3]); o.z = pack2(y[4], y[5]); o.w = pack2(y[6], y[7]);
    *(uint4*)(p.mixed + (size_t)row * MC + 384 + ch) = o;
    float* so = nullptr;
    if (prompt) { if (t >= 2046) so = p.out + O_CONVP + ((size_t)(l * 8 + n) * 2 + (t - 2046)) * 384 + ch; }
    else { if (t >= 6) so = p.out + O_CONVS + ((size_t)(l * 32 + n) * 2 + (t - 6)) * 384 + ch; }
    if (so) { *(float4*)so = make_float4(z[2][0], z[2][1], z[2][2], z[2][3]); *(float4*)(so + 4) = make_float4(z[2][4], z[2][5], z[2][6], z[2][7]); }
  }
  for (size_t idx = gt; idx < (size_t)MT * 16; idx += ntd) {
    const int row = (int)(idx >> 4), chunk = (int)(idx & 15);
    const int hslot = chunk >> 3, d0 = (chunk & 7) * 8;
    float lg[3];
#pragma unroll
    for (int g = 0; g < 3; ++g) lg[g] = p.lse[((size_t)g * MT + row) * 2 + hslot];
    const float m = fmaxf(lg[0], fmaxf(lg[1], lg[2]));
    float wg[3]; wg[0] = __expf(lg[0] - m); wg[1] = __expf(lg[1] - m); wg[2] = __expf(lg[2] - m);
    const float iw = 1.0f / (wg[0] + wg[1] + wg[2]);
    float y[8];
#pragma unroll
    for (int j = 0; j < 8; ++j) y[j] = 0.f;
#pragma unroll
    for (int g = 0; g < 3; ++g) {
      const float* op = p.opart + ((size_t)g * MT + row) * 128 + hslot * 64 + d0;
      const float4 a = *(const float4*)op, bb = *(const float4*)(op + 4);
      const float ww = wg[g] * iw;
      y[0] += ww * a.x; y[1] += ww * a.y; y[2] += ww * a.z; y[3] += ww * a.w; y[4] += ww * bb.x; y[5] += ww * bb.y; y[6] += ww * bb.z; y[7] += ww * bb.w;
    }
    uint4 o; o.x = pack2(y[0], y[1]); o.y = pack2(y[2], y[3]); o.z = pack2(y[4], y[5]); o.w = pack2(y[6], y[7]);
    *(uint4*)(p.mixed + (size_t)row * MC + 256 + hslot * 64 + d0) = o;
  }
  for (size_t idx = gt; idx < (size_t)8 * 15 * 256; idx += ntd) {
    const int c = (int)(idx & 255); const int bi = (int)(idx >> 8); const int i = bi % 15, b = bi / 15;
    p.out[O_POOLP + (size_t)l * 8 * 15 * 256 + idx] = bf2f(p.proj[((size_t)b * 2048 + 2033 + i) * IC + C_U + c]);
  }
  for (size_t idx = gt; idx < (size_t)32 * 15 * 256; idx += ntd) {
    const int c = (int)(idx & 255); const int bi = (int)(idx >> 8); const int i = bi % 15, n = bi / 15;
    float v;
    if (i < 7) v = p.state_pool[((size_t)(l * 32 + n) * 15 + 8 + i) * 256 + c];
    else v = bf2f(p.proj[((size_t)NP + n * 8 + (i - 7)) * IC + C_U + c]);
    p.out[O_POOLS + (size_t)l * 32 * 15 * 256 + idx] = v;
  }
}

#ifndef REPM
#define REPM 0
#endif
#define NREP(k) (1 + ((REPM >> (k)) & 1))
typedef const __attribute__((address_space(4))) Params* CP;
#if defined(__HIP_DEVICE_COMPILE__)
#define LOAD_PARAMS() CP pp_ = (CP)__builtin_amdgcn_kernarg_segment_ptr(); asm volatile("" : "+s"(pp_)); const Params p = *pp_
#else
#define LOAD_PARAMS() const Params& p = p_unused
#endif
__global__ void __launch_bounds__(512, 2) mega(const Params p_unused, const int ph_lo, const int ph_hi) {
  const int wave_s = __builtin_amdgcn_readfirstlane((int)(threadIdx.x >> 6));
  if (ph_hi - ph_lo > 1) cg::this_grid().sync();
  int ph = 0;
#define IN_PH() (ph_lo <= ph && ph < ph_hi)
#define SEAM() do { if (ph_lo <= ph && ph + 1 < ph_hi) { LOAD_PARAMS(); grid_bar(p.bar, (unsigned)(ph - ph_lo + 1) * gridDim.x, wave_s); } ++ph; } while (0)
  if (IN_PH()) for (int rep = 0; rep < NREP(0); ++rep) { LOAD_PARAMS(); phase0(p, wave_s); }
  SEAM();
#pragma unroll 1
  for (int l = 0; l < 2; ++l) {
    if (IN_PH()) for (int rep = 0; rep < NREP(1); ++rep) {
      LOAD_PARAMS();
      GemmEpi e{}; e.sumsq_in = p.sumsq + (size_t)(2 * l) * MT; e.out_bf = p.proj; e.ldo = IC;
      gemm_phase<1>(p.xg, p.wt_in + (size_t)l * IC * D, NP, IC, D, e, wave_s);
      { const int G = gridDim.x, first = (64 * (IC / 256)) % G;
        const int b0 = first ? first : 0, nb = G - b0;
        kv_shift_copy(p, l, b0, nb, opaque_tid(wave_s));
        sample_gemm<1>(p.xg, p.wt_in + (size_t)l * IC * D, IC, D, e, wave_s, b0, nb); }
    }
    SEAM();
    if (IN_PH()) for (int rep = 0; rep < NREP(2); ++rep) { LOAD_PARAMS(); phaseA(p, l, wave_s); }
    SEAM();
    if (IN_PH()) for (int rep = 0; rep < NREP(3); ++rep) { LOAD_PARAMS(); phaseB(p, l, wave_s); }
    SEAM();
    if (IN_PH()) for (int rep = 0; rep < NREP(4); ++rep) {
      LOAD_PARAMS();
      GemmEpi e{};
      if (l == 0) { e.resid_p = p.x_prompt; e.resid_s = p.x_sample; } else { e.resid_p = p.xb; e.resid_s = p.xb + (size_t)NP * D; }
      e.out_p = p.xa; e.out_s = p.xa + (size_t)NP * D;
      e.out_xg = p.xg; e.gnext = p.norm2_g + l * D; e.sumsq_out = p.sumsq + (size_t)(2 * l + 1) * MT;
      if (rep) e.sumsq_out = nullptr;
      gemm_phase<2>(p.mixed, p.wt_out + (size_t)l * D * MC, NP, D, MC, e, wave_s);
      sample_gemm<2>(p.mixed, p.wt_out + (size_t)l * D * MC, D, MC, e, wave_s, 0, gridDim.x);
    }
    SEAM();
    if (IN_PH()) for (int rep = 0; rep < NREP(5); ++rep) {
      LOAD_PARAMS();
      GemmEpi e{}; e.sumsq_in = p.sumsq + (size_t)(2 * l + 1) * MT; e.out_bf = p.hf; e.ldo = FF;
      gemm_phase<3>(p.xg, p.wt_up + (size_t)l * FF * D, NP, FF, D, e, wave_s);
      sample_gemm<3>(p.xg, p.wt_up + (size_t)l * FF * D, FF, D, e, wave_s, 0, gridDim.x);
    }
    SEAM();
    if (IN_PH()) for (int rep = 0; rep < NREP(6); ++rep) {
      LOAD_PARAMS();
      GemmEpi e{};
      e.resid_p = p.xa; e.resid_s = p.xa + (size_t)NP * D;
      if (l == 0) { e.out_p = p.xb; e.out_s = p.xb + (size_t)NP * D; e.out_xg = p.xg; e.gnext = p.norm1_g + D; e.sumsq_out = p.sumsq + (size_t)2 * MT; }
      else { e.out_p = p.out + O_YP; e.out_s = p.out + O_YS; e.out_xg = nullptr; e.gnext = nullptr; e.sumsq_out = nullptr; }
      if (rep) e.sumsq_out = nullptr;
      gemm_phase<2>(p.hf, p.wt_down + (size_t)l * D * FF, NP, D, FF, e, wave_s);
      sample_gemm<2>(p.hf, p.wt_down + (size_t)l * D * FF, D, FF, e, wave_s, 0, gridDim.x);
    }
    SEAM();
  }
}

extern "C" void kernel_launch(void* const* d_in, const int* in_sizes, int n_in, void* d_out, int out_size, void* d_ws, size_t ws_size, hipStream_t stream) {
  static int grid_blocks = 0;
  if (!grid_blocks) {
    int dev = 0, cus = 0, per_cu = 0;
    hipGetDevice(&dev);
    hipDeviceGetAttribute(&cus, hipDeviceAttributeMultiprocessorCount, dev);
    hipFuncSetAttribute((const void*)mega, hipFuncAttributeMaxDynamicSharedMemorySize, GEMM_LDS);
    hipOccupancyMaxActiveBlocksPerMultiprocessor(&per_cu, (const void*)mega, 512, GEMM_LDS);
    if (per_cu < 1) { fprintf(stderr, "occupancy query returned %d\n", per_cu); per_cu = 1; }
    grid_blocks = cus * 1;
  }
  Params p{};
  p.x_prompt = (const float*)d_in[0]; p.x_sample = (const float*)d_in[1]; p.state_pool = (const float*)d_in[2]; p.state_conv = (const float*)d_in[3];
  p.kv_in[0] = (const float*)d_in[4]; p.kv_in[1] = (const float*)d_in[5]; p.kv_in[2] = (const float*)d_in[6];
  p.norm1_g = (const float*)d_in[7]; p.w_in = (const float*)d_in[8]; p.q_norm_g = (const float*)d_in[9]; p.k_norm_g = (const float*)d_in[10];
  p.pool_w = (const float*)d_in[11]; p.pool_scale = (const float*)d_in[12]; p.conv_w = (const float*)d_in[13]; p.w_out = (const float*)d_in[14];
  p.norm2_g = (const float*)d_in[15]; p.w_up = (const float*)d_in[16]; p.w_down = (const float*)d_in[17];
  p.out = (float*)d_out;
  unsigned char* w = (unsigned char*)d_ws; size_t off = 0;
  auto carve = [&](size_t bytes) { unsigned char* r = w + off; off += (bytes + 255) & ~(size_t)255; return r; };
  p.bar = (unsigned*)carve(256);
  p.wt_in = (u16*)carve((size_t)2 * IC * D * 2);
  p.wt_out = (u16*)carve((size_t)2 * D * MC * 2);
  p.wt_up = (u16*)carve((size_t)2 * FF * D * 2);
  p.wt_down = (u16*)carve((size_t)2 * D * FF * 2);
  p.pwT = (u16*)carve((size_t)2 * 4 * 4096 * 2);
  p.xg = (u16*)carve((size_t)MT * D * 2);
  p.mixed = (u16*)carve((size_t)MT * MC * 2);
  p.xa = (float*)carve((size_t)MT * D * 4);
  p.xb = (float*)carve((size_t)MT * D * 4);
  p.sumsq = (float*)carve((size_t)4 * MT * 4);
  p.lse = (float*)carve((size_t)3 * MT * 2 * 4);
  p.rope = (float*)carve((size_t)2056 * 16 * 4);
  p.hf = (u16*)carve((size_t)MT * FF * 2);
  p.proj = p.hf;
  p.opart = (float*)((unsigned char*)p.hf + (((size_t)MT * IC * 2 + 255) & ~(size_t)255));
  if (off > ws_size) { fprintf(stderr, "workspace too small: need %zu have %zu\n", off, ws_size); return; }
  (void)hipMemsetAsync(p.bar, 0, 256, stream);
  int lo = 0, hi = 13;
  void* args[] = {(void*)&p, (void*)&lo, (void*)&hi};
  hipError_t e = hipLaunchCooperativeKernel((const void*)mega, dim3(grid_blocks), dim3(512), args, GEMM_LDS, stream);
  if (e != hipSuccess) fprintf(stderr, "cooperative launch failed: %s (grid %d)\n", hipGetErrorString(e), grid_blocks);
}
```

```cpp
#include <hip/hip_runtime.h>
#include <hip/hip_cooperative_groups.h>
#include <cstdio>
namespace cg = cooperative_groups;

typedef unsigned short u16;
using bf16x8 = __attribute__((ext_vector_type(8))) short;
using f32x4 = __attribute__((ext_vector_type(4))) float;
using f32x16 = __attribute__((ext_vector_type(16))) float;

constexpr int NP = 16384, NS = 256, MT = NP + NS;
constexpr int D = 1024, IC = 2560, MC = 768, FF = 4096;
constexpr float EPS = 1e-6f;
constexpr int C_U = 0, C_Q = 256, C_K = 640, C_V = 1024, C_GB = 1408, C_GC = 1792, C_GH = 2176;
constexpr size_t O_YP = 0;
constexpr size_t O_YS = O_YP + (size_t)NP * D;
constexpr size_t O_POOLP = O_YS + (size_t)NS * D;
constexpr size_t O_CONVP = O_POOLP + 2 * 8 * 15 * 256;
constexpr size_t O_KV128P = O_CONVP + 2 * 8 * 2 * 384;
constexpr size_t O_KV512P = O_KV128P + (size_t)2 * 8 * 128 * 256;
constexpr size_t O_KV2048P = O_KV512P + (size_t)2 * 8 * 512 * 256;
constexpr size_t O_POOLS = O_KV2048P + (size_t)2 * 8 * 2048 * 256;
constexpr size_t O_CONVS = O_POOLS + 2 * 32 * 15 * 256;
constexpr size_t O_KV128S = O_CONVS + 2 * 32 * 2 * 384;
constexpr size_t O_KV512S = O_KV128S + (size_t)2 * 32 * 128 * 256;
constexpr size_t O_KV2048S = O_KV512S + (size_t)2 * 32 * 512 * 256;

struct Params {
  const float *x_prompt, *x_sample, *state_pool, *state_conv, *kv_in[3];
  const float *norm1_g, *w_in, *q_norm_g, *k_norm_g, *pool_w, *pool_scale, *conv_w, *w_out, *norm2_g, *w_up, *w_down;
  float* out;
  u16 *wt_in, *wt_out, *wt_up, *wt_down, *pwT;
  u16 *xg, *proj, *mixed, *hf;
  float *sumsq, *opart, *lse, *rope;
  unsigned* bar;
};

extern __shared__ __attribute__((aligned(16))) unsigned char smem[];
typedef __attribute__((address_space(3))) void* LDSP;

__device__ __forceinline__ u16 f2bf(float f) { unsigned u = __float_as_uint(f); u += 0x7fffu + ((u >> 16) & 1u); return (u16)(u >> 16); }
__device__ __forceinline__ float bf2f(u16 h) { return __uint_as_float(((unsigned)h) << 16); }
__device__ __forceinline__ float bfs2f(short h) { return __uint_as_float(((unsigned)(u16)h) << 16); }
__device__ __forceinline__ unsigned pack2(float a, float b) { return (unsigned)f2bf(a) | ((unsigned)f2bf(b) << 16); }
__device__ __forceinline__ int opaque_tid(const int wave_s) {
  int l; asm volatile("v_mbcnt_lo_u32_b32 %0, -1, 0\n\tv_mbcnt_hi_u32_b32 %0, -1, %0" : "=v"(l));
  return wave_s * 64 + l;
}
__device__ __forceinline__ int opaque_lane() {
  int l; asm volatile("v_mbcnt_lo_u32_b32 %0, -1, 0\n\tv_mbcnt_hi_u32_b32 %0, -1, %0" : "=v"(l));
  return l;
}
__device__ __forceinline__ void grid_bar(unsigned* cnt, const unsigned target, const int wave_s) {
  asm volatile("s_waitcnt vmcnt(0)" ::: "memory");
  __syncthreads();
  if (opaque_tid(wave_s) == 0) {
    __builtin_amdgcn_fence(__ATOMIC_RELEASE, "agent");
    asm volatile("s_waitcnt vmcnt(0)" ::: "memory");
    __hip_atomic_fetch_add(cnt, 1u, __ATOMIC_RELAXED, __HIP_MEMORY_SCOPE_AGENT);
    while (__hip_atomic_load(cnt, __ATOMIC_RELAXED, __HIP_MEMORY_SCOPE_AGENT) < target) __builtin_amdgcn_s_sleep(4);
    __builtin_amdgcn_fence(__ATOMIC_ACQUIRE, "agent");
    asm volatile("s_waitcnt vmcnt(0)" ::: "memory");
  }
  __syncthreads();
}
__device__ __forceinline__ float wave_sum(float v) { for (int o = 32; o; o >>= 1) v += __shfl_xor(v, o); return v; }
__device__ __forceinline__ float wave_max(float v) { for (int o = 32; o; o >>= 1) v = fmaxf(v, __shfl_xor(v, o)); return v; }

constexpr int BM = 256, BK = 64, HALF = 128, NXCD = 8, WGM = 8, HT = HALF * BK;
constexpr int GEMM_LDS = 8 * HT * 2;

__device__ __forceinline__ int lds_byte(int r, int c) {
  int st = (r >> 4) * 2 + (c >> 5), rr = r & 15, cc = c & 31, ob = rr * 64 + cc * 2;
  return st * 1024 + (ob ^ (((ob >> 9) & 1) << 5));
}
__device__ __forceinline__ int perm32(int rho) { const int n = rho >> 4, i = rho & 15; return 8 * (i >> 2) + 4 * n + (i & 3); }
__device__ __forceinline__ void stage_rc(int b, int& R, int& C) {
  int st = b / 1024, sb = b % 1024, swz = sb ^ (((sb >> 9) & 1) << 5);
  R = (st >> 1) * 16 + swz / 64; C = (st & 1) * 32 + (swz % 64) / 2;
}

struct GemmEpi {
  const float* sumsq_in;
  u16* out_bf; int ldo;
  u16* xh;
  float* out_f;
  float* sumsq_out;
};

template <int MODE, bool ADD_RESID>
__device__ __forceinline__ void epi4(const GemmEpi& e, const f32x4 a, const float rs, const size_t grow, const int col0, float& ssq) {
  if (MODE == 1 || MODE == 3) {
    float v0 = a[0] * rs, v1 = a[1] * rs, v2 = a[2] * rs, v3 = a[3] * rs;
    if (MODE == 3) { v0 = fmaxf(v0, 0.f); v1 = fmaxf(v1, 0.f); v2 = fmaxf(v2, 0.f); v3 = fmaxf(v3, 0.f); v0 *= v0; v1 *= v1; v2 *= v2; v3 *= v3; }
    uint2 o; o.x = pack2(v0, v1); o.y = pack2(v2, v3);
    *(uint2*)(e.out_bf + grow * e.ldo + col0) = o;
  } else {
    float4 x; x.x = a[0]; x.y = a[1]; x.z = a[2]; x.w = a[3];
    if (ADD_RESID) {
      const uint2 r = *(const uint2*)(e.xh + grow * D + col0);
      x.x += __uint_as_float(r.x << 16); x.y += __uint_as_float(r.x & 0xffff0000u); x.z += __uint_as_float(r.y << 16); x.w += __uint_as_float(r.y & 0xffff0000u);
    }
    if (e.out_f) *(float4*)(e.out_f + grow * D + col0) = x;
    else { uint2 ob; ob.x = pack2(x.x, x.y); ob.y = pack2(x.z, x.w); *(uint2*)(e.xh + grow * D + col0) = ob; }
    ssq += x.x * x.x + x.y * x.y + x.z * x.z + x.w * x.w;
  }
}

template <int MODE>
__device__ __forceinline__ void epi8(const GemmEpi& e, const f32x4 a0, const f32x4 a1, const float rs, const size_t grow, const int col8, float& ssq) {
  float v[8] = {a0[0], a0[1], a0[2], a0[3], a1[0], a1[1], a1[2], a1[3]};
  if (MODE == 1 || MODE == 3) {
#pragma unroll
    for (int i = 0; i < 8; ++i) { v[i] *= rs; if (MODE == 3) { v[i] = fmaxf(v[i], 0.f); v[i] *= v[i]; } }
    uint4 o; o.x = pack2(v[0], v[1]); o.y = pack2(v[2], v[3]); o.z = pack2(v[4], v[5]); o.w = pack2(v[6], v[7]);
    *(uint4*)(e.out_bf + grow * e.ldo + col8) = o;
  } else {
    if (e.out_f) { *(float4*)(e.out_f + grow * D + col8) = make_float4(v[0], v[1], v[2], v[3]); *(float4*)(e.out_f + grow * D + col8 + 4) = make_float4(v[4], v[5], v[6], v[7]); }
    else { uint4 o; o.x = pack2(v[0], v[1]); o.y = pack2(v[2], v[3]); o.z = pack2(v[4], v[5]); o.w = pack2(v[6], v[7]); *(uint4*)(e.xh + grow * D + col8) = o; }
#pragma unroll
    for (int i = 0; i < 8; ++i) ssq += v[i] * v[i];
  }
}

template <int MODE>
__device__ __forceinline__ void gemm_phase(const u16* __restrict__ A, const u16* __restrict__ Bt, const int M, const int N, const int K, const GemmEpi e, const int wave_s) {
  u16* shm = (u16*)smem;
#define SA(b, h) (shm + ((b) * 2 + (h)) * HT)
#define SB(b, h) (shm + (4 + (b) * 2 + (h)) * HT)
#define STAGE_(P, RS, br, kt, o0, o1) do { const unsigned _so = (unsigned)(((br) * K + (kt) * BK) * 2); \
    __builtin_amdgcn_raw_ptr_buffer_load_lds(RS, (LDSP)((char*)(P) + tid0 * 16), 16, o0, _so, 0, 0); \
    __builtin_amdgcn_raw_ptr_buffer_load_lds(RS, (LDSP)((char*)(P) + tid0 * 16 + 8192), 16, o1, _so, 0, 0); } while (0)
#define STAGE(P, RS, br, kt) STAGE_(P, RS, br, kt, toff0, toff1)
#define STAGEB(P, RS, br, kt) STAGE_(P, RS, br, kt, toffb0, toffb1)
#define LDA(dst, b, h) for (int m = 0; m < 4; ++m) for (int k = 0; k < 2; ++k) \
    dst[m][k] = *reinterpret_cast<const bf16x8*>((char*)SA(b, h) + lds_byte(wr * 64 + m * 16 + fr, k * 32 + fq * 8))
#define LDB(dst, b, h) for (int n = 0; n < 2; ++n) for (int k = 0; k < 2; ++k) \
    dst[n][k] = *reinterpret_cast<const bf16x8*>((char*)SB(b, h) + lds_byte(wc * 32 + n * 16 + fr, k * 32 + fq * 8))
#define MMA(ai, bj, At, Bt_) do { __builtin_amdgcn_s_setprio(1); \
    for (int m = 0; m < 4; ++m) for (int n = 0; n < 2; ++n) for (int k = 0; k < 2; ++k) \
      acc[ai][bj][m][n] = __builtin_amdgcn_mfma_f32_16x16x32_bf16(Bt_[n][k], At[m][k], acc[ai][bj][m][n], 0, 0, 0); \
    __builtin_amdgcn_s_setprio(0); } while (0)
#define WAIT_V(n) asm volatile("s_waitcnt vmcnt(" #n ")" ::: "memory")
#define WAIT_L(n) asm volatile("s_waitcnt lgkmcnt(" #n ")" ::: "memory")
#define BAR __builtin_amdgcn_s_barrier()
#define SCHED __builtin_amdgcn_sched_barrier(0)
#define DECODE(tt_, brow_, bcol_) do { int wgid = (tt_); \
    { int q = nwg / NXCD, r = nwg % NXCD, xcd = wgid % NXCD, off = wgid / NXCD; \
      wgid = (xcd < r ? xcd * (q + 1) : r * (q + 1) + (xcd - r) * q) + off; } \
    int nig = WGM * nN, gid = wgid / nig, fm = gid * WGM, gsz = min(nM - fm, WGM); \
    brow_ = (fm + ((wgid % nig) % gsz)) * BM; bcol_ = ((wgid % nig) / gsz) * BM; } while (0)
#define STAGE7(brow_, bcol_) do { \
    STAGEB(SB(0, 0), rsB, bcol_, 0); STAGE(SA(0, 0), rsA, brow_, 0); \
    STAGEB(SB(0, 1), rsB, bcol_ + HALF, 0); STAGE(SA(0, 1), rsA, brow_ + HALF, 0); \
    STAGEB(SB(1, 0), rsB, bcol_, 1); STAGE(SA(1, 0), rsA, brow_, 1); STAGEB(SB(1, 1), rsB, bcol_ + HALF, 1); } while (0)

  const int nM = M / BM, nN = N / BM, nwg = nM * nN;
  const int nt = K / BK;
  unsigned toff0, toff1;
  const int tid0 = opaque_tid(wave_s);
  const int wr = (tid0 >> 6) >> 2, wc = (tid0 >> 6) & 3, fr = tid0 & 15, fq = (tid0 & 63) >> 4;
  unsigned toffb0, toffb1;
  { int r_, c_; stage_rc(tid0 * 16, r_, c_); toff0 = (unsigned)(r_ * K + c_) * 2u; toffb0 = (unsigned)(((r_ & ~31) | perm32(r_ & 31)) * K + c_) * 2u;
    stage_rc(tid0 * 16 + 8192, r_, c_); toff1 = (unsigned)(r_ * K + c_) * 2u; toffb1 = (unsigned)(((r_ & ~31) | perm32(r_ & 31)) * K + c_) * 2u; }
  const __amdgpu_buffer_rsrc_t rsA = __builtin_amdgcn_make_buffer_rsrc((void*)A, 0, -1, 0x00020000);
  const __amdgpu_buffer_rsrc_t rsB = __builtin_amdgcn_make_buffer_rsrc((void*)Bt, 0, -1, 0x00020000);
  int tt = blockIdx.x;
  int brow = 0, bcol = 0;
  if (tt < nwg) { DECODE(tt, brow, bcol); STAGE7(brow, bcol); WAIT_V(0); }
  f32x4 acc[2][2][4][2];
#define ACC_INIT(brow_, bcol_) do { \
    if (MODE == 2) { \
      const int t2 = opaque_tid(wave_s); const int wr_ = (t2 >> 6) >> 2, wc_ = (t2 >> 6) & 3, fr_ = t2 & 15, fq_ = (t2 & 63) >> 4; \
      const u16* rp_ = e.xh + (size_t)(brow_ + wr_ * 64 + fr_) * D + bcol_ + wc_ * 32 + fq_ * 8; \
      _Pragma("unroll") for (int ai = 0; ai < 2; ++ai) _Pragma("unroll") for (int bj = 0; bj < 2; ++bj) \
      _Pragma("unroll") for (int m = 0; m < 4; ++m) { \
        const uint4 x0 = *(const uint4*)(rp_ + (size_t)(ai * HALF + m * 16) * D + bj * HALF); \
        acc[ai][bj][m][0][0] = __uint_as_float(x0.x << 16); acc[ai][bj][m][0][1] = __uint_as_float(x0.x & 0xffff0000u); \
        acc[ai][bj][m][0][2] = __uint_as_float(x0.y << 16); acc[ai][bj][m][0][3] = __uint_as_float(x0.y & 0xffff0000u); \
        acc[ai][bj][m][1][0] = __uint_as_float(x0.z << 16); acc[ai][bj][m][1][1] = __uint_as_float(x0.z & 0xffff0000u); \
        acc[ai][bj][m][1][2] = __uint_as_float(x0.w << 16); acc[ai][bj][m][1][3] = __uint_as_float(x0.w & 0xffff0000u); } \
    } else { \
      _Pragma("unroll") for (int ai = 0; ai < 2; ++ai) _Pragma("unroll") for (int bj = 0; bj < 2; ++bj) \
      _Pragma("unroll") for (int m = 0; m < 4; ++m) _Pragma("unroll") for (int n = 0; n < 2; ++n) \
        acc[ai][bj][m][n] = (f32x4){0.f, 0.f, 0.f, 0.f}; \
    } } while (0)
  if (tt < nwg) ACC_INIT(brow, bcol);
  while (tt < nwg) {
    bf16x8 At[4][2], B0[2][2], B1[2][2];
    if (wr == 1) BAR;
    BAR;
    for (int t = 0; t < nt - 2; t += 2) {
      LDB(B0, 0, 0); SCHED; LDA(At, 0, 0); STAGE(SA(1, 1), rsA, brow + HALF, t + 1);
      WAIT_L(8); BAR; WAIT_L(0); MMA(0, 0, At, B0); BAR; SCHED;
      LDB(B1, 0, 1); STAGEB(SB(0, 0), rsB, bcol, t + 2);
      BAR; WAIT_L(0); MMA(0, 1, At, B1); BAR;
      LDA(At, 0, 1); STAGE(SA(0, 0), rsA, brow, t + 2);
      BAR; WAIT_L(0); MMA(1, 0, At, B0); BAR; SCHED;
      STAGEB(SB(0, 1), rsB, bcol + HALF, t + 2);
      WAIT_V(6); BAR; MMA(1, 1, At, B1); BAR;
      LDB(B0, 1, 0); SCHED; LDA(At, 1, 0); STAGE(SA(0, 1), rsA, brow + HALF, t + 2);
      WAIT_L(8); BAR; WAIT_L(0); MMA(0, 0, At, B0); BAR; SCHED;
      LDB(B1, 1, 1); STAGEB(SB(1, 0), rsB, bcol, t + 3);
      BAR; WAIT_L(0); MMA(0, 1, At, B1); BAR;
      LDA(At, 1, 1); STAGE(SA(1, 0), rsA, brow, t + 3);
      BAR; WAIT_L(0); MMA(1, 0, At, B0); BAR; SCHED;
      STAGEB(SB(1, 1), rsB, bcol + HALF, t + 3);
      WAIT_V(6); BAR; MMA(1, 1, At, B1); BAR;
    }
    { LDB(B0, 0, 0); LDA(At, 0, 0); STAGE(SA(1, 1), rsA, brow + HALF, nt - 1);
      BAR; WAIT_L(0); MMA(0, 0, At, B0); BAR;
      LDB(B1, 0, 1); BAR; WAIT_L(0); MMA(0, 1, At, B1); BAR;
      LDA(At, 0, 1); WAIT_V(4); BAR; WAIT_L(0); MMA(1, 0, At, B0); MMA(1, 1, At, B1); BAR; }
    { LDB(B0, 1, 0); LDA(At, 1, 0); WAIT_V(2); BAR; WAIT_L(0); MMA(0, 0, At, B0); BAR;
      LDB(B1, 1, 1); WAIT_V(0); BAR; WAIT_L(0); MMA(0, 1, At, B1); BAR;
      LDA(At, 1, 1); BAR; WAIT_L(0); MMA(1, 0, At, B0); MMA(1, 1, At, B1); BAR; }
    if (wr == 0) BAR;
    const int erow = brow, ecol = bcol;
    tt += gridDim.x;
    if (tt < nwg) { DECODE(tt, brow, bcol); STAGE7(brow, bcol); }
    SCHED;
    {
      const int tid1 = opaque_tid(wave_s);
      const int wr = (tid1 >> 6) >> 2, wc = (tid1 >> 6) & 3, fr = tid1 & 15, fq = (tid1 & 63) >> 4;
      float rsv[2][4];
#pragma unroll
      for (int ai = 0; ai < 2; ++ai)
#pragma unroll
        for (int m = 0; m < 4; ++m) {
          rsv[ai][m] = 0.f;
          if (MODE == 1 || MODE == 3) rsv[ai][m] = e.sumsq_in[(size_t)erow + ai * HALF + wr * 64 + m * 16 + fr];
        }
#pragma unroll
      for (int ai = 0; ai < 2; ++ai)
#pragma unroll
        for (int m = 0; m < 4; ++m) {
          const int lrow = ai * HALF + wr * 64 + m * 16 + fr;
          const size_t grow = (size_t)erow + lrow;
          float rs = 0.f, ssq = 0.f;
          if (MODE == 1 || MODE == 3) rs = rsqrtf(rsv[ai][m] * (1.0f / 1024.0f) + EPS);
#pragma unroll
          for (int bj = 0; bj < 2; ++bj)
            epi8<MODE>(e, acc[ai][bj][m][0], acc[ai][bj][m][1], rs, grow, ecol + bj * HALF + wc * 32 + fq * 8, ssq);
          if (MODE == 2 && e.sumsq_out) {
            ssq += __shfl_xor(ssq, 16); ssq += __shfl_xor(ssq, 32);
            if (fq == 0) atomicAdd(e.sumsq_out + grow, ssq);
          }
          SCHED;
        }
    }
    if (tt < nwg) ACC_INIT(brow, bcol);
    WAIT_V(16);
  }
  WAIT_V(0);
#undef SA
#undef SB
#undef STAGE
#undef STAGEB
#undef STAGE_
#undef LDA
#undef LDB
#undef MMA
}

#define MFMA32(a, b, c) __builtin_amdgcn_mfma_f32_32x32x16_bf16((a), (b), (c), 0, 0, 0)

template <int MODE>
__device__ __forceinline__ void sample_gemm(const u16* __restrict__ A, const u16* __restrict__ Bt, const int N, const int K, const GemmEpi e, const int wave_s, const int b0, const int nb) {
  const int bi = (int)blockIdx.x - b0;
  if (bi < 0 || bi >= nb) return;
  const int tid = opaque_tid(wave_s);
  const int lane = tid & 63, wid = tid >> 6;
  const int i = lane & 31, h = lane >> 5;
  const int ntask = 8 * (N / 32);
  const int ks = K / 8;
  float* red = (float*)smem;
  for (int id = bi; id < ntask; id += nb) {
    const int r0 = (id & 7) * 32, c0 = (id >> 3) * 32;
    const u16* ap = A + (size_t)(NP + r0 + i) * K + wid * ks + 8 * h;
    const u16* bp = Bt + (size_t)(c0 + i) * K + wid * ks + 8 * h;
    f32x16 acc;
#pragma unroll
    for (int q = 0; q < 16; ++q) acc[q] = 0.f;
#pragma unroll 8
    for (int k = 0; k < ks; k += 16) {
      const bf16x8 a = *(const bf16x8*)(ap + k);
      const bf16x8 b = *(const bf16x8*)(bp + k);
      acc = MFMA32(b, a, acc);
    }
#pragma unroll
    for (int q = 0; q < 4; ++q)
      *(float4*)(red + (wid * 32 + i) * 36 + 8 * q + 4 * h) = make_float4(acc[4 * q], acc[4 * q + 1], acc[4 * q + 2], acc[4 * q + 3]);
    __syncthreads();
    if (tid < 256) {
      const int row = tid >> 3, c4 = (tid & 7) * 4;
      f32x4 s4; s4[0] = 0.f; s4[1] = 0.f; s4[2] = 0.f; s4[3] = 0.f;
#pragma unroll
      for (int w = 0; w < 8; ++w) {
        const float4 v = *(const float4*)(red + (w * 32 + row) * 36 + c4);
        s4[0] += v.x; s4[1] += v.y; s4[2] += v.z; s4[3] += v.w;
      }
      const int srow = r0 + row, col0 = c0 + c4;
      const size_t grow = (size_t)NP + srow;
      float rs = 0.f, ssq = 0.f;
      if (MODE == 1 || MODE == 3) rs = rsqrtf(e.sumsq_in[grow] * (1.0f / 1024.0f) + EPS);
      epi4<MODE, true>(e, s4, rs, grow, col0, ssq);
      if (MODE == 2 && e.sumsq_out) {
        ssq += __shfl_xor(ssq, 1); ssq += __shfl_xor(ssq, 2); ssq += __shfl_xor(ssq, 4);
        if ((tid & 7) == 0) atomicAdd(e.sumsq_out + grow, ssq);
      }
    }
    __syncthreads();
  }
}

__device__ __forceinline__ void kv_shift_copy(const Params& p, const int l, const int b0, const int nb, const int tid) {
  const int bi = (int)blockIdx.x - b0;
  if (bi < 0 || bi >= nb) return;
  const size_t gt = (size_t)bi * 512 + tid, ntd = (size_t)nb * 512;
#pragma unroll
  for (int g = 0; g < 3; ++g) {
    const int W = 128 << (2 * g);
    const size_t n4 = (size_t)32 * W * 64;
    const size_t oo = (g == 0) ? O_KV128S : (g == 1) ? O_KV512S : O_KV2048S;
    const f32x4* src = (const f32x4*)p.kv_in[g] + (size_t)l * n4;
    f32x4* dst = (f32x4*)(p.out + oo) + (size_t)l * n4;
    const unsigned per = (unsigned)W * 64u, lim = (unsigned)(W - 8) * 64u;
    for (size_t i = gt; i < n4; i += ntd) {
      if (((unsigned)i % per) < lim) __builtin_nontemporal_store(__builtin_nontemporal_load(src + i + 512), dst + i);
    }
  }
}

__device__ __forceinline__ void tr_tile(const float* __restrict__ src, u16* __restrict__ dst, int K, int N, int k0, int n0, const int tid, const float* __restrict__ gain) {
  float* lt = (float*)smem;
  { const int kk = tid >> 4, n4 = tid & 15;
#pragma unroll
    for (int i = 0; i < 2; ++i) {
      const int k = kk + i * 32;
      const float4 v = *(const float4*)(src + (size_t)(k0 + k) * N + n0 + n4 * 4);
      float* d = lt + k * 65 + n4 * 4;
      d[0] = v.x; d[1] = v.y; d[2] = v.z; d[3] = v.w;
    } }
  __syncthreads();
  { const int n = tid >> 3, k8 = tid & 7;
    float f[8];
#pragma unroll
    for (int i = 0; i < 8; ++i) f[i] = lt[(k8 * 8 + i) * 65 + n] * (gain ? gain[k0 + k8 * 8 + i] : 1.0f);
    uint4 o; o.x = pack2(f[0], f[1]); o.y = pack2(f[2], f[3]); o.z = pack2(f[4], f[5]); o.w = pack2(f[6], f[7]);
    *(uint4*)(dst + (size_t)(n0 + n) * K + k0 + k8 * 8) = o; }
  __syncthreads();
}

__device__ void phase0(const Params& p, const int wave_s) {
  const int tid = opaque_tid(wave_s), lane = tid & 63, wid = tid >> 6;
  const int gw = blockIdx.x * 8 + wid, nw = gridDim.x * 8;
  const size_t gt = (size_t)blockIdx.x * 512 + tid, ntd = (size_t)gridDim.x * 512;
  for (int row = gw; row < MT; row += nw) {
    const float4* xr = (const float4*)(row < NP ? p.x_prompt + (size_t)row * D : p.x_sample + (size_t)(row - NP) * D);
    float ss = 0.f;
#pragma unroll
    for (int i = 0; i < 4; ++i) {
      const float4 v = xr[lane + 64 * i];
      ss += v.x * v.x + v.y * v.y + v.z * v.z + v.w * v.w;
      uint2 o; o.x = pack2(v.x, v.y); o.y = pack2(v.z, v.w);
      *(uint2*)(p.xg + (size_t)row * D + (lane + 64 * i) * 4) = o;
    }
    ss = wave_sum(ss);
    if (lane == 0) p.sumsq[row] = ss;
  }
  for (size_t i = gt; i < (size_t)3 * MT; i += ntd) p.sumsq[MT + i] = 0.f;
  for (size_t i = gt; i < (size_t)2056 * 8; i += ntd) {
    const int pi = (int)(i >> 3), fi = (int)(i & 7);
    const int pos = pi < 2048 ? pi : 8192 + (pi - 2048);
    float inv;
    switch (fi) { case 0: inv = 1.0f; break; case 1: inv = 0.1939227432012558f; break; case 2: inv = 0.03760603070259094f; break;
      case 3: inv = 0.007292664609849453f; break; case 4: inv = 0.0014142135623842478f; break; case 5: inv = 0.00027424818836152554f; break;
      case 6: inv = 5.318296098266728e-05f; break; default: inv = 1.0313386155758053e-05f; break; }
    const float ang = (float)pos * inv;
    p.rope[pi * 16 + fi] = cosf(ang);
    p.rope[pi * 16 + 8 + fi] = sinf(ang);
  }
  {
    float* lt = (float*)smem;
    constexpr int QL = (640 + 192 + 1024 + 1024) / 4;
    for (int t = blockIdx.x; t < 2 * QL; t += gridDim.x) {
      const int l = t / QL; int r = t % QL;
      const float* src; u16* dst; int K, N; const float* gain = nullptr;
      if (r < 160) { src = p.w_in + (size_t)l * D * IC; dst = p.wt_in + (size_t)l * IC * D; K = D; N = IC; gain = p.norm1_g + l * D; }
      else if (r < 208) { r -= 160; src = p.w_out + (size_t)l * MC * D; dst = p.wt_out + (size_t)l * D * MC; K = MC; N = D; }
      else if (r < 464) { r -= 208; src = p.w_up + (size_t)l * D * FF; dst = p.wt_up + (size_t)l * FF * D; K = D; N = FF; gain = p.norm2_g + l * D; }
      else { r -= 464; src = p.w_down + (size_t)l * FF * D; dst = p.wt_down + (size_t)l * D * FF; K = FF; N = D; }
      const int nq = N / 256;
      const int k0 = (r / nq) * 64, n0 = (r % nq) * 256;
      { const int kk = tid >> 6, n4 = tid & 63;
        float4 v[8];
#pragma unroll
        for (int i = 0; i < 8; ++i) v[i] = *(const float4*)(src + (size_t)(k0 + kk + 8 * i) * N + n0 + n4 * 4);
#pragma unroll
        for (int i = 0; i < 8; ++i) {
          const float gg = gain ? gain[k0 + kk + 8 * i] : 1.0f;
          *(float4*)(lt + (kk + 8 * i) * 260 + n4 * 4) = make_float4(v[i].x * gg, v[i].y * gg, v[i].z * gg, v[i].w * gg);
        } }
      __syncthreads();
      { const int n = tid >> 1, kh = (tid & 1) * 32;
        u16* dp = dst + (size_t)(n0 + n) * K + k0 + kh;
#pragma unroll
        for (int c = 0; c < 4; ++c) {
          float f[8];
#pragma unroll
          for (int i = 0; i < 8; ++i) f[i] = lt[(kh + c * 8 + i) * 260 + n];
          uint4 o; o.x = pack2(f[0], f[1]); o.y = pack2(f[2], f[3]); o.z = pack2(f[4], f[5]); o.w = pack2(f[6], f[7]);
          *(uint4*)(dp + c * 8) = o;
        } }
      __syncthreads();
    }
    for (int t = blockIdx.x; t < 8; t += gridDim.x)
      tr_tile(p.pool_w + (size_t)t * 4096, p.pwT + (size_t)t * 4096, 64, 64, 0, 0, tid, nullptr);
  }
}


__device__ __forceinline__ void load_qk(const u16* __restrict__ rowp, const float* __restrict__ ropep, const float* __restrict__ gain,
                                        const float scale, bf16x8 out[4], const int h) {
  float f[4][8];
  float ss = 0.f;
#pragma unroll
  for (int s = 0; s < 4; ++s) {
    const bf16x8 raw = *(const bf16x8*)(rowp + 16 * s + 8 * h);
#pragma unroll
    for (int j = 0; j < 8; ++j) { f[s][j] = bfs2f(raw[j]); ss += f[s][j] * f[s][j]; }
  }
  ss += __shfl_xor(ss, 32);
  const float inv = rsqrtf(ss * (1.0f / 64.0f) + EPS);
#pragma unroll
  for (int s = 0; s < 4; ++s) {
    const float4 g0 = *(const float4*)(gain + 16 * s + 8 * h), g1 = *(const float4*)(gain + 16 * s + 8 * h + 4);
    f[s][0] *= inv * g0.x; f[s][1] *= inv * g0.y; f[s][2] *= inv * g0.z; f[s][3] *= inv * g0.w;
    f[s][4] *= inv * g1.x; f[s][5] *= inv * g1.y; f[s][6] *= inv * g1.z; f[s][7] *= inv * g1.w;
  }
  {
    const float4 c0 = *(const float4*)(ropep), c1 = *(const float4*)(ropep + 4), s0 = *(const float4*)(ropep + 8), s1 = *(const float4*)(ropep + 12);
    const float cs[8] = {c0.x, c0.y, c0.z, c0.w, c1.x, c1.y, c1.z, c1.w};
    const float sn[8] = {s0.x, s0.y, s0.z, s0.w, s1.x, s1.y, s1.z, s1.w};
#pragma unroll
    for (int j = 0; j < 8; ++j) {
      const float other = __shfl_xor(f[0][j], 32);
      f[0][j] = (h == 0) ? (f[0][j] * cs[j] - other * sn[j]) : (f[0][j] * cs[j] + other * sn[j]);
    }
  }
#pragma unroll
  for (int s = 0; s < 4; ++s)
#pragma unroll
    for (int j = 0; j < 8; ++j) out[s][j] = (short)f2bf(f[s][j] * scale);
}

template <bool SAMPLE>
__device__ __forceinline__ void attn_task(const Params& p, const int layer, const int task, const int lane_unused) {
  const int lane = opaque_lane();
  int g, hslot, b, r, tile, nq;
  if (!SAMPLE) {
    const int c = task & 63; int tmp = task >> 6; g = tmp % 3; tmp /= 3; hslot = tmp & 1; b = tmp >> 1;
    const int tpc = 64 >> (2 * g);
    r = c / tpc; tile = c % tpc; nq = 32;
  } else {
    b = task / 26; const int rem = task % 26; hslot = rem / 13; const int c = rem % 13;
    if (c == 0) { g = 0; r = 0; nq = 8; } else if (c < 5) { g = 1; r = c - 1; nq = 2; } else { g = 2; r = c - 5; nq = 1; }
    tile = 4;
  }
  const int dl = 1 << (2 * g);
  const int W = 128 << (2 * g);
  const int m0 = tile * 32;
  const int head = 2 * g + hslot;
  const u16* projb = SAMPLE ? p.proj + (size_t)(NP + b * 8) * IC : p.proj + (size_t)b * 2048 * IC;
  const int ropeb = SAMPLE ? 2048 : 0;
  const float* cache = SAMPLE ? ((g == 0) ? p.kv_in[0] : (g == 1) ? p.kv_in[1] : p.kv_in[2]) + (size_t)(layer * 32 + b) * W * 256 + hslot * 64 : nullptr;
  const int qi = lane & 31, h = lane >> 5;
  int tq;
  if (SAMPLE) tq = r + dl * (qi < nq ? qi : 0); else tq = (m0 + qi) * dl + r;
  bf16x8 qf[4];
  load_qk(projb + (size_t)tq * IC + C_Q + head * 64, p.rope + (ropeb + tq) * 16, p.q_norm_g + layer * 64, 0.125f, qf, h);
  const int kt_lo = SAMPLE ? 0 : max(0, 4 - tile);
  f32x16 sacc[5];
#pragma unroll
  for (int kt = 0; kt < 5; ++kt) {
#pragma unroll
    for (int i = 0; i < 16; ++i) sacc[kt][i] = 0.f;
    if (kt >= kt_lo) {
      bf16x8 kf[4];
      if (SAMPLE && kt < 4) {
        const float* kp = cache + (size_t)(r + dl * (32 * kt + qi)) * 256 + 8 * h;
#pragma unroll
        for (int s = 0; s < 4; ++s) {
          const float4 x0 = *(const float4*)(kp + 16 * s), x1 = *(const float4*)(kp + 16 * s + 4);
          kf[s][0] = (short)f2bf(x0.x); kf[s][1] = (short)f2bf(x0.y); kf[s][2] = (short)f2bf(x0.z); kf[s][3] = (short)f2bf(x0.w);
          kf[s][4] = (short)f2bf(x1.x); kf[s][5] = (short)f2bf(x1.y); kf[s][6] = (short)f2bf(x1.z); kf[s][7] = (short)f2bf(x1.w);
        }
      } else {
        int tk;
        if (SAMPLE) tk = r + dl * (qi < nq ? qi : 0); else tk = (m0 - 128 + 32 * kt + qi) * dl + r;
        load_qk(projb + (size_t)tk * IC + C_K + head * 64, p.rope + (ropeb + tk) * 16, p.k_norm_g + layer * 64, 1.0f, kf, h);
      }
#pragma unroll
      for (int s = 0; s < 4; ++s) sacc[kt] = MFMA32(kf[s], qf[s], sacc[kt]);
    }
  }
  float mx = -1e30f;
#pragma unroll
  for (int kt = 0; kt < 5; ++kt)
#pragma unroll
    for (int rr = 0; rr < 16; ++rr) {
      const int keyrow = (rr & 3) + 8 * (rr >> 2) + 4 * h;
      const int dist = 128 - 32 * kt + qi - keyrow;
      const bool valid = (kt >= kt_lo) && dist >= 0 && dist <= 128;
      const float s = valid ? sacc[kt][rr] : -1e30f;
      sacc[kt][rr] = s;
      mx = fmaxf(mx, s);
    }
  mx = fmaxf(mx, __shfl_xor(mx, 32));
  float sum = 0.f;
#pragma unroll
  for (int kt = 0; kt < 5; ++kt)
#pragma unroll
    for (int rr = 0; rr < 16; ++rr) {
      const float s = sacc[kt][rr];
      const float ex = (s > -1e29f) ? __expf(s - mx) : 0.f;
      sacc[kt][rr] = ex;
      sum += ex;
    }
  sum += __shfl_xor(sum, 32);
  f32x16 oacc[2];
#pragma unroll
  for (int i = 0; i < 16; ++i) { oacc[0][i] = 0.f; oacc[1][i] = 0.f; }
#pragma unroll
  for (int kt = 0; kt < 5; ++kt) {
    if (kt >= kt_lo) {
#pragma unroll
      for (int s2 = 0; s2 < 2; ++s2) {
        bf16x8 pf;
#pragma unroll
        for (int j = 0; j < 8; ++j) pf[j] = (short)f2bf(sacc[kt][8 * s2 + j]);
        bf16x8 v0, v1;
#pragma unroll
        for (int j = 0; j < 8; ++j) {
          const int kr = 16 * s2 + 8 * (j >> 2) + 4 * h + (j & 3);
          if (SAMPLE && kt < 4) {
            const float* vp = cache + (size_t)(r + dl * (32 * kt + kr)) * 256 + 128 + qi;
            v0[j] = (short)f2bf(vp[0]); v1[j] = (short)f2bf(vp[32]);
          } else {
            int tk;
            if (SAMPLE) tk = r + dl * (kr < nq ? kr : 0); else tk = (m0 - 128 + 32 * kt + kr) * dl + r;
            const u16* vp = projb + (size_t)tk * IC + C_V + head * 64 + qi;
            v0[j] = (short)vp[0]; v1[j] = (short)vp[32];
          }
        }
        oacc[0] = MFMA32(v0, pf, oacc[0]);
        oacc[1] = MFMA32(v1, pf, oacc[1]);
      }
    }
  }
  const float isum = 1.0f / sum;
  const size_t rowq = SAMPLE ? (size_t)NP + b * 8 + tq : (size_t)b * 2048 + tq;
  if (!SAMPLE || qi < nq) {
    float* op = p.opart + ((size_t)g * MT + rowq) * 128 + hslot * 64;
#pragma unroll
    for (int db = 0; db < 2; ++db)
#pragma unroll
      for (int i4 = 0; i4 < 4; ++i4) {
        float4 o; o.x = oacc[db][4 * i4] * isum; o.y = oacc[db][4 * i4 + 1] * isum; o.z = oacc[db][4 * i4 + 2] * isum; o.w = oacc[db][4 * i4 + 3] * isum;
        *(float4*)(op + db * 32 + 8 * i4 + 4 * h) = o;
      }
    if (h == 0) p.lse[((size_t)g * MT + rowq) * 2 + hslot] = mx + __logf(sum);
  }
}

__device__ __forceinline__ void kv_row_task(const Params& p, const int l, const int row, const int lane) {
  const int hl = lane < 48 ? lane : 47;
  const int head = hl >> 3, c8 = hl & 7;
  int b, t, ridx;
  const bool prompt = row < NP;
  if (prompt) { b = row >> 11; t = row & 2047; ridx = t; } else { b = (row - NP) >> 3; t = (row - NP) & 7; ridx = 2048 + t; }
  const u16* pr = p.proj + (size_t)row * IC;
  const bf16x8 kr = *(const bf16x8*)(pr + C_K + hl * 8);
  const bf16x8 vr = *(const bf16x8*)(pr + C_V + hl * 8);
  float f[8]; float ss = 0.f;
#pragma unroll
  for (int j = 0; j < 8; ++j) { f[j] = bfs2f(kr[j]); ss += f[j] * f[j]; }
  ss += __shfl_xor(ss, 1); ss += __shfl_xor(ss, 2); ss += __shfl_xor(ss, 4);
  const float inv = rsqrtf(ss * (1.0f / 64.0f) + EPS);
  const float* gk = p.k_norm_g + l * 64 + c8 * 8;
#pragma unroll
  for (int j = 0; j < 8; ++j) f[j] *= inv * gk[j];
  const float* rp = p.rope + ridx * 16;
#pragma unroll
  for (int j = 0; j < 8; ++j) {
    const float other = __shfl_xor(f[j], 1);
    const float cs = rp[j], sn = rp[8 + j];
    if (c8 == 0) f[j] = f[j] * cs - other * sn;
    else if (c8 == 1) f[j] = f[j] * cs + other * sn;
  }
  const int g = head >> 1, hh = head & 1;
  const int W = 128 << (2 * g);
  float* dst = nullptr;
  if (prompt) {
    const int r = t - (2048 - W);
    const size_t base = (g == 0) ? O_KV128P : (g == 1) ? O_KV512P : O_KV2048P;
    if (r >= 0) dst = p.out + base + ((size_t)(l * 8 + b) * W + r) * 256 + hh * 64 + c8 * 8;
  } else {
    const int r = W - 8 + t;
    const size_t base = (g == 0) ? O_KV128S : (g == 1) ? O_KV512S : O_KV2048S;
    dst = p.out + base + ((size_t)(l * 32 + b) * W + r) * 256 + hh * 64 + c8 * 8;
  }
  if (dst && lane < 48) {
    *(float4*)(dst) = make_float4(f[0], f[1], f[2], f[3]);
    *(float4*)(dst + 4) = make_float4(f[4], f[5], f[6], f[7]);
    *(float4*)(dst + 128) = make_float4(bfs2f(vr[0]), bfs2f(vr[1]), bfs2f(vr[2]), bfs2f(vr[3]));
    *(float4*)(dst + 132) = make_float4(bfs2f(vr[4]), bfs2f(vr[5]), bfs2f(vr[6]), bfs2f(vr[7]));
  }
}

__device__ void phaseA(const Params& p, const int l, const int wave_s) {
  const int tid = opaque_tid(wave_s);
  const int lane = tid & 63, wid = tid >> 6;
  const int gw = blockIdx.x * 8 + wid, nw = gridDim.x * 8;
  for (int task = gw; task < 832 + 3072; task += nw) { if (task < 832) attn_task<true>(p, l, task, lane); else attn_task<false>(p, l, task - 832, lane); }
  for (int row = nw - 1 - gw; row < MT; row += nw) kv_row_task(p, l, row, lane);
}

template <int GRP>
__device__ __forceinline__ void pool_task(const Params& p, const int l, const int task, const int lane) {
  const int tile = task >> 2; constexpr int grp = GRP;
  const int qi = lane & 31, h = lane >> 5;
  const int row = tile * 32 + qi;
  constexpr int w = 2 << GRP;
  const bool prompt = row < NP;
  int n, t; float cnt;
  if (prompt) { n = row >> 11; t = row & 2047; cnt = (float)min(t + 1, w); } else { n = (row - NP) >> 3; t = (row - NP) & 7; cnt = (float)w; }
  const float icnt = 1.0f / cnt;
  f32x16 acc[2];
#pragma unroll
  for (int i = 0; i < 16; ++i) { acc[0][i] = 0.f; acc[1][i] = 0.f; }
  const u16* pw = p.pwT + (size_t)(l * 4 + grp) * 4096;
#pragma unroll
  for (int s = 0; s < 4; ++s) {
    const int c0 = grp * 64 + 16 * s + 8 * h;
    float sum[8], own[8];
#pragma unroll
    for (int j = 0; j < 8; ++j) { sum[j] = 0.f; own[j] = 0.f; }
#pragma unroll
    for (int i = 0; i < w; ++i) {
      const int tt = t - i;
      float v[8];
      if (tt >= 0) {
        const bf16x8 raw = *(const bf16x8*)(p.proj + (size_t)(row - i) * IC + C_U + c0);
#pragma unroll
        for (int j = 0; j < 8; ++j) v[j] = bfs2f(raw[j]);
      } else if (!prompt) {
        const float* sp = p.state_pool + ((size_t)(l * 32 + n) * 15 + 15 + tt) * 256 + c0;
        const float4 a = *(const float4*)sp, bb = *(const float4*)(sp + 4);
        v[0] = a.x; v[1] = a.y; v[2] = a.z; v[3] = a.w; v[4] = bb.x; v[5] = bb.y; v[6] = bb.z; v[7] = bb.w;
      } else {
#pragma unroll
        for (int j = 0; j < 8; ++j) v[j] = 0.f;
      }
#pragma unroll
      for (int j = 0; j < 8; ++j) sum[j] += v[j];
      if (i == 0) {
#pragma unroll
        for (int j = 0; j < 8; ++j) own[j] = v[j];
      }
    }
    bf16x8 df;
#pragma unroll
    for (int j = 0; j < 8; ++j) df[j] = (short)f2bf(sum[j] * icnt - own[j]);
    const bf16x8 a0 = *(const bf16x8*)(pw + (size_t)qi * 64 + 16 * s + 8 * h);
    const bf16x8 a1 = *(const bf16x8*)(pw + (size_t)(qi + 32) * 64 + 16 * s + 8 * h);
    acc[0] = MFMA32(a0, df, acc[0]);
    acc[1] = MFMA32(a1, df, acc[1]);
  }
  const float* ps = p.pool_scale + l * 256 + grp * 64;
  u16* mp = p.mixed + (size_t)row * MC + grp * 64;
#pragma unroll
  for (int db = 0; db < 2; ++db)
#pragma unroll
    for (int i4 = 0; i4 < 4; ++i4) {
      const int dd0 = db * 32 + 8 * i4 + 4 * h;
      const float4 sc = *(const float4*)(ps + dd0);
      uint2 o; o.x = pack2(acc[db][4 * i4] * sc.x, acc[db][4 * i4 + 1] * sc.y); o.y = pack2(acc[db][4 * i4 + 2] * sc.z, acc[db][4 * i4 + 3] * sc.w);
      *(uint2*)(mp + dd0) = o;
    }
}

__device__ void phaseB(const Params& p, const int l, const int wave_s) {
  const int tid = opaque_tid(wave_s), lane = tid & 63, wid = tid >> 6;
  const int gw = blockIdx.x * 8 + wid, nw = gridDim.x * 8;
  const size_t gt = (size_t)blockIdx.x * 512 + tid, ntd = (size_t)gridDim.x * 512;
  for (int task = gw; task < 520 * 4; task += nw) {
    switch (task & 3) { case 0: pool_task<0>(p, l, task, lane); break; case 1: pool_task<1>(p, l, task, lane); break;
                        case 2: pool_task<2>(p, l, task, lane); break; default: pool_task<3>(p, l, task, lane); break; }
  }
  for (size_t idx = gt; idx < (size_t)MT * 48; idx += ntd) {
    const int row = (int)(idx / 48), ch = (int)(idx % 48) * 8;
    const bool prompt = row < NP;
    int n, t;
    if (prompt) { n = row >> 11; t = row & 2047; } else { n = (row - NP) >> 3; t = (row - NP) & 7; }
    float z[3][8];
#pragma unroll
    for (int i = 0; i < 3; ++i) {
      const int tt = t - 2 + i;
      if (tt >= 0) {
        const u16* pr = p.proj + (size_t)(row - 2 + i) * IC;
        const bf16x8 gc = *(const bf16x8*)(pr + C_GC + ch), gh = *(const bf16x8*)(pr + C_GH + ch);
#pragma unroll
        for (int j = 0; j < 8; ++j) z[i][j] = bfs2f(gc[j]) * bfs2f(gh[j]);
      } else if (!prompt) {
        const float* sp = p.state_conv + ((size_t)(l * 32 + n) * 2 + 2 + tt) * 384 + ch;
        const float4 a = *(const float4*)sp, bb = *(const float4*)(sp + 4);
        z[i][0] = a.x; z[i][1] = a.y; z[i][2] = a.z; z[i][3] = a.w; z[i][4] = bb.x; z[i][5] = bb.y; z[i][6] = bb.z; z[i][7] = bb.w;
      } else {
#pragma unroll
        for (int j = 0; j < 8; ++j) z[i][j] = 0.f;
      }
    }
    const bf16x8 gb = *(const bf16x8*)(p.proj + (size_t)row * IC + C_GB + ch);
    const float* cw = p.conv_w + (size_t)l * 3 * 384 + ch;
    float y[8];
#pragma unroll
    for (int j = 0; j < 8; ++j) y[j] = bfs2f(gb[j]) * (cw[j] * z[0][j] + cw[384 + j] * z[1][j] + cw[768 + j] * z[2][j]);
    uint4 o; o.x = pack2(y[0], y[1]); o.y = pack2(y[2], y[3]); o.z = pack2(y[4], y[5]); o.w = pack2(y[6], y[7]);
    *(uint4*)(p.mixed + (size_t)row * MC + 384 + ch) = o;
    float* so = nullptr;
    if (prompt) { if (t >= 2046) so = p.out + O_CONVP + ((size_t)(l * 8 + n) * 2 + (t - 2046)) * 384 + ch; }
    else { if (t >= 6) so = p.out + O_CONVS + ((size_t)(l * 32 + n) * 2 + (t - 6)) * 384 + ch; }
    if (so) { *(float4*)so = make_float4(z[2][0], z[2][1], z[2][2], z[2][3]); *(float4*)(so + 4) = make_float4(z[2][4], z[2][5], z[2][6], z[2][7]); }
  }
  for (size_t idx = gt; idx < (size_t)MT * 16; idx += ntd) {
    const int row = (int)(idx >> 4), chunk = (int)(idx & 15);
    const int hslot = chunk >> 3, d0 = (chunk & 7) * 8;
    float lg[3];
#pragma unroll
    for (int g = 0; g < 3; ++g) lg[g] = p.lse[((size_t)g * MT + row) * 2 + hslot];
    const float m = fmaxf(lg[0], fmaxf(lg[1], lg[2]));
    float wg[3]; wg[0] = __expf(lg[0] - m); wg[1] = __expf(lg[1] - m); wg[2] = __expf(lg[2] - m);
    const float iw = 1.0f / (wg[0] + wg[1] + wg[2]);
    float y[8];
#pragma unroll
    for (int j = 0; j < 8; ++j) y[j] = 0.f;
#pragma unroll
    for (int g = 0; g < 3; ++g) {
      const float* op = p.opart + ((size_t)g * MT + row) * 128 + hslot * 64 + d0;
      const float4 a = *(const float4*)op, bb = *(const float4*)(op + 4);
      const float ww = wg[g] * iw;
      y[0] += ww * a.x; y[1] += ww * a.y; y[2] += ww * a.z; y[3] += ww * a.w; y[4] += ww * bb.x; y[5] += ww * bb.y; y[6] += ww * bb.z; y[7] += ww * bb.w;
    }
    uint4 o; o.x = pack2(y[0], y[1]); o.y = pack2(y[2], y[3]); o.z = pack2(y[4], y[5]); o.w = pack2(y[6], y[7]);
    *(uint4*)(p.mixed + (size_t)row * MC + 256 + hslot * 64 + d0) = o;
  }
  for (size_t idx = gt; idx < (size_t)8 * 15 * 256; idx += ntd) {
    const int c = (int)(idx & 255); const int bi = (int)(idx >> 8); const int i = bi % 15, b = bi / 15;
    p.out[O_POOLP + (size_t)l * 8 * 15 * 256 + idx] = bf2f(p.proj[((size_t)b * 2048 + 2033 + i) * IC + C_U + c]);
  }
  for (size_t idx = gt; idx < (size_t)32 * 15 * 256; idx += ntd) {
    const int c = (int)(idx & 255); const int bi = (int)(idx >> 8); const int i = bi % 15, n = bi / 15;
    float v;
    if (i < 7) v = p.state_pool[((size_t)(l * 32 + n) * 15 + 8 + i) * 256 + c];
    else v = bf2f(p.proj[((size_t)NP + n * 8 + (i - 7)) * IC + C_U + c]);
    p.out[O_POOLS + (size_t)l * 32 * 15 * 256 + idx] = v;
  }
}

#ifndef REPM
#define REPM 0
#endif
#define NREP(k) (1 + ((REPM >> (k)) & 1))
typedef const __attribute__((address_space(4))) Params* CP;
#if defined(__HIP_DEVICE_COMPILE__)
#define LOAD_PARAMS() CP pp_ = (CP)__builtin_amdgcn_kernarg_segment_ptr(); asm volatile("" : "+s"(pp_)); const Params p = *pp_
#else
#define LOAD_PARAMS() const Params& p = p_unused
#endif
__global__ void __launch_bounds__(512, 2) mega(const Params p_unused, const int ph_lo, const int ph_hi) {
  const int wave_s = __builtin_amdgcn_readfirstlane((int)(threadIdx.x >> 6));
  if (ph_hi - ph_lo > 1) cg::this_grid().sync();
  int ph = 0;
#define IN_PH() (ph_lo <= ph && ph < ph_hi)
#define SEAM() do { if (ph_lo <= ph && ph + 1 < ph_hi) { LOAD_PARAMS(); grid_bar(p.bar, (unsigned)(ph - ph_lo + 1) * gridDim.x, wave_s); } ++ph; } while (0)
  if (IN_PH()) for (int rep = 0; rep < NREP(0); ++rep) { LOAD_PARAMS(); phase0(p, wave_s); }
  SEAM();
#pragma unroll 1
  for (int l = 0; l < 2; ++l) {
    if (IN_PH()) for (int rep = 0; rep < NREP(1); ++rep) {
      LOAD_PARAMS();
      GemmEpi e{}; e.sumsq_in = p.sumsq + (size_t)(2 * l) * MT; e.out_bf = p.proj; e.ldo = IC;
      gemm_phase<1>(p.xg, p.wt_in + (size_t)l * IC * D, NP, IC, D, e, wave_s);
      { const int G = gridDim.x, first = (64 * (IC / 256)) % G;
        const int b0 = first ? first : 0, nb = G - b0;
        kv_shift_copy(p, l, b0, nb, opaque_tid(wave_s));
        sample_gemm<1>(p.xg, p.wt_in + (size_t)l * IC * D, IC, D, e, wave_s, b0, nb); }
    }
    SEAM();
    if (IN_PH()) for (int rep = 0; rep < NREP(2); ++rep) { LOAD_PARAMS(); phaseA(p, l, wave_s); }
    SEAM();
    if (IN_PH()) for (int rep = 0; rep < NREP(3); ++rep) { LOAD_PARAMS(); phaseB(p, l, wave_s); }
    SEAM();
    if (IN_PH()) for (int rep = 0; rep < NREP(4); ++rep) {
      LOAD_PARAMS();
      GemmEpi e{};
      e.xh = p.xg; e.out_f = nullptr; e.sumsq_out = p.sumsq + (size_t)(2 * l + 1) * MT;
      gemm_phase<2>(p.mixed, p.wt_out + (size_t)l * D * MC, NP, D, MC, e, wave_s);
      sample_gemm<2>(p.mixed, p.wt_out + (size_t)l * D * MC, D, MC, e, wave_s, 0, gridDim.x);
    }
    SEAM();
    if (IN_PH()) for (int rep = 0; rep < NREP(5); ++rep) {
      LOAD_PARAMS();
      GemmEpi e{}; e.sumsq_in = p.sumsq + (size_t)(2 * l + 1) * MT; e.out_bf = p.hf; e.ldo = FF;
      gemm_phase<3>(p.xg, p.wt_up + (size_t)l * FF * D, NP, FF, D, e, wave_s);
      sample_gemm<3>(p.xg, p.wt_up + (size_t)l * FF * D, FF, D, e, wave_s, 0, gridDim.x);
    }
    SEAM();
    if (IN_PH()) for (int rep = 0; rep < NREP(6); ++rep) {
      LOAD_PARAMS();
      GemmEpi e{};
      e.xh = p.xg;
      if (l == 0) { e.out_f = nullptr; e.sumsq_out = p.sumsq + (size_t)2 * MT; } else { e.out_f = p.out; e.sumsq_out = nullptr; }
      gemm_phase<2>(p.hf, p.wt_down + (size_t)l * D * FF, NP, D, FF, e, wave_s);
      sample_gemm<2>(p.hf, p.wt_down + (size_t)l * D * FF, D, FF, e, wave_s, 0, gridDim.x);
    }
    SEAM();
  }
}

extern "C" void kernel_launch(void* const* d_in, const int* in_sizes, int n_in, void* d_out, int out_size, void* d_ws, size_t ws_size, hipStream_t stream) {
  static int grid_blocks = 0;
  if (!grid_blocks) {
    int dev = 0, cus = 0, per_cu = 0;
    hipGetDevice(&dev);
    hipDeviceGetAttribute(&cus, hipDeviceAttributeMultiprocessorCount, dev);
    hipFuncSetAttribute((const void*)mega, hipFuncAttributeMaxDynamicSharedMemorySize, GEMM_LDS);
    hipOccupancyMaxActiveBlocksPerMultiprocessor(&per_cu, (const void*)mega, 512, GEMM_LDS);
    if (per_cu < 1) { fprintf(stderr, "occupancy query returned %d\n", per_cu); per_cu = 1; }
    grid_blocks = cus * 1;
  }
  Params p{};
  p.x_prompt = (const float*)d_in[0]; p.x_sample = (const float*)d_in[1]; p.state_pool = (const float*)d_in[2]; p.state_conv = (const float*)d_in[3];
  p.kv_in[0] = (const float*)d_in[4]; p.kv_in[1] = (const float*)d_in[5]; p.kv_in[2] = (const float*)d_in[6];
  p.norm1_g = (const float*)d_in[7]; p.w_in = (const float*)d_in[8]; p.q_norm_g = (const float*)d_in[9]; p.k_norm_g = (const float*)d_in[10];
  p.pool_w = (const float*)d_in[11]; p.pool_scale = (const float*)d_in[12]; p.conv_w = (const float*)d_in[13]; p.w_out = (const float*)d_in[14];
  p.norm2_g = (const float*)d_in[15]; p.w_up = (const float*)d_in[16]; p.w_down = (const float*)d_in[17];
  p.out = (float*)d_out;
  unsigned char* w = (unsigned char*)d_ws; size_t off = 0;
  auto carve = [&](size_t bytes) { unsigned char* r = w + off; off += (bytes + 255) & ~(size_t)255; return r; };
  p.bar = (unsigned*)carve(256);
  p.wt_in = (u16*)carve((size_t)2 * IC * D * 2);
  p.wt_out = (u16*)carve((size_t)2 * D * MC * 2);
  p.wt_up = (u16*)carve((size_t)2 * FF * D * 2);
  p.wt_down = (u16*)carve((size_t)2 * D * FF * 2);
  p.pwT = (u16*)carve((size_t)2 * 4 * 4096 * 2);
  p.xg = (u16*)carve((size_t)MT * D * 2);
  p.mixed = (u16*)carve((size_t)MT * MC * 2);
  p.sumsq = (float*)carve((size_t)4 * MT * 4);
  p.lse = (float*)carve((size_t)3 * MT * 2 * 4);
  p.rope = (float*)carve((size_t)2056 * 16 * 4);
  p.hf = (u16*)carve((size_t)MT * FF * 2);
  p.proj = p.hf;
  p.opart = (float*)((unsigned char*)p.hf + (((size_t)MT * IC * 2 + 255) & ~(size_t)255));
  if (off > ws_size) { fprintf(stderr, "workspace too small: need %zu have %zu\n", off, ws_size); return; }
  (void)hipMemsetAsync(p.bar, 0, 256, stream);
  int lo = 0, hi = 13;
  void* args[] = {(void*)&p, (void*)&lo, (void*)&hi};
  hipError_t e = hipLaunchCooperativeKernel((const void*)mega, dim3(grid_blocks), dim3(512), args, GEMM_LDS, stream);
  if (e != hipSuccess) fprintf(stderr, "cooperative launch failed: %s (grid %d)\n", hipGetErrorString(e), grid_blocks);
}
```

```cpp
#include <hip/hip_runtime.h>
#include <hip/hip_cooperative_groups.h>
#include <cstdio>
namespace cg = cooperative_groups;

typedef unsigned short u16;
using bf16x8 = __attribute__((ext_vector_type(8))) short;
using f32x4 = __attribute__((ext_vector_type(4))) float;
using f32x16 = __attribute__((ext_vector_type(16))) float;

constexpr int NP = 16384, NS = 256, MT = NP + NS;
constexpr int D = 1024, IC = 2560, MC = 768, FF = 4096;
constexpr float EPS = 1e-6f;
constexpr int C_U = 0, C_Q = 256, C_K = 640, C_V = 1024, C_GB = 1408, C_GC = 1792, C_GH = 2176;
constexpr size_t O_YP = 0;
constexpr size_t O_YS = O_YP + (size_t)NP * D;
constexpr size_t O_POOLP = O_YS + (size_t)NS * D;
constexpr size_t O_CONVP = O_POOLP + 2 * 8 * 15 * 256;
constexpr size_t O_KV128P = O_CONVP + 2 * 8 * 2 * 384;
constexpr size_t O_KV512P = O_KV128P + (size_t)2 * 8 * 128 * 256;
constexpr size_t O_KV2048P = O_KV512P + (size_t)2 * 8 * 512 * 256;
constexpr size_t O_POOLS = O_KV2048P + (size_t)2 * 8 * 2048 * 256;
constexpr size_t O_CONVS = O_POOLS + 2 * 32 * 15 * 256;
constexpr size_t O_KV128S = O_CONVS + 2 * 32 * 2 * 384;
constexpr size_t O_KV512S = O_KV128S + (size_t)2 * 32 * 128 * 256;
constexpr size_t O_KV2048S = O_KV512S + (size_t)2 * 32 * 512 * 256;

struct Params {
  const float *x_prompt, *x_sample, *state_pool, *state_conv, *kv_in[3];
  const float *norm1_g, *w_in, *q_norm_g, *k_norm_g, *pool_w, *pool_scale, *conv_w, *w_out, *norm2_g, *w_up, *w_down;
  float* out;
  u16 *wt_in, *wt_out, *wt_up, *wt_down, *pwT;
  u16 *xg, *proj, *mixed, *hf;
  float *sumsq, *opart, *lse, *rope;
  unsigned* bar;
};

extern __shared__ __attribute__((aligned(16))) unsigned char smem[];
typedef __attribute__((address_space(3))) void* LDSP;

__device__ __forceinline__ u16 f2bf(float f) { unsigned u = __float_as_uint(f); u += 0x7fffu + ((u >> 16) & 1u); return (u16)(u >> 16); }
__device__ __forceinline__ float bf2f(u16 h) { return __uint_as_float(((unsigned)h) << 16); }
__device__ __forceinline__ float bfs2f(short h) { return __uint_as_float(((unsigned)(u16)h) << 16); }
__device__ __forceinline__ unsigned pack2(float a, float b) { return (unsigned)f2bf(a) | ((unsigned)f2bf(b) << 16); }
__device__ __forceinline__ int opaque_tid(const int wave_s) {
  int l; asm volatile("v_mbcnt_lo_u32_b32 %0, -1, 0\n\tv_mbcnt_hi_u32_b32 %0, -1, %0" : "=v"(l));
  return wave_s * 64 + l;
}
__device__ __forceinline__ int opaque_lane() {
  int l; asm volatile("v_mbcnt_lo_u32_b32 %0, -1, 0\n\tv_mbcnt_hi_u32_b32 %0, -1, %0" : "=v"(l));
  return l;
}
#define XB_TMO      128
#define XB_XCNT(j)  (256  + 64 * (j))
#define XB_XSUB(j)  (1280 + 64 * (j))
#define XB_XGEN(j)  (2304 + 64 * (j))
#define XB_TOP      3328
#define XB_TOPGEN   3392
#define XCD_BAR_WORDS 3456
#define XB_SPIN_CAP (1u << 18)
constexpr int BAR_LDS_OFF = 131072;
__device__ __forceinline__ unsigned xb_ld(unsigned* p)              { return __hip_atomic_load(p, __ATOMIC_RELAXED, __HIP_MEMORY_SCOPE_AGENT); }
__device__ __forceinline__ unsigned xb_add(unsigned* p, unsigned v) { return __hip_atomic_fetch_add(p, v, __ATOMIC_RELAXED, __HIP_MEMORY_SCOPE_AGENT); }
__device__ __forceinline__ unsigned xb_xcc_id() { return (unsigned)__builtin_amdgcn_s_getreg((3 << 11) | 20) & 0xFu; }
#define XB_SPIN(cond, bar) do { unsigned _sp = 0; while (cond) { __builtin_amdgcn_s_sleep(1); \
    if ((++_sp & 255u) == 0u) { if (xb_ld(&(bar)[XB_TMO])) break; if (_sp > XB_SPIN_CAP) { atomicAdd(&(bar)[XB_TMO], 1u); break; } } } } while (0)
__device__ __forceinline__ void xcd_barrier_complete(unsigned* bar, unsigned x, unsigned& nloc, unsigned& nx) {
  const unsigned G = gridDim.x;
  unsigned sum, cnt, mine, sp = 0u;
  for (;;) {
    sum = 0u; cnt = 0u; mine = 0u;
#pragma unroll
    for (unsigned j = 0; j < 16; ++j) { const unsigned c = xb_ld(&bar[XB_XCNT(j)]); sum += c; cnt += (c > 0u) ? 1u : 0u; mine = (j == x) ? c : mine; }
    if (sum == G) break;
    __builtin_amdgcn_s_sleep(1);
    if ((++sp & 255u) == 0u) { if (xb_ld(&bar[XB_TMO])) break; if (sp > XB_SPIN_CAP) { atomicAdd(&bar[XB_TMO], 1u); break; } }
  }
  nloc = mine > 0u ? mine : 1u; nx = cnt > 0u ? cnt : 1u;
}
__device__ __forceinline__ void grid_bar(unsigned* bar, const int wave_s) {
  asm volatile("s_waitcnt vmcnt(0)" ::: "memory");
  __syncthreads();
  if (opaque_tid(wave_s) == 0) {
    volatile __attribute__((address_space(3))) unsigned* st = (volatile __attribute__((address_space(3))) unsigned*)(smem + BAR_LDS_OFF);
    const unsigned x = xb_xcc_id();
    __builtin_amdgcn_s_waitcnt(0);
    unsigned nloc = st[0], nx = st[1];
    if (nloc == 0u) { xcd_barrier_complete(bar, x, nloc, nx); st[0] = nloc; st[1] = nx; }
    const unsigned old = xb_add(&bar[XB_XSUB(x)], 1u);
    const unsigned gen = old / nloc;
    if (old + 1u == (gen + 1u) * nloc) {
      __builtin_amdgcn_fence(__ATOMIC_RELEASE, "agent");
      asm volatile("s_waitcnt vmcnt(0)" ::: "memory");
      const unsigned og = xb_add(&bar[XB_TOP], 1u);
      const unsigned tg = og / nx;
      if (og + 1u == (tg + 1u) * nx) xb_add(&bar[XB_TOPGEN], 1u);
      else XB_SPIN(xb_ld(&bar[XB_TOPGEN]) == tg, bar);
      __builtin_amdgcn_fence(__ATOMIC_ACQUIRE, "agent");
      xb_add(&bar[XB_XGEN(x)], 1u);
      asm volatile("s_waitcnt vmcnt(0)" ::: "memory");
    } else {
      XB_SPIN(xb_ld(&bar[XB_XGEN(x)]) == gen, bar);
      __builtin_amdgcn_fence(__ATOMIC_ACQUIRE, "agent");
      asm volatile("s_waitcnt vmcnt(0)" ::: "memory");
    }
  }
  __syncthreads();
}
__device__ __forceinline__ float wave_sum(float v) { for (int o = 32; o; o >>= 1) v += __shfl_xor(v, o); return v; }
__device__ __forceinline__ float wave_max(float v) { for (int o = 32; o; o >>= 1) v = fmaxf(v, __shfl_xor(v, o)); return v; }

constexpr int BM = 256, BK = 64, HALF = 128, NXCD = 8, WGM = 8, HT = HALF * BK;
constexpr int GEMM_LDS = 8 * HT * 2 + 16;

__device__ __forceinline__ int lds_byte(int r, int c) {
  int st = (r >> 4) * 2 + (c >> 5), rr = r & 15, cc = c & 31, ob = rr * 64 + cc * 2;
  return st * 1024 + (ob ^ (((ob >> 9) & 1) << 5));
}
__device__ __forceinline__ int perm32(int rho) { const int n = rho >> 4, i = rho & 15; return 8 * (i >> 2) + 4 * n + (i & 3); }
__device__ __forceinline__ void stage_rc(int b, int& R, int& C) {
  int st = b / 1024, sb = b % 1024, swz = sb ^ (((sb >> 9) & 1) << 5);
  R = (st >> 1) * 16 + swz / 64; C = (st & 1) * 32 + (swz % 64) / 2;
}

struct GemmEpi {
  const float* sumsq_in;
  u16* out_bf; int ldo;
  u16* xh;
  float* out_f;
  float* sumsq_out;
};

template <int MODE, bool ADD_RESID>
__device__ __forceinline__ void epi4(const GemmEpi& e, const f32x4 a, const float rs, const size_t grow, const int col0, float& ssq) {
  if (MODE == 1 || MODE == 3) {
    float v0 = a[0] * rs, v1 = a[1] * rs, v2 = a[2] * rs, v3 = a[3] * rs;
    if (MODE == 3) { v0 = fmaxf(v0, 0.f); v1 = fmaxf(v1, 0.f); v2 = fmaxf(v2, 0.f); v3 = fmaxf(v3, 0.f); v0 *= v0; v1 *= v1; v2 *= v2; v3 *= v3; }
    uint2 o; o.x = pack2(v0, v1); o.y = pack2(v2, v3);
    *(uint2*)(e.out_bf + grow * e.ldo + col0) = o;
  } else {
    float4 x; x.x = a[0]; x.y = a[1]; x.z = a[2]; x.w = a[3];
    if (ADD_RESID) {
      const uint2 r = *(const uint2*)(e.xh + grow * D + col0);
      x.x += __uint_as_float(r.x << 16); x.y += __uint_as_float(r.x & 0xffff0000u); x.z += __uint_as_float(r.y << 16); x.w += __uint_as_float(r.y & 0xffff0000u);
    }
    if (e.out_f) *(float4*)(e.out_f + grow * D + col0) = x;
    else { uint2 ob; ob.x = pack2(x.x, x.y); ob.y = pack2(x.z, x.w); *(uint2*)(e.xh + grow * D + col0) = ob; }
    ssq += x.x * x.x + x.y * x.y + x.z * x.z + x.w * x.w;
  }
}

template <int MODE>
__device__ __forceinline__ void epi8(const GemmEpi& e, const f32x4 a0, const f32x4 a1, const float rs, const size_t grow, const int col8, float& ssq) {
  float v[8] = {a0[0], a0[1], a0[2], a0[3], a1[0], a1[1], a1[2], a1[3]};
  if (MODE == 1 || MODE == 3) {
#pragma unroll
    for (int i = 0; i < 8; ++i) { v[i] *= rs; if (MODE == 3) { v[i] = fmaxf(v[i], 0.f); v[i] *= v[i]; } }
    uint4 o; o.x = pack2(v[0], v[1]); o.y = pack2(v[2], v[3]); o.z = pack2(v[4], v[5]); o.w = pack2(v[6], v[7]);
    *(uint4*)(e.out_bf + grow * e.ldo + col8) = o;
  } else {
    if (e.out_f) { *(float4*)(e.out_f + grow * D + col8) = make_float4(v[0], v[1], v[2], v[3]); *(float4*)(e.out_f + grow * D + col8 + 4) = make_float4(v[4], v[5], v[6], v[7]); }
    else { uint4 o; o.x = pack2(v[0], v[1]); o.y = pack2(v[2], v[3]); o.z = pack2(v[4], v[5]); o.w = pack2(v[6], v[7]); *(uint4*)(e.xh + grow * D + col8) = o; }
#pragma unroll
    for (int i = 0; i < 8; ++i) ssq += v[i] * v[i];
  }
}

template <int MODE>
__device__ __forceinline__ void gemm_phase(const u16* __restrict__ A, const u16* __restrict__ Bt, const int M, const int N, const int K, const GemmEpi e, const int wave_s) {
  u16* shm = (u16*)smem;
#define SA(b, h) (shm + ((b) * 2 + (h)) * HT)
#define SB(b, h) (shm + (4 + (b) * 2 + (h)) * HT)
#define STAGE_(P, RS, br, kt, o0, o1) do { const unsigned _so = (unsigned)(((br) * K + (kt) * BK) * 2); \
    __builtin_amdgcn_raw_ptr_buffer_load_lds(RS, (LDSP)((char*)(P) + tid0 * 16), 16, o0, _so, 0, 0); \
    __builtin_amdgcn_raw_ptr_buffer_load_lds(RS, (LDSP)((char*)(P) + tid0 * 16 + 8192), 16, o1, _so, 0, 0); } while (0)
#define STAGE(P, RS, br, kt) STAGE_(P, RS, br, kt, toff0, toff1)
#define STAGEB(P, RS, br, kt) STAGE_(P, RS, br, kt, toffb0, toffb1)
#define LDA(dst, b, h) for (int m = 0; m < 4; ++m) for (int k = 0; k < 2; ++k) \
    dst[m][k] = *reinterpret_cast<const bf16x8*>((char*)SA(b, h) + lds_byte(wr * 64 + m * 16 + fr, k * 32 + fq * 8))
#define LDB(dst, b, h) for (int n = 0; n < 2; ++n) for (int k = 0; k < 2; ++k) \
    dst[n][k] = *reinterpret_cast<const bf16x8*>((char*)SB(b, h) + lds_byte(wc * 32 + n * 16 + fr, k * 32 + fq * 8))
#define MMA(ai, bj, At, Bt_) do { __builtin_amdgcn_s_setprio(1); \
    for (int m = 0; m < 4; ++m) for (int n = 0; n < 2; ++n) for (int k = 0; k < 2; ++k) \
      acc[ai][bj][m][n] = __builtin_amdgcn_mfma_f32_16x16x32_bf16(Bt_[n][k], At[m][k], acc[ai][bj][m][n], 0, 0, 0); \
    __builtin_amdgcn_s_setprio(0); } while (0)
#define WAIT_V(n) asm volatile("s_waitcnt vmcnt(" #n ")" ::: "memory")
#define WAIT_L(n) asm volatile("s_waitcnt lgkmcnt(" #n ")" ::: "memory")
#define BAR __builtin_amdgcn_s_barrier()
#define SCHED __builtin_amdgcn_sched_barrier(0)
#define DECODE(tt_, brow_, bcol_) do { int wgid = (tt_); \
    { int q = nwg / NXCD, r = nwg % NXCD, xcd = wgid % NXCD, off = wgid / NXCD; \
      wgid = (xcd < r ? xcd * (q + 1) : r * (q + 1) + (xcd - r) * q) + off; } \
    int nig = WGM * nN, gid = wgid / nig, fm = gid * WGM, gsz = min(nM - fm, WGM); \
    brow_ = (fm + ((wgid % nig) % gsz)) * BM; bcol_ = ((wgid % nig) / gsz) * BM; } while (0)
#define STAGE7(brow_, bcol_) do { \
    STAGEB(SB(0, 0), rsB, bcol_, 0); STAGE(SA(0, 0), rsA, brow_, 0); \
    STAGEB(SB(0, 1), rsB, bcol_ + HALF, 0); STAGE(SA(0, 1), rsA, brow_ + HALF, 0); \
    STAGEB(SB(1, 0), rsB, bcol_, 1); STAGE(SA(1, 0), rsA, brow_, 1); STAGEB(SB(1, 1), rsB, bcol_ + HALF, 1); } while (0)

  const int nM = M / BM, nN = N / BM, nwg = nM * nN;
  const int nt = K / BK;
  unsigned toff0, toff1;
  const int tid0 = opaque_tid(wave_s);
  const int wr = (tid0 >> 6) >> 2, wc = (tid0 >> 6) & 3, fr = tid0 & 15, fq = (tid0 & 63) >> 4;
  unsigned toffb0, toffb1;
  { int r_, c_; stage_rc(tid0 * 16, r_, c_); toff0 = (unsigned)(r_ * K + c_) * 2u; toffb0 = (unsigned)(((r_ & ~31) | perm32(r_ & 31)) * K + c_) * 2u;
    stage_rc(tid0 * 16 + 8192, r_, c_); toff1 = (unsigned)(r_ * K + c_) * 2u; toffb1 = (unsigned)(((r_ & ~31) | perm32(r_ & 31)) * K + c_) * 2u; }
  const __amdgpu_buffer_rsrc_t rsA = __builtin_amdgcn_make_buffer_rsrc((void*)A, 0, -1, 0x00020000);
  const __amdgpu_buffer_rsrc_t rsB = __builtin_amdgcn_make_buffer_rsrc((void*)Bt, 0, -1, 0x00020000);
  int tt = blockIdx.x;
  int brow = 0, bcol = 0;
  if (tt < nwg) { DECODE(tt, brow, bcol); STAGE7(brow, bcol); WAIT_V(0); }
  f32x4 acc[2][2][4][2];
#define ACC_INIT(brow_, bcol_) do { \
    if (MODE == 2) { \
      const int t2 = opaque_tid(wave_s); const int wr_ = (t2 >> 6) >> 2, wc_ = (t2 >> 6) & 3, fr_ = t2 & 15, fq_ = (t2 & 63) >> 4; \
      const u16* rp_ = e.xh + (size_t)(brow_ + wr_ * 64 + fr_) * D + bcol_ + wc_ * 32 + fq_ * 8; \
      _Pragma("unroll") for (int ai = 0; ai < 2; ++ai) _Pragma("unroll") for (int bj = 0; bj < 2; ++bj) \
      _Pragma("unroll") for (int m = 0; m < 4; ++m) { \
        const uint4 x0 = *(const uint4*)(rp_ + (size_t)(ai * HALF + m * 16) * D + bj * HALF); \
        acc[ai][bj][m][0][0] = __uint_as_float(x0.x << 16); acc[ai][bj][m][0][1] = __uint_as_float(x0.x & 0xffff0000u); \
        acc[ai][bj][m][0][2] = __uint_as_float(x0.y << 16); acc[ai][bj][m][0][3] = __uint_as_float(x0.y & 0xffff0000u); \
        acc[ai][bj][m][1][0] = __uint_as_float(x0.z << 16); acc[ai][bj][m][1][1] = __uint_as_float(x0.z & 0xffff0000u); \
        acc[ai][bj][m][1][2] = __uint_as_float(x0.w << 16); acc[ai][bj][m][1][3] = __uint_as_float(x0.w & 0xffff0000u); } \
    } else { \
      _Pragma("unroll") for (int ai = 0; ai < 2; ++ai) _Pragma("unroll") for (int bj = 0; bj < 2; ++bj) \
      _Pragma("unroll") for (int m = 0; m < 4; ++m) _Pragma("unroll") for (int n = 0; n < 2; ++n) \
        acc[ai][bj][m][n] = (f32x4){0.f, 0.f, 0.f, 0.f}; \
    } } while (0)
  if (tt < nwg) ACC_INIT(brow, bcol);
  while (tt < nwg) {
    bf16x8 At[4][2], B0[2][2], B1[2][2];
    if (wr == 1) BAR;
    BAR;
    for (int t = 0; t < nt - 2; t += 2) {
      LDB(B0, 0, 0); SCHED; LDA(At, 0, 0); STAGE(SA(1, 1), rsA, brow + HALF, t + 1);
      WAIT_L(8); BAR; WAIT_L(0); MMA(0, 0, At, B0); BAR; SCHED;
      LDB(B1, 0, 1); STAGEB(SB(0, 0), rsB, bcol, t + 2);
      BAR; WAIT_L(0); MMA(0, 1, At, B1); BAR;
      LDA(At, 0, 1); STAGE(SA(0, 0), rsA, brow, t + 2);
      BAR; WAIT_L(0); MMA(1, 0, At, B0); BAR; SCHED;
      STAGEB(SB(0, 1), rsB, bcol + HALF, t + 2);
      WAIT_V(6); BAR; MMA(1, 1, At, B1); BAR;
      LDB(B0, 1, 0); SCHED; LDA(At, 1, 0); STAGE(SA(0, 1), rsA, brow + HALF, t + 2);
      WAIT_L(8); BAR; WAIT_L(0); MMA(0, 0, At, B0); BAR; SCHED;
      LDB(B1, 1, 1); STAGEB(SB(1, 0), rsB, bcol, t + 3);
      BAR; WAIT_L(0); MMA(0, 1, At, B1); BAR;
      LDA(At, 1, 1); STAGE(SA(1, 0), rsA, brow, t + 3);
      BAR; WAIT_L(0); MMA(1, 0, At, B0); BAR; SCHED;
      STAGEB(SB(1, 1), rsB, bcol + HALF, t + 3);
      WAIT_V(6); BAR; MMA(1, 1, At, B1); BAR;
    }
    { LDB(B0, 0, 0); LDA(At, 0, 0); STAGE(SA(1, 1), rsA, brow + HALF, nt - 1);
      BAR; WAIT_L(0); MMA(0, 0, At, B0); BAR;
      LDB(B1, 0, 1); BAR; WAIT_L(0); MMA(0, 1, At, B1); BAR;
      LDA(At, 0, 1); WAIT_V(4); BAR; WAIT_L(0); MMA(1, 0, At, B0); MMA(1, 1, At, B1); BAR; }
    { LDB(B0, 1, 0); LDA(At, 1, 0); WAIT_V(2); BAR; WAIT_L(0); MMA(0, 0, At, B0); BAR;
      LDB(B1, 1, 1); WAIT_V(0); BAR; WAIT_L(0); MMA(0, 1, At, B1); BAR;
      LDA(At, 1, 1); BAR; WAIT_L(0); MMA(1, 0, At, B0); MMA(1, 1, At, B1); BAR; }
    if (wr == 0) BAR;
    const int erow = brow, ecol = bcol;
    tt += gridDim.x;
    if (tt < nwg) { DECODE(tt, brow, bcol); STAGE7(brow, bcol); }
    SCHED;
    {
      const int tid1 = opaque_tid(wave_s);
      const int wr = (tid1 >> 6) >> 2, wc = (tid1 >> 6) & 3, fr = tid1 & 15, fq = (tid1 & 63) >> 4;
      float rsv[2][4];
#pragma unroll
      for (int ai = 0; ai < 2; ++ai)
#pragma unroll
        for (int m = 0; m < 4; ++m) {
          rsv[ai][m] = 0.f;
          if (MODE == 1 || MODE == 3) rsv[ai][m] = e.sumsq_in[(size_t)erow + ai * HALF + wr * 64 + m * 16 + fr];
        }
#pragma unroll
      for (int ai = 0; ai < 2; ++ai)
#pragma unroll
        for (int m = 0; m < 4; ++m) {
          const int lrow = ai * HALF + wr * 64 + m * 16 + fr;
          const size_t grow = (size_t)erow + lrow;
          float rs = 0.f, ssq = 0.f;
          if (MODE == 1 || MODE == 3) rs = rsqrtf(rsv[ai][m] * (1.0f / 1024.0f) + EPS);
#pragma unroll
          for (int bj = 0; bj < 2; ++bj)
            epi8<MODE>(e, acc[ai][bj][m][0], acc[ai][bj][m][1], rs, grow, ecol + bj * HALF + wc * 32 + fq * 8, ssq);
          if (MODE == 2 && e.sumsq_out) {
            ssq += __shfl_xor(ssq, 16); ssq += __shfl_xor(ssq, 32);
            if (fq == 0) atomicAdd(e.sumsq_out + grow, ssq);
          }
          SCHED;
        }
    }
    if (tt < nwg) ACC_INIT(brow, bcol);
    WAIT_V(16);
  }
  WAIT_V(0);
#undef SA
#undef SB
#undef STAGE
#undef STAGEB
#undef STAGE_
#undef LDA
#undef LDB
#undef MMA
}

#define MFMA32(a, b, c) __builtin_amdgcn_mfma_f32_32x32x16_bf16((a), (b), (c), 0, 0, 0)

template <int MODE>
__device__ __forceinline__ void sample_gemm(const u16* __restrict__ A, const u16* __restrict__ Bt, const int N, const int K, const GemmEpi e, const int wave_s, const int b0, const int nb) {
  const int bi = (int)blockIdx.x - b0;
  if (bi < 0 || bi >= nb) return;
  const int tid = opaque_tid(wave_s);
  const int lane = tid & 63, wid = tid >> 6;
  const int i = lane & 31, h = lane >> 5;
  const int ntask = 8 * (N / 32);
  const int ks = K / 8;
  float* red = (float*)smem;
  for (int id = bi; id < ntask; id += nb) {
    const int r0 = (id & 7) * 32, c0 = (id >> 3) * 32;
    const u16* ap = A + (size_t)(NP + r0 + i) * K + wid * ks + 8 * h;
    const u16* bp = Bt + (size_t)(c0 + i) * K + wid * ks + 8 * h;
    f32x16 acc;
#pragma unroll
    for (int q = 0; q < 16; ++q) acc[q] = 0.f;
#pragma unroll 8
    for (int k = 0; k < ks; k += 16) {
      const bf16x8 a = *(const bf16x8*)(ap + k);
      const bf16x8 b = *(const bf16x8*)(bp + k);
      acc = MFMA32(b, a, acc);
    }
#pragma unroll
    for (int q = 0; q < 4; ++q)
      *(float4*)(red + (wid * 32 + i) * 36 + 8 * q + 4 * h) = make_float4(acc[4 * q], acc[4 * q + 1], acc[4 * q + 2], acc[4 * q + 3]);
    __syncthreads();
    if (tid < 256) {
      const int row = tid >> 3, c4 = (tid & 7) * 4;
      f32x4 s4; s4[0] = 0.f; s4[1] = 0.f; s4[2] = 0.f; s4[3] = 0.f;
#pragma unroll
      for (int w = 0; w < 8; ++w) {
        const float4 v = *(const float4*)(red + (w * 32 + row) * 36 + c4);
        s4[0] += v.x; s4[1] += v.y; s4[2] += v.z; s4[3] += v.w;
      }
      const int srow = r0 + row, col0 = c0 + c4;
      const size_t grow = (size_t)NP + srow;
      float rs = 0.f, ssq = 0.f;
      if (MODE == 1 || MODE == 3) rs = rsqrtf(e.sumsq_in[grow] * (1.0f / 1024.0f) + EPS);
      epi4<MODE, true>(e, s4, rs, grow, col0, ssq);
      if (MODE == 2 && e.sumsq_out) {
        ssq += __shfl_xor(ssq, 1); ssq += __shfl_xor(ssq, 2); ssq += __shfl_xor(ssq, 4);
        if ((tid & 7) == 0) atomicAdd(e.sumsq_out + grow, ssq);
      }
    }
    __syncthreads();
  }
}

__device__ __forceinline__ void kv_shift_copy(const Params& p, const int l, const int b0, const int nb, const int tid) {
  const int bi = (int)blockIdx.x - b0;
  if (bi < 0 || bi >= nb) return;
  const size_t gt = (size_t)bi * 512 + tid, ntd = (size_t)nb * 512;
#pragma unroll
  for (int g = 0; g < 3; ++g) {
    const int W = 128 << (2 * g);
    const size_t n4 = (size_t)32 * W * 64;
    const size_t oo = (g == 0) ? O_KV128S : (g == 1) ? O_KV512S : O_KV2048S;
    const f32x4* src = (const f32x4*)p.kv_in[g] + (size_t)l * n4;
    f32x4* dst = (f32x4*)(p.out + oo) + (size_t)l * n4;
    const unsigned per = (unsigned)W * 64u, lim = (unsigned)(W - 8) * 64u;
    for (size_t i = gt; i < n4; i += ntd) {
      if (((unsigned)i % per) < lim) __builtin_nontemporal_store(__builtin_nontemporal_load(src + i + 512), dst + i);
    }
  }
}

__device__ __forceinline__ void tr_tile(const float* __restrict__ src, u16* __restrict__ dst, int K, int N, int k0, int n0, const int tid, const float* __restrict__ gain) {
  float* lt = (float*)smem;
  { const int kk = tid >> 4, n4 = tid & 15;
#pragma unroll
    for (int i = 0; i < 2; ++i) {
      const int k = kk + i * 32;
      const float4 v = *(const float4*)(src + (size_t)(k0 + k) * N + n0 + n4 * 4);
      float* d = lt + k * 65 + n4 * 4;
      d[0] = v.x; d[1] = v.y; d[2] = v.z; d[3] = v.w;
    } }
  __syncthreads();
  { const int n = tid >> 3, k8 = tid & 7;
    float f[8];
#pragma unroll
    for (int i = 0; i < 8; ++i) f[i] = lt[(k8 * 8 + i) * 65 + n] * (gain ? gain[k0 + k8 * 8 + i] : 1.0f);
    uint4 o; o.x = pack2(f[0], f[1]); o.y = pack2(f[2], f[3]); o.z = pack2(f[4], f[5]); o.w = pack2(f[6], f[7]);
    *(uint4*)(dst + (size_t)(n0 + n) * K + k0 + k8 * 8) = o; }
  __syncthreads();
}

__device__ __forceinline__ void phase0(const Params& p, const int wave_s) {
  const int tid = opaque_tid(wave_s), lane = tid & 63, wid = tid >> 6;
  const int gw = blockIdx.x * 8 + wid, nw = gridDim.x * 8;
  const size_t gt = (size_t)blockIdx.x * 512 + tid, ntd = (size_t)gridDim.x * 512;
  for (int row = gw; row < MT; row += nw) {
    const float4* xr = (const float4*)(row < NP ? p.x_prompt + (size_t)row * D : p.x_sample + (size_t)(row - NP) * D);
    float ss = 0.f;
#pragma unroll
    for (int i = 0; i < 4; ++i) {
      const float4 v = xr[lane + 64 * i];
      ss += v.x * v.x + v.y * v.y + v.z * v.z + v.w * v.w;
      uint2 o; o.x = pack2(v.x, v.y); o.y = pack2(v.z, v.w);
      *(uint2*)(p.xg + (size_t)row * D + (lane + 64 * i) * 4) = o;
    }
    ss = wave_sum(ss);
    if (lane == 0) p.sumsq[row] = ss;
  }
  for (size_t i = gt; i < (size_t)3 * MT; i += ntd) p.sumsq[MT + i] = 0.f;
  for (size_t i = gt; i < (size_t)2056 * 8; i += ntd) {
    const int pi = (int)(i >> 3), fi = (int)(i & 7);
    const int pos = pi < 2048 ? pi : 8192 + (pi - 2048);
    float inv;
    switch (fi) { case 0: inv = 1.0f; break; case 1: inv = 0.1939227432012558f; break; case 2: inv = 0.03760603070259094f; break;
      case 3: inv = 0.007292664609849453f; break; case 4: inv = 0.0014142135623842478f; break; case 5: inv = 0.00027424818836152554f; break;
      case 6: inv = 5.318296098266728e-05f; break; default: inv = 1.0313386155758053e-05f; break; }
    const float ang = (float)pos * inv;
    p.rope[pi * 16 + fi] = cosf(ang);
    p.rope[pi * 16 + 8 + fi] = sinf(ang);
  }
  {
    float* lt = (float*)smem;
    constexpr int QL = (640 + 192 + 1024 + 1024) / 4;
    for (int t = blockIdx.x; t < 2 * QL; t += gridDim.x) {
      const int l = t / QL; int r = t % QL;
      const float* src; u16* dst; int K, N; const float* gain = nullptr;
      if (r < 160) { src = p.w_in + (size_t)l * D * IC; dst = p.wt_in + (size_t)l * IC * D; K = D; N = IC; gain = p.norm1_g + l * D; }
      else if (r < 208) { r -= 160; src = p.w_out + (size_t)l * MC * D; dst = p.wt_out + (size_t)l * D * MC; K = MC; N = D; }
      else if (r < 464) { r -= 208; src = p.w_up + (size_t)l * D * FF; dst = p.wt_up + (size_t)l * FF * D; K = D; N = FF; gain = p.norm2_g + l * D; }
      else { r -= 464; src = p.w_down + (size_t)l * FF * D; dst = p.wt_down + (size_t)l * D * FF; K = FF; N = D; }
      const int nq = N / 256;
      const int k0 = (r / nq) * 64, n0 = (r % nq) * 256;
      { const int kk = tid >> 6, n4 = tid & 63;
        float4 v[8];
#pragma unroll
        for (int i = 0; i < 8; ++i) v[i] = *(const float4*)(src + (size_t)(k0 + kk + 8 * i) * N + n0 + n4 * 4);
#pragma unroll
        for (int i = 0; i < 8; ++i) {
          const float gg = gain ? gain[k0 + kk + 8 * i] : 1.0f;
          *(float4*)(lt + (kk + 8 * i) * 260 + n4 * 4) = make_float4(v[i].x * gg, v[i].y * gg, v[i].z * gg, v[i].w * gg);
        } }
      __syncthreads();
      { const int n = tid >> 1, kh = (tid & 1) * 32;
        u16* dp = dst + (size_t)(n0 + n) * K + k0 + kh;
#pragma unroll
        for (int c = 0; c < 4; ++c) {
          float f[8];
#pragma unroll
          for (int i = 0; i < 8; ++i) f[i] = lt[(kh + c * 8 + i) * 260 + n];
          uint4 o; o.x = pack2(f[0], f[1]); o.y = pack2(f[2], f[3]); o.z = pack2(f[4], f[5]); o.w = pack2(f[6], f[7]);
          *(uint4*)(dp + c * 8) = o;
        } }
      __syncthreads();
    }
    for (int t = blockIdx.x; t < 8; t += gridDim.x)
      tr_tile(p.pool_w + (size_t)t * 4096, p.pwT + (size_t)t * 4096, 64, 64, 0, 0, tid, nullptr);
  }
}


__device__ __forceinline__ void load_qk(const u16* __restrict__ rowp, const float* __restrict__ ropep, const float* __restrict__ gain,
                                        const float scale, bf16x8 out[4], const int h) {
  float f[4][8];
  float ss = 0.f;
#pragma unroll
  for (int s = 0; s < 4; ++s) {
    const bf16x8 raw = *(const bf16x8*)(rowp + 16 * s + 8 * h);
#pragma unroll
    for (int j = 0; j < 8; ++j) { f[s][j] = bfs2f(raw[j]); ss += f[s][j] * f[s][j]; }
  }
  ss += __shfl_xor(ss, 32);
  const float inv = rsqrtf(ss * (1.0f / 64.0f) + EPS);
#pragma unroll
  for (int s = 0; s < 4; ++s) {
    const float4 g0 = *(const float4*)(gain + 16 * s + 8 * h), g1 = *(const float4*)(gain + 16 * s + 8 * h + 4);
    f[s][0] *= inv * g0.x; f[s][1] *= inv * g0.y; f[s][2] *= inv * g0.z; f[s][3] *= inv * g0.w;
    f[s][4] *= inv * g1.x; f[s][5] *= inv * g1.y; f[s][6] *= inv * g1.z; f[s][7] *= inv * g1.w;
  }
  {
    const float4 c0 = *(const float4*)(ropep), c1 = *(const float4*)(ropep + 4), s0 = *(const float4*)(ropep + 8), s1 = *(const float4*)(ropep + 12);
    const float cs[8] = {c0.x, c0.y, c0.z, c0.w, c1.x, c1.y, c1.z, c1.w};
    const float sn[8] = {s0.x, s0.y, s0.z, s0.w, s1.x, s1.y, s1.z, s1.w};
#pragma unroll
    for (int j = 0; j < 8; ++j) {
      const float other = __shfl_xor(f[0][j], 32);
      f[0][j] = (h == 0) ? (f[0][j] * cs[j] - other * sn[j]) : (f[0][j] * cs[j] + other * sn[j]);
    }
  }
#pragma unroll
  for (int s = 0; s < 4; ++s)
#pragma unroll
    for (int j = 0; j < 8; ++j) out[s][j] = (short)f2bf(f[s][j] * scale);
}

template <bool SAMPLE>
__device__ __forceinline__ void attn_task(const Params& p, const int layer, const int task, const int lane_unused) {
  const int lane = opaque_lane();
  int g, hslot, b, r, tile, nq;
  if (!SAMPLE) {
    const int c = task & 63; int tmp = task >> 6; g = tmp % 3; tmp /= 3; hslot = tmp & 1; b = tmp >> 1;
    const int tpc = 64 >> (2 * g);
    r = c / tpc; tile = c % tpc; nq = 32;
  } else {
    b = task / 26; const int rem = task % 26; hslot = rem / 13; const int c = rem % 13;
    if (c == 0) { g = 0; r = 0; nq = 8; } else if (c < 5) { g = 1; r = c - 1; nq = 2; } else { g = 2; r = c - 5; nq = 1; }
    tile = 4;
  }
  const int dl = 1 << (2 * g);
  const int W = 128 << (2 * g);
  const int m0 = tile * 32;
  const int head = 2 * g + hslot;
  const u16* projb = SAMPLE ? p.proj + (size_t)(NP + b * 8) * IC : p.proj + (size_t)b * 2048 * IC;
  const int ropeb = SAMPLE ? 2048 : 0;
  const float* cache = SAMPLE ? ((g == 0) ? p.kv_in[0] : (g == 1) ? p.kv_in[1] : p.kv_in[2]) + (size_t)(layer * 32 + b) * W * 256 + hslot * 64 : nullptr;
  const int qi = lane & 31, h = lane >> 5;
  int tq;
  if (SAMPLE) tq = r + dl * (qi < nq ? qi : 0); else tq = (m0 + qi) * dl + r;
  bf16x8 qf[4];
  load_qk(projb + (size_t)tq * IC + C_Q + head * 64, p.rope + (ropeb + tq) * 16, p.q_norm_g + layer * 64, 0.125f, qf, h);
  const int kt_lo = SAMPLE ? 0 : max(0, 4 - tile);
  f32x16 sacc[5];
#pragma unroll
  for (int kt = 0; kt < 5; ++kt) {
#pragma unroll
    for (int i = 0; i < 16; ++i) sacc[kt][i] = 0.f;
    if (kt >= kt_lo) {
      bf16x8 kf[4];
      if (SAMPLE && kt < 4) {
        const float* kp = cache + (size_t)(r + dl * (32 * kt + qi)) * 256 + 8 * h;
#pragma unroll
        for (int s = 0; s < 4; ++s) {
          const float4 x0 = *(const float4*)(kp + 16 * s), x1 = *(const float4*)(kp + 16 * s + 4);
          kf[s][0] = (short)f2bf(x0.x); kf[s][1] = (short)f2bf(x0.y); kf[s][2] = (short)f2bf(x0.z); kf[s][3] = (short)f2bf(x0.w);
          kf[s][4] = (short)f2bf(x1.x); kf[s][5] = (short)f2bf(x1.y); kf[s][6] = (short)f2bf(x1.z); kf[s][7] = (short)f2bf(x1.w);
        }
      } else {
        int tk;
        if (SAMPLE) tk = r + dl * (qi < nq ? qi : 0); else tk = (m0 - 128 + 32 * kt + qi) * dl + r;
        load_qk(projb + (size_t)tk * IC + C_K + head * 64, p.rope + (ropeb + tk) * 16, p.k_norm_g + layer * 64, 1.0f, kf, h);
      }
#pragma unroll
      for (int s = 0; s < 4; ++s) sacc[kt] = MFMA32(kf[s], qf[s], sacc[kt]);
    }
  }
  float mx = -1e30f;
#pragma unroll
  for (int kt = 0; kt < 5; ++kt)
#pragma unroll
    for (int rr = 0; rr < 16; ++rr) {
      const int keyrow = (rr & 3) + 8 * (rr >> 2) + 4 * h;
      const int dist = 128 - 32 * kt + qi - keyrow;
      const bool valid = (kt >= kt_lo) && dist >= 0 && dist <= 128;
      const float s = valid ? sacc[kt][rr] : -1e30f;
      sacc[kt][rr] = s;
      mx = fmaxf(mx, s);
    }
  mx = fmaxf(mx, __shfl_xor(mx, 32));
  float sum = 0.f;
#pragma unroll
  for (int kt = 0; kt < 5; ++kt)
#pragma unroll
    for (int rr = 0; rr < 16; ++rr) {
      const float s = sacc[kt][rr];
      const float ex = (s > -1e29f) ? __expf(s - mx) : 0.f;
      sacc[kt][rr] = ex;
      sum += ex;
    }
  sum += __shfl_xor(sum, 32);
  f32x16 oacc[2];
#pragma unroll
  for (int i = 0; i < 16; ++i) { oacc[0][i] = 0.f; oacc[1][i] = 0.f; }
#pragma unroll
  for (int kt = 0; kt < 5; ++kt) {
    if (kt >= kt_lo) {
#pragma unroll
      for (int s2 = 0; s2 < 2; ++s2) {
        bf16x8 pf;
#pragma unroll
        for (int j = 0; j < 8; ++j) pf[j] = (short)f2bf(sacc[kt][8 * s2 + j]);
        bf16x8 v0, v1;
#pragma unroll
        for (int j = 0; j < 8; ++j) {
          const int kr = 16 * s2 + 8 * (j >> 2) + 4 * h + (j & 3);
          if (SAMPLE && kt < 4) {
            const float* vp = cache + (size_t)(r + dl * (32 * kt + kr)) * 256 + 128 + qi;
            v0[j] = (short)f2bf(vp[0]); v1[j] = (short)f2bf(vp[32]);
          } else {
            int tk;
            if (SAMPLE) tk = r + dl * (kr < nq ? kr : 0); else tk = (m0 - 128 + 32 * kt + kr) * dl + r;
            const u16* vp = projb + (size_t)tk * IC + C_V + head * 64 + qi;
            v0[j] = (short)vp[0]; v1[j] = (short)vp[32];
          }
        }
        oacc[0] = MFMA32(v0, pf, oacc[0]);
        oacc[1] = MFMA32(v1, pf, oacc[1]);
      }
    }
  }
  const float isum = 1.0f / sum;
  const size_t rowq = SAMPLE ? (size_t)NP + b * 8 + tq : (size_t)b * 2048 + tq;
  if (!SAMPLE || qi < nq) {
    float* op = p.opart + ((size_t)g * MT + rowq) * 128 + hslot * 64;
#pragma unroll
    for (int db = 0; db < 2; ++db)
#pragma unroll
      for (int i4 = 0; i4 < 4; ++i4) {
        float4 o; o.x = oacc[db][4 * i4] * isum; o.y = oacc[db][4 * i4 + 1] * isum; o.z = oacc[db][4 * i4 + 2] * isum; o.w = oacc[db][4 * i4 + 3] * isum;
        *(float4*)(op + db * 32 + 8 * i4 + 4 * h) = o;
      }
    if (h == 0) p.lse[((size_t)g * MT + rowq) * 2 + hslot] = mx + __logf(sum);
  }
}

__device__ __forceinline__ void kv_row_task(const Params& p, const int l, const int row, const int lane) {
  const int hl = lane < 48 ? lane : 47;
  const int head = hl >> 3, c8 = hl & 7;
  int b, t, ridx;
  const bool prompt = row < NP;
  if (prompt) { b = row >> 11; t = row & 2047; ridx = t; } else { b = (row - NP) >> 3; t = (row - NP) & 7; ridx = 2048 + t; }
  const u16* pr = p.proj + (size_t)row * IC;
  const bf16x8 kr = *(const bf16x8*)(pr + C_K + hl * 8);
  const bf16x8 vr = *(const bf16x8*)(pr + C_V + hl * 8);
  float f[8]; float ss = 0.f;
#pragma unroll
  for (int j = 0; j < 8; ++j) { f[j] = bfs2f(kr[j]); ss += f[j] * f[j]; }
  ss += __shfl_xor(ss, 1); ss += __shfl_xor(ss, 2); ss += __shfl_xor(ss, 4);
  const float inv = rsqrtf(ss * (1.0f / 64.0f) + EPS);
  const float* gk = p.k_norm_g + l * 64 + c8 * 8;
#pragma unroll
  for (int j = 0; j < 8; ++j) f[j] *= inv * gk[j];
  const float* rp = p.rope + ridx * 16;
#pragma unroll
  for (int j = 0; j < 8; ++j) {
    const float other = __shfl_xor(f[j], 1);
    const float cs = rp[j], sn = rp[8 + j];
    if (c8 == 0) f[j] = f[j] * cs - other * sn;
    else if (c8 == 1) f[j] = f[j] * cs + other * sn;
  }
  const int g = head >> 1, hh = head & 1;
  const int W = 128 << (2 * g);
  float* dst = nullptr;
  if (prompt) {
    const int r = t - (2048 - W);
    const size_t base = (g == 0) ? O_KV128P : (g == 1) ? O_KV512P : O_KV2048P;
    if (r >= 0) dst = p.out + base + ((size_t)(l * 8 + b) * W + r) * 256 + hh * 64 + c8 * 8;
  } else {
    const int r = W - 8 + t;
    const size_t base = (g == 0) ? O_KV128S : (g == 1) ? O_KV512S : O_KV2048S;
    dst = p.out + base + ((size_t)(l * 32 + b) * W + r) * 256 + hh * 64 + c8 * 8;
  }
  if (dst && lane < 48) {
    *(float4*)(dst) = make_float4(f[0], f[1], f[2], f[3]);
    *(float4*)(dst + 4) = make_float4(f[4], f[5], f[6], f[7]);
    *(float4*)(dst + 128) = make_float4(bfs2f(vr[0]), bfs2f(vr[1]), bfs2f(vr[2]), bfs2f(vr[3]));
    *(float4*)(dst + 132) = make_float4(bfs2f(vr[4]), bfs2f(vr[5]), bfs2f(vr[6]), bfs2f(vr[7]));
  }
}

__device__ __forceinline__ void phaseA(const Params& p, const int l, const int wave_s) {
  const int tid = opaque_tid(wave_s);
  const int lane = tid & 63, wid = tid >> 6;
  const int gw = blockIdx.x * 8 + wid, nw = gridDim.x * 8;
  for (int task = gw; task < 832 + 3072; task += nw) { if (task < 832) attn_task<true>(p, l, task, lane); else attn_task<false>(p, l, task - 832, lane); }
  for (int row = nw - 1 - gw; row < MT; row += nw) kv_row_task(p, l, row, lane);
}

template <int GRP>
__device__ __forceinline__ void pool_task(const Params& p, const int l, const int task, const int lane) {
  const int tile = task >> 2; constexpr int grp = GRP;
  const int qi = lane & 31, h = lane >> 5;
  const int row = tile * 32 + qi;
  constexpr int w = 2 << GRP;
  const bool prompt = row < NP;
  int n, t; float cnt;
  if (prompt) { n = row >> 11; t = row & 2047; cnt = (float)min(t + 1, w); } else { n = (row - NP) >> 3; t = (row - NP) & 7; cnt = (float)w; }
  const float icnt = 1.0f / cnt;
  f32x16 acc[2];
#pragma unroll
  for (int i = 0; i < 16; ++i) { acc[0][i] = 0.f; acc[1][i] = 0.f; }
  const u16* pw = p.pwT + (size_t)(l * 4 + grp) * 4096;
#pragma unroll
  for (int s = 0; s < 4; ++s) {
    const int c0 = grp * 64 + 16 * s + 8 * h;
    float sum[8], own[8];
#pragma unroll
    for (int j = 0; j < 8; ++j) { sum[j] = 0.f; own[j] = 0.f; }
#pragma unroll
    for (int i = 0; i < w; ++i) {
      const int tt = t - i;
      float v[8];
      if (tt >= 0) {
        const bf16x8 raw = *(const bf16x8*)(p.proj + (size_t)(row - i) * IC + C_U + c0);
#pragma unroll
        for (int j = 0; j < 8; ++j) v[j] = bfs2f(raw[j]);
      } else if (!prompt) {
        const float* sp = p.state_pool + ((size_t)(l * 32 + n) * 15 + 15 + tt) * 256 + c0;
        const float4 a = *(const float4*)sp, bb = *(const float4*)(sp + 4);
        v[0] = a.x; v[1] = a.y; v[2] = a.z; v[3] = a.w; v[4] = bb.x; v[5] = bb.y; v[6] = bb.z; v[7] = bb.w;
      } else {
#pragma unroll
        for (int j = 0; j < 8; ++j) v[j] = 0.f;
      }
#pragma unroll
      for (int j = 0; j < 8; ++j) sum[j] += v[j];
      if (i == 0) {
#pragma unroll
        for (int j = 0; j < 8; ++j) own[j] = v[j];
      }
    }
    bf16x8 df;
#pragma unroll
    for (int j = 0; j < 8; ++j) df[j] = (short)f2bf(sum[j] * icnt - own[j]);
    const bf16x8 a0 = *(const bf16x8*)(pw + (size_t)qi * 64 + 16 * s + 8 * h);
    const bf16x8 a1 = *(const bf16x8*)(pw + (size_t)(qi + 32) * 64 + 16 * s + 8 * h);
    acc[0] = MFMA32(a0, df, acc[0]);
    acc[1] = MFMA32(a1, df, acc[1]);
  }
  const float* ps = p.pool_scale + l * 256 + grp * 64;
  u16* mp = p.mixed + (size_t)row * MC + grp * 64;
#pragma unroll
  for (int db = 0; db < 2; ++db)
#pragma unroll
    for (int i4 = 0; i4 < 4; ++i4) {
      const int dd0 = db * 32 + 8 * i4 + 4 * h;
      const float4 sc = *(const float4*)(ps + dd0);
      uint2 o; o.x = pack2(acc[db][4 * i4] * sc.x, acc[db][4 * i4 + 1] * sc.y); o.y = pack2(acc[db][4 * i4 + 2] * sc.z, acc[db][4 * i4 + 3] * sc.w);
      *(uint2*)(mp + dd0) = o;
    }
}

__device__ __forceinline__ void phaseB(const Params& p, const int l, const int wave_s) {
  const int tid = opaque_tid(wave_s), lane = tid & 63, wid = tid >> 6;
  const int gw = blockIdx.x * 8 + wid, nw = gridDim.x * 8;
  const size_t gt = (size_t)blockIdx.x * 512 + tid, ntd = (size_t)gridDim.x * 512;
  for (int task = gw; task < 520 * 4; task += nw) {
    switch (task & 3) { case 0: pool_task<0>(p, l, task, lane); break; case 1: pool_task<1>(p, l, task, lane); break;
                        case 2: pool_task<2>(p, l, task, lane); break; default: pool_task<3>(p, l, task, lane); break; }
  }
  for (size_t idx = gt; idx < (size_t)MT * 48; idx += ntd) {
    const int row = (int)(idx / 48), ch = (int)(idx % 48) * 8;
    const bool prompt = row < NP;
    int n, t;
    if (prompt) { n = row >> 11; t = row & 2047; } else { n = (row - NP) >> 3; t = (row - NP) & 7; }
    float z[3][8];
#pragma unroll
    for (int i = 0; i < 3; ++i) {
      const int tt = t - 2 + i;
      if (tt >= 0) {
        const u16* pr = p.proj + (size_t)(row - 2 + i) * IC;
        const bf16x8 gc = *(const bf16x8*)(pr + C_GC + ch), gh = *(const bf16x8*)(pr + C_GH + ch);
#pragma unroll
        for (int j = 0; j < 8; ++j) z[i][j] = bfs2f(gc[j]) * bfs2f(gh[j]);
      } else if (!prompt) {
        const float* sp = p.state_conv + ((size_t)(l * 32 + n) * 2 + 2 + tt) * 384 + ch;
        const float4 a = *(const float4*)sp, bb = *(const float4*)(sp + 4);
        z[i][0] = a.x; z[i][1] = a.y; z[i][2] = a.z; z[i][3] = a.w; z[i][4] = bb.x; z[i][5] = bb.y; z[i][6] = bb.z; z[i][7] = bb.w;
      } else {
#pragma unroll
        for (int j = 0; j < 8; ++j) z[i][j] = 0.f;
      }
    }
    const bf16x8 gb = *(const bf16x8*)(p.proj + (size_t)row * IC + C_GB + ch);
    const float* cw = p.conv_w + (size_t)l * 3 * 384 + ch;
    float y[8];
#pragma unroll
    for (int j = 0; j < 8; ++j) y[j] = bfs2f(gb[j]) * (cw[j] * z[0][j] + cw[384 + j] * z[1][j] + cw[768 + j] * z[2][j]);
    uint4 o; o.x = pack2(y[0], y[1]); o.y = pack2(y[2], y[3]); o.z = pack2(y[4], y[5]); o.w = pack2(y[6], y[7]);
    *(uint4*)(p.mixed + (size_t)row * MC + 384 + ch) = o;
    float* so = nullptr;
    if (prompt) { if (t >= 2046) so = p.out + O_CONVP + ((size_t)(l * 8 + n) * 2 + (t - 2046)) * 384 + ch; }
    else { if (t >= 6) so = p.out + O_CONVS + ((size_t)(l * 32 + n) * 2 + (t - 6)) * 384 + ch; }
    if (so) { *(float4*)so = make_float4(z[2][0], z[2][1], z[2][2], z[2][3]); *(float4*)(so + 4) = make_float4(z[2][4], z[2][5], z[2][6], z[2][7]); }
  }
  for (size_t idx = gt; idx < (size_t)MT * 16; idx += ntd) {
    const int row = (int)(idx >> 4), chunk = (int)(idx & 15);
    const int hslot = chunk >> 3, d0 = (chunk & 7) * 8;
    float lg[3];
#pragma unroll
    for (int g = 0; g < 3; ++g) lg[g] = p.lse[((size_t)g * MT + row) * 2 + hslot];
    const float m = fmaxf(lg[0], fmaxf(lg[1], lg[2]));
    float wg[3]; wg[0] = __expf(lg[0] - m); wg[1] = __expf(lg[1] - m); wg[2] = __expf(lg[2] - m);
    const float iw = 1.0f / (wg[0] + wg[1] + wg[2]);
    float y[8];
#pragma unroll
    for (int j = 0; j < 8; ++j) y[j] = 0.f;
#pragma unroll
    for (int g = 0; g < 3; ++g) {
      const float* op = p.opart + ((size_t)g * MT + row) * 128 + hslot * 64 + d0;
      const float4 a = *(const float4*)op, bb = *(const float4*)(op + 4);
      const float ww = wg[g] * iw;
      y[0] += ww * a.x; y[1] += ww * a.y; y[2] += ww * a.z; y[3] += ww * a.w; y[4] += ww * bb.x; y[5] += ww * bb.y; y[6] += ww * bb.z; y[7] += ww * bb.w;
    }
    uint4 o; o.x = pack2(y[0], y[1]); o.y = pack2(y[2], y[3]); o.z = pack2(y[4], y[5]); o.w = pack2(y[6], y[7]);
    *(uint4*)(p.mixed + (size_t)row * MC + 256 + hslot * 64 + d0) = o;
  }
  for (size_t idx = gt; idx < (size_t)8 * 15 * 256; idx += ntd) {
    const int c = (int)(idx & 255); const int bi = (int)(idx >> 8); const int i = bi % 15, b = bi / 15;
    p.out[O_POOLP + (size_t)l * 8 * 15 * 256 + idx] = bf2f(p.proj[((size_t)b * 2048 + 2033 + i) * IC + C_U + c]);
  }
  for (size_t idx = gt; idx < (size_t)32 * 15 * 256; idx += ntd) {
    const int c = (int)(idx & 255); const int bi = (int)(idx >> 8); const int i = bi % 15, n = bi / 15;
    float v;
    if (i < 7) v = p.state_pool[((size_t)(l * 32 + n) * 15 + 8 + i) * 256 + c];
    else v = bf2f(p.proj[((size_t)NP + n * 8 + (i - 7)) * IC + C_U + c]);
    p.out[O_POOLS + (size_t)l * 32 * 15 * 256 + idx] = v;
  }
}

#ifndef REPM
#define REPM 0
#endif
#define NREP(k) (1 + ((REPM >> (k)) & 1))
typedef const __attribute__((address_space(4))) Params* CP;
#if defined(__HIP_DEVICE_COMPILE__)
#define LOAD_PARAMS() CP pp_ = (CP)__builtin_amdgcn_kernarg_segment_ptr(); asm volatile("" : "+s"(pp_)); const Params p = *pp_
#else
#define LOAD_PARAMS() const Params& p = p_unused
#endif
__global__ void __launch_bounds__(512, 2) mega(const Params p_unused, const int ph_lo, const int ph_hi) {
  const int wave_s = __builtin_amdgcn_readfirstlane((int)(threadIdx.x >> 6));
  if (ph_hi == -12345) cg::this_grid().sync();
  {
    LOAD_PARAMS();
    if (opaque_tid(wave_s) == 0) {
      volatile __attribute__((address_space(3))) unsigned* st = (volatile __attribute__((address_space(3))) unsigned*)(smem + BAR_LDS_OFF);
      st[0] = 0u; st[1] = 0u;
      (void)xb_add(&p.bar[XB_XCNT(xb_xcc_id())], 1u);
    }
    __syncthreads();
  }
  int ph = 0;
#define IN_PH() (ph_lo <= ph && ph < ph_hi)
#define SEAM() do { if (ph_lo <= ph && ph + 1 < ph_hi) { LOAD_PARAMS(); grid_bar(p.bar, wave_s); } ++ph; } while (0)
  if (IN_PH()) for (int rep = 0; rep < NREP(0); ++rep) { LOAD_PARAMS(); phase0(p, wave_s); }
  SEAM();
#pragma unroll 1
  for (int l = 0; l < 2; ++l) {
    if (IN_PH()) for (int rep = 0; rep < NREP(1); ++rep) {
      LOAD_PARAMS();
      GemmEpi e{}; e.sumsq_in = p.sumsq + (size_t)(2 * l) * MT; e.out_bf = p.proj; e.ldo = IC;
      gemm_phase<1>(p.xg, p.wt_in + (size_t)l * IC * D, NP, IC, D, e, wave_s);
      { const int G = gridDim.x, first = (64 * (IC / 256)) % G;
        const int b0 = first ? first : 0, nb = G - b0;
        kv_shift_copy(p, l, b0, nb, opaque_tid(wave_s));
        sample_gemm<1>(p.xg, p.wt_in + (size_t)l * IC * D, IC, D, e, wave_s, b0, nb); }
    }
    SEAM();
    if (IN_PH()) for (int rep = 0; rep < NREP(2); ++rep) { LOAD_PARAMS(); phaseA(p, l, wave_s); }
    SEAM();
    if (IN_PH()) for (int rep = 0; rep < NREP(3); ++rep) { LOAD_PARAMS(); phaseB(p, l, wave_s); }
    SEAM();
    if (IN_PH()) for (int rep = 0; rep < NREP(4); ++rep) {
      LOAD_PARAMS();
      GemmEpi e{};
      e.xh = p.xg; e.out_f = nullptr; e.sumsq_out = p.sumsq + (size_t)(2 * l + 1) * MT;
      gemm_phase<2>(p.mixed, p.wt_out + (size_t)l * D * MC, NP, D, MC, e, wave_s);
      sample_gemm<2>(p.mixed, p.wt_out + (size_t)l * D * MC, D, MC, e, wave_s, 0, gridDim.x);
    }
    SEAM();
    if (IN_PH()) for (int rep = 0; rep < NREP(5); ++rep) {
      LOAD_PARAMS();
      GemmEpi e{}; e.sumsq_in = p.sumsq + (size_t)(2 * l + 1) * MT; e.out_bf = p.hf; e.ldo = FF;
      gemm_phase<3>(p.xg, p.wt_up + (size_t)l * FF * D, NP, FF, D, e, wave_s);
      sample_gemm<3>(p.xg, p.wt_up + (size_t)l * FF * D, FF, D, e, wave_s, 0, gridDim.x);
    }
    SEAM();
    if (IN_PH()) for (int rep = 0; rep < NREP(6); ++rep) {
      LOAD_PARAMS();
      GemmEpi e{};
      e.xh = p.xg;
      if (l == 0) { e.out_f = nullptr; e.sumsq_out = p.sumsq + (size_t)2 * MT; } else { e.out_f = p.out; e.sumsq_out = nullptr; }
      gemm_phase<2>(p.hf, p.wt_down + (size_t)l * D * FF, NP, D, FF, e, wave_s);
      sample_gemm<2>(p.hf, p.wt_down + (size_t)l * D * FF, D, FF, e, wave_s, 0, gridDim.x);
    }
    SEAM();
  }
}

extern "C" void kernel_launch(void* const* d_in, const int* in_sizes, int n_in, void* d_out, int out_size, void* d_ws, size_t ws_size, hipStream_t stream) {
  static int grid_blocks = 0;
  if (!grid_blocks) {
    int dev = 0, cus = 0, per_cu = 0;
    hipGetDevice(&dev);
    hipDeviceGetAttribute(&cus, hipDeviceAttributeMultiprocessorCount, dev);
    hipFuncSetAttribute((const void*)mega, hipFuncAttributeMaxDynamicSharedMemorySize, GEMM_LDS);
    hipOccupancyMaxActiveBlocksPerMultiprocessor(&per_cu, (const void*)mega, 512, GEMM_LDS);
    if (per_cu < 1) { fprintf(stderr, "occupancy query returned %d\n", per_cu); per_cu = 1; }
    grid_blocks = cus * 1;
  }
  Params p{};
  p.x_prompt = (const float*)d_in[0]; p.x_sample = (const float*)d_in[1]; p.state_pool = (const float*)d_in[2]; p.state_conv = (const float*)d_in[3];
  p.kv_in[0] = (const float*)d_in[4]; p.kv_in[1] = (const float*)d_in[5]; p.kv_in[2] = (const float*)d_in[6];
  p.norm1_g = (const float*)d_in[7]; p.w_in = (const float*)d_in[8]; p.q_norm_g = (const float*)d_in[9]; p.k_norm_g = (const float*)d_in[10];
  p.pool_w = (const float*)d_in[11]; p.pool_scale = (const float*)d_in[12]; p.conv_w = (const float*)d_in[13]; p.w_out = (const float*)d_in[14];
  p.norm2_g = (const float*)d_in[15]; p.w_up = (const float*)d_in[16]; p.w_down = (const float*)d_in[17];
  p.out = (float*)d_out;
  unsigned char* w = (unsigned char*)d_ws; size_t off = 0;
  auto carve = [&](size_t bytes) { unsigned char* r = w + off; off += (bytes + 255) & ~(size_t)255; return r; };
  p.bar = (unsigned*)carve(XCD_BAR_WORDS * 4);
  p.wt_in = (u16*)carve((size_t)2 * IC * D * 2);
  p.wt_out = (u16*)carve((size_t)2 * D * MC * 2);
  p.wt_up = (u16*)carve((size_t)2 * FF * D * 2);
  p.wt_down = (u16*)carve((size_t)2 * D * FF * 2);
  p.pwT = (u16*)carve((size_t)2 * 4 * 4096 * 2);
  p.xg = (u16*)carve((size_t)MT * D * 2);
  p.mixed = (u16*)carve((size_t)MT * MC * 2);
  p.sumsq = (float*)carve((size_t)4 * MT * 4);
  p.lse = (float*)carve((size_t)3 * MT * 2 * 4);
  p.rope = (float*)carve((size_t)2056 * 16 * 4);
  p.hf = (u16*)carve((size_t)MT * FF * 2);
  p.proj = p.hf;
  p.opart = (float*)((unsigned char*)p.hf + (((size_t)MT * IC * 2 + 255) & ~(size_t)255));
  if (off > ws_size) { fprintf(stderr, "workspace too small: need %zu have %zu\n", off, ws_size); return; }
  (void)hipMemsetAsync(p.bar, 0, XCD_BAR_WORDS * 4, stream);
  int lo = 0, hi = 13;
  void* args[] = {(void*)&p, (void*)&lo, (void*)&hi};
  hipError_t e = hipLaunchCooperativeKernel((const void*)mega, dim3(grid_blocks), dim3(512), args, GEMM_LDS, stream);
  if (e != hipSuccess) fprintf(stderr, "cooperative launch failed: %s (grid %d)\n", hipGetErrorString(e), grid_blocks);
}
```

```cpp
#include <hip/hip_runtime.h>
#include <hip/hip_cooperative_groups.h>
#include <cstdio>
namespace cg = cooperative_groups;

typedef unsigned short u16;
using bf16x8 = __attribute__((ext_vector_type(8))) short;
using f32x4 = __attribute__((ext_vector_type(4))) float;
using f32x16 = __attribute__((ext_vector_type(16))) float;

constexpr int NP = 16384, NS = 256, MT = NP + NS;
constexpr int D = 1024, IC = 2560, MC = 768, FF = 4096;
constexpr float EPS = 1e-6f;
constexpr int C_U = 0, C_Q = 256, C_K = 640, C_V = 1024, C_GB = 1408, C_GC = 1792, C_GH = 2176;
constexpr size_t O_YP = 0;
constexpr size_t O_YS = O_YP + (size_t)NP * D;
constexpr size_t O_POOLP = O_YS + (size_t)NS * D;
constexpr size_t O_CONVP = O_POOLP + 2 * 8 * 15 * 256;
constexpr size_t O_KV128P = O_CONVP + 2 * 8 * 2 * 384;
constexpr size_t O_KV512P = O_KV128P + (size_t)2 * 8 * 128 * 256;
constexpr size_t O_KV2048P = O_KV512P + (size_t)2 * 8 * 512 * 256;
constexpr size_t O_POOLS = O_KV2048P + (size_t)2 * 8 * 2048 * 256;
constexpr size_t O_CONVS = O_POOLS + 2 * 32 * 15 * 256;
constexpr size_t O_KV128S = O_CONVS + 2 * 32 * 2 * 384;
constexpr size_t O_KV512S = O_KV128S + (size_t)2 * 32 * 128 * 256;
constexpr size_t O_KV2048S = O_KV512S + (size_t)2 * 32 * 512 * 256;

struct Params {
  const float *x_prompt, *x_sample, *state_pool, *state_conv, *kv_in[3];
  const float *norm1_g, *w_in, *q_norm_g, *k_norm_g, *pool_w, *pool_scale, *conv_w, *w_out, *norm2_g, *w_up, *w_down;
  float* out;
  u16 *wt_in, *wt_out, *wt_up, *wt_down, *pwT;
  u16 *xg, *proj, *mixed, *hf;
  float *sumsq, *opart, *lse, *rope;
  unsigned* bar;
  u16* scr16; float* scrss; float* scrf;
};

extern __shared__ __attribute__((aligned(16))) unsigned char smem[];
typedef __attribute__((address_space(3))) void* LDSP;

__device__ __forceinline__ u16 f2bf(float f) { unsigned u = __float_as_uint(f); u += 0x7fffu + ((u >> 16) & 1u); return (u16)(u >> 16); }
__device__ __forceinline__ float bf2f(u16 h) { return __uint_as_float(((unsigned)h) << 16); }
__device__ __forceinline__ float bfs2f(short h) { return __uint_as_float(((unsigned)(u16)h) << 16); }
__device__ __forceinline__ unsigned pack2(float a, float b) { return (unsigned)f2bf(a) | ((unsigned)f2bf(b) << 16); }
__device__ __forceinline__ int opaque_tid(const int wave_s) {
  int l; asm volatile("v_mbcnt_lo_u32_b32 %0, -1, 0\n\tv_mbcnt_hi_u32_b32 %0, -1, %0" : "=v"(l));
  return wave_s * 64 + l;
}
__device__ __forceinline__ int opaque_lane() {
  int l; asm volatile("v_mbcnt_lo_u32_b32 %0, -1, 0\n\tv_mbcnt_hi_u32_b32 %0, -1, %0" : "=v"(l));
  return l;
}
#define XB_TMO      128
#define XB_XCNT(j)  (256  + 64 * (j))
#define XB_XSUB(j)  (1280 + 64 * (j))
#define XB_XGEN(j)  (2304 + 64 * (j))
#define XB_TOP      3328
#define XB_TOPGEN   3392
#define XCD_BAR_WORDS 3456
#define XB_SPIN_CAP (1u << 18)
constexpr int BAR_LDS_OFF = 131072;
__device__ __forceinline__ unsigned xb_ld(unsigned* p)              { return __hip_atomic_load(p, __ATOMIC_RELAXED, __HIP_MEMORY_SCOPE_AGENT); }
__device__ __forceinline__ unsigned xb_add(unsigned* p, unsigned v) { return __hip_atomic_fetch_add(p, v, __ATOMIC_RELAXED, __HIP_MEMORY_SCOPE_AGENT); }
__device__ __forceinline__ unsigned xb_xcc_id() { return (unsigned)__builtin_amdgcn_s_getreg((3 << 11) | 20) & 0xFu; }
#define XB_SPIN(cond, bar) do { unsigned _sp = 0; while (cond) { __builtin_amdgcn_s_sleep(1); \
    if ((++_sp & 255u) == 0u) { if (xb_ld(&(bar)[XB_TMO])) break; if (_sp > XB_SPIN_CAP) { atomicAdd(&(bar)[XB_TMO], 1u); break; } } } } while (0)
__device__ __forceinline__ void xcd_barrier_complete(unsigned* bar, unsigned x, unsigned& nloc, unsigned& nx) {
  const unsigned G = gridDim.x;
  unsigned sum, cnt, mine, sp = 0u;
  for (;;) {
    sum = 0u; cnt = 0u; mine = 0u;
#pragma unroll
    for (unsigned j = 0; j < 16; ++j) { const unsigned c = xb_ld(&bar[XB_XCNT(j)]); sum += c; cnt += (c > 0u) ? 1u : 0u; mine = (j == x) ? c : mine; }
    if (sum == G) break;
    __builtin_amdgcn_s_sleep(1);
    if ((++sp & 255u) == 0u) { if (xb_ld(&bar[XB_TMO])) break; if (sp > XB_SPIN_CAP) { atomicAdd(&bar[XB_TMO], 1u); break; } }
  }
  nloc = mine > 0u ? mine : 1u; nx = cnt > 0u ? cnt : 1u;
}
__device__ __forceinline__ void grid_bar(unsigned* bar, const int wave_s) {
  asm volatile("s_waitcnt vmcnt(0)" ::: "memory");
  __syncthreads();
  if (opaque_tid(wave_s) == 0) {
    volatile __attribute__((address_space(3))) unsigned* st = (volatile __attribute__((address_space(3))) unsigned*)(smem + BAR_LDS_OFF);
    const unsigned x = xb_xcc_id();
    __builtin_amdgcn_s_waitcnt(0);
    unsigned nloc = st[0], nx = st[1];
    if (nloc == 0u) { xcd_barrier_complete(bar, x, nloc, nx); st[0] = nloc; st[1] = nx; }
    const unsigned old = xb_add(&bar[XB_XSUB(x)], 1u);
    const unsigned gen = old / nloc;
    if (old + 1u == (gen + 1u) * nloc) {
      __builtin_amdgcn_fence(__ATOMIC_RELEASE, "agent");
      asm volatile("s_waitcnt vmcnt(0)" ::: "memory");
      const unsigned og = xb_add(&bar[XB_TOP], 1u);
      const unsigned tg = og / nx;
      if (og + 1u == (tg + 1u) * nx) xb_add(&bar[XB_TOPGEN], 1u);
      else XB_SPIN(xb_ld(&bar[XB_TOPGEN]) == tg, bar);
      __builtin_amdgcn_fence(__ATOMIC_ACQUIRE, "agent");
      xb_add(&bar[XB_XGEN(x)], 1u);
      asm volatile("s_waitcnt vmcnt(0)" ::: "memory");
    } else {
      XB_SPIN(xb_ld(&bar[XB_XGEN(x)]) == gen, bar);
      __builtin_amdgcn_fence(__ATOMIC_ACQUIRE, "agent");
      asm volatile("s_waitcnt vmcnt(0)" ::: "memory");
    }
  }
  __syncthreads();
}
__device__ __forceinline__ float wave_sum(float v) { for (int o = 32; o; o >>= 1) v += __shfl_xor(v, o); return v; }
__device__ __forceinline__ float wave_max(float v) { for (int o = 32; o; o >>= 1) v = fmaxf(v, __shfl_xor(v, o)); return v; }

constexpr int BM = 256, BK = 64, HALF = 128, NXCD = 8, WGM = 8, HT = HALF * BK;
constexpr int GEMM_LDS = 8 * HT * 2 + 16;

__device__ __forceinline__ int lds_byte(int r, int c) {
  int st = (r >> 4) * 2 + (c >> 5), rr = r & 15, cc = c & 31, ob = rr * 64 + cc * 2;
  return st * 1024 + (ob ^ (((ob >> 9) & 1) << 5));
}
__device__ __forceinline__ int perm32(int rho) { const int n = rho >> 4, i = rho & 15; return 8 * (i >> 2) + 4 * n + (i & 3); }
__device__ __forceinline__ void stage_rc(int b, int& R, int& C) {
  int st = b / 1024, sb = b % 1024, swz = sb ^ (((sb >> 9) & 1) << 5);
  R = (st >> 1) * 16 + swz / 64; C = (st & 1) * 32 + (swz % 64) / 2;
}

struct GemmEpi {
  const float* sumsq_in;
  u16* out_bf; int ldo;
  u16* xh;
  u16* xh_out;
  float* out_f;
  float* sumsq_out;
};

template <int MODE, bool ADD_RESID>
__device__ __forceinline__ void epi4(const GemmEpi& e, const f32x4 a, const float rs, const size_t grow, const int col0, float& ssq) {
  if (MODE == 1 || MODE == 3) {
    float v0 = a[0] * rs, v1 = a[1] * rs, v2 = a[2] * rs, v3 = a[3] * rs;
    if (MODE == 3) { v0 = fmaxf(v0, 0.f); v1 = fmaxf(v1, 0.f); v2 = fmaxf(v2, 0.f); v3 = fmaxf(v3, 0.f); v0 *= v0; v1 *= v1; v2 *= v2; v3 *= v3; }
    uint2 o; o.x = pack2(v0, v1); o.y = pack2(v2, v3);
    *(uint2*)(e.out_bf + grow * e.ldo + col0) = o;
  } else {
    float4 x; x.x = a[0]; x.y = a[1]; x.z = a[2]; x.w = a[3];
    if (ADD_RESID) {
      const uint2 r = *(const uint2*)(e.xh + grow * D + col0);
      x.x += __uint_as_float(r.x << 16); x.y += __uint_as_float(r.x & 0xffff0000u); x.z += __uint_as_float(r.y << 16); x.w += __uint_as_float(r.y & 0xffff0000u);
    }
    if (e.out_f) *(float4*)(e.out_f + grow * D + col0) = x;
    else { uint2 ob; ob.x = pack2(x.x, x.y); ob.y = pack2(x.z, x.w); *(uint2*)(e.xh_out + grow * D + col0) = ob; }
    ssq += x.x * x.x + x.y * x.y + x.z * x.z + x.w * x.w;
  }
}

template <int MODE>
__device__ __forceinline__ void epi8(const GemmEpi& e, const f32x4 a0, const f32x4 a1, const float rs, const size_t grow, const int col8, float& ssq) {
  float v[8] = {a0[0], a0[1], a0[2], a0[3], a1[0], a1[1], a1[2], a1[3]};
  if (MODE == 1 || MODE == 3) {
#pragma unroll
    for (int i = 0; i < 8; ++i) { v[i] *= rs; if (MODE == 3) { v[i] = fmaxf(v[i], 0.f); v[i] *= v[i]; } }
    uint4 o; o.x = pack2(v[0], v[1]); o.y = pack2(v[2], v[3]); o.z = pack2(v[4], v[5]); o.w = pack2(v[6], v[7]);
    *(uint4*)(e.out_bf + grow * e.ldo + col8) = o;
  } else {
    if (e.out_f) { *(float4*)(e.out_f + grow * D + col8) = make_float4(v[0], v[1], v[2], v[3]); *(float4*)(e.out_f + grow * D + col8 + 4) = make_float4(v[4], v[5], v[6], v[7]); }
    else { uint4 o; o.x = pack2(v[0], v[1]); o.y = pack2(v[2], v[3]); o.z = pack2(v[4], v[5]); o.w = pack2(v[6], v[7]); *(uint4*)(e.xh_out + grow * D + col8) = o; }
#pragma unroll
    for (int i = 0; i < 8; ++i) ssq += v[i] * v[i];
  }
}

template <int MODE>
__device__ __forceinline__ void gemm_phase(const u16* __restrict__ A, const u16* __restrict__ Bt, const int M, const int N, const int K, const GemmEpi e, const int wave_s, const int dry = 0) {
  u16* shm = (u16*)smem;
#define SA(b, h) (shm + ((b) * 2 + (h)) * HT)
#define SB(b, h) (shm + (4 + (b) * 2 + (h)) * HT)
#define STAGE_(P, RS, br, kt, o0, o1) do { const unsigned _so = (unsigned)(((br) * K + (kt) * BK) * 2); \
    __builtin_amdgcn_raw_ptr_buffer_load_lds(RS, (LDSP)((char*)(P) + tid0 * 16), 16, o0, _so, 0, 0); \
    __builtin_amdgcn_raw_ptr_buffer_load_lds(RS, (LDSP)((char*)(P) + tid0 * 16 + 8192), 16, o1, _so, 0, 0); } while (0)
#define STAGE(P, RS, br, kt) STAGE_(P, RS, br, kt, toff0, toff1)
#define STAGEB(P, RS, br, kt) STAGE_(P, RS, br, kt, toffb0, toffb1)
#define LDA(dst, b, h) for (int m = 0; m < 4; ++m) for (int k = 0; k < 2; ++k) \
    dst[m][k] = *reinterpret_cast<const bf16x8*>((char*)SA(b, h) + lds_byte(wr * 64 + m * 16 + fr, k * 32 + fq * 8))
#define LDB(dst, b, h) for (int n = 0; n < 2; ++n) for (int k = 0; k < 2; ++k) \
    dst[n][k] = *reinterpret_cast<const bf16x8*>((char*)SB(b, h) + lds_byte(wc * 32 + n * 16 + fr, k * 32 + fq * 8))
#define MMA(ai, bj, At, Bt_) do { __builtin_amdgcn_s_setprio(1); \
    for (int m = 0; m < 4; ++m) for (int n = 0; n < 2; ++n) for (int k = 0; k < 2; ++k) \
      acc[ai][bj][m][n] = __builtin_amdgcn_mfma_f32_16x16x32_bf16(Bt_[n][k], At[m][k], acc[ai][bj][m][n], 0, 0, 0); \
    __builtin_amdgcn_s_setprio(0); } while (0)
#define WAIT_V(n) asm volatile("s_waitcnt vmcnt(" #n ")" ::: "memory")
#define WAIT_L(n) asm volatile("s_waitcnt lgkmcnt(" #n ")" ::: "memory")
#define BAR __builtin_amdgcn_s_barrier()
#define SCHED __builtin_amdgcn_sched_barrier(0)
#define DECODE(tt_, brow_, bcol_) do { int wgid = (tt_); \
    { int q = nwg / NXCD, r = nwg % NXCD, xcd = wgid % NXCD, off = wgid / NXCD; \
      wgid = (xcd < r ? xcd * (q + 1) : r * (q + 1) + (xcd - r) * q) + off; } \
    int nig = WGM * nN, gid = wgid / nig, fm = gid * WGM, gsz = min(nM - fm, WGM); \
    brow_ = (fm + ((wgid % nig) % gsz)) * BM; bcol_ = ((wgid % nig) / gsz) * BM; } while (0)
#define STAGE7(brow_, bcol_) do { \
    STAGEB(SB(0, 0), rsB, bcol_, 0); STAGE(SA(0, 0), rsA, brow_, 0); \
    STAGEB(SB(0, 1), rsB, bcol_ + HALF, 0); STAGE(SA(0, 1), rsA, brow_ + HALF, 0); \
    STAGEB(SB(1, 0), rsB, bcol_, 1); STAGE(SA(1, 0), rsA, brow_, 1); STAGEB(SB(1, 1), rsB, bcol_ + HALF, 1); } while (0)

  const int nM = M / BM, nN = N / BM, nwg = nM * nN;
  const int nt = K / BK;
  unsigned toff0, toff1;
  const int tid0 = opaque_tid(wave_s);
  const int wr = (tid0 >> 6) >> 2, wc = (tid0 >> 6) & 3, fr = tid0 & 15, fq = (tid0 & 63) >> 4;
  unsigned toffb0, toffb1;
  { int r_, c_; stage_rc(tid0 * 16, r_, c_); toff0 = (unsigned)(r_ * K + c_) * 2u; toffb0 = (unsigned)(((r_ & ~31) | perm32(r_ & 31)) * K + c_) * 2u;
    stage_rc(tid0 * 16 + 8192, r_, c_); toff1 = (unsigned)(r_ * K + c_) * 2u; toffb1 = (unsigned)(((r_ & ~31) | perm32(r_ & 31)) * K + c_) * 2u; }
  const __amdgpu_buffer_rsrc_t rsA = __builtin_amdgcn_make_buffer_rsrc((void*)A, 0, -1, 0x00020000);
  const __amdgpu_buffer_rsrc_t rsB = __builtin_amdgcn_make_buffer_rsrc((void*)Bt, 0, -1, 0x00020000);
  int tt = blockIdx.x;
  int brow = 0, bcol = 0;
  if (tt < nwg) { DECODE(tt, brow, bcol); STAGE7(brow, bcol); WAIT_V(0); }
  f32x4 acc[2][2][4][2];
#define ACC_INIT(brow_, bcol_) do { \
    if (MODE == 2) { \
      const int t2 = opaque_tid(wave_s); const int wr_ = (t2 >> 6) >> 2, wc_ = (t2 >> 6) & 3, fr_ = t2 & 15, fq_ = (t2 & 63) >> 4; \
      const u16* rp_ = e.xh + (size_t)(brow_ + wr_ * 64 + fr_) * D + bcol_ + wc_ * 32 + fq_ * 8; \
      _Pragma("unroll") for (int ai = 0; ai < 2; ++ai) _Pragma("unroll") for (int bj = 0; bj < 2; ++bj) \
      _Pragma("unroll") for (int m = 0; m < 4; ++m) { \
        const uint4 x0 = *(const uint4*)(rp_ + (size_t)(ai * HALF + m * 16) * D + bj * HALF); \
        acc[ai][bj][m][0][0] = __uint_as_float(x0.x << 16); acc[ai][bj][m][0][1] = __uint_as_float(x0.x & 0xffff0000u); \
        acc[ai][bj][m][0][2] = __uint_as_float(x0.y << 16); acc[ai][bj][m][0][3] = __uint_as_float(x0.y & 0xffff0000u); \
        acc[ai][bj][m][1][0] = __uint_as_float(x0.z << 16); acc[ai][bj][m][1][1] = __uint_as_float(x0.z & 0xffff0000u); \
        acc[ai][bj][m][1][2] = __uint_as_float(x0.w << 16); acc[ai][bj][m][1][3] = __uint_as_float(x0.w & 0xffff0000u); } \
    } else { \
      _Pragma("unroll") for (int ai = 0; ai < 2; ++ai) _Pragma("unroll") for (int bj = 0; bj < 2; ++bj) \
      _Pragma("unroll") for (int m = 0; m < 4; ++m) _Pragma("unroll") for (int n = 0; n < 2; ++n) \
        acc[ai][bj][m][n] = (f32x4){0.f, 0.f, 0.f, 0.f}; \
    } } while (0)
  if (tt < nwg) ACC_INIT(brow, bcol);
  while (tt < nwg) {
    bf16x8 At[4][2], B0[2][2], B1[2][2];
    if (wr == 1) BAR;
    BAR;
    for (int t = 0; t < nt - 2; t += 2) {
      LDB(B0, 0, 0); SCHED; LDA(At, 0, 0); STAGE(SA(1, 1), rsA, brow + HALF, t + 1);
      WAIT_L(8); BAR; WAIT_L(0); MMA(0, 0, At, B0); BAR; SCHED;
      LDB(B1, 0, 1); STAGEB(SB(0, 0), rsB, bcol, t + 2);
      BAR; WAIT_L(0); MMA(0, 1, At, B1); BAR;
      LDA(At, 0, 1); STAGE(SA(0, 0), rsA, brow, t + 2);
      BAR; WAIT_L(0); MMA(1, 0, At, B0); BAR; SCHED;
      STAGEB(SB(0, 1), rsB, bcol + HALF, t + 2);
      WAIT_V(6); BAR; MMA(1, 1, At, B1); BAR;
      LDB(B0, 1, 0); SCHED; LDA(At, 1, 0); STAGE(SA(0, 1), rsA, brow + HALF, t + 2);
      WAIT_L(8); BAR; WAIT_L(0); MMA(0, 0, At, B0); BAR; SCHED;
      LDB(B1, 1, 1); STAGEB(SB(1, 0), rsB, bcol, t + 3);
      BAR; WAIT_L(0); MMA(0, 1, At, B1); BAR;
      LDA(At, 1, 1); STAGE(SA(1, 0), rsA, brow, t + 3);
      BAR; WAIT_L(0); MMA(1, 0, At, B0); BAR; SCHED;
      STAGEB(SB(1, 1), rsB, bcol + HALF, t + 3);
      WAIT_V(6); BAR; MMA(1, 1, At, B1); BAR;
    }
    { LDB(B0, 0, 0); LDA(At, 0, 0); STAGE(SA(1, 1), rsA, brow + HALF, nt - 1);
      BAR; WAIT_L(0); MMA(0, 0, At, B0); BAR;
      LDB(B1, 0, 1); BAR; WAIT_L(0); MMA(0, 1, At, B1); BAR;
      LDA(At, 0, 1); WAIT_V(4); BAR; WAIT_L(0); MMA(1, 0, At, B0); MMA(1, 1, At, B1); BAR; }
    { LDB(B0, 1, 0); LDA(At, 1, 0); WAIT_V(2); BAR; WAIT_L(0); MMA(0, 0, At, B0); BAR;
      LDB(B1, 1, 1); WAIT_V(0); BAR; WAIT_L(0); MMA(0, 1, At, B1); BAR;
      LDA(At, 1, 1); BAR; WAIT_L(0); MMA(1, 0, At, B0); MMA(1, 1, At, B1); BAR; }
    if (wr == 0) BAR;
    const int erow = brow, ecol = bcol;
    tt += gridDim.x;
    if (tt < nwg) { DECODE(tt, brow, bcol); STAGE7(brow, bcol); }
    SCHED;
    if (!dry) {
      const int tid1 = opaque_tid(wave_s);
      const int wr = (tid1 >> 6) >> 2, wc = (tid1 >> 6) & 3, fr = tid1 & 15, fq = (tid1 & 63) >> 4;
      float rsv[2][4];
#pragma unroll
      for (int ai = 0; ai < 2; ++ai)
#pragma unroll
        for (int m = 0; m < 4; ++m) {
          rsv[ai][m] = 0.f;
          if (MODE == 1 || MODE == 3) rsv[ai][m] = e.sumsq_in[(size_t)erow + ai * HALF + wr * 64 + m * 16 + fr];
        }
#pragma unroll
      for (int ai = 0; ai < 2; ++ai)
#pragma unroll
        for (int m = 0; m < 4; ++m) {
          const int lrow = ai * HALF + wr * 64 + m * 16 + fr;
          const size_t grow = (size_t)erow + lrow;
          float rs = 0.f, ssq = 0.f;
          if (MODE == 1 || MODE == 3) rs = rsqrtf(rsv[ai][m] * (1.0f / 1024.0f) + EPS);
#pragma unroll
          for (int bj = 0; bj < 2; ++bj)
            epi8<MODE>(e, acc[ai][bj][m][0], acc[ai][bj][m][1], rs, grow, ecol + bj * HALF + wc * 32 + fq * 8, ssq);
          if (MODE == 2 && e.sumsq_out) {
            ssq += __shfl_xor(ssq, 16); ssq += __shfl_xor(ssq, 32);
            if (fq == 0) atomicAdd(e.sumsq_out + grow, ssq);
          }
          SCHED;
        }
    }
    if (tt < nwg) ACC_INIT(brow, bcol);
    if (dry) WAIT_V(0); else WAIT_V(16);
  }
  WAIT_V(0);
#undef SA
#undef SB
#undef STAGE
#undef STAGEB
#undef STAGE_
#undef LDA
#undef LDB
#undef MMA
}

#define MFMA32(a, b, c) __builtin_amdgcn_mfma_f32_32x32x16_bf16((a), (b), (c), 0, 0, 0)

template <int MODE>
__device__ __forceinline__ void sample_gemm(const u16* __restrict__ A, const u16* __restrict__ Bt, const int N, const int K, const GemmEpi e, const int wave_s, const int b0, const int nb) {
  const int bi = (int)blockIdx.x - b0;
  if (bi < 0 || bi >= nb) return;
  const int tid = opaque_tid(wave_s);
  const int lane = tid & 63, wid = tid >> 6;
  const int i = lane & 31, h = lane >> 5;
  const int ntask = 8 * (N / 32);
  const int ks = K / 8;
  float* red = (float*)smem;
  for (int id = bi; id < ntask; id += nb) {
    const int r0 = (id & 7) * 32, c0 = (id >> 3) * 32;
    const u16* ap = A + (size_t)(NP + r0 + i) * K + wid * ks + 8 * h;
    const u16* bp = Bt + (size_t)(c0 + i) * K + wid * ks + 8 * h;
    f32x16 acc;
#pragma unroll
    for (int q = 0; q < 16; ++q) acc[q] = 0.f;
#pragma unroll 8
    for (int k = 0; k < ks; k += 16) {
      const bf16x8 a = *(const bf16x8*)(ap + k);
      const bf16x8 b = *(const bf16x8*)(bp + k);
      acc = MFMA32(b, a, acc);
    }
#pragma unroll
    for (int q = 0; q < 4; ++q)
      *(float4*)(red + (wid * 32 + i) * 36 + 8 * q + 4 * h) = make_float4(acc[4 * q], acc[4 * q + 1], acc[4 * q + 2], acc[4 * q + 3]);
    __syncthreads();
    if (tid < 256) {
      const int row = tid >> 3, c4 = (tid & 7) * 4;
      f32x4 s4; s4[0] = 0.f; s4[1] = 0.f; s4[2] = 0.f; s4[3] = 0.f;
#pragma unroll
      for (int w = 0; w < 8; ++w) {
        const float4 v = *(const float4*)(red + (w * 32 + row) * 36 + c4);
        s4[0] += v.x; s4[1] += v.y; s4[2] += v.z; s4[3] += v.w;
      }
      const int srow = r0 + row, col0 = c0 + c4;
      const size_t grow = (size_t)NP + srow;
      float rs = 0.f, ssq = 0.f;
      if (MODE == 1 || MODE == 3) rs = rsqrtf(e.sumsq_in[grow] * (1.0f / 1024.0f) + EPS);
      epi4<MODE, true>(e, s4, rs, grow, col0, ssq);
      if (MODE == 2 && e.sumsq_out) {
        ssq += __shfl_xor(ssq, 1); ssq += __shfl_xor(ssq, 2); ssq += __shfl_xor(ssq, 4);
        if ((tid & 7) == 0) atomicAdd(e.sumsq_out + grow, ssq);
      }
    }
    __syncthreads();
  }
}

template <int MODE>
__device__ __forceinline__ void sample_gemm64(const u16* __restrict__ A, const u16* __restrict__ Bt, const int N, const int K, const GemmEpi e, const int wave_s, const bool reverse) {
  const int tid = opaque_tid(wave_s);
  const int lane = tid & 63, wid = tid >> 6;
  const int i = lane & 31, h = lane >> 5;
  const int ri = wid & 1, ci = (wid >> 1) & 1, kh = wid >> 2;
  const int ntask = 4 * (N / 64);
  const int kspan = K / 2;
  float* red = (float*)smem;
  const int G = gridDim.x;
  for (int id = reverse ? G - 1 - (int)blockIdx.x : (int)blockIdx.x; id < ntask; id += G) {
    const int r0 = (id & 3) * 64 + ri * 32, c0 = (id >> 2) * 64 + ci * 32;
    const u16* ap = A + (size_t)(NP + r0 + i) * K + kh * kspan + 8 * h;
    const u16* bp = Bt + (size_t)(c0 + i) * K + kh * kspan + 8 * h;
    f32x16 acc;
#pragma unroll
    for (int q = 0; q < 16; ++q) acc[q] = 0.f;
#pragma unroll 16
    for (int k = 0; k < kspan; k += 16) {
      const bf16x8 a = *(const bf16x8*)(ap + k);
      const bf16x8 b = *(const bf16x8*)(bp + k);
      acc = MFMA32(b, a, acc);
    }
    float* rb = red + ((wid & 3) * 32 + i) * 36 + 4 * h;
    if (kh == 1) {
#pragma unroll
      for (int q = 0; q < 4; ++q) *(float4*)(rb + 8 * q) = make_float4(acc[4 * q], acc[4 * q + 1], acc[4 * q + 2], acc[4 * q + 3]);
    }
    __syncthreads();
    if (kh == 0) {
      const size_t grow = (size_t)NP + r0 + i;
      const float rs = rsqrtf(e.sumsq_in[grow] * (1.0f / 1024.0f) + EPS);
      float ssq = 0.f;
#pragma unroll
      for (int q = 0; q < 4; ++q) {
        const float4 o = *(const float4*)(rb + 8 * q);
        f32x4 a4; a4[0] = acc[4 * q] + o.x; a4[1] = acc[4 * q + 1] + o.y; a4[2] = acc[4 * q + 2] + o.z; a4[3] = acc[4 * q + 3] + o.w;
        epi4<MODE, false>(e, a4, rs, grow, c0 + 8 * q + 4 * h, ssq);
      }
    }
    __syncthreads();
  }
}

__device__ __forceinline__ void kv_shift_copy(const Params& p, const int l, const int b0, const int nb, const int tid) {
  const int bi = (int)blockIdx.x - b0;
  if (bi < 0 || bi >= nb) return;
  const size_t gt = (size_t)bi * 512 + tid, ntd = (size_t)nb * 512;
#pragma unroll
  for (int g = 0; g < 3; ++g) {
    const int W = 128 << (2 * g);
    const size_t n4 = (size_t)32 * W * 64;
    const size_t oo = (g == 0) ? O_KV128S : (g == 1) ? O_KV512S : O_KV2048S;
    const f32x4* src = (const f32x4*)p.kv_in[g] + (size_t)l * n4;
    f32x4* dst = (f32x4*)(p.out + oo) + (size_t)l * n4;
    const unsigned per = (unsigned)W * 64u, lim = (unsigned)(W - 8) * 64u;
    for (size_t i0 = gt; i0 < n4; i0 += ntd * 8) {
      f32x4 v[8];
#pragma unroll
      for (int k = 0; k < 8; ++k) {
        const size_t i = i0 + (size_t)k * ntd;
        v[k] = (f32x4){0.f, 0.f, 0.f, 0.f};
        if (i < n4 && ((unsigned)i % per) < lim) v[k] = __builtin_nontemporal_load(src + i + 512);
      }
#pragma unroll
      for (int k = 0; k < 8; ++k) {
        const size_t i = i0 + (size_t)k * ntd;
        if (i < n4 && ((unsigned)i % per) < lim) __builtin_nontemporal_store(v[k], dst + i);
      }
    }
  }
}

__device__ __forceinline__ void tr_tile(const float* __restrict__ src, u16* __restrict__ dst, int K, int N, int k0, int n0, const int tid, const float* __restrict__ gain) {
  float* lt = (float*)smem;
  { const int kk = tid >> 4, n4 = tid & 15;
#pragma unroll
    for (int i = 0; i < 2; ++i) {
      const int k = kk + i * 32;
      const float4 v = *(const float4*)(src + (size_t)(k0 + k) * N + n0 + n4 * 4);
      float* d = lt + k * 65 + n4 * 4;
      d[0] = v.x; d[1] = v.y; d[2] = v.z; d[3] = v.w;
    } }
  __syncthreads();
  { const int n = tid >> 3, k8 = tid & 7;
    float f[8];
#pragma unroll
    for (int i = 0; i < 8; ++i) f[i] = lt[(k8 * 8 + i) * 65 + n] * (gain ? gain[k0 + k8 * 8 + i] : 1.0f);
    uint4 o; o.x = pack2(f[0], f[1]); o.y = pack2(f[2], f[3]); o.z = pack2(f[4], f[5]); o.w = pack2(f[6], f[7]);
    *(uint4*)(dst + (size_t)(n0 + n) * K + k0 + k8 * 8) = o; }
  __syncthreads();
}

__device__ __forceinline__ void phase0(const Params& p, const int wave_s) {
  const int tid = opaque_tid(wave_s), lane = tid & 63, wid = tid >> 6;
  const int gw = blockIdx.x * 8 + wid, nw = gridDim.x * 8;
  const size_t gt = (size_t)blockIdx.x * 512 + tid, ntd = (size_t)gridDim.x * 512;
  for (int row = gw; row < MT; row += nw) {
    const float4* xr = (const float4*)(row < NP ? p.x_prompt + (size_t)row * D : p.x_sample + (size_t)(row - NP) * D);
    float ss = 0.f;
#pragma unroll
    for (int i = 0; i < 4; ++i) {
      const float4 v = xr[lane + 64 * i];
      ss += v.x * v.x + v.y * v.y + v.z * v.z + v.w * v.w;
      uint2 o; o.x = pack2(v.x, v.y); o.y = pack2(v.z, v.w);
      *(uint2*)(p.xg + (size_t)row * D + (lane + 64 * i) * 4) = o;
    }
    ss = wave_sum(ss);
    if (lane == 0) p.sumsq[row] = ss;
  }
  for (size_t i = gt; i < (size_t)3 * MT; i += ntd) p.sumsq[MT + i] = 0.f;
  for (size_t i = gt; i < (size_t)2056 * 8; i += ntd) {
    const int pi = (int)(i >> 3), fi = (int)(i & 7);
    const int pos = pi < 2048 ? pi : 8192 + (pi - 2048);
    float inv;
    switch (fi) { case 0: inv = 1.0f; break; case 1: inv = 0.1939227432012558f; break; case 2: inv = 0.03760603070259094f; break;
      case 3: inv = 0.007292664609849453f; break; case 4: inv = 0.0014142135623842478f; break; case 5: inv = 0.00027424818836152554f; break;
      case 6: inv = 5.318296098266728e-05f; break; default: inv = 1.0313386155758053e-05f; break; }
    const float ang = (float)pos * inv;
    p.rope[pi * 16 + fi] = cosf(ang);
    p.rope[pi * 16 + 8 + fi] = sinf(ang);
  }
  {
    float* lt = (float*)smem;
    constexpr int QL = (640 + 192 + 1024 + 1024) / 4;
    for (int t = blockIdx.x; t < 2 * QL; t += gridDim.x) {
      const int l = t / QL; int r = t % QL;
      const float* src; u16* dst; int K, N; const float* gain = nullptr;
      if (r < 160) { src = p.w_in + (size_t)l * D * IC; dst = p.wt_in + (size_t)l * IC * D; K = D; N = IC; gain = p.norm1_g + l * D; }
      else if (r < 208) { r -= 160; src = p.w_out + (size_t)l * MC * D; dst = p.wt_out + (size_t)l * D * MC; K = MC; N = D; }
      else if (r < 464) { r -= 208; src = p.w_up + (size_t)l * D * FF; dst = p.wt_up + (size_t)l * FF * D; K = D; N = FF; gain = p.norm2_g + l * D; }
      else { r -= 464; src = p.w_down + (size_t)l * FF * D; dst = p.wt_down + (size_t)l * D * FF; K = FF; N = D; }
      const int nq = N / 256;
      const int k0 = (r / nq) * 64, n0 = (r % nq) * 256;
      { const int kk = tid >> 6, n4 = tid & 63;
        float4 v[8];
#pragma unroll
        for (int i = 0; i < 8; ++i) v[i] = *(const float4*)(src + (size_t)(k0 + kk + 8 * i) * N + n0 + n4 * 4);
#pragma unroll
        for (int i = 0; i < 8; ++i) {
          const float gg = gain ? gain[k0 + kk + 8 * i] : 1.0f;
          *(float4*)(lt + (kk + 8 * i) * 260 + n4 * 4) = make_float4(v[i].x * gg, v[i].y * gg, v[i].z * gg, v[i].w * gg);
        } }
      __syncthreads();
      { const int n = tid >> 1, kh = (tid & 1) * 32;
        u16* dp = dst + (size_t)(n0 + n) * K + k0 + kh;
#pragma unroll
        for (int c = 0; c < 4; ++c) {
          float f[8];
#pragma unroll
          for (int i = 0; i < 8; ++i) f[i] = lt[(kh + c * 8 + i) * 260 + n];
          uint4 o; o.x = pack2(f[0], f[1]); o.y = pack2(f[2], f[3]); o.z = pack2(f[4], f[5]); o.w = pack2(f[6], f[7]);
          *(uint4*)(dp + c * 8) = o;
        } }
      __syncthreads();
    }
    for (int t = blockIdx.x; t < 8; t += gridDim.x)
      tr_tile(p.pool_w + (size_t)t * 4096, p.pwT + (size_t)t * 4096, 64, 64, 0, 0, tid, nullptr);
  }
}


__device__ __forceinline__ void load_qk(const u16* __restrict__ rowp, const float* __restrict__ ropep, const float* __restrict__ gain,
                                        const float scale, bf16x8 out[4], const int h) {
  float f[4][8];
  float ss = 0.f;
#pragma unroll
  for (int s = 0; s < 4; ++s) {
    const bf16x8 raw = *(const bf16x8*)(rowp + 16 * s + 8 * h);
#pragma unroll
    for (int j = 0; j < 8; ++j) { f[s][j] = bfs2f(raw[j]); ss += f[s][j] * f[s][j]; }
  }
  ss += __shfl_xor(ss, 32);
  const float inv = rsqrtf(ss * (1.0f / 64.0f) + EPS);
#pragma unroll
  for (int s = 0; s < 4; ++s) {
    const float4 g0 = *(const float4*)(gain + 16 * s + 8 * h), g1 = *(const float4*)(gain + 16 * s + 8 * h + 4);
    f[s][0] *= inv * g0.x; f[s][1] *= inv * g0.y; f[s][2] *= inv * g0.z; f[s][3] *= inv * g0.w;
    f[s][4] *= inv * g1.x; f[s][5] *= inv * g1.y; f[s][6] *= inv * g1.z; f[s][7] *= inv * g1.w;
  }
  {
    const float4 c0 = *(const float4*)(ropep), c1 = *(const float4*)(ropep + 4), s0 = *(const float4*)(ropep + 8), s1 = *(const float4*)(ropep + 12);
    const float cs[8] = {c0.x, c0.y, c0.z, c0.w, c1.x, c1.y, c1.z, c1.w};
    const float sn[8] = {s0.x, s0.y, s0.z, s0.w, s1.x, s1.y, s1.z, s1.w};
#pragma unroll
    for (int j = 0; j < 8; ++j) {
      const float other = __shfl_xor(f[0][j], 32);
      f[0][j] = (h == 0) ? (f[0][j] * cs[j] - other * sn[j]) : (f[0][j] * cs[j] + other * sn[j]);
    }
  }
#pragma unroll
  for (int s = 0; s < 4; ++s)
#pragma unroll
    for (int j = 0; j < 8; ++j) out[s][j] = (short)f2bf(f[s][j] * scale);
}

template <bool SAMPLE>
__device__ __forceinline__ void attn_task(const Params& p, const int layer, const int task, const int wid) {
  const int lane = opaque_lane();
  int g, hslot, b, r, tile, nq;
  if (!SAMPLE) {
    const int c = task & 63; int tmp = task >> 6; g = tmp % 3; tmp /= 3; hslot = tmp & 1; b = tmp >> 1;
    const int tpc = 64 >> (2 * g);
    r = c / tpc; tile = c % tpc; nq = 32;
  } else {
    b = task / 26; const int rem = task % 26; hslot = rem / 13; const int c = rem % 13;
    if (c == 0) { g = 0; r = 0; nq = 8; } else if (c < 5) { g = 1; r = c - 1; nq = 2; } else { g = 2; r = c - 5; nq = 1; }
    tile = 4;
  }
  const int dl = 1 << (2 * g);
  const int W = 128 << (2 * g);
  const int m0 = tile * 32;
  const int head = 2 * g + hslot;
  const u16* projb = SAMPLE ? p.proj + (size_t)(NP + b * 8) * IC : p.proj + (size_t)b * 2048 * IC;
  const int ropeb = SAMPLE ? 2048 : 0;
  const float* cache = SAMPLE ? ((g == 0) ? p.kv_in[0] : (g == 1) ? p.kv_in[1] : p.kv_in[2]) + (size_t)(layer * 32 + b) * W * 256 + hslot * 64 : nullptr;
  const int qi = lane & 31, h = lane >> 5;
  int tq;
  if (SAMPLE) tq = r + dl * (qi < nq ? qi : 0); else tq = (m0 + qi) * dl + r;
  bf16x8 qf[4];
  load_qk(projb + (size_t)tq * IC + C_Q + head * 64, p.rope + (ropeb + tq) * 16, p.q_norm_g + layer * 64, 0.125f, qf, h);
  const int kt_lo = SAMPLE ? 0 : max(0, 4 - tile);
  f32x16 sacc[5];
#pragma unroll
  for (int kt = 0; kt < 5; ++kt) {
#pragma unroll
    for (int i = 0; i < 16; ++i) sacc[kt][i] = 0.f;
    if (kt >= kt_lo) {
      bf16x8 kf[4];
      if (SAMPLE && kt < 4) {
        const float* kp = cache + (size_t)(r + dl * (32 * kt + qi)) * 256 + 8 * h;
#pragma unroll
        for (int s = 0; s < 4; ++s) {
          const float4 x0 = *(const float4*)(kp + 16 * s), x1 = *(const float4*)(kp + 16 * s + 4);
          kf[s][0] = (short)f2bf(x0.x); kf[s][1] = (short)f2bf(x0.y); kf[s][2] = (short)f2bf(x0.z); kf[s][3] = (short)f2bf(x0.w);
          kf[s][4] = (short)f2bf(x1.x); kf[s][5] = (short)f2bf(x1.y); kf[s][6] = (short)f2bf(x1.z); kf[s][7] = (short)f2bf(x1.w);
        }
      } else {
        int tk;
        if (SAMPLE) tk = r + dl * (qi < nq ? qi : 0); else tk = (m0 - 128 + 32 * kt + qi) * dl + r;
        load_qk(projb + (size_t)tk * IC + C_K + head * 64, p.rope + (ropeb + tk) * 16, p.k_norm_g + layer * 64, 1.0f, kf, h);
      }
#pragma unroll
      for (int s = 0; s < 4; ++s) sacc[kt] = MFMA32(kf[s], qf[s], sacc[kt]);
    }
  }
  float mx = -1e30f;
#pragma unroll
  for (int kt = 0; kt < 5; ++kt)
#pragma unroll
    for (int rr = 0; rr < 16; ++rr) {
      const int keyrow = (rr & 3) + 8 * (rr >> 2) + 4 * h;
      const int dist = 128 - 32 * kt + qi - keyrow;
      const bool valid = (kt >= kt_lo) && dist >= 0 && dist <= 128;
      const float s = valid ? sacc[kt][rr] : -1e30f;
      sacc[kt][rr] = s;
      mx = fmaxf(mx, s);
    }
  mx = fmaxf(mx, __shfl_xor(mx, 32));
  float sum = 0.f;
#pragma unroll
  for (int kt = 0; kt < 5; ++kt)
#pragma unroll
    for (int rr = 0; rr < 16; ++rr) {
      const float s = sacc[kt][rr];
      const float ex = (s > -1e29f) ? __expf(s - mx) : 0.f;
      sacc[kt][rr] = ex;
      sum += ex;
    }
  sum += __shfl_xor(sum, 32);
  bf16x8 pfa[5][2];
#pragma unroll
  for (int kt = 0; kt < 5; ++kt)
#pragma unroll
    for (int s2 = 0; s2 < 2; ++s2)
#pragma unroll
      for (int j = 0; j < 8; ++j) pfa[kt][s2][j] = (short)f2bf(sacc[kt][8 * s2 + j]);
  f32x16 oacc[2];
#pragma unroll
  for (int i = 0; i < 16; ++i) { oacc[0][i] = 0.f; oacc[1][i] = 0.f; }
  u16* vt = (u16*)(smem + wid * 16384);
  const int srow = lane >> 1, shf = (lane & 1) * 32;
#pragma unroll
  for (int kt = 0; kt < 5; ++kt) {
    if (kt >= kt_lo) {
      u16* vb = vt + (kt & 1) * (32 * 72);
      if (SAMPLE && kt < 4) {
        const float* vp = cache + (size_t)(r + dl * (32 * kt + srow)) * 256 + 128 + shf;
#pragma unroll
        for (int c = 0; c < 4; ++c) {
          const float4 x0 = *(const float4*)(vp + 8 * c), x1 = *(const float4*)(vp + 8 * c + 4);
          uint4 o; o.x = pack2(x0.x, x0.y); o.y = pack2(x0.z, x0.w); o.z = pack2(x1.x, x1.y); o.w = pack2(x1.z, x1.w);
          *(uint4*)(vb + srow * 72 + shf + 8 * c) = o;
        }
      } else {
        int tk;
        if (SAMPLE) tk = r + dl * (srow < nq ? srow : 0); else tk = (m0 - 128 + 32 * kt + srow) * dl + r;
        const u16* vp = projb + (size_t)tk * IC + C_V + head * 64 + shf;
#pragma unroll
        for (int c = 0; c < 4; ++c) *(uint4*)(vb + srow * 72 + shf + 8 * c) = *(const uint4*)(vp + 8 * c);
      }
#pragma unroll
      for (int s2 = 0; s2 < 2; ++s2) {
        bf16x8 v0, v1;
#pragma unroll
        for (int j = 0; j < 8; ++j) {
          const int kr = 16 * s2 + 8 * (j >> 2) + 4 * h + (j & 3);
          v0[j] = (short)vb[kr * 72 + qi]; v1[j] = (short)vb[kr * 72 + qi + 32];
        }
        oacc[0] = MFMA32(v0, pfa[kt][s2], oacc[0]);
        oacc[1] = MFMA32(v1, pfa[kt][s2], oacc[1]);
      }
    }
  }
  const float isum = 1.0f / sum;
  const size_t rowq = SAMPLE ? (size_t)NP + b * 8 + tq : (size_t)b * 2048 + tq;
  if (!SAMPLE || qi < nq) {
    float* op = p.opart + ((size_t)g * MT + rowq) * 128 + hslot * 64;
#pragma unroll
    for (int db = 0; db < 2; ++db)
#pragma unroll
      for (int i4 = 0; i4 < 4; ++i4) {
        float4 o; o.x = oacc[db][4 * i4] * isum; o.y = oacc[db][4 * i4 + 1] * isum; o.z = oacc[db][4 * i4 + 2] * isum; o.w = oacc[db][4 * i4 + 3] * isum;
        *(float4*)(op + db * 32 + 8 * i4 + 4 * h) = o;
      }
    if (h == 0) p.lse[((size_t)g * MT + rowq) * 2 + hslot] = mx + __logf(sum);
  }
}

__device__ __forceinline__ void kv_row_task(const Params& p, const int l, const int row, const int lane) {
  const int hl = lane < 48 ? lane : 47;
  const int head = hl >> 3, c8 = hl & 7;
  int b, t, ridx;
  const bool prompt = row < NP;
  if (prompt) { b = row >> 11; t = row & 2047; ridx = t; } else { b = (row - NP) >> 3; t = (row - NP) & 7; ridx = 2048 + t; }
  const u16* pr = p.proj + (size_t)row * IC;
  const bf16x8 kr = *(const bf16x8*)(pr + C_K + hl * 8);
  const bf16x8 vr = *(const bf16x8*)(pr + C_V + hl * 8);
  float f[8]; float ss = 0.f;
#pragma unroll
  for (int j = 0; j < 8; ++j) { f[j] = bfs2f(kr[j]); ss += f[j] * f[j]; }
  ss += __shfl_xor(ss, 1); ss += __shfl_xor(ss, 2); ss += __shfl_xor(ss, 4);
  const float inv = rsqrtf(ss * (1.0f / 64.0f) + EPS);
  const float* gk = p.k_norm_g + l * 64 + c8 * 8;
#pragma unroll
  for (int j = 0; j < 8; ++j) f[j] *= inv * gk[j];
  const float* rp = p.rope + ridx * 16;
#pragma unroll
  for (int j = 0; j < 8; ++j) {
    const float other = __shfl_xor(f[j], 1);
    const float cs = rp[j], sn = rp[8 + j];
    if (c8 == 0) f[j] = f[j] * cs - other * sn;
    else if (c8 == 1) f[j] = f[j] * cs + other * sn;
  }
  const int g = head >> 1, hh = head & 1;
  const int W = 128 << (2 * g);
  float* dst = nullptr;
  if (prompt) {
    const int r = t - (2048 - W);
    const size_t base = (g == 0) ? O_KV128P : (g == 1) ? O_KV512P : O_KV2048P;
    if (r >= 0) dst = p.out + base + ((size_t)(l * 8 + b) * W + r) * 256 + hh * 64 + c8 * 8;
  } else {
    const int r = W - 8 + t;
    const size_t base = (g == 0) ? O_KV128S : (g == 1) ? O_KV512S : O_KV2048S;
    dst = p.out + base + ((size_t)(l * 32 + b) * W + r) * 256 + hh * 64 + c8 * 8;
  }
  if (dst && lane < 48) {
    *(float4*)(dst) = make_float4(f[0], f[1], f[2], f[3]);
    *(float4*)(dst + 4) = make_float4(f[4], f[5], f[6], f[7]);
    *(float4*)(dst + 128) = make_float4(bfs2f(vr[0]), bfs2f(vr[1]), bfs2f(vr[2]), bfs2f(vr[3]));
    *(float4*)(dst + 132) = make_float4(bfs2f(vr[4]), bfs2f(vr[5]), bfs2f(vr[6]), bfs2f(vr[7]));
  }
}

__device__ __forceinline__ void phaseA(const Params& p, const int l, const int wave_s) {
  const int tid = opaque_tid(wave_s);
  const int lane = tid & 63, wid = tid >> 6;
  const int gw = blockIdx.x * 8 + wid, nw = gridDim.x * 8;
  for (int task = gw; task < 832 + 3072; task += nw) { if (task < 832) attn_task<true>(p, l, task, wid); else attn_task<false>(p, l, task - 832, wid); }
  for (int row = nw - 1 - gw; row < MT; row += nw) kv_row_task(p, l, row, lane);
}

template <int GRP>
__device__ __forceinline__ void pool_task(const Params& p, const int l, const int task, const int lane) {
  const int tile = task >> 2; constexpr int grp = GRP;
  const int qi = lane & 31, h = lane >> 5;
  const int row = tile * 32 + qi;
  constexpr int w = 2 << GRP;
  const bool prompt = row < NP;
  int n, t; float cnt;
  if (prompt) { n = row >> 11; t = row & 2047; cnt = (float)min(t + 1, w); } else { n = (row - NP) >> 3; t = (row - NP) & 7; cnt = (float)w; }
  const float icnt = 1.0f / cnt;
  f32x16 acc[2];
#pragma unroll
  for (int i = 0; i < 16; ++i) { acc[0][i] = 0.f; acc[1][i] = 0.f; }
  const u16* pw = p.pwT + (size_t)(l * 4 + grp) * 4096;
#pragma unroll
  for (int s = 0; s < 4; ++s) {
    const int c0 = grp * 64 + 16 * s + 8 * h;
    float sum[8], own[8];
#pragma unroll
    for (int j = 0; j < 8; ++j) { sum[j] = 0.f; own[j] = 0.f; }
#pragma unroll
    for (int i = 0; i < w; ++i) {
      const int tt = t - i;
      float v[8];
      if (tt >= 0) {
        const bf16x8 raw = *(const bf16x8*)(p.proj + (size_t)(row - i) * IC + C_U + c0);
#pragma unroll
        for (int j = 0; j < 8; ++j) v[j] = bfs2f(raw[j]);
      } else if (!prompt) {
        const float* sp = p.state_pool + ((size_t)(l * 32 + n) * 15 + 15 + tt) * 256 + c0;
        const float4 a = *(const float4*)sp, bb = *(const float4*)(sp + 4);
        v[0] = a.x; v[1] = a.y; v[2] = a.z; v[3] = a.w; v[4] = bb.x; v[5] = bb.y; v[6] = bb.z; v[7] = bb.w;
      } else {
#pragma unroll
        for (int j = 0; j < 8; ++j) v[j] = 0.f;
      }
#pragma unroll
      for (int j = 0; j < 8; ++j) sum[j] += v[j];
      if (i == 0) {
#pragma unroll
        for (int j = 0; j < 8; ++j) own[j] = v[j];
      }
    }
    bf16x8 df;
#pragma unroll
    for (int j = 0; j < 8; ++j) df[j] = (short)f2bf(sum[j] * icnt - own[j]);
    const bf16x8 a0 = *(const bf16x8*)(pw + (size_t)qi * 64 + 16 * s + 8 * h);
    const bf16x8 a1 = *(const bf16x8*)(pw + (size_t)(qi + 32) * 64 + 16 * s + 8 * h);
    acc[0] = MFMA32(a0, df, acc[0]);
    acc[1] = MFMA32(a1, df, acc[1]);
  }
  const float* ps = p.pool_scale + l * 256 + grp * 64;
  u16* mp = p.mixed + (size_t)row * MC + grp * 64;
#pragma unroll
  for (int db = 0; db < 2; ++db)
#pragma unroll
    for (int i4 = 0; i4 < 4; ++i4) {
      const int dd0 = db * 32 + 8 * i4 + 4 * h;
      const float4 sc = *(const float4*)(ps + dd0);
      uint2 o; o.x = pack2(acc[db][4 * i4] * sc.x, acc[db][4 * i4 + 1] * sc.y); o.y = pack2(acc[db][4 * i4 + 2] * sc.z, acc[db][4 * i4 + 3] * sc.w);
      *(uint2*)(mp + dd0) = o;
    }
}

__device__ __forceinline__ void phaseB(const Params& p, const int l, const int wave_s) {
  const int tid = opaque_tid(wave_s), lane = tid & 63, wid = tid >> 6;
  const int gw = blockIdx.x * 8 + wid, nw = gridDim.x * 8;
  const size_t gt = (size_t)blockIdx.x * 512 + tid, ntd = (size_t)gridDim.x * 512;
  for (int task = gw; task < 520 * 4; task += nw) {
    switch (task & 3) { case 0: pool_task<0>(p, l, task, lane); break; case 1: pool_task<1>(p, l, task, lane); break;
                        case 2: pool_task<2>(p, l, task, lane); break; default: pool_task<3>(p, l, task, lane); break; }
  }
  for (size_t idx = gt; idx < (size_t)MT * 48; idx += ntd) {
    const int row = (int)(idx / 48), ch = (int)(idx % 48) * 8;
    const bool prompt = row < NP;
    int n, t;
    if (prompt) { n = row >> 11; t = row & 2047; } else { n = (row - NP) >> 3; t = (row - NP) & 7; }
    float z[3][8];
#pragma unroll
    for (int i = 0; i < 3; ++i) {
      const int tt = t - 2 + i;
      if (tt >= 0) {
        const u16* pr = p.proj + (size_t)(row - 2 + i) * IC;
        const bf16x8 gc = *(const bf16x8*)(pr + C_GC + ch), gh = *(const bf16x8*)(pr + C_GH + ch);
#pragma unroll
        for (int j = 0; j < 8; ++j) z[i][j] = bfs2f(gc[j]) * bfs2f(gh[j]);
      } else if (!prompt) {
        const float* sp = p.state_conv + ((size_t)(l * 32 + n) * 2 + 2 + tt) * 384 + ch;
        const float4 a = *(const float4*)sp, bb = *(const float4*)(sp + 4);
        z[i][0] = a.x; z[i][1] = a.y; z[i][2] = a.z; z[i][3] = a.w; z[i][4] = bb.x; z[i][5] = bb.y; z[i][6] = bb.z; z[i][7] = bb.w;
      } else {
#pragma unroll
        for (int j = 0; j < 8; ++j) z[i][j] = 0.f;
      }
    }
    const bf16x8 gb = *(const bf16x8*)(p.proj + (size_t)row * IC + C_GB + ch);
    const float* cw = p.conv_w + (size_t)l * 3 * 384 + ch;
    float y[8];
#pragma unroll
    for (int j = 0; j < 8; ++j) y[j] = bfs2f(gb[j]) * (cw[j] * z[0][j] + cw[384 + j] * z[1][j] + cw[768 + j] * z[2][j]);
    uint4 o; o.x = pack2(y[0], y[1]); o.y = pack2(y[2], y[3]); o.z = pack2(y[4], y[5]); o.w = pack2(y[6], y[7]);
    *(uint4*)(p.mixed + (size_t)row * MC + 384 + ch) = o;
    float* so = nullptr;
    if (prompt) { if (t >= 2046) so = p.out + O_CONVP + ((size_t)(l * 8 + n) * 2 + (t - 2046)) * 384 + ch; }
    else { if (t >= 6) so = p.out + O_CONVS + ((size_t)(l * 32 + n) * 2 + (t - 6)) * 384 + ch; }
    if (so) { *(float4*)so = make_float4(z[2][0], z[2][1], z[2][2], z[2][3]); *(float4*)(so + 4) = make_float4(z[2][4], z[2][5], z[2][6], z[2][7]); }
  }
  for (size_t idx = gt; idx < (size_t)MT * 16; idx += ntd) {
    const int row = (int)(idx >> 4), chunk = (int)(idx & 15);
    const int hslot = chunk >> 3, d0 = (chunk & 7) * 8;
    float lg[3];
#pragma unroll
    for (int g = 0; g < 3; ++g) lg[g] = p.lse[((size_t)g * MT + row) * 2 + hslot];
    const float m = fmaxf(lg[0], fmaxf(lg[1], lg[2]));
    float wg[3]; wg[0] = __expf(lg[0] - m); wg[1] = __expf(lg[1] - m); wg[2] = __expf(lg[2] - m);
    const float iw = 1.0f / (wg[0] + wg[1] + wg[2]);
    float y[8];
#pragma unroll
    for (int j = 0; j < 8; ++j) y[j] = 0.f;
#pragma unroll
    for (int g = 0; g < 3; ++g) {
      const float* op = p.opart + ((size_t)g * MT + row) * 128 + hslot * 64 + d0;
      const float4 a = *(const float4*)op, bb = *(const float4*)(op + 4);
      const float ww = wg[g] * iw;
      y[0] += ww * a.x; y[1] += ww * a.y; y[2] += ww * a.z; y[3] += ww * a.w; y[4] += ww * bb.x; y[5] += ww * bb.y; y[6] += ww * bb.z; y[7] += ww * bb.w;
    }
    uint4 o; o.x = pack2(y[0], y[1]); o.y = pack2(y[2], y[3]); o.z = pack2(y[4], y[5]); o.w = pack2(y[6], y[7]);
    *(uint4*)(p.mixed + (size_t)row * MC + 256 + hslot * 64 + d0) = o;
  }
  for (size_t idx = gt; idx < (size_t)8 * 15 * 256; idx += ntd) {
    const int c = (int)(idx & 255); const int bi = (int)(idx >> 8); const int i = bi % 15, b = bi / 15;
    p.out[O_POOLP + (size_t)l * 8 * 15 * 256 + idx] = bf2f(p.proj[((size_t)b * 2048 + 2033 + i) * IC + C_U + c]);
  }
  for (size_t idx = gt; idx < (size_t)32 * 15 * 256; idx += ntd) {
    const int c = (int)(idx & 255); const int bi = (int)(idx >> 8); const int i = bi % 15, n = bi / 15;
    float v;
    if (i < 7) v = p.state_pool[((size_t)(l * 32 + n) * 15 + 8 + i) * 256 + c];
    else v = bf2f(p.proj[((size_t)NP + n * 8 + (i - 7)) * IC + C_U + c]);
    p.out[O_POOLS + (size_t)l * 32 * 15 * 256 + idx] = v;
  }
}

#ifndef PROBEV
#define PROBEV 0
#endif
#ifndef REPM
#define REPM 0
#endif
#define NREP(k) (1 + ((REPM >> (k)) & 1))
typedef const __attribute__((address_space(4))) Params* CP;
#if defined(__HIP_DEVICE_COMPILE__)
#define LOAD_PARAMS() CP pp_ = (CP)__builtin_amdgcn_kernarg_segment_ptr(); asm volatile("" : "+s"(pp_)); const Params p = *pp_
#else
#define LOAD_PARAMS() const Params& p = p_unused
#endif
__global__ void __launch_bounds__(512, 2) mega(const Params p_unused, const int ph_lo, const int ph_hi) {
  const int wave_s = __builtin_amdgcn_readfirstlane((int)(threadIdx.x >> 6));
  if (ph_hi == -12345) cg::this_grid().sync();
  {
    LOAD_PARAMS();
    if (opaque_tid(wave_s) == 0) {
      volatile __attribute__((address_space(3))) unsigned* st = (volatile __attribute__((address_space(3))) unsigned*)(smem + BAR_LDS_OFF);
      st[0] = 0u; st[1] = 0u;
      (void)xb_add(&p.bar[XB_XCNT(xb_xcc_id())], 1u);
    }
    __syncthreads();
  }
  int ph = 0;
#define IN_PH() (ph_lo <= ph && ph < ph_hi)
#define SEAM() do { if (ph_lo <= ph && ph + 1 < ph_hi) { LOAD_PARAMS(); grid_bar(p.bar, wave_s); } ++ph; } while (0)
  if (IN_PH()) for (int rep = 0; rep < NREP(0); ++rep) { LOAD_PARAMS(); phase0(p, wave_s); }
  SEAM();
#pragma unroll 1
  for (int l = 0; l < 2; ++l) {
    if (IN_PH()) for (int rep = 0; rep < NREP(1); ++rep) {
      LOAD_PARAMS();
      GemmEpi e{}; e.sumsq_in = p.sumsq + (size_t)(2 * l) * MT; e.out_bf = p.proj; e.ldo = IC;
      gemm_phase<1>(p.xg, p.wt_in + (size_t)l * IC * D, NP, IC, D, e, wave_s);
      { const int G = gridDim.x, first = (64 * (IC / 256)) % G;
        const int b0 = first ? first : 0, nb = G - b0;
        kv_shift_copy(p, l, b0, nb, opaque_tid(wave_s));
        sample_gemm64<1>(p.xg, p.wt_in + (size_t)l * IC * D, IC, D, e, wave_s, true); }
    }
    SEAM();
    if (IN_PH()) for (int rep = 0; rep < NREP(2); ++rep) { LOAD_PARAMS(); phaseA(p, l, wave_s); }
    SEAM();
    if (IN_PH()) for (int rep = 0; rep < NREP(3); ++rep) { LOAD_PARAMS(); phaseB(p, l, wave_s); }
    SEAM();
    if (IN_PH()) for (int rep = 0; rep < NREP(4); ++rep) {
      LOAD_PARAMS();
      GemmEpi e{};
      const bool last = (rep == NREP(4) - 1);
      e.xh = p.xg; e.xh_out = last ? p.xg : p.scr16; e.out_f = nullptr; e.sumsq_out = last ? p.sumsq + (size_t)(2 * l + 1) * MT : p.scrss;
      gemm_phase<2>(p.mixed, p.wt_out + (size_t)l * D * MC, NP, D, MC, e, wave_s, 0);
      sample_gemm<2>(p.mixed, p.wt_out + (size_t)l * D * MC, D, MC, e, wave_s, 0, gridDim.x);
    }
    SEAM();
    if (IN_PH()) for (int rep = 0; rep < NREP(5); ++rep) {
      LOAD_PARAMS();
      GemmEpi e{}; e.sumsq_in = p.sumsq + (size_t)(2 * l + 1) * MT; e.out_bf = p.hf; e.ldo = FF;
      gemm_phase<3>(p.xg, p.wt_up + (size_t)l * FF * D, NP, FF, D, e, wave_s, (rep && (PROBEV & 1)) ? 1 : 0);
      if (!(rep && (PROBEV & 2))) sample_gemm64<3>(p.xg, p.wt_up + (size_t)l * FF * D, FF, D, e, wave_s, false);
    }
    SEAM();
    if (IN_PH()) for (int rep = 0; rep < NREP(6); ++rep) {
      LOAD_PARAMS();
      GemmEpi e{};
      const bool last = (rep == NREP(6) - 1);
      e.xh = p.xg; e.xh_out = last ? p.xg : p.scr16;
      if (l == 0) { e.out_f = nullptr; e.sumsq_out = last ? p.sumsq + (size_t)2 * MT : p.scrss; } else { e.out_f = last ? p.out : p.scrf; e.sumsq_out = nullptr; }
      gemm_phase<2>(p.hf, p.wt_down + (size_t)l * D * FF, NP, D, FF, e, wave_s, 0);
      sample_gemm<2>(p.hf, p.wt_down + (size_t)l * D * FF, D, FF, e, wave_s, 0, gridDim.x);
    }
    SEAM();
  }
}

extern "C" void kernel_launch(void* const* d_in, const int* in_sizes, int n_in, void* d_out, int out_size, void* d_ws, size_t ws_size, hipStream_t stream) {
  static int grid_blocks = 0;
  if (!grid_blocks) {
    int dev = 0, cus = 0, per_cu = 0;
    hipGetDevice(&dev);
    hipDeviceGetAttribute(&cus, hipDeviceAttributeMultiprocessorCount, dev);
    hipFuncSetAttribute((const void*)mega, hipFuncAttributeMaxDynamicSharedMemorySize, GEMM_LDS);
    hipOccupancyMaxActiveBlocksPerMultiprocessor(&per_cu, (const void*)mega, 512, GEMM_LDS);
    if (per_cu < 1) { fprintf(stderr, "occupancy query returned %d\n", per_cu); per_cu = 1; }
    grid_blocks = cus * 1;
  }
  Params p{};
  p.x_prompt = (const float*)d_in[0]; p.x_sample = (const float*)d_in[1]; p.state_pool = (const float*)d_in[2]; p.state_conv = (const float*)d_in[3];
  p.kv_in[0] = (const float*)d_in[4]; p.kv_in[1] = (const float*)d_in[5]; p.kv_in[2] = (const float*)d_in[6];
  p.norm1_g = (const float*)d_in[7]; p.w_in = (const float*)d_in[8]; p.q_norm_g = (const float*)d_in[9]; p.k_norm_g = (const float*)d_in[10];
  p.pool_w = (const float*)d_in[11]; p.pool_scale = (const float*)d_in[12]; p.conv_w = (const float*)d_in[13]; p.w_out = (const float*)d_in[14];
  p.norm2_g = (const float*)d_in[15]; p.w_up = (const float*)d_in[16]; p.w_down = (const float*)d_in[17];
  p.out = (float*)d_out;
  unsigned char* w = (unsigned char*)d_ws; size_t off = 0;
  auto carve = [&](size_t bytes) { unsigned char* r = w + off; off += (bytes + 255) & ~(size_t)255; return r; };
  p.bar = (unsigned*)carve(XCD_BAR_WORDS * 4);
  p.wt_in = (u16*)carve((size_t)2 * IC * D * 2);
  p.wt_out = (u16*)carve((size_t)2 * D * MC * 2);
  p.wt_up = (u16*)carve((size_t)2 * FF * D * 2);
  p.wt_down = (u16*)carve((size_t)2 * D * FF * 2);
  p.pwT = (u16*)carve((size_t)2 * 4 * 4096 * 2);
  p.xg = (u16*)carve((size_t)MT * D * 2);
  p.mixed = (u16*)carve((size_t)MT * MC * 2);
  p.sumsq = (float*)carve((size_t)4 * MT * 4);
  p.lse = (float*)carve((size_t)3 * MT * 2 * 4);
  p.rope = (float*)carve((size_t)2056 * 16 * 4);
  p.scr16 = (u16*)carve((size_t)MT * D * 2); p.scrss = (float*)carve((size_t)MT * 4); p.scrf = (float*)carve((size_t)MT * D * 4);
  p.hf = (u16*)carve((size_t)MT * FF * 2);
  p.proj = p.hf;
  p.opart = (float*)((unsigned char*)p.hf + (((size_t)MT * IC * 2 + 255) & ~(size_t)255));
  if (off > ws_size) { fprintf(stderr, "workspace too small: need %zu have %zu\n", off, ws_size); return; }
  (void)hipMemsetAsync(p.bar, 0, XCD_BAR_WORDS * 4, stream);
  int lo = 0, hi = 13;
  void* args[] = {(void*)&p, (void*)&lo, (void*)&hi};
  hipError_t e = hipLaunchCooperativeKernel((const void*)mega, dim3(grid_blocks), dim3(512), args, GEMM_LDS, stream);
  if (e != hipSuccess) fprintf(stderr, "cooperative launch failed: %s (grid %d)\n", hipGetErrorString(e), grid_blocks);
}
```

```cpp
#include <hip/hip_runtime.h>
#include <hip/hip_cooperative_groups.h>
#include <cstdio>
namespace cg = cooperative_groups;

typedef unsigned short u16;
using bf16x8 = __attribute__((ext_vector_type(8))) short;
using f32x4 = __attribute__((ext_vector_type(4))) float;
using f32x16 = __attribute__((ext_vector_type(16))) float;

constexpr int NP = 16384, NS = 256, MT = NP + NS;
constexpr int D = 1024, IC = 2560, MC = 768, FF = 4096;
constexpr float EPS = 1e-6f;
constexpr int C_U = 0, C_Q = 256, C_K = 640, C_V = 1024, C_GB = 1408, C_GC = 1792, C_GH = 2176;
constexpr size_t O_YP = 0;
constexpr size_t O_YS = O_YP + (size_t)NP * D;
constexpr size_t O_POOLP = O_YS + (size_t)NS * D;
constexpr size_t O_CONVP = O_POOLP + 2 * 8 * 15 * 256;
constexpr size_t O_KV128P = O_CONVP + 2 * 8 * 2 * 384;
constexpr size_t O_KV512P = O_KV128P + (size_t)2 * 8 * 128 * 256;
constexpr size_t O_KV2048P = O_KV512P + (size_t)2 * 8 * 512 * 256;
constexpr size_t O_POOLS = O_KV2048P + (size_t)2 * 8 * 2048 * 256;
constexpr size_t O_CONVS = O_POOLS + 2 * 32 * 15 * 256;
constexpr size_t O_KV128S = O_CONVS + 2 * 32 * 2 * 384;
constexpr size_t O_KV512S = O_KV128S + (size_t)2 * 32 * 128 * 256;
constexpr size_t O_KV2048S = O_KV512S + (size_t)2 * 32 * 512 * 256;

struct Params {
  const float *x_prompt, *x_sample, *state_pool, *state_conv, *kv_in[3];
  const float *norm1_g, *w_in, *q_norm_g, *k_norm_g, *pool_w, *pool_scale, *conv_w, *w_out, *norm2_g, *w_up, *w_down;
  float* out;
  u16 *wt_in, *wt_out, *wt_up, *wt_down, *pwT;
  u16 *xg, *proj, *mixed, *hf;
  float *sumsq, *opart, *lse, *rope;
  unsigned* bar;
  u16* scr16; float* scrss; float* scrf;
};

extern __shared__ __attribute__((aligned(16))) unsigned char smem[];
typedef __attribute__((address_space(3))) void* LDSP;

typedef __bf16 bf16x2_t __attribute__((ext_vector_type(2)));
typedef float f32x2_t __attribute__((ext_vector_type(2)));
__device__ __forceinline__ unsigned pack2(float a, float b) { f32x2_t v = {a, b}; bf16x2_t r = __builtin_convertvector(v, bf16x2_t); return __builtin_bit_cast(unsigned, r); }
__device__ __forceinline__ u16 f2bf(float f) { return (u16)(pack2(f, 0.f) & 0xffffu); }
typedef unsigned u32x4_t __attribute__((ext_vector_type(4)));
__device__ __forceinline__ bf16x8 pack8(float a, float b, float c, float d, float e, float f, float g, float h) {
  u32x4_t t = {pack2(a, b), pack2(c, d), pack2(e, f), pack2(g, h)}; return __builtin_bit_cast(bf16x8, t); }
__device__ __forceinline__ float bf2f(u16 h) { return __uint_as_float(((unsigned)h) << 16); }
__device__ __forceinline__ float bfs2f(short h) { return __uint_as_float(((unsigned)(u16)h) << 16); }
__device__ __forceinline__ int opaque_tid(const int wave_s) {
  int l; asm volatile("v_mbcnt_lo_u32_b32 %0, -1, 0\n\tv_mbcnt_hi_u32_b32 %0, -1, %0" : "=v"(l));
  return wave_s * 64 + l;
}
__device__ __forceinline__ int opaque_lane() {
  int l; asm volatile("v_mbcnt_lo_u32_b32 %0, -1, 0\n\tv_mbcnt_hi_u32_b32 %0, -1, %0" : "=v"(l));
  return l;
}
#define XB_TMO      128
#define XB_XCNT(j)  (256  + 64 * (j))
#define XB_XSUB(j)  (1280 + 64 * (j))
#define XB_XGEN(j)  (2304 + 64 * (j))
#define XB_TOP      3328
#define XB_TOPGEN   3392
#define XCD_BAR_WORDS 3456
#define XB_SPIN_CAP (1u << 18)
constexpr int BAR_LDS_OFF = 131072;
__device__ __forceinline__ unsigned xb_ld(unsigned* p)              { return __hip_atomic_load(p, __ATOMIC_RELAXED, __HIP_MEMORY_SCOPE_AGENT); }
__device__ __forceinline__ unsigned xb_add(unsigned* p, unsigned v) { return __hip_atomic_fetch_add(p, v, __ATOMIC_RELAXED, __HIP_MEMORY_SCOPE_AGENT); }
__device__ __forceinline__ unsigned xb_xcc_id() { return (unsigned)__builtin_amdgcn_s_getreg((3 << 11) | 20) & 0xFu; }
#define XB_SPIN(cond, bar) do { unsigned _sp = 0; while (cond) { __builtin_amdgcn_s_sleep(1); \
    if ((++_sp & 255u) == 0u) { if (xb_ld(&(bar)[XB_TMO])) break; if (_sp > XB_SPIN_CAP) { atomicAdd(&(bar)[XB_TMO], 1u); break; } } } } while (0)
__device__ __forceinline__ void xcd_barrier_complete(unsigned* bar, unsigned x, unsigned& nloc, unsigned& nx) {
  const unsigned G = gridDim.x;
  unsigned sum, cnt, mine, sp = 0u;
  for (;;) {
    sum = 0u; cnt = 0u; mine = 0u;
#pragma unroll
    for (unsigned j = 0; j < 16; ++j) { const unsigned c = xb_ld(&bar[XB_XCNT(j)]); sum += c; cnt += (c > 0u) ? 1u : 0u; mine = (j == x) ? c : mine; }
    if (sum == G) break;
    __builtin_amdgcn_s_sleep(1);
    if ((++sp & 255u) == 0u) { if (xb_ld(&bar[XB_TMO])) break; if (sp > XB_SPIN_CAP) { atomicAdd(&bar[XB_TMO], 1u); break; } }
  }
  nloc = mine > 0u ? mine : 1u; nx = cnt > 0u ? cnt : 1u;
}
__device__ __forceinline__ void grid_bar(unsigned* bar, const int wave_s) {
  asm volatile("s_waitcnt vmcnt(0)" ::: "memory");
  __syncthreads();
  if (opaque_tid(wave_s) == 0) {
    volatile __attribute__((address_space(3))) unsigned* st = (volatile __attribute__((address_space(3))) unsigned*)(smem + BAR_LDS_OFF);
    const unsigned x = xb_xcc_id();
    __builtin_amdgcn_s_waitcnt(0);
    unsigned nloc = st[0], nx = st[1];
    if (nloc == 0u) { xcd_barrier_complete(bar, x, nloc, nx); st[0] = nloc; st[1] = nx; }
    const unsigned old = xb_add(&bar[XB_XSUB(x)], 1u);
    const unsigned gen = old / nloc;
    if (old + 1u == (gen + 1u) * nloc) {
      __builtin_amdgcn_fence(__ATOMIC_RELEASE, "agent");
      asm volatile("s_waitcnt vmcnt(0)" ::: "memory");
      const unsigned og = xb_add(&bar[XB_TOP], 1u);
      const unsigned tg = og / nx;
      if (og + 1u == (tg + 1u) * nx) xb_add(&bar[XB_TOPGEN], 1u);
      else XB_SPIN(xb_ld(&bar[XB_TOPGEN]) == tg, bar);
      __builtin_amdgcn_fence(__ATOMIC_ACQUIRE, "agent");
      xb_add(&bar[XB_XGEN(x)], 1u);
      asm volatile("s_waitcnt vmcnt(0)" ::: "memory");
    } else {
      XB_SPIN(xb_ld(&bar[XB_XGEN(x)]) == gen, bar);
      __builtin_amdgcn_fence(__ATOMIC_ACQUIRE, "agent");
      asm volatile("s_waitcnt vmcnt(0)" ::: "memory");
    }
  }
  __syncthreads();
}
__device__ __forceinline__ float wave_sum(float v) { for (int o = 32; o; o >>= 1) v += __shfl_xor(v, o); return v; }
__device__ __forceinline__ float wave_max(float v) { for (int o = 32; o; o >>= 1) v = fmaxf(v, __shfl_xor(v, o)); return v; }

constexpr int BM = 256, BK = 64, HALF = 128, NXCD = 8, WGM = 8, HT = HALF * BK;
constexpr int GEMM_LDS = 8 * HT * 2 + 16;

__device__ __forceinline__ int lds_byte(int r, int c) {
  int st = (r >> 4) * 2 + (c >> 5), rr = r & 15, cc = c & 31, ob = rr * 64 + cc * 2;
  return st * 1024 + (ob ^ (((ob >> 9) & 1) << 5));
}
__device__ __forceinline__ int perm32(int rho) { const int n = rho >> 4, i = rho & 15; return 8 * (i >> 2) + 4 * n + (i & 3); }
__device__ __forceinline__ void stage_rc(int b, int& R, int& C) {
  int st = b / 1024, sb = b % 1024, swz = sb ^ (((sb >> 9) & 1) << 5);
  R = (st >> 1) * 16 + swz / 64; C = (st & 1) * 32 + (swz % 64) / 2;
}

struct GemmEpi {
  const float* sumsq_in;
  u16* out_bf; int ldo;
  u16* xh;
  u16* xh_out;
  float* out_f;
  float* sumsq_out;
};

template <int MODE, bool ADD_RESID>
__device__ __forceinline__ void epi4(const GemmEpi& e, const f32x4 a, const float rs, const size_t grow, const int col0, float& ssq) {
  if (MODE == 1 || MODE == 3) {
    float v0 = a[0] * rs, v1 = a[1] * rs, v2 = a[2] * rs, v3 = a[3] * rs;
    if (MODE == 3) { v0 = fmaxf(v0, 0.f); v1 = fmaxf(v1, 0.f); v2 = fmaxf(v2, 0.f); v3 = fmaxf(v3, 0.f); v0 *= v0; v1 *= v1; v2 *= v2; v3 *= v3; }
    uint2 o; o.x = pack2(v0, v1); o.y = pack2(v2, v3);
    *(uint2*)(e.out_bf + grow * e.ldo + col0) = o;
  } else {
    float4 x; x.x = a[0]; x.y = a[1]; x.z = a[2]; x.w = a[3];
    if (ADD_RESID) {
      const uint2 r = *(const uint2*)(e.xh + grow * D + col0);
      x.x += __uint_as_float(r.x << 16); x.y += __uint_as_float(r.x & 0xffff0000u); x.z += __uint_as_float(r.y << 16); x.w += __uint_as_float(r.y & 0xffff0000u);
    }
    if (e.out_f) *(float4*)(e.out_f + grow * D + col0) = x;
    else { uint2 ob; ob.x = pack2(x.x, x.y); ob.y = pack2(x.z, x.w); *(uint2*)(e.xh_out + grow * D + col0) = ob; }
    ssq += x.x * x.x + x.y * x.y + x.z * x.z + x.w * x.w;
  }
}

template <int MODE>
__device__ __forceinline__ void epi8(const GemmEpi& e, const f32x4 a0, const f32x4 a1, const float rs, const size_t grow, const int col8, float& ssq) {
  float v[8] = {a0[0], a0[1], a0[2], a0[3], a1[0], a1[1], a1[2], a1[3]};
  if (MODE == 1 || MODE == 3) {
#pragma unroll
    for (int i = 0; i < 8; ++i) { v[i] *= rs; if (MODE == 3) { v[i] = fmaxf(v[i], 0.f); v[i] *= v[i]; } }
    uint4 o; o.x = pack2(v[0], v[1]); o.y = pack2(v[2], v[3]); o.z = pack2(v[4], v[5]); o.w = pack2(v[6], v[7]);
    *(uint4*)(e.out_bf + grow * e.ldo + col8) = o;
  } else {
    if (e.out_f) { *(float4*)(e.out_f + grow * D + col8) = make_float4(v[0], v[1], v[2], v[3]); *(float4*)(e.out_f + grow * D + col8 + 4) = make_float4(v[4], v[5], v[6], v[7]); }
    else { uint4 o; o.x = pack2(v[0], v[1]); o.y = pack2(v[2], v[3]); o.z = pack2(v[4], v[5]); o.w = pack2(v[6], v[7]); *(uint4*)(e.xh_out + grow * D + col8) = o; }
#pragma unroll
    for (int i = 0; i < 8; ++i) ssq += v[i] * v[i];
  }
}

template <int MODE>
__device__ __forceinline__ void gemm_phase(const u16* __restrict__ A, const u16* __restrict__ Bt, const int M, const int N, const int K, const GemmEpi e, const int wave_s, const int dry = 0) {
  u16* shm = (u16*)smem;
#define SA(b, h) (shm + ((b) * 2 + (h)) * HT)
#define SB(b, h) (shm + (4 + (b) * 2 + (h)) * HT)
#define STAGE_(P, RS, br, kt, o0, o1) do { const unsigned _so = (unsigned)(((br) * K + (kt) * BK) * 2); \
    __builtin_amdgcn_raw_ptr_buffer_load_lds(RS, (LDSP)((char*)(P) + tid0 * 16), 16, o0, _so, 0, 0); \
    __builtin_amdgcn_raw_ptr_buffer_load_lds(RS, (LDSP)((char*)(P) + tid0 * 16 + 8192), 16, o1, _so, 0, 0); } while (0)
#define STAGE(P, RS, br, kt) STAGE_(P, RS, br, kt, toff0, toff1)
#define STAGEB(P, RS, br, kt) STAGE_(P, RS, br, kt, toffb0, toffb1)
#define LDA(dst, b, h) for (int m = 0; m < 4; ++m) for (int k = 0; k < 2; ++k) \
    dst[m][k] = *reinterpret_cast<const bf16x8*>((char*)SA(b, h) + lds_byte(wr * 64 + m * 16 + fr, k * 32 + fq * 8))
#define LDB(dst, b, h) for (int n = 0; n < 2; ++n) for (int k = 0; k < 2; ++k) \
    dst[n][k] = *reinterpret_cast<const bf16x8*>((char*)SB(b, h) + lds_byte(wc * 32 + n * 16 + fr, k * 32 + fq * 8))
#define MMA(ai, bj, At, Bt_) do { __builtin_amdgcn_s_setprio(1); \
    for (int m = 0; m < 4; ++m) for (int n = 0; n < 2; ++n) for (int k = 0; k < 2; ++k) \
      acc[ai][bj][m][n] = __builtin_amdgcn_mfma_f32_16x16x32_bf16(Bt_[n][k], At[m][k], acc[ai][bj][m][n], 0, 0, 0); \
    __builtin_amdgcn_s_setprio(0); } while (0)
#define WAIT_V(n) asm volatile("s_waitcnt vmcnt(" #n ")" ::: "memory")
#define WAIT_L(n) asm volatile("s_waitcnt lgkmcnt(" #n ")" ::: "memory")
#define BAR __builtin_amdgcn_s_barrier()
#define SCHED __builtin_amdgcn_sched_barrier(0)
#define DECODE(tt_, brow_, bcol_) do { int wgid = (tt_); \
    { int q = nwg / NXCD, r = nwg % NXCD, xcd = wgid % NXCD, off = wgid / NXCD; \
      wgid = (xcd < r ? xcd * (q + 1) : r * (q + 1) + (xcd - r) * q) + off; } \
    int nig = WGM * nN, gid = wgid / nig, fm = gid * WGM, gsz = min(nM - fm, WGM); \
    brow_ = (fm + ((wgid % nig) % gsz)) * BM; bcol_ = ((wgid % nig) / gsz) * BM; } while (0)
#define STAGE7(brow_, bcol_) do { \
    STAGEB(SB(0, 0), rsB, bcol_, 0); STAGE(SA(0, 0), rsA, brow_, 0); \
    STAGEB(SB(0, 1), rsB, bcol_ + HALF, 0); STAGE(SA(0, 1), rsA, brow_ + HALF, 0); \
    STAGEB(SB(1, 0), rsB, bcol_, 1); STAGE(SA(1, 0), rsA, brow_, 1); STAGEB(SB(1, 1), rsB, bcol_ + HALF, 1); } while (0)

  const int nM = M / BM, nN = N / BM, nwg = nM * nN;
  const int nt = K / BK;
  unsigned toff0, toff1;
  const int tid0 = opaque_tid(wave_s);
  const int wr = (tid0 >> 6) >> 2, wc = (tid0 >> 6) & 3, fr = tid0 & 15, fq = (tid0 & 63) >> 4;
  unsigned toffb0, toffb1;
  { int r_, c_; stage_rc(tid0 * 16, r_, c_); toff0 = (unsigned)(r_ * K + c_) * 2u; toffb0 = (unsigned)(((r_ & ~31) | perm32(r_ & 31)) * K + c_) * 2u;
    stage_rc(tid0 * 16 + 8192, r_, c_); toff1 = (unsigned)(r_ * K + c_) * 2u; toffb1 = (unsigned)(((r_ & ~31) | perm32(r_ & 31)) * K + c_) * 2u; }
  const __amdgpu_buffer_rsrc_t rsA = __builtin_amdgcn_make_buffer_rsrc((void*)A, 0, -1, 0x00020000);
  const __amdgpu_buffer_rsrc_t rsB = __builtin_amdgcn_make_buffer_rsrc((void*)Bt, 0, -1, 0x00020000);
  int tt = blockIdx.x;
  int brow = 0, bcol = 0;
  if (tt < nwg) { DECODE(tt, brow, bcol); STAGE7(brow, bcol); WAIT_V(0); }
  f32x4 acc[2][2][4][2];
#define ACC_INIT(brow_, bcol_) do { \
    if (MODE == 2) { \
      const int t2 = opaque_tid(wave_s); const int wr_ = (t2 >> 6) >> 2, wc_ = (t2 >> 6) & 3, fr_ = t2 & 15, fq_ = (t2 & 63) >> 4; \
      const u16* rp_ = e.xh + (size_t)(brow_ + wr_ * 64 + fr_) * D + bcol_ + wc_ * 32 + fq_ * 8; \
      _Pragma("unroll") for (int ai = 0; ai < 2; ++ai) _Pragma("unroll") for (int bj = 0; bj < 2; ++bj) \
      _Pragma("unroll") for (int m = 0; m < 4; ++m) { \
        const uint4 x0 = *(const uint4*)(rp_ + (size_t)(ai * HALF + m * 16) * D + bj * HALF); \
        acc[ai][bj][m][0][0] = __uint_as_float(x0.x << 16); acc[ai][bj][m][0][1] = __uint_as_float(x0.x & 0xffff0000u); \
        acc[ai][bj][m][0][2] = __uint_as_float(x0.y << 16); acc[ai][bj][m][0][3] = __uint_as_float(x0.y & 0xffff0000u); \
        acc[ai][bj][m][1][0] = __uint_as_float(x0.z << 16); acc[ai][bj][m][1][1] = __uint_as_float(x0.z & 0xffff0000u); \
        acc[ai][bj][m][1][2] = __uint_as_float(x0.w << 16); acc[ai][bj][m][1][3] = __uint_as_float(x0.w & 0xffff0000u); } \
    } else { \
      _Pragma("unroll") for (int ai = 0; ai < 2; ++ai) _Pragma("unroll") for (int bj = 0; bj < 2; ++bj) \
      _Pragma("unroll") for (int m = 0; m < 4; ++m) _Pragma("unroll") for (int n = 0; n < 2; ++n) \
        acc[ai][bj][m][n] = (f32x4){0.f, 0.f, 0.f, 0.f}; \
    } } while (0)
  if (tt < nwg) ACC_INIT(brow, bcol);
  while (tt < nwg) {
    bf16x8 At[4][2], B0[2][2], B1[2][2];
    if (wr == 1) BAR;
    BAR;
    for (int t = 0; t < nt - 2; t += 2) {
      LDB(B0, 0, 0); SCHED; LDA(At, 0, 0); STAGE(SA(1, 1), rsA, brow + HALF, t + 1);
      WAIT_L(8); BAR; WAIT_L(0); MMA(0, 0, At, B0); BAR; SCHED;
      LDB(B1, 0, 1); STAGEB(SB(0, 0), rsB, bcol, t + 2);
      BAR; WAIT_L(0); MMA(0, 1, At, B1); BAR;
      LDA(At, 0, 1); STAGE(SA(0, 0), rsA, brow, t + 2);
      BAR; WAIT_L(0); MMA(1, 0, At, B0); BAR; SCHED;
      STAGEB(SB(0, 1), rsB, bcol + HALF, t + 2);
      WAIT_V(6); BAR; MMA(1, 1, At, B1); BAR;
      LDB(B0, 1, 0); SCHED; LDA(At, 1, 0); STAGE(SA(0, 1), rsA, brow + HALF, t + 2);
      WAIT_L(8); BAR; WAIT_L(0); MMA(0, 0, At, B0); BAR; SCHED;
      LDB(B1, 1, 1); STAGEB(SB(1, 0), rsB, bcol, t + 3);
      BAR; WAIT_L(0); MMA(0, 1, At, B1); BAR;
      LDA(At, 1, 1); STAGE(SA(1, 0), rsA, brow, t + 3);
      BAR; WAIT_L(0); MMA(1, 0, At, B0); BAR; SCHED;
      STAGEB(SB(1, 1), rsB, bcol + HALF, t + 3);
      WAIT_V(6); BAR; MMA(1, 1, At, B1); BAR;
    }
    { LDB(B0, 0, 0); LDA(At, 0, 0); STAGE(SA(1, 1), rsA, brow + HALF, nt - 1);
      BAR; WAIT_L(0); MMA(0, 0, At, B0); BAR;
      LDB(B1, 0, 1); BAR; WAIT_L(0); MMA(0, 1, At, B1); BAR;
      LDA(At, 0, 1); WAIT_V(4); BAR; WAIT_L(0); MMA(1, 0, At, B0); MMA(1, 1, At, B1); BAR; }
    { LDB(B0, 1, 0); LDA(At, 1, 0); WAIT_V(2); BAR; WAIT_L(0); MMA(0, 0, At, B0); BAR;
      LDB(B1, 1, 1); WAIT_V(0); BAR; WAIT_L(0); MMA(0, 1, At, B1); BAR;
      LDA(At, 1, 1); BAR; WAIT_L(0); MMA(1, 0, At, B0); MMA(1, 1, At, B1); BAR; }
    if (wr == 0) BAR;
    const int erow = brow, ecol = bcol;
    tt += gridDim.x;
    if (tt < nwg) { DECODE(tt, brow, bcol); STAGE7(brow, bcol); }
    SCHED;
    if (!dry) {
      const int tid1 = opaque_tid(wave_s);
      const int wr = (tid1 >> 6) >> 2, wc = (tid1 >> 6) & 3, fr = tid1 & 15, fq = (tid1 & 63) >> 4;
      float rsv[2][4];
#pragma unroll
      for (int ai = 0; ai < 2; ++ai)
#pragma unroll
        for (int m = 0; m < 4; ++m) {
          rsv[ai][m] = 0.f;
          if (MODE == 1 || MODE == 3) rsv[ai][m] = e.sumsq_in[(size_t)erow + ai * HALF + wr * 64 + m * 16 + fr];
        }
#pragma unroll
      for (int ai = 0; ai < 2; ++ai)
#pragma unroll
        for (int m = 0; m < 4; ++m) {
          const int lrow = ai * HALF + wr * 64 + m * 16 + fr;
          const size_t grow = (size_t)erow + lrow;
          float rs = 0.f, ssq = 0.f;
          if (MODE == 1 || MODE == 3) rs = rsqrtf(rsv[ai][m] * (1.0f / 1024.0f) + EPS);
#pragma unroll
          for (int bj = 0; bj < 2; ++bj)
            epi8<MODE>(e, acc[ai][bj][m][0], acc[ai][bj][m][1], rs, grow, ecol + bj * HALF + wc * 32 + fq * 8, ssq);
          if (MODE == 2 && e.sumsq_out) {
            ssq += __shfl_xor(ssq, 16); ssq += __shfl_xor(ssq, 32);
            if (fq == 0) atomicAdd(e.sumsq_out + grow, ssq);
          }
          SCHED;
        }
    }
    if (tt < nwg) ACC_INIT(brow, bcol);
    if (dry) WAIT_V(0); else WAIT_V(16);
  }
  WAIT_V(0);
#undef SA
#undef SB
#undef STAGE
#undef STAGEB
#undef STAGE_
#undef LDA
#undef LDB
#undef MMA
}

#define MFMA32(a, b, c) __builtin_amdgcn_mfma_f32_32x32x16_bf16((a), (b), (c), 0, 0, 0)

template <int MODE>
__device__ __forceinline__ void sample_gemm(const u16* __restrict__ A, const u16* __restrict__ Bt, const int N, const int K, const GemmEpi e, const int wave_s, const int b0, const int nb) {
  const int bi = (int)blockIdx.x - b0;
  if (bi < 0 || bi >= nb) return;
  const int tid = opaque_tid(wave_s);
  const int lane = tid & 63, wid = tid >> 6;
  const int i = lane & 31, h = lane >> 5;
  const int ntask = 8 * (N / 32);
  const int ks = K / 8;
  float* red = (float*)smem;
  for (int id = bi; id < ntask; id += nb) {
    const int r0 = (id & 7) * 32, c0 = (id >> 3) * 32;
    const u16* ap = A + (size_t)(NP + r0 + i) * K + wid * ks + 8 * h;
    const u16* bp = Bt + (size_t)(c0 + i) * K + wid * ks + 8 * h;
    f32x16 acc;
#pragma unroll
    for (int q = 0; q < 16; ++q) acc[q] = 0.f;
#pragma unroll 16
    for (int k = 0; k < ks; k += 16) {
      const bf16x8 a = *(const bf16x8*)(ap + k);
      const bf16x8 b = *(const bf16x8*)(bp + k);
      acc = MFMA32(b, a, acc);
    }
#pragma unroll
    for (int q = 0; q < 4; ++q)
      *(float4*)(red + (wid * 32 + i) * 36 + 8 * q + 4 * h) = make_float4(acc[4 * q], acc[4 * q + 1], acc[4 * q + 2], acc[4 * q + 3]);
    __syncthreads();
    if (tid < 256) {
      const int row = tid >> 3, c4 = (tid & 7) * 4;
      f32x4 s4; s4[0] = 0.f; s4[1] = 0.f; s4[2] = 0.f; s4[3] = 0.f;
#pragma unroll
      for (int w = 0; w < 8; ++w) {
        const float4 v = *(const float4*)(red + (w * 32 + row) * 36 + c4);
        s4[0] += v.x; s4[1] += v.y; s4[2] += v.z; s4[3] += v.w;
      }
      const int srow = r0 + row, col0 = c0 + c4;
      const size_t grow = (size_t)NP + srow;
      float rs = 0.f, ssq = 0.f;
      if (MODE == 1 || MODE == 3) rs = rsqrtf(e.sumsq_in[grow] * (1.0f / 1024.0f) + EPS);
      epi4<MODE, true>(e, s4, rs, grow, col0, ssq);
      if (MODE == 2 && e.sumsq_out) {
        ssq += __shfl_xor(ssq, 1); ssq += __shfl_xor(ssq, 2); ssq += __shfl_xor(ssq, 4);
        if ((tid & 7) == 0) atomicAdd(e.sumsq_out + grow, ssq);
      }
    }
    __syncthreads();
  }
}

template <int MODE>
__device__ __forceinline__ void sample_gemm64(const u16* __restrict__ A, const u16* __restrict__ Bt, const int N, const int K, const GemmEpi e, const int wave_s, const bool reverse) {
  const int tid = opaque_tid(wave_s);
  const int lane = tid & 63, wid = tid >> 6;
  const int i = lane & 31, h = lane >> 5;
  const int ri = wid & 1, ci = (wid >> 1) & 1, kh = wid >> 2;
  const int ntask = 4 * (N / 64);
  const int kspan = K / 2;
  float* red = (float*)smem;
  const int G = gridDim.x;
  for (int id = reverse ? G - 1 - (int)blockIdx.x : (int)blockIdx.x; id < ntask; id += G) {
    const int r0 = (id & 3) * 64 + ri * 32, c0 = (id >> 2) * 64 + ci * 32;
    const u16* ap = A + (size_t)(NP + r0 + i) * K + kh * kspan + 8 * h;
    const u16* bp = Bt + (size_t)(c0 + i) * K + kh * kspan + 8 * h;
    f32x16 acc;
#pragma unroll
    for (int q = 0; q < 16; ++q) acc[q] = 0.f;
#pragma unroll 16
    for (int k = 0; k < kspan; k += 16) {
      const bf16x8 a = *(const bf16x8*)(ap + k);
      const bf16x8 b = *(const bf16x8*)(bp + k);
      acc = MFMA32(b, a, acc);
    }
    float* rb = red + ((wid & 3) * 32 + i) * 36 + 4 * h;
    if (kh == 1) {
#pragma unroll
      for (int q = 0; q < 4; ++q) *(float4*)(rb + 8 * q) = make_float4(acc[4 * q], acc[4 * q + 1], acc[4 * q + 2], acc[4 * q + 3]);
    }
    __syncthreads();
    if (kh == 0) {
      const size_t grow = (size_t)NP + r0 + i;
      const float rs = rsqrtf(e.sumsq_in[grow] * (1.0f / 1024.0f) + EPS);
      float ssq = 0.f;
#pragma unroll
      for (int q = 0; q < 4; ++q) {
        const float4 o = *(const float4*)(rb + 8 * q);
        f32x4 a4; a4[0] = acc[4 * q] + o.x; a4[1] = acc[4 * q + 1] + o.y; a4[2] = acc[4 * q + 2] + o.z; a4[3] = acc[4 * q + 3] + o.w;
        epi4<MODE, false>(e, a4, rs, grow, c0 + 8 * q + 4 * h, ssq);
      }
    }
    __syncthreads();
  }
}

__device__ __forceinline__ void kv_shift_copy(const Params& p, const int l, const int b0, const int nb, const int tid) {
  const int bi = (int)blockIdx.x - b0;
  if (bi < 0 || bi >= nb) return;
  const size_t gt = (size_t)bi * 512 + tid, ntd = (size_t)nb * 512;
#pragma unroll
  for (int g = 0; g < 3; ++g) {
    const int W = 128 << (2 * g);
    const size_t n4 = (size_t)32 * W * 64;
    const size_t oo = (g == 0) ? O_KV128S : (g == 1) ? O_KV512S : O_KV2048S;
    const f32x4* src = (const f32x4*)p.kv_in[g] + (size_t)l * n4;
    f32x4* dst = (f32x4*)(p.out + oo) + (size_t)l * n4;
    const unsigned per = (unsigned)W * 64u, lim = (unsigned)(W - 8) * 64u;
    for (size_t i0 = gt; i0 < n4; i0 += ntd * 8) {
      f32x4 v[8];
#pragma unroll
      for (int k = 0; k < 8; ++k) {
        const size_t i = i0 + (size_t)k * ntd;
        v[k] = (f32x4){0.f, 0.f, 0.f, 0.f};
        if (i < n4 && ((unsigned)i % per) < lim) v[k] = __builtin_nontemporal_load(src + i + 512);
      }
#pragma unroll
      for (int k = 0; k < 8; ++k) {
        const size_t i = i0 + (size_t)k * ntd;
        if (i < n4 && ((unsigned)i % per) < lim) __builtin_nontemporal_store(v[k], dst + i);
      }
    }
  }
}

__device__ __forceinline__ void tr_tile(const float* __restrict__ src, u16* __restrict__ dst, int K, int N, int k0, int n0, const int tid, const float* __restrict__ gain) {
  float* lt = (float*)smem;
  { const int kk = tid >> 4, n4 = tid & 15;
#pragma unroll
    for (int i = 0; i < 2; ++i) {
      const int k = kk + i * 32;
      const float4 v = *(const float4*)(src + (size_t)(k0 + k) * N + n0 + n4 * 4);
      float* d = lt + k * 65 + n4 * 4;
      d[0] = v.x; d[1] = v.y; d[2] = v.z; d[3] = v.w;
    } }
  __syncthreads();
  { const int n = tid >> 3, k8 = tid & 7;
    float f[8];
#pragma unroll
    for (int i = 0; i < 8; ++i) f[i] = lt[(k8 * 8 + i) * 65 + n] * (gain ? gain[k0 + k8 * 8 + i] : 1.0f);
    uint4 o; o.x = pack2(f[0], f[1]); o.y = pack2(f[2], f[3]); o.z = pack2(f[4], f[5]); o.w = pack2(f[6], f[7]);
    *(uint4*)(dst + (size_t)(n0 + n) * K + k0 + k8 * 8) = o; }
  __syncthreads();
}

__device__ __forceinline__ void phase0(const Params& p, const int wave_s) {
  const int tid = opaque_tid(wave_s), lane = tid & 63, wid = tid >> 6;
  const int gw = blockIdx.x * 8 + wid, nw = gridDim.x * 8;
  const size_t gt = (size_t)blockIdx.x * 512 + tid, ntd = (size_t)gridDim.x * 512;
  for (int row0 = gw; row0 < MT; row0 += 2 * nw) {
    float4 v[2][4];
#pragma unroll
    for (int u = 0; u < 2; ++u) {
      const int row = min(row0 + u * nw, MT - 1);
      const float4* xr = (const float4*)(row < NP ? p.x_prompt + (size_t)row * D : p.x_sample + (size_t)(row - NP) * D);
#pragma unroll
      for (int i = 0; i < 4; ++i) v[u][i] = xr[lane + 64 * i];
    }
#pragma unroll
    for (int u = 0; u < 2; ++u) {
      const int row = row0 + u * nw;
      if (row < MT) {
        float ss = 0.f;
#pragma unroll
        for (int i = 0; i < 4; ++i) {
          const float4 x = v[u][i];
          ss += x.x * x.x + x.y * x.y + x.z * x.z + x.w * x.w;
          uint2 o; o.x = pack2(x.x, x.y); o.y = pack2(x.z, x.w);
          *(uint2*)(p.xg + (size_t)row * D + (lane + 64 * i) * 4) = o;
        }
        ss = wave_sum(ss);
        if (lane == 0) p.sumsq[row] = ss;
      }
    }
  }
  for (size_t i = gt; i < (size_t)3 * MT; i += ntd) p.sumsq[MT + i] = 0.f;
  for (size_t i = gt; i < (size_t)2056 * 8; i += ntd) {
    const int pi = (int)(i >> 3), fi = (int)(i & 7);
    const int pos = pi < 2048 ? pi : 8192 + (pi - 2048);
    float inv;
    switch (fi) { case 0: inv = 1.0f; break; case 1: inv = 0.1939227432012558f; break; case 2: inv = 0.03760603070259094f; break;
      case 3: inv = 0.007292664609849453f; break; case 4: inv = 0.0014142135623842478f; break; case 5: inv = 0.00027424818836152554f; break;
      case 6: inv = 5.318296098266728e-05f; break; default: inv = 1.0313386155758053e-05f; break; }
    const float ang = (float)pos * inv;
    p.rope[pi * 16 + fi] = cosf(ang);
    p.rope[pi * 16 + 8 + fi] = sinf(ang);
  }
  {
    float* lt = (float*)smem;
    constexpr int QL = (640 + 192 + 1024 + 1024) / 4;
    for (int t = blockIdx.x; t < 2 * QL; t += gridDim.x) {
      const int l = t / QL; int r = t % QL;
      const float* src; u16* dst; int K, N; const float* gain = nullptr;
      if (r < 160) { src = p.w_in + (size_t)l * D * IC; dst = p.wt_in + (size_t)l * IC * D; K = D; N = IC; gain = p.norm1_g + l * D; }
      else if (r < 208) { r -= 160; src = p.w_out + (size_t)l * MC * D; dst = p.wt_out + (size_t)l * D * MC; K = MC; N = D; }
      else if (r < 464) { r -= 208; src = p.w_up + (size_t)l * D * FF; dst = p.wt_up + (size_t)l * FF * D; K = D; N = FF; gain = p.norm2_g + l * D; }
      else { r -= 464; src = p.w_down + (size_t)l * FF * D; dst = p.wt_down + (size_t)l * D * FF; K = FF; N = D; }
      const int nq = N / 256;
      const int k0 = (r / nq) * 64, n0 = (r % nq) * 256;
      { const int kk = tid >> 6, n4 = tid & 63;
        float4 v[8];
#pragma unroll
        for (int i = 0; i < 8; ++i) v[i] = *(const float4*)(src + (size_t)(k0 + kk + 8 * i) * N + n0 + n4 * 4);
#pragma unroll
        for (int i = 0; i < 8; ++i) {
          const float gg = gain ? gain[k0 + kk + 8 * i] : 1.0f;
          *(float4*)(lt + (kk + 8 * i) * 260 + n4 * 4) = make_float4(v[i].x * gg, v[i].y * gg, v[i].z * gg, v[i].w * gg);
        } }
      __syncthreads();
      { const int n = tid >> 1, kh = (tid & 1) * 32;
        u16* dp = dst + (size_t)(n0 + n) * K + k0 + kh;
#pragma unroll
        for (int c = 0; c < 4; ++c) {
          float f[8];
#pragma unroll
          for (int i = 0; i < 8; ++i) f[i] = lt[(kh + c * 8 + i) * 260 + n];
          uint4 o; o.x = pack2(f[0], f[1]); o.y = pack2(f[2], f[3]); o.z = pack2(f[4], f[5]); o.w = pack2(f[6], f[7]);
          *(uint4*)(dp + c * 8) = o;
        } }
      __syncthreads();
    }
    for (int t = blockIdx.x; t < 8; t += gridDim.x)
      tr_tile(p.pool_w + (size_t)t * 4096, p.pwT + (size_t)t * 4096, 64, 64, 0, 0, tid, nullptr);
  }
}


__device__ __forceinline__ void load_qk(const u16* __restrict__ rowp, const float* __restrict__ ropep, const float* __restrict__ gain,
                                        const float scale, bf16x8 out[4], const int h) {
  float f[4][8];
  float ss = 0.f;
#pragma unroll
  for (int s = 0; s < 4; ++s) {
    const bf16x8 raw = *(const bf16x8*)(rowp + 16 * s + 8 * h);
#pragma unroll
    for (int j = 0; j < 8; ++j) { f[s][j] = bfs2f(raw[j]); ss += f[s][j] * f[s][j]; }
  }
  ss += __shfl_xor(ss, 32);
  const float inv = rsqrtf(ss * (1.0f / 64.0f) + EPS);
#pragma unroll
  for (int s = 0; s < 4; ++s) {
    const float4 g0 = *(const float4*)(gain + 16 * s + 8 * h), g1 = *(const float4*)(gain + 16 * s + 8 * h + 4);
    f[s][0] *= inv * g0.x; f[s][1] *= inv * g0.y; f[s][2] *= inv * g0.z; f[s][3] *= inv * g0.w;
    f[s][4] *= inv * g1.x; f[s][5] *= inv * g1.y; f[s][6] *= inv * g1.z; f[s][7] *= inv * g1.w;
  }
  {
    const float4 c0 = *(const float4*)(ropep), c1 = *(const float4*)(ropep + 4), s0 = *(const float4*)(ropep + 8), s1 = *(const float4*)(ropep + 12);
    const float cs[8] = {c0.x, c0.y, c0.z, c0.w, c1.x, c1.y, c1.z, c1.w};
    const float sn[8] = {s0.x, s0.y, s0.z, s0.w, s1.x, s1.y, s1.z, s1.w};
#pragma unroll
    for (int j = 0; j < 8; ++j) {
      const float other = __shfl_xor(f[0][j], 32);
      f[0][j] = (h == 0) ? (f[0][j] * cs[j] - other * sn[j]) : (f[0][j] * cs[j] + other * sn[j]);
    }
  }
#pragma unroll
  for (int s = 0; s < 4; ++s)
    out[s] = pack8(f[s][0] * scale, f[s][1] * scale, f[s][2] * scale, f[s][3] * scale, f[s][4] * scale, f[s][5] * scale, f[s][6] * scale, f[s][7] * scale);
}

template <bool SAMPLE>
__device__ __forceinline__ void attn_task(const Params& p, const int layer, const int task, const int wid) {
  const int lane = opaque_lane();
  int g, hslot, b, r, tile, nq;
  if (!SAMPLE) {
    const int c = task & 63; int tmp = task >> 6; g = tmp % 3; tmp /= 3; hslot = tmp & 1; b = tmp >> 1;
    const int tpc = 64 >> (2 * g);
    r = c / tpc; tile = c % tpc; nq = 32;
  } else {
    b = task / 26; const int rem = task % 26; hslot = rem / 13; const int c = rem % 13;
    if (c == 0) { g = 0; r = 0; nq = 8; } else if (c < 5) { g = 1; r = c - 1; nq = 2; } else { g = 2; r = c - 5; nq = 1; }
    tile = 4;
  }
  const int dl = 1 << (2 * g);
  const int W = 128 << (2 * g);
  const int m0 = tile * 32;
  const int head = 2 * g + hslot;
  const u16* projb = SAMPLE ? p.proj + (size_t)(NP + b * 8) * IC : p.proj + (size_t)b * 2048 * IC;
  const int ropeb = SAMPLE ? 2048 : 0;
  const float* cache = SAMPLE ? ((g == 0) ? p.kv_in[0] : (g == 1) ? p.kv_in[1] : p.kv_in[2]) + (size_t)(layer * 32 + b) * W * 256 + hslot * 64 : nullptr;
  const int qi = lane & 31, h = lane >> 5;
  int tq;
  if (SAMPLE) tq = r + dl * (qi < nq ? qi : 0); else tq = (m0 + qi) * dl + r;
  bf16x8 qf[4];
  load_qk(projb + (size_t)tq * IC + C_Q + head * 64, p.rope + (ropeb + tq) * 16, p.q_norm_g + layer * 64, 0.125f, qf, h);
  const int kt_lo = SAMPLE ? 0 : max(0, 4 - tile);
  f32x16 sacc[5];
#pragma unroll
  for (int kt = 0; kt < 5; ++kt) {
#pragma unroll
    for (int i = 0; i < 16; ++i) sacc[kt][i] = 0.f;
    if (kt >= kt_lo) {
      bf16x8 kf[4];
      if (SAMPLE && kt < 4) {
        const float* kp = cache + (size_t)(r + dl * (32 * kt + qi)) * 256 + 8 * h;
#pragma unroll
        for (int s = 0; s < 4; ++s) {
          const float4 x0 = *(const float4*)(kp + 16 * s), x1 = *(const float4*)(kp + 16 * s + 4);
          kf[s] = pack8(x0.x, x0.y, x0.z, x0.w, x1.x, x1.y, x1.z, x1.w);
        }
      } else {
        int tk;
        if (SAMPLE) tk = r + dl * (qi < nq ? qi : 0); else tk = (m0 - 128 + 32 * kt + qi) * dl + r;
        load_qk(projb + (size_t)tk * IC + C_K + head * 64, p.rope + (ropeb + tk) * 16, p.k_norm_g + layer * 64, 1.0f, kf, h);
      }
#pragma unroll
      for (int s = 0; s < 4; ++s) sacc[kt] = MFMA32(kf[s], qf[s], sacc[kt]);
    }
  }
  float mx = -1e30f;
#pragma unroll
  for (int kt = 0; kt < 5; ++kt)
#pragma unroll
    for (int rr = 0; rr < 16; ++rr) {
      const int keyrow = (rr & 3) + 8 * (rr >> 2) + 4 * h;
      const int dist = 128 - 32 * kt + qi - keyrow;
      const bool valid = (kt >= kt_lo) && dist >= 0 && dist <= 128;
      const float s = valid ? sacc[kt][rr] : -1e30f;
      sacc[kt][rr] = s;
      mx = fmaxf(mx, s);
    }
  mx = fmaxf(mx, __shfl_xor(mx, 32));
  float sum = 0.f;
#pragma unroll
  for (int kt = 0; kt < 5; ++kt)
#pragma unroll
    for (int rr = 0; rr < 16; ++rr) {
      const float s = sacc[kt][rr];
      const float ex = (s > -1e29f) ? __expf(s - mx) : 0.f;
      sacc[kt][rr] = ex;
      sum += ex;
    }
  sum += __shfl_xor(sum, 32);
  bf16x8 pfa[5][2];
#pragma unroll
  for (int kt = 0; kt < 5; ++kt)
#pragma unroll
    for (int s2 = 0; s2 < 2; ++s2)
      pfa[kt][s2] = pack8(sacc[kt][8 * s2], sacc[kt][8 * s2 + 1], sacc[kt][8 * s2 + 2], sacc[kt][8 * s2 + 3], sacc[kt][8 * s2 + 4], sacc[kt][8 * s2 + 5], sacc[kt][8 * s2 + 6], sacc[kt][8 * s2 + 7]);
  f32x16 oacc[2];
#pragma unroll
  for (int i = 0; i < 16; ++i) { oacc[0][i] = 0.f; oacc[1][i] = 0.f; }
  u16* vt = (u16*)(smem + wid * 16384);
  const int srow = lane >> 1, shf = (lane & 1) * 32;
#pragma unroll
  for (int kt = 0; kt < 5; ++kt) {
    if (kt >= kt_lo) {
      u16* vb = vt + (kt & 1) * (32 * 72);
      if (SAMPLE && kt < 4) {
        const float* vp = cache + (size_t)(r + dl * (32 * kt + srow)) * 256 + 128 + shf;
#pragma unroll
        for (int c = 0; c < 4; ++c) {
          const float4 x0 = *(const float4*)(vp + 8 * c), x1 = *(const float4*)(vp + 8 * c + 4);
          uint4 o; o.x = pack2(x0.x, x0.y); o.y = pack2(x0.z, x0.w); o.z = pack2(x1.x, x1.y); o.w = pack2(x1.z, x1.w);
          *(uint4*)(vb + srow * 72 + shf + 8 * c) = o;
        }
      } else {
        int tk;
        if (SAMPLE) tk = r + dl * (srow < nq ? srow : 0); else tk = (m0 - 128 + 32 * kt + srow) * dl + r;
        const u16* vp = projb + (size_t)tk * IC + C_V + head * 64 + shf;
#pragma unroll
        for (int c = 0; c < 4; ++c) *(uint4*)(vb + srow * 72 + shf + 8 * c) = *(const uint4*)(vp + 8 * c);
      }
#pragma unroll
      for (int s2 = 0; s2 < 2; ++s2) {
        bf16x8 v0, v1;
#pragma unroll
        for (int j = 0; j < 8; ++j) {
          const int kr = 16 * s2 + 8 * (j >> 2) + 4 * h + (j & 3);
          v0[j] = (short)vb[kr * 72 + qi]; v1[j] = (short)vb[kr * 72 + qi + 32];
        }
        oacc[0] = MFMA32(v0, pfa[kt][s2], oacc[0]);
        oacc[1] = MFMA32(v1, pfa[kt][s2], oacc[1]);
      }
    }
  }
  const float isum = 1.0f / sum;
  const size_t rowq = SAMPLE ? (size_t)NP + b * 8 + tq : (size_t)b * 2048 + tq;
  if (!SAMPLE || qi < nq) {
    float* op = p.opart + ((size_t)g * MT + rowq) * 128 + hslot * 64;
#pragma unroll
    for (int db = 0; db < 2; ++db)
#pragma unroll
      for (int i4 = 0; i4 < 4; ++i4) {
        float4 o; o.x = oacc[db][4 * i4] * isum; o.y = oacc[db][4 * i4 + 1] * isum; o.z = oacc[db][4 * i4 + 2] * isum; o.w = oacc[db][4 * i4 + 3] * isum;
        *(float4*)(op + db * 32 + 8 * i4 + 4 * h) = o;
      }
    if (h == 0) p.lse[((size_t)g * MT + rowq) * 2 + hslot] = mx + __logf(sum);
  }
}

__device__ __forceinline__ void kv_row_task(const Params& p, const int l, const int row, const int lane, const bf16x8 kr, const bf16x8 vr) {
  const int hl = lane < 48 ? lane : 47;
  const int head = hl >> 3, c8 = hl & 7;
  int b, t, ridx;
  const bool prompt = row < NP;
  if (prompt) { b = row >> 11; t = row & 2047; ridx = t; } else { b = (row - NP) >> 3; t = (row - NP) & 7; ridx = 2048 + t; }
  float f[8]; float ss = 0.f;
#pragma unroll
  for (int j = 0; j < 8; ++j) { f[j] = bfs2f(kr[j]); ss += f[j] * f[j]; }
  ss += __shfl_xor(ss, 1); ss += __shfl_xor(ss, 2); ss += __shfl_xor(ss, 4);
  const float inv = rsqrtf(ss * (1.0f / 64.0f) + EPS);
  const float* gk = p.k_norm_g + l * 64 + c8 * 8;
#pragma unroll
  for (int j = 0; j < 8; ++j) f[j] *= inv * gk[j];
  const float* rp = p.rope + ridx * 16;
#pragma unroll
  for (int j = 0; j < 8; ++j) {
    const float other = __shfl_xor(f[j], 1);
    const float cs = rp[j], sn = rp[8 + j];
    if (c8 == 0) f[j] = f[j] * cs - other * sn;
    else if (c8 == 1) f[j] = f[j] * cs + other * sn;
  }
  const int g = head >> 1, hh = head & 1;
  const int W = 128 << (2 * g);
  float* dst = nullptr;
  if (prompt) {
    const int r = t - (2048 - W);
    const size_t base = (g == 0) ? O_KV128P : (g == 1) ? O_KV512P : O_KV2048P;
    if (r >= 0) dst = p.out + base + ((size_t)(l * 8 + b) * W + r) * 256 + hh * 64 + c8 * 8;
  } else {
    const int r = W - 8 + t;
    const size_t base = (g == 0) ? O_KV128S : (g == 1) ? O_KV512S : O_KV2048S;
    dst = p.out + base + ((size_t)(l * 32 + b) * W + r) * 256 + hh * 64 + c8 * 8;
  }
  if (dst && lane < 48) {
    *(float4*)(dst) = make_float4(f[0], f[1], f[2], f[3]);
    *(float4*)(dst + 4) = make_float4(f[4], f[5], f[6], f[7]);
    *(float4*)(dst + 128) = make_float4(bfs2f(vr[0]), bfs2f(vr[1]), bfs2f(vr[2]), bfs2f(vr[3]));
    *(float4*)(dst + 132) = make_float4(bfs2f(vr[4]), bfs2f(vr[5]), bfs2f(vr[6]), bfs2f(vr[7]));
  }
}

__device__ __forceinline__ void phaseA(const Params& p, const int l, const int wave_s) {
  const int tid = opaque_tid(wave_s);
  const int lane = tid & 63, wid = tid >> 6;
  const int gw = blockIdx.x * 8 + wid, nw = gridDim.x * 8;
  for (int task = gw; task < 832 + 3072; task += nw) { if (task < 832) attn_task<true>(p, l, task, wid); else attn_task<false>(p, l, task - 832, wid); }
  for (int row0 = nw - 1 - gw; row0 < MT; row0 += 4 * nw) {
    const int hl = lane < 48 ? lane : 47;
    bf16x8 kr[4], vr[4];
#pragma unroll
    for (int u = 0; u < 4; ++u) {
      const int rc = min(row0 + u * nw, MT - 1);
      const u16* pr = p.proj + (size_t)rc * IC;
      kr[u] = *(const bf16x8*)(pr + C_K + hl * 8);
      vr[u] = *(const bf16x8*)(pr + C_V + hl * 8);
    }
#pragma unroll
    for (int u = 0; u < 4; ++u) if (row0 + u * nw < MT) kv_row_task(p, l, row0 + u * nw, lane, kr[u], vr[u]);
  }
}

template <int GRP>
__device__ __forceinline__ void pool_task(const Params& p, const int l, const int task, const int lane) {
  const int tile = task >> 2; constexpr int grp = GRP;
  const int qi = lane & 31, h = lane >> 5;
  const int row = tile * 32 + qi;
  constexpr int w = 2 << GRP;
  const bool prompt = row < NP;
  int n, t; float cnt;
  if (prompt) { n = row >> 11; t = row & 2047; cnt = (float)min(t + 1, w); } else { n = (row - NP) >> 3; t = (row - NP) & 7; cnt = (float)w; }
  const float icnt = 1.0f / cnt;
  f32x16 acc[2];
#pragma unroll
  for (int i = 0; i < 16; ++i) { acc[0][i] = 0.f; acc[1][i] = 0.f; }
  const u16* pw = p.pwT + (size_t)(l * 4 + grp) * 4096;
#pragma unroll
  for (int s = 0; s < 4; ++s) {
    const int c0 = grp * 64 + 16 * s + 8 * h;
    float sum[8], own[8];
#pragma unroll
    for (int j = 0; j < 8; ++j) { sum[j] = 0.f; own[j] = 0.f; }
#pragma unroll
    for (int i = 0; i < w; ++i) {
      const int tt = t - i;
      float v[8];
      if (tt >= 0) {
        const bf16x8 raw = *(const bf16x8*)(p.proj + (size_t)(row - i) * IC + C_U + c0);
#pragma unroll
        for (int j = 0; j < 8; ++j) v[j] = bfs2f(raw[j]);
      } else if (!prompt) {
        const float* sp = p.state_pool + ((size_t)(l * 32 + n) * 15 + 15 + tt) * 256 + c0;
        const float4 a = *(const float4*)sp, bb = *(const float4*)(sp + 4);
        v[0] = a.x; v[1] = a.y; v[2] = a.z; v[3] = a.w; v[4] = bb.x; v[5] = bb.y; v[6] = bb.z; v[7] = bb.w;
      } else {
#pragma unroll
        for (int j = 0; j < 8; ++j) v[j] = 0.f;
      }
#pragma unroll
      for (int j = 0; j < 8; ++j) sum[j] += v[j];
      if (i == 0) {
#pragma unroll
        for (int j = 0; j < 8; ++j) own[j] = v[j];
      }
    }
    const bf16x8 df = pack8(sum[0] * icnt - own[0], sum[1] * icnt - own[1], sum[2] * icnt - own[2], sum[3] * icnt - own[3],
                            sum[4] * icnt - own[4], sum[5] * icnt - own[5], sum[6] * icnt - own[6], sum[7] * icnt - own[7]);
    const bf16x8 a0 = *(const bf16x8*)(pw + (size_t)qi * 64 + 16 * s + 8 * h);
    const bf16x8 a1 = *(const bf16x8*)(pw + (size_t)(qi + 32) * 64 + 16 * s + 8 * h);
    acc[0] = MFMA32(a0, df, acc[0]);
    acc[1] = MFMA32(a1, df, acc[1]);
  }
  const float* ps = p.pool_scale + l * 256 + grp * 64;
  u16* mp = p.mixed + (size_t)row * MC + grp * 64;
#pragma unroll
  for (int db = 0; db < 2; ++db)
#pragma unroll
    for (int i4 = 0; i4 < 4; ++i4) {
      const int dd0 = db * 32 + 8 * i4 + 4 * h;
      const float4 sc = *(const float4*)(ps + dd0);
      uint2 o; o.x = pack2(acc[db][4 * i4] * sc.x, acc[db][4 * i4 + 1] * sc.y); o.y = pack2(acc[db][4 * i4 + 2] * sc.z, acc[db][4 * i4 + 3] * sc.w);
      *(uint2*)(mp + dd0) = o;
    }
}

__device__ __forceinline__ void phaseB(const Params& p, const int l, const int wave_s) {
  const int tid = opaque_tid(wave_s), lane = tid & 63, wid = tid >> 6;
  const int gw = blockIdx.x * 8 + wid, nw = gridDim.x * 8;
  const size_t gt = (size_t)blockIdx.x * 512 + tid, ntd = (size_t)gridDim.x * 512;
  for (int task = gw; task < 520 * 4; task += nw) {
    switch (task & 3) { case 0: pool_task<0>(p, l, task, lane); break; case 1: pool_task<1>(p, l, task, lane); break;
                        case 2: pool_task<2>(p, l, task, lane); break; default: pool_task<3>(p, l, task, lane); break; }
  }
  for (size_t idx = gt; idx < (size_t)(MT / 4) * 48; idx += ntd) {
    const int row0 = (int)(idx / 48) * 4, ch = (int)(idx % 48) * 8;
    const bool prompt = row0 < NP;
    int n, t0;
    if (prompt) { n = row0 >> 11; t0 = row0 & 2047; } else { n = (row0 - NP) >> 3; t0 = (row0 - NP) & 7; }
    float z[6][8];
#pragma unroll
    for (int i = 0; i < 6; ++i) {
      const int tt = t0 - 2 + i;
      if (tt >= 0) {
        const u16* pr = p.proj + (size_t)(row0 - 2 + i) * IC;
        const bf16x8 gc = *(const bf16x8*)(pr + C_GC + ch), gh = *(const bf16x8*)(pr + C_GH + ch);
#pragma unroll
        for (int j = 0; j < 8; ++j) z[i][j] = bfs2f(gc[j]) * bfs2f(gh[j]);
      } else if (!prompt) {
        const float* sp = p.state_conv + ((size_t)(l * 32 + n) * 2 + 2 + tt) * 384 + ch;
        const float4 a = *(const float4*)sp, bb = *(const float4*)(sp + 4);
        z[i][0] = a.x; z[i][1] = a.y; z[i][2] = a.z; z[i][3] = a.w; z[i][4] = bb.x; z[i][5] = bb.y; z[i][6] = bb.z; z[i][7] = bb.w;
      } else {
#pragma unroll
        for (int j = 0; j < 8; ++j) z[i][j] = 0.f;
      }
    }
    const float* cw = p.conv_w + (size_t)l * 3 * 384 + ch;
    float c0[8], c1[8], c2[8];
#pragma unroll
    for (int j = 0; j < 8; ++j) { c0[j] = cw[j]; c1[j] = cw[384 + j]; c2[j] = cw[768 + j]; }
#pragma unroll
    for (int u = 0; u < 4; ++u) {
      const int row = row0 + u, t = t0 + u;
      const bf16x8 gb = *(const bf16x8*)(p.proj + (size_t)row * IC + C_GB + ch);
      float y[8];
#pragma unroll
      for (int j = 0; j < 8; ++j) y[j] = bfs2f(gb[j]) * (c0[j] * z[u][j] + c1[j] * z[u + 1][j] + c2[j] * z[u + 2][j]);
      uint4 o; o.x = pack2(y[0], y[1]); o.y = pack2(y[2], y[3]); o.z = pack2(y[4], y[5]); o.w = pack2(y[6], y[7]);
      *(uint4*)(p.mixed + (size_t)row * MC + 384 + ch) = o;
      float* so = nullptr;
      if (prompt) { if (t >= 2046) so = p.out + O_CONVP + ((size_t)(l * 8 + n) * 2 + (t - 2046)) * 384 + ch; }
      else { if (t >= 6) so = p.out + O_CONVS + ((size_t)(l * 32 + n) * 2 + (t - 6)) * 384 + ch; }
      if (so) { *(float4*)so = make_float4(z[u + 2][0], z[u + 2][1], z[u + 2][2], z[u + 2][3]); *(float4*)(so + 4) = make_float4(z[u + 2][4], z[u + 2][5], z[u + 2][6], z[u + 2][7]); }
    }
  }
  for (size_t idx = gt; idx < (size_t)MT * 16; idx += ntd) {
    const int row = (int)(idx >> 4), chunk = (int)(idx & 15);
    const int hslot = chunk >> 3, d0 = (chunk & 7) * 8;
    float lg[3];
#pragma unroll
    for (int g = 0; g < 3; ++g) lg[g] = p.lse[((size_t)g * MT + row) * 2 + hslot];
    const float m = fmaxf(lg[0], fmaxf(lg[1], lg[2]));
    float wg[3]; wg[0] = __expf(lg[0] - m); wg[1] = __expf(lg[1] - m); wg[2] = __expf(lg[2] - m);
    const float iw = 1.0f / (wg[0] + wg[1] + wg[2]);
    float y[8];
#pragma unroll
    for (int j = 0; j < 8; ++j) y[j] = 0.f;
#pragma unroll
    for (int g = 0; g < 3; ++g) {
      const float* op = p.opart + ((size_t)g * MT + row) * 128 + hslot * 64 + d0;
      const float4 a = *(const float4*)op, bb = *(const float4*)(op + 4);
      const float ww = wg[g] * iw;
      y[0] += ww * a.x; y[1] += ww * a.y; y[2] += ww * a.z; y[3] += ww * a.w; y[4] += ww * bb.x; y[5] += ww * bb.y; y[6] += ww * bb.z; y[7] += ww * bb.w;
    }
    uint4 o; o.x = pack2(y[0], y[1]); o.y = pack2(y[2], y[3]); o.z = pack2(y[4], y[5]); o.w = pack2(y[6], y[7]);
    *(uint4*)(p.mixed + (size_t)row * MC + 256 + hslot * 64 + d0) = o;
  }
  for (size_t idx = gt; idx < (size_t)8 * 15 * 256; idx += ntd) {
    const int c = (int)(idx & 255); const int bi = (int)(idx >> 8); const int i = bi % 15, b = bi / 15;
    p.out[O_POOLP + (size_t)l * 8 * 15 * 256 + idx] = bf2f(p.proj[((size_t)b * 2048 + 2033 + i) * IC + C_U + c]);
  }
  for (size_t idx = gt; idx < (size_t)32 * 15 * 256; idx += ntd) {
    const int c = (int)(idx & 255); const int bi = (int)(idx >> 8); const int i = bi % 15, n = bi / 15;
    float v;
    if (i < 7) v = p.state_pool[((size_t)(l * 32 + n) * 15 + 8 + i) * 256 + c];
    else v = bf2f(p.proj[((size_t)NP + n * 8 + (i - 7)) * IC + C_U + c]);
    p.out[O_POOLS + (size_t)l * 32 * 15 * 256 + idx] = v;
  }
}

#ifndef PROBEV
#define PROBEV 0
#endif
#ifndef REPM
#define REPM 0
#endif
#define NREP(k) (1 + ((REPM >> (k)) & 1))
typedef const __attribute__((address_space(4))) Params* CP;
#if defined(__HIP_DEVICE_COMPILE__)
#define LOAD_PARAMS() CP pp_ = (CP)__builtin_amdgcn_kernarg_segment_ptr(); asm volatile("" : "+s"(pp_)); const Params p = *pp_
#else
#define LOAD_PARAMS() const Params& p = p_unused
#endif
__global__ void __launch_bounds__(512, 2) mega(const Params p_unused, const int ph_lo, const int ph_hi) {
  const int wave_s = __builtin_amdgcn_readfirstlane((int)(threadIdx.x >> 6));
  if (ph_hi == -12345) cg::this_grid().sync();
  {
    LOAD_PARAMS();
    if (opaque_tid(wave_s) == 0) {
      volatile __attribute__((address_space(3))) unsigned* st = (volatile __attribute__((address_space(3))) unsigned*)(smem + BAR_LDS_OFF);
      st[0] = 0u; st[1] = 0u;
      (void)xb_add(&p.bar[XB_XCNT(xb_xcc_id())], 1u);
    }
    __syncthreads();
  }
  int ph = 0;
#define IN_PH() (ph_lo <= ph && ph < ph_hi)
#define SEAM() do { if (ph_lo <= ph && ph + 1 < ph_hi) { LOAD_PARAMS(); grid_bar(p.bar, wave_s); } ++ph; } while (0)
  if (IN_PH()) for (int rep = 0; rep < NREP(0); ++rep) { LOAD_PARAMS(); phase0(p, wave_s); }
  SEAM();
#pragma unroll 1
  for (int l = 0; l < 2; ++l) {
    if (IN_PH()) for (int rep = 0; rep < NREP(1); ++rep) {
      LOAD_PARAMS();
      GemmEpi e{}; e.sumsq_in = p.sumsq + (size_t)(2 * l) * MT; e.out_bf = p.proj; e.ldo = IC;
      gemm_phase<1>(p.xg, p.wt_in + (size_t)l * IC * D, NP, IC, D, e, wave_s);
      { const int G = gridDim.x, first = (64 * (IC / 256)) % G;
        const int b0 = first ? first : 0, nb = G - b0;
        kv_shift_copy(p, l, b0, nb, opaque_tid(wave_s));
        sample_gemm64<1>(p.xg, p.wt_in + (size_t)l * IC * D, IC, D, e, wave_s, true); }
    }
    SEAM();
    if (IN_PH()) for (int rep = 0; rep < NREP(2); ++rep) { LOAD_PARAMS(); phaseA(p, l, wave_s); }
    SEAM();
    if (IN_PH()) for (int rep = 0; rep < NREP(3); ++rep) { LOAD_PARAMS(); phaseB(p, l, wave_s); }
    SEAM();
    if (IN_PH()) for (int rep = 0; rep < NREP(4); ++rep) {
      LOAD_PARAMS();
      GemmEpi e{};
      const bool last = (rep == NREP(4) - 1);
      e.xh = p.xg; e.xh_out = last ? p.xg : p.scr16; e.out_f = nullptr; e.sumsq_out = last ? p.sumsq + (size_t)(2 * l + 1) * MT : p.scrss;
      gemm_phase<2>(p.mixed, p.wt_out + (size_t)l * D * MC, NP, D, MC, e, wave_s, 0);
      sample_gemm<2>(p.mixed, p.wt_out + (size_t)l * D * MC, D, MC, e, wave_s, 0, gridDim.x);
    }
    SEAM();
    if (IN_PH()) for (int rep = 0; rep < NREP(5); ++rep) {
      LOAD_PARAMS();
      GemmEpi e{}; e.sumsq_in = p.sumsq + (size_t)(2 * l + 1) * MT; e.out_bf = p.hf; e.ldo = FF;
      gemm_phase<3>(p.xg, p.wt_up + (size_t)l * FF * D, NP, FF, D, e, wave_s, (rep && (PROBEV & 1)) ? 1 : 0);
      if (!(rep && (PROBEV & 2))) sample_gemm64<3>(p.xg, p.wt_up + (size_t)l * FF * D, FF, D, e, wave_s, false);
    }
    SEAM();
    if (IN_PH()) for (int rep = 0; rep < NREP(6); ++rep) {
      LOAD_PARAMS();
      GemmEpi e{};
      const bool last = (rep == NREP(6) - 1);
      e.xh = p.xg; e.xh_out = last ? p.xg : p.scr16;
      if (l == 0) { e.out_f = nullptr; e.sumsq_out = last ? p.sumsq + (size_t)2 * MT : p.scrss; } else { e.out_f = last ? p.out : p.scrf; e.sumsq_out = nullptr; }
      gemm_phase<2>(p.hf, p.wt_down + (size_t)l * D * FF, NP, D, FF, e, wave_s, 0);
      sample_gemm<2>(p.hf, p.wt_down + (size_t)l * D * FF, D, FF, e, wave_s, 0, gridDim.x);
    }
    SEAM();
  }
}

extern "C" void kernel_launch(void* const* d_in, const int* in_sizes, int n_in, void* d_out, int out_size, void* d_ws, size_t ws_size, hipStream_t stream) {
  static int grid_blocks = 0;
  if (!grid_blocks) {
    int dev = 0, cus = 0, per_cu = 0;
    hipGetDevice(&dev);
    hipDeviceGetAttribute(&cus, hipDeviceAttributeMultiprocessorCount, dev);
    hipFuncSetAttribute((const void*)mega, hipFuncAttributeMaxDynamicSharedMemorySize, GEMM_LDS);
    hipOccupancyMaxActiveBlocksPerMultiprocessor(&per_cu, (const void*)mega, 512, GEMM_LDS);
    if (per_cu < 1) { fprintf(stderr, "occupancy query returned %d\n", per_cu); per_cu = 1; }
    grid_blocks = cus * 1;
  }
  Params p{};
  p.x_prompt = (const float*)d_in[0]; p.x_sample = (const float*)d_in[1]; p.state_pool = (const float*)d_in[2]; p.state_conv = (const float*)d_in[3];
  p.kv_in[0] = (const float*)d_in[4]; p.kv_in[1] = (const float*)d_in[5]; p.kv_in[2] = (const float*)d_in[6];
  p.norm1_g = (const float*)d_in[7]; p.w_in = (const float*)d_in[8]; p.q_norm_g = (const float*)d_in[9]; p.k_norm_g = (const float*)d_in[10];
  p.pool_w = (const float*)d_in[11]; p.pool_scale = (const float*)d_in[12]; p.conv_w = (const float*)d_in[13]; p.w_out = (const float*)d_in[14];
  p.norm2_g = (const float*)d_in[15]; p.w_up = (const float*)d_in[16]; p.w_down = (const float*)d_in[17];
  p.out = (float*)d_out;
  unsigned char* w = (unsigned char*)d_ws; size_t off = 0;
  auto carve = [&](size_t bytes) { unsigned char* r = w + off; off += (bytes + 255) & ~(size_t)255; return r; };
  p.bar = (unsigned*)carve(XCD_BAR_WORDS * 4);
  p.wt_in = (u16*)carve((size_t)2 * IC * D * 2);
  p.wt_out = (u16*)carve((size_t)2 * D * MC * 2);
  p.wt_up = (u16*)carve((size_t)2 * FF * D * 2);
  p.wt_down = (u16*)carve((size_t)2 * D * FF * 2);
  p.pwT = (u16*)carve((size_t)2 * 4 * 4096 * 2);
  p.xg = (u16*)carve((size_t)MT * D * 2);
  p.mixed = (u16*)carve((size_t)MT * MC * 2);
  p.sumsq = (float*)carve((size_t)4 * MT * 4);
  p.lse = (float*)carve((size_t)3 * MT * 2 * 4);
  p.rope = (float*)carve((size_t)2056 * 16 * 4);
  p.scr16 = (u16*)carve((size_t)MT * D * 2); p.scrss = (float*)carve((size_t)MT * 4); p.scrf = (float*)carve((size_t)MT * D * 4);
  p.hf = (u16*)carve((size_t)MT * FF * 2);
  p.proj = p.hf;
  p.opart = (float*)((unsigned char*)p.hf + (((size_t)MT * IC * 2 + 255) & ~(size_t)255));
  if (off > ws_size) { fprintf(stderr, "workspace too small: need %zu have %zu\n", off, ws_size); return; }
  (void)hipMemsetAsync(p.bar, 0, XCD_BAR_WORDS * 4, stream);
  int lo = 0, hi = 13;
  void* args[] = {(void*)&p, (void*)&lo, (void*)&hi};
  hipError_t e = hipLaunchCooperativeKernel((const void*)mega, dim3(grid_blocks), dim3(512), args, GEMM_LDS, stream);
  if (e != hipSuccess) fprintf(stderr, "cooperative launch failed: %s (grid %d)\n", hipGetErrorString(e), grid_blocks);
}
```

```cpp
#include <hip/hip_runtime.h>
#include <hip/hip_cooperative_groups.h>
#include <cstdio>
namespace cg = cooperative_groups;

typedef unsigned short u16;
using bf16x8 = __attribute__((ext_vector_type(8))) short;
using f32x4 = __attribute__((ext_vector_type(4))) float;
using f32x16 = __attribute__((ext_vector_type(16))) float;

constexpr int NP = 16384, NS = 256, MT = NP + NS;
constexpr int D = 1024, IC = 2560, MC = 768, FF = 4096;
constexpr float EPS = 1e-6f;
constexpr int C_U = 0, C_Q = 256, C_K = 640, C_V = 1024, C_GB = 1408, C_GC = 1792, C_GH = 2176;
constexpr size_t O_YP = 0;
constexpr size_t O_YS = O_YP + (size_t)NP * D;
constexpr size_t O_POOLP = O_YS + (size_t)NS * D;
constexpr size_t O_CONVP = O_POOLP + 2 * 8 * 15 * 256;
constexpr size_t O_KV128P = O_CONVP + 2 * 8 * 2 * 384;
constexpr size_t O_KV512P = O_KV128P + (size_t)2 * 8 * 128 * 256;
constexpr size_t O_KV2048P = O_KV512P + (size_t)2 * 8 * 512 * 256;
constexpr size_t O_POOLS = O_KV2048P + (size_t)2 * 8 * 2048 * 256;
constexpr size_t O_CONVS = O_POOLS + 2 * 32 * 15 * 256;
constexpr size_t O_KV128S = O_CONVS + 2 * 32 * 2 * 384;
constexpr size_t O_KV512S = O_KV128S + (size_t)2 * 32 * 128 * 256;
constexpr size_t O_KV2048S = O_KV512S + (size_t)2 * 32 * 512 * 256;

struct Params {
  const float *x_prompt, *x_sample, *state_pool, *state_conv, *kv_in[3];
  const float *norm1_g, *w_in, *q_norm_g, *k_norm_g, *pool_w, *pool_scale, *conv_w, *w_out, *norm2_g, *w_up, *w_down;
  float* out;
  u16 *wt_in, *wt_out, *wt_up, *wt_down, *pwT;
  u16 *xg, *proj, *mixed, *hf;
  float *sumsq, *opart, *lse, *rope;
  unsigned* bar;
  u16* scr16; float* scrss; float* scrf;
};

extern __shared__ __attribute__((aligned(16))) unsigned char smem[];
typedef __attribute__((address_space(3))) void* LDSP;

typedef __bf16 bf16x2_t __attribute__((ext_vector_type(2)));
typedef float f32x2_t __attribute__((ext_vector_type(2)));
__device__ __forceinline__ unsigned pack2(float a, float b) { f32x2_t v = {a, b}; bf16x2_t r = __builtin_convertvector(v, bf16x2_t); return __builtin_bit_cast(unsigned, r); }
__device__ __forceinline__ u16 f2bf(float f) { return (u16)(pack2(f, 0.f) & 0xffffu); }
typedef unsigned u32x4_t __attribute__((ext_vector_type(4)));
__device__ __forceinline__ bf16x8 pack8(float a, float b, float c, float d, float e, float f, float g, float h) {
  u32x4_t t = {pack2(a, b), pack2(c, d), pack2(e, f), pack2(g, h)}; return __builtin_bit_cast(bf16x8, t); }
__device__ __forceinline__ float bf2f(u16 h) { return __uint_as_float(((unsigned)h) << 16); }
__device__ __forceinline__ float bfs2f(short h) { return __uint_as_float(((unsigned)(u16)h) << 16); }
__device__ __forceinline__ int opaque_tid(const int wave_s) {
  int l; asm volatile("v_mbcnt_lo_u32_b32 %0, -1, 0\n\tv_mbcnt_hi_u32_b32 %0, -1, %0" : "=v"(l));
  return wave_s * 64 + l;
}
__device__ __forceinline__ int opaque_lane() {
  int l; asm volatile("v_mbcnt_lo_u32_b32 %0, -1, 0\n\tv_mbcnt_hi_u32_b32 %0, -1, %0" : "=v"(l));
  return l;
}
#define XB_TMO      128
#define XB_XCNT(j)  (256  + 64 * (j))
#define XB_XSUB(j)  (1280 + 64 * (j))
#define XB_XGEN(j)  (2304 + 64 * (j))
#define XB_TOP      3328
#define XB_TOPGEN   3392
#define XCD_BAR_WORDS 3456
#define XB_SPIN_CAP (1u << 18)
constexpr int BAR_LDS_OFF = 131072;
__device__ __forceinline__ unsigned xb_ld(unsigned* p)              { return __hip_atomic_load(p, __ATOMIC_RELAXED, __HIP_MEMORY_SCOPE_AGENT); }
__device__ __forceinline__ unsigned xb_add(unsigned* p, unsigned v) { return __hip_atomic_fetch_add(p, v, __ATOMIC_RELAXED, __HIP_MEMORY_SCOPE_AGENT); }
__device__ __forceinline__ unsigned xb_xcc_id() { return (unsigned)__builtin_amdgcn_s_getreg((3 << 11) | 20) & 0xFu; }
#define XB_SPIN(cond, bar) do { unsigned _sp = 0; while (cond) { __builtin_amdgcn_s_sleep(1); \
    if ((++_sp & 255u) == 0u) { if (xb_ld(&(bar)[XB_TMO])) break; if (_sp > XB_SPIN_CAP) { atomicAdd(&(bar)[XB_TMO], 1u); break; } } } } while (0)
__device__ __forceinline__ void xcd_barrier_complete(unsigned* bar, unsigned x, unsigned& nloc, unsigned& nx) {
  const unsigned G = gridDim.x;
  unsigned sum, cnt, mine, sp = 0u;
  for (;;) {
    sum = 0u; cnt = 0u; mine = 0u;
#pragma unroll
    for (unsigned j = 0; j < 16; ++j) { const unsigned c = xb_ld(&bar[XB_XCNT(j)]); sum += c; cnt += (c > 0u) ? 1u : 0u; mine = (j == x) ? c : mine; }
    if (sum == G) break;
    __builtin_amdgcn_s_sleep(1);
    if ((++sp & 255u) == 0u) { if (xb_ld(&bar[XB_TMO])) break; if (sp > XB_SPIN_CAP) { atomicAdd(&bar[XB_TMO], 1u); break; } }
  }
  nloc = mine > 0u ? mine : 1u; nx = cnt > 0u ? cnt : 1u;
}
__device__ __forceinline__ void grid_bar(unsigned* bar, const int wave_s) {
  asm volatile("s_waitcnt vmcnt(0)" ::: "memory");
  __syncthreads();
  if (opaque_tid(wave_s) == 0) {
    volatile __attribute__((address_space(3))) unsigned* st = (volatile __attribute__((address_space(3))) unsigned*)(smem + BAR_LDS_OFF);
    const unsigned x = xb_xcc_id();
    __builtin_amdgcn_s_waitcnt(0);
    unsigned nloc = st[0], nx = st[1];
    if (nloc == 0u) { xcd_barrier_complete(bar, x, nloc, nx); st[0] = nloc; st[1] = nx; }
    const unsigned old = xb_add(&bar[XB_XSUB(x)], 1u);
    const unsigned gen = old / nloc;
    if (old + 1u == (gen + 1u) * nloc) {
      __builtin_amdgcn_fence(__ATOMIC_RELEASE, "agent");
      asm volatile("s_waitcnt vmcnt(0)" ::: "memory");
      const unsigned og = xb_add(&bar[XB_TOP], 1u);
      const unsigned tg = og / nx;
      if (og + 1u == (tg + 1u) * nx) xb_add(&bar[XB_TOPGEN], 1u);
      else XB_SPIN(xb_ld(&bar[XB_TOPGEN]) == tg, bar);
      __builtin_amdgcn_fence(__ATOMIC_ACQUIRE, "agent");
      xb_add(&bar[XB_XGEN(x)], 1u);
      asm volatile("s_waitcnt vmcnt(0)" ::: "memory");
    } else {
      XB_SPIN(xb_ld(&bar[XB_XGEN(x)]) == gen, bar);
      __builtin_amdgcn_fence(__ATOMIC_ACQUIRE, "agent");
      asm volatile("s_waitcnt vmcnt(0)" ::: "memory");
    }
  }
  __syncthreads();
}
__device__ __forceinline__ float wave_sum(float v) { for (int o = 32; o; o >>= 1) v += __shfl_xor(v, o); return v; }
__device__ __forceinline__ float wave_max(float v) { for (int o = 32; o; o >>= 1) v = fmaxf(v, __shfl_xor(v, o)); return v; }

constexpr int BM = 256, BK = 64, HALF = 128, NXCD = 8, WGM = 8, HT = HALF * BK;
constexpr int GEMM_LDS = 8 * HT * 2 + 16;

__device__ __forceinline__ int lds_byte(int r, int c) {
  int st = (r >> 4) * 2 + (c >> 5), rr = r & 15, cc = c & 31, ob = rr * 64 + cc * 2;
  return st * 1024 + (ob ^ (((ob >> 9) & 1) << 5));
}
__device__ __forceinline__ int perm32(int rho) { const int n = rho >> 4, i = rho & 15; return 8 * (i >> 2) + 4 * n + (i & 3); }
__device__ __forceinline__ void stage_rc(int b, int& R, int& C) {
  int st = b / 1024, sb = b % 1024, swz = sb ^ (((sb >> 9) & 1) << 5);
  R = (st >> 1) * 16 + swz / 64; C = (st & 1) * 32 + (swz % 64) / 2;
}

struct GemmEpi {
  const float* sumsq_in;
  u16* out_bf; int ldo;
  u16* xh;
  u16* xh_out;
  float* out_f;
  float* sumsq_out;
};

template <int MODE, bool ADD_RESID>
__device__ __forceinline__ void epi4(const GemmEpi& e, const f32x4 a, const float rs, const size_t grow, const int col0, float& ssq) {
  if (MODE == 1 || MODE == 3) {
    float v0 = a[0] * rs, v1 = a[1] * rs, v2 = a[2] * rs, v3 = a[3] * rs;
    if (MODE == 3) { v0 = fmaxf(v0, 0.f); v1 = fmaxf(v1, 0.f); v2 = fmaxf(v2, 0.f); v3 = fmaxf(v3, 0.f); v0 *= v0; v1 *= v1; v2 *= v2; v3 *= v3; }
    uint2 o; o.x = pack2(v0, v1); o.y = pack2(v2, v3);
    *(uint2*)(e.out_bf + grow * e.ldo + col0) = o;
  } else {
    float4 x; x.x = a[0]; x.y = a[1]; x.z = a[2]; x.w = a[3];
    if (ADD_RESID) {
      const uint2 r = *(const uint2*)(e.xh + grow * D + col0);
      x.x += __uint_as_float(r.x << 16); x.y += __uint_as_float(r.x & 0xffff0000u); x.z += __uint_as_float(r.y << 16); x.w += __uint_as_float(r.y & 0xffff0000u);
    }
    if (e.out_f) *(float4*)(e.out_f + grow * D + col0) = x;
    else { uint2 ob; ob.x = pack2(x.x, x.y); ob.y = pack2(x.z, x.w); *(uint2*)(e.xh_out + grow * D + col0) = ob; }
    ssq += x.x * x.x + x.y * x.y + x.z * x.z + x.w * x.w;
  }
}

template <int MODE>
__device__ __forceinline__ void epi8(const GemmEpi& e, const f32x4 a0, const f32x4 a1, const float rs, const size_t grow, const int col8, float& ssq) {
  float v[8] = {a0[0], a0[1], a0[2], a0[3], a1[0], a1[1], a1[2], a1[3]};
  if (MODE == 1 || MODE == 3) {
#pragma unroll
    for (int i = 0; i < 8; ++i) { v[i] *= rs; if (MODE == 3) { v[i] = fmaxf(v[i], 0.f); v[i] *= v[i]; } }
    uint4 o; o.x = pack2(v[0], v[1]); o.y = pack2(v[2], v[3]); o.z = pack2(v[4], v[5]); o.w = pack2(v[6], v[7]);
    *(uint4*)(e.out_bf + grow * e.ldo + col8) = o;
  } else {
    if (e.out_f) { *(float4*)(e.out_f + grow * D + col8) = make_float4(v[0], v[1], v[2], v[3]); *(float4*)(e.out_f + grow * D + col8 + 4) = make_float4(v[4], v[5], v[6], v[7]); }
    else { uint4 o; o.x = pack2(v[0], v[1]); o.y = pack2(v[2], v[3]); o.z = pack2(v[4], v[5]); o.w = pack2(v[6], v[7]); *(uint4*)(e.xh_out + grow * D + col8) = o; }
#pragma unroll
    for (int i = 0; i < 8; ++i) ssq += v[i] * v[i];
  }
}

template <int MODE>
__device__ __forceinline__ void gemm_phase(const u16* __restrict__ A, const u16* __restrict__ Bt, const int M, const int N, const int K, const GemmEpi e, const int wave_s, const int dry = 0) {
  u16* shm = (u16*)smem;
#define SA(b, h) (shm + ((b) * 2 + (h)) * HT)
#define SB(b, h) (shm + (4 + (b) * 2 + (h)) * HT)
#define STAGE_(P, RS, br, kt, o0, o1) do { const unsigned _so = (unsigned)(((br) * K + (kt) * BK) * 2); \
    __builtin_amdgcn_raw_ptr_buffer_load_lds(RS, (LDSP)((char*)(P) + tid0 * 16), 16, o0, _so, 0, 0); \
    __builtin_amdgcn_raw_ptr_buffer_load_lds(RS, (LDSP)((char*)(P) + tid0 * 16 + 8192), 16, o1, _so, 0, 0); } while (0)
#define STAGE(P, RS, br, kt) STAGE_(P, RS, br, kt, toff0, toff1)
#define STAGEB(P, RS, br, kt) STAGE_(P, RS, br, kt, toffb0, toffb1)
#define LDA(dst, b, h) for (int m = 0; m < 4; ++m) for (int k = 0; k < 2; ++k) \
    dst[m][k] = *reinterpret_cast<const bf16x8*>((char*)SA(b, h) + lds_byte(wr * 64 + m * 16 + fr, k * 32 + fq * 8))
#define LDB(dst, b, h) for (int n = 0; n < 2; ++n) for (int k = 0; k < 2; ++k) \
    dst[n][k] = *reinterpret_cast<const bf16x8*>((char*)SB(b, h) + lds_byte(wc * 32 + n * 16 + fr, k * 32 + fq * 8))
#define MMA(ai, bj, At, Bt_) do { __builtin_amdgcn_s_setprio(1); \
    for (int m = 0; m < 4; ++m) for (int n = 0; n < 2; ++n) for (int k = 0; k < 2; ++k) \
      acc[ai][bj][m][n] = __builtin_amdgcn_mfma_f32_16x16x32_bf16(Bt_[n][k], At[m][k], acc[ai][bj][m][n], 0, 0, 0); \
    __builtin_amdgcn_s_setprio(0); } while (0)
#define WAIT_V(n) asm volatile("s_waitcnt vmcnt(" #n ")" ::: "memory")
#define WAIT_L(n) asm volatile("s_waitcnt lgkmcnt(" #n ")" ::: "memory")
#define BAR __builtin_amdgcn_s_barrier()
#define SCHED __builtin_amdgcn_sched_barrier(0)
#define DECODE(tt_, brow_, bcol_) do { int wgid = (tt_); \
    { int q = nwg / NXCD, r = nwg % NXCD, xcd = wgid % NXCD, off = wgid / NXCD; \
      wgid = (xcd < r ? xcd * (q + 1) : r * (q + 1) + (xcd - r) * q) + off; } \
    int nig = WGM * nN, gid = wgid / nig, fm = gid * WGM, gsz = min(nM - fm, WGM); \
    brow_ = (fm + ((wgid % nig) % gsz)) * BM; bcol_ = ((wgid % nig) / gsz) * BM; } while (0)
#define STAGE7(brow_, bcol_) do { \
    STAGEB(SB(0, 0), rsB, bcol_, 0); STAGE(SA(0, 0), rsA, brow_, 0); \
    STAGEB(SB(0, 1), rsB, bcol_ + HALF, 0); STAGE(SA(0, 1), rsA, brow_ + HALF, 0); \
    STAGEB(SB(1, 0), rsB, bcol_, 1); STAGE(SA(1, 0), rsA, brow_, 1); STAGEB(SB(1, 1), rsB, bcol_ + HALF, 1); } while (0)

  const int nM = M / BM, nN = N / BM, nwg = nM * nN;
  const int nt = K / BK;
  unsigned toff0, toff1;
  const int tid0 = opaque_tid(wave_s);
  const int wr = (tid0 >> 6) >> 2, wc = (tid0 >> 6) & 3, fr = tid0 & 15, fq = (tid0 & 63) >> 4;
  unsigned toffb0, toffb1;
  { int r_, c_; stage_rc(tid0 * 16, r_, c_); toff0 = (unsigned)(r_ * K + c_) * 2u; toffb0 = (unsigned)(((r_ & ~31) | perm32(r_ & 31)) * K + c_) * 2u;
    stage_rc(tid0 * 16 + 8192, r_, c_); toff1 = (unsigned)(r_ * K + c_) * 2u; toffb1 = (unsigned)(((r_ & ~31) | perm32(r_ & 31)) * K + c_) * 2u; }
  const __amdgpu_buffer_rsrc_t rsA = __builtin_amdgcn_make_buffer_rsrc((void*)A, 0, -1, 0x00020000);
  const __amdgpu_buffer_rsrc_t rsB = __builtin_amdgcn_make_buffer_rsrc((void*)Bt, 0, -1, 0x00020000);
  int tt = blockIdx.x;
  int brow = 0, bcol = 0;
  if (tt < nwg) { DECODE(tt, brow, bcol); STAGE7(brow, bcol); WAIT_V(0); }
  f32x4 acc[2][2][4][2];
#define ACC_INIT(brow_, bcol_) do { \
    if (MODE == 2) { \
      const int t2 = opaque_tid(wave_s); const int wr_ = (t2 >> 6) >> 2, wc_ = (t2 >> 6) & 3, fr_ = t2 & 15, fq_ = (t2 & 63) >> 4; \
      const u16* rp_ = e.xh + (size_t)(brow_ + wr_ * 64 + fr_) * D + bcol_ + wc_ * 32 + fq_ * 8; \
      _Pragma("unroll") for (int ai = 0; ai < 2; ++ai) _Pragma("unroll") for (int bj = 0; bj < 2; ++bj) \
      _Pragma("unroll") for (int m = 0; m < 4; ++m) { \
        const uint4 x0 = *(const uint4*)(rp_ + (size_t)(ai * HALF + m * 16) * D + bj * HALF); \
        acc[ai][bj][m][0][0] = __uint_as_float(x0.x << 16); acc[ai][bj][m][0][1] = __uint_as_float(x0.x & 0xffff0000u); \
        acc[ai][bj][m][0][2] = __uint_as_float(x0.y << 16); acc[ai][bj][m][0][3] = __uint_as_float(x0.y & 0xffff0000u); \
        acc[ai][bj][m][1][0] = __uint_as_float(x0.z << 16); acc[ai][bj][m][1][1] = __uint_as_float(x0.z & 0xffff0000u); \
        acc[ai][bj][m][1][2] = __uint_as_float(x0.w << 16); acc[ai][bj][m][1][3] = __uint_as_float(x0.w & 0xffff0000u); } \
    } else { \
      _Pragma("unroll") for (int ai = 0; ai < 2; ++ai) _Pragma("unroll") for (int bj = 0; bj < 2; ++bj) \
      _Pragma("unroll") for (int m = 0; m < 4; ++m) _Pragma("unroll") for (int n = 0; n < 2; ++n) \
        acc[ai][bj][m][n] = (f32x4){0.f, 0.f, 0.f, 0.f}; \
    } } while (0)
  if (tt < nwg) ACC_INIT(brow, bcol);
  while (tt < nwg) {
    bf16x8 At[4][2], B0[2][2], B1[2][2];
    if (wr == 1) BAR;
    BAR;
    for (int t = 0; t < nt - 2; t += 2) {
      LDB(B0, 0, 0); SCHED; LDA(At, 0, 0); STAGE(SA(1, 1), rsA, brow + HALF, t + 1);
      WAIT_L(8); BAR; WAIT_L(0); MMA(0, 0, At, B0); BAR; SCHED;
      LDB(B1, 0, 1); STAGEB(SB(0, 0), rsB, bcol, t + 2);
      BAR; WAIT_L(0); MMA(0, 1, At, B1); BAR;
      LDA(At, 0, 1); STAGE(SA(0, 0), rsA, brow, t + 2);
      BAR; WAIT_L(0); MMA(1, 0, At, B0); BAR; SCHED;
      STAGEB(SB(0, 1), rsB, bcol + HALF, t + 2);
      WAIT_V(6); BAR; MMA(1, 1, At, B1); BAR;
      LDB(B0, 1, 0); SCHED; LDA(At, 1, 0); STAGE(SA(0, 1), rsA, brow + HALF, t + 2);
      WAIT_L(8); BAR; WAIT_L(0); MMA(0, 0, At, B0); BAR; SCHED;
      LDB(B1, 1, 1); STAGEB(SB(1, 0), rsB, bcol, t + 3);
      BAR; WAIT_L(0); MMA(0, 1, At, B1); BAR;
      LDA(At, 1, 1); STAGE(SA(1, 0), rsA, brow, t + 3);
      BAR; WAIT_L(0); MMA(1, 0, At, B0); BAR; SCHED;
      STAGEB(SB(1, 1), rsB, bcol + HALF, t + 3);
      WAIT_V(6); BAR; MMA(1, 1, At, B1); BAR;
    }
    { LDB(B0, 0, 0); LDA(At, 0, 0); STAGE(SA(1, 1), rsA, brow + HALF, nt - 1);
      BAR; WAIT_L(0); MMA(0, 0, At, B0); BAR;
      LDB(B1, 0, 1); BAR; WAIT_L(0); MMA(0, 1, At, B1); BAR;
      LDA(At, 0, 1); WAIT_V(4); BAR; WAIT_L(0); MMA(1, 0, At, B0); MMA(1, 1, At, B1); BAR; }
    { LDB(B0, 1, 0); LDA(At, 1, 0); WAIT_V(2); BAR; WAIT_L(0); MMA(0, 0, At, B0); BAR;
      LDB(B1, 1, 1); WAIT_V(0); BAR; WAIT_L(0); MMA(0, 1, At, B1); BAR;
      LDA(At, 1, 1); BAR; WAIT_L(0); MMA(1, 0, At, B0); MMA(1, 1, At, B1); BAR; }
    if (wr == 0) BAR;
    const int erow = brow, ecol = bcol;
    tt += gridDim.x;
    if (tt < nwg) { DECODE(tt, brow, bcol); STAGE7(brow, bcol); }
    SCHED;
    if (!dry) {
      const int tid1 = opaque_tid(wave_s);
      const int wr = (tid1 >> 6) >> 2, wc = (tid1 >> 6) & 3, fr = tid1 & 15, fq = (tid1 & 63) >> 4;
      float rsv[2][4];
#pragma unroll
      for (int ai = 0; ai < 2; ++ai)
#pragma unroll
        for (int m = 0; m < 4; ++m) {
          rsv[ai][m] = 0.f;
          if (MODE == 1 || MODE == 3) rsv[ai][m] = e.sumsq_in[(size_t)erow + ai * HALF + wr * 64 + m * 16 + fr];
        }
#pragma unroll
      for (int ai = 0; ai < 2; ++ai)
#pragma unroll
        for (int m = 0; m < 4; ++m) {
          const int lrow = ai * HALF + wr * 64 + m * 16 + fr;
          const size_t grow = (size_t)erow + lrow;
          float rs = 0.f, ssq = 0.f;
          if (MODE == 1 || MODE == 3) rs = rsqrtf(rsv[ai][m] * (1.0f / 1024.0f) + EPS);
#pragma unroll
          for (int bj = 0; bj < 2; ++bj)
            epi8<MODE>(e, acc[ai][bj][m][0], acc[ai][bj][m][1], rs, grow, ecol + bj * HALF + wc * 32 + fq * 8, ssq);
          if (MODE == 2 && e.sumsq_out) {
            ssq += __shfl_xor(ssq, 16); ssq += __shfl_xor(ssq, 32);
            if (fq == 0) atomicAdd(e.sumsq_out + grow, ssq);
          }
          SCHED;
        }
    }
    if (tt < nwg) ACC_INIT(brow, bcol);
    if (dry) WAIT_V(0); else WAIT_V(16);
  }
  WAIT_V(0);
#undef SA
#undef SB
#undef STAGE
#undef STAGEB
#undef STAGE_
#undef LDA
#undef LDB
#undef MMA
}

#define MFMA32(a, b, c) __builtin_amdgcn_mfma_f32_32x32x16_bf16((a), (b), (c), 0, 0, 0)

template <int MODE>
__device__ __forceinline__ void sample_gemm(const u16* __restrict__ A, const u16* __restrict__ Bt, const int N, const int K, const GemmEpi e, const int wave_s, const int b0, const int nb) {
  const int bi = (int)blockIdx.x - b0;
  if (bi < 0 || bi >= nb) return;
  const int tid = opaque_tid(wave_s);
  const int lane = tid & 63, wid = tid >> 6;
  const int i = lane & 31, h = lane >> 5;
  const int ntask = 8 * (N / 32);
  const int ks = K / 8;
  float* red = (float*)smem;
  for (int id = bi; id < ntask; id += nb) {
    const int r0 = (id & 7) * 32, c0 = (id >> 3) * 32;
    const u16* ap = A + (size_t)(NP + r0 + i) * K + wid * ks + 8 * h;
    const u16* bp = Bt + (size_t)(c0 + i) * K + wid * ks + 8 * h;
    f32x16 acc;
#pragma unroll
    for (int q = 0; q < 16; ++q) acc[q] = 0.f;
#pragma unroll 16
    for (int k = 0; k < ks; k += 16) {
      const bf16x8 a = *(const bf16x8*)(ap + k);
      const bf16x8 b = *(const bf16x8*)(bp + k);
      acc = MFMA32(b, a, acc);
    }
#pragma unroll
    for (int q = 0; q < 4; ++q)
      *(float4*)(red + (wid * 32 + i) * 36 + 8 * q + 4 * h) = make_float4(acc[4 * q], acc[4 * q + 1], acc[4 * q + 2], acc[4 * q + 3]);
    __syncthreads();
    if (tid < 256) {
      const int row = tid >> 3, c4 = (tid & 7) * 4;
      f32x4 s4; s4[0] = 0.f; s4[1] = 0.f; s4[2] = 0.f; s4[3] = 0.f;
#pragma unroll
      for (int w = 0; w < 8; ++w) {
        const float4 v = *(const float4*)(red + (w * 32 + row) * 36 + c4);
        s4[0] += v.x; s4[1] += v.y; s4[2] += v.z; s4[3] += v.w;
      }
      const int srow = r0 + row, col0 = c0 + c4;
      const size_t grow = (size_t)NP + srow;
      float rs = 0.f, ssq = 0.f;
      if (MODE == 1 || MODE == 3) rs = rsqrtf(e.sumsq_in[grow] * (1.0f / 1024.0f) + EPS);
      epi4<MODE, true>(e, s4, rs, grow, col0, ssq);
      if (MODE == 2 && e.sumsq_out) {
        ssq += __shfl_xor(ssq, 1); ssq += __shfl_xor(ssq, 2); ssq += __shfl_xor(ssq, 4);
        if ((tid & 7) == 0) atomicAdd(e.sumsq_out + grow, ssq);
      }
    }
    __syncthreads();
  }
}

template <int MODE>
__device__ __forceinline__ void sample_gemm64(const u16* __restrict__ A, const u16* __restrict__ Bt, const int N, const int K, const GemmEpi e, const int wave_s, const bool reverse) {
  const int tid = opaque_tid(wave_s);
  const int lane = tid & 63, wid = tid >> 6;
  const int i = lane & 31, h = lane >> 5;
  const int ri = wid & 1, ci = (wid >> 1) & 1, kh = wid >> 2;
  const int ntask = 4 * (N / 64);
  const int kspan = K / 2;
  float* red = (float*)smem;
  const int G = gridDim.x;
  for (int id = reverse ? G - 1 - (int)blockIdx.x : (int)blockIdx.x; id < ntask; id += G) {
    const int r0 = (id & 3) * 64 + ri * 32, c0 = (id >> 2) * 64 + ci * 32;
    const u16* ap = A + (size_t)(NP + r0 + i) * K + kh * kspan + 8 * h;
    const u16* bp = Bt + (size_t)(c0 + i) * K + kh * kspan + 8 * h;
    f32x16 acc;
#pragma unroll
    for (int q = 0; q < 16; ++q) acc[q] = 0.f;
#pragma unroll 16
    for (int k = 0; k < kspan; k += 16) {
      const bf16x8 a = *(const bf16x8*)(ap + k);
      const bf16x8 b = *(const bf16x8*)(bp + k);
      acc = MFMA32(b, a, acc);
    }
    float* rb = red + ((wid & 3) * 32 + i) * 36 + 4 * h;
    if (kh == 1) {
#pragma unroll
      for (int q = 0; q < 4; ++q) *(float4*)(rb + 8 * q) = make_float4(acc[4 * q], acc[4 * q + 1], acc[4 * q + 2], acc[4 * q + 3]);
    }
    __syncthreads();
    if (kh == 0) {
      const size_t grow = (size_t)NP + r0 + i;
      const float rs = rsqrtf(e.sumsq_in[grow] * (1.0f / 1024.0f) + EPS);
      float ssq = 0.f;
#pragma unroll
      for (int q = 0; q < 4; ++q) {
        const float4 o = *(const float4*)(rb + 8 * q);
        f32x4 a4; a4[0] = acc[4 * q] + o.x; a4[1] = acc[4 * q + 1] + o.y; a4[2] = acc[4 * q + 2] + o.z; a4[3] = acc[4 * q + 3] + o.w;
        epi4<MODE, false>(e, a4, rs, grow, c0 + 8 * q + 4 * h, ssq);
      }
    }
    __syncthreads();
  }
}

__device__ __forceinline__ void kv_shift_copy(const Params& p, const int l, const int b0, const int nb, const int tid) {
  const int bi = (int)blockIdx.x - b0;
  if (bi < 0 || bi >= nb) return;
  const size_t gt = (size_t)bi * 512 + tid, ntd = (size_t)nb * 512;
#pragma unroll
  for (int g = 0; g < 3; ++g) {
    const int W = 128 << (2 * g);
    const size_t n4 = (size_t)32 * W * 64;
    const size_t oo = (g == 0) ? O_KV128S : (g == 1) ? O_KV512S : O_KV2048S;
    const f32x4* src = (const f32x4*)p.kv_in[g] + (size_t)l * n4;
    f32x4* dst = (f32x4*)(p.out + oo) + (size_t)l * n4;
    const unsigned per = (unsigned)W * 64u, lim = (unsigned)(W - 8) * 64u;
    for (size_t i0 = gt; i0 < n4; i0 += ntd * 8) {
      f32x4 v[8];
#pragma unroll
      for (int k = 0; k < 8; ++k) {
        const size_t i = i0 + (size_t)k * ntd;
        v[k] = (f32x4){0.f, 0.f, 0.f, 0.f};
        if (i < n4 && ((unsigned)i % per) < lim) v[k] = __builtin_nontemporal_load(src + i + 512);
      }
#pragma unroll
      for (int k = 0; k < 8; ++k) {
        const size_t i = i0 + (size_t)k * ntd;
        if (i < n4 && ((unsigned)i % per) < lim) __builtin_nontemporal_store(v[k], dst + i);
      }
    }
  }
}

__device__ __forceinline__ void tr_tile(const float* __restrict__ src, u16* __restrict__ dst, int K, int N, int k0, int n0, const int tid, const float* __restrict__ gain) {
  float* lt = (float*)smem;
  { const int kk = tid >> 4, n4 = tid & 15;
#pragma unroll
    for (int i = 0; i < 2; ++i) {
      const int k = kk + i * 32;
      const float4 v = *(const float4*)(src + (size_t)(k0 + k) * N + n0 + n4 * 4);
      float* d = lt + k * 65 + n4 * 4;
      d[0] = v.x; d[1] = v.y; d[2] = v.z; d[3] = v.w;
    } }
  __syncthreads();
  { const int n = tid >> 3, k8 = tid & 7;
    float f[8];
#pragma unroll
    for (int i = 0; i < 8; ++i) f[i] = lt[(k8 * 8 + i) * 65 + n] * (gain ? gain[k0 + k8 * 8 + i] : 1.0f);
    uint4 o; o.x = pack2(f[0], f[1]); o.y = pack2(f[2], f[3]); o.z = pack2(f[4], f[5]); o.w = pack2(f[6], f[7]);
    *(uint4*)(dst + (size_t)(n0 + n) * K + k0 + k8 * 8) = o; }
  __syncthreads();
}

__device__ __forceinline__ void phase0(const Params& p, const int wave_s) {
  const int tid = opaque_tid(wave_s), lane = tid & 63, wid = tid >> 6;
  const int gw = blockIdx.x * 8 + wid, nw = gridDim.x * 8;
  const size_t gt = (size_t)blockIdx.x * 512 + tid, ntd = (size_t)gridDim.x * 512;
  for (int row0 = gw; row0 < MT; row0 += 2 * nw) {
    float4 v[2][4];
#pragma unroll
    for (int u = 0; u < 2; ++u) {
      const int row = min(row0 + u * nw, MT - 1);
      const float4* xr = (const float4*)(row < NP ? p.x_prompt + (size_t)row * D : p.x_sample + (size_t)(row - NP) * D);
#pragma unroll
      for (int i = 0; i < 4; ++i) v[u][i] = xr[lane + 64 * i];
    }
#pragma unroll
    for (int u = 0; u < 2; ++u) {
      const int row = row0 + u * nw;
      if (row < MT) {
        float ss = 0.f;
#pragma unroll
        for (int i = 0; i < 4; ++i) {
          const float4 x = v[u][i];
          ss += x.x * x.x + x.y * x.y + x.z * x.z + x.w * x.w;
          uint2 o; o.x = pack2(x.x, x.y); o.y = pack2(x.z, x.w);
          *(uint2*)(p.xg + (size_t)row * D + (lane + 64 * i) * 4) = o;
        }
        ss = wave_sum(ss);
        if (lane == 0) p.sumsq[row] = ss;
      }
    }
  }
  for (size_t i = gt; i < (size_t)3 * MT; i += ntd) p.sumsq[MT + i] = 0.f;
  for (size_t i = gt; i < (size_t)2056 * 8; i += ntd) {
    const int pi = (int)(i >> 3), fi = (int)(i & 7);
    const int pos = pi < 2048 ? pi : 8192 + (pi - 2048);
    float inv;
    switch (fi) { case 0: inv = 1.0f; break; case 1: inv = 0.1939227432012558f; break; case 2: inv = 0.03760603070259094f; break;
      case 3: inv = 0.007292664609849453f; break; case 4: inv = 0.0014142135623842478f; break; case 5: inv = 0.00027424818836152554f; break;
      case 6: inv = 5.318296098266728e-05f; break; default: inv = 1.0313386155758053e-05f; break; }
    const float ang = (float)pos * inv;
    p.rope[pi * 16 + fi] = cosf(ang);
    p.rope[pi * 16 + 8 + fi] = sinf(ang);
  }
  {
    float* lt = (float*)smem;
    constexpr int QL = (640 + 192 + 1024 + 1024) / 4;
    for (int t = blockIdx.x; t < 2 * QL; t += gridDim.x) {
      const int l = t / QL; int r = t % QL;
      const float* src; u16* dst; int K, N; const float* gain = nullptr;
      if (r < 160) { src = p.w_in + (size_t)l * D * IC; dst = p.wt_in + (size_t)l * IC * D; K = D; N = IC; gain = p.norm1_g + l * D; }
      else if (r < 208) { r -= 160; src = p.w_out + (size_t)l * MC * D; dst = p.wt_out + (size_t)l * D * MC; K = MC; N = D; }
      else if (r < 464) { r -= 208; src = p.w_up + (size_t)l * D * FF; dst = p.wt_up + (size_t)l * FF * D; K = D; N = FF; gain = p.norm2_g + l * D; }
      else { r -= 464; src = p.w_down + (size_t)l * FF * D; dst = p.wt_down + (size_t)l * D * FF; K = FF; N = D; }
      const int nq = N / 256;
      const int k0 = (r / nq) * 64, n0 = (r % nq) * 256;
      { const int kk = tid >> 6, n4 = tid & 63;
        float4 v[8];
#pragma unroll
        for (int i = 0; i < 8; ++i) v[i] = *(const float4*)(src + (size_t)(k0 + kk + 8 * i) * N + n0 + n4 * 4);
#pragma unroll
        for (int i = 0; i < 8; ++i) {
          const float gg = gain ? gain[k0 + kk + 8 * i] : 1.0f;
          *(float4*)(lt + (kk + 8 * i) * 260 + n4 * 4) = make_float4(v[i].x * gg, v[i].y * gg, v[i].z * gg, v[i].w * gg);
        } }
      __syncthreads();
      { const int n = tid >> 1, kh = (tid & 1) * 32;
        u16* dp = dst + (size_t)(n0 + n) * K + k0 + kh;
#pragma unroll
        for (int c = 0; c < 4; ++c) {
          float f[8];
#pragma unroll
          for (int i = 0; i < 8; ++i) f[i] = lt[(kh + c * 8 + i) * 260 + n];
          uint4 o; o.x = pack2(f[0], f[1]); o.y = pack2(f[2], f[3]); o.z = pack2(f[4], f[5]); o.w = pack2(f[6], f[7]);
          *(uint4*)(dp + c * 8) = o;
        } }
      __syncthreads();
    }
    for (int t = blockIdx.x; t < 8; t += gridDim.x)
      tr_tile(p.pool_w + (size_t)t * 4096, p.pwT + (size_t)t * 4096, 64, 64, 0, 0, tid, nullptr);
  }
}


__device__ __forceinline__ void load_qk(const u16* __restrict__ rowp, const float* __restrict__ ropep, const float* __restrict__ gain,
                                        const float scale, bf16x8 out[4], const int h) {
  float f[4][8];
  float ss = 0.f;
#pragma unroll
  for (int s = 0; s < 4; ++s) {
    const bf16x8 raw = *(const bf16x8*)(rowp + 16 * s + 8 * h);
#pragma unroll
    for (int j = 0; j < 8; ++j) { f[s][j] = bfs2f(raw[j]); ss += f[s][j] * f[s][j]; }
  }
  ss += __shfl_xor(ss, 32);
  const float inv = rsqrtf(ss * (1.0f / 64.0f) + EPS);
#pragma unroll
  for (int s = 0; s < 4; ++s) {
    const float4 g0 = *(const float4*)(gain + 16 * s + 8 * h), g1 = *(const float4*)(gain + 16 * s + 8 * h + 4);
    f[s][0] *= inv * g0.x; f[s][1] *= inv * g0.y; f[s][2] *= inv * g0.z; f[s][3] *= inv * g0.w;
    f[s][4] *= inv * g1.x; f[s][5] *= inv * g1.y; f[s][6] *= inv * g1.z; f[s][7] *= inv * g1.w;
  }
  {
    const float4 c0 = *(const float4*)(ropep), c1 = *(const float4*)(ropep + 4), s0 = *(const float4*)(ropep + 8), s1 = *(const float4*)(ropep + 12);
    const float cs[8] = {c0.x, c0.y, c0.z, c0.w, c1.x, c1.y, c1.z, c1.w};
    const float sn[8] = {s0.x, s0.y, s0.z, s0.w, s1.x, s1.y, s1.z, s1.w};
#pragma unroll
    for (int j = 0; j < 8; ++j) {
      const float other = __shfl_xor(f[0][j], 32);
      f[0][j] = (h == 0) ? (f[0][j] * cs[j] - other * sn[j]) : (f[0][j] * cs[j] + other * sn[j]);
    }
  }
#pragma unroll
  for (int s = 0; s < 4; ++s)
    out[s] = pack8(f[s][0] * scale, f[s][1] * scale, f[s][2] * scale, f[s][3] * scale, f[s][4] * scale, f[s][5] * scale, f[s][6] * scale, f[s][7] * scale);
}

template <bool SAMPLE>
__device__ __forceinline__ void attn_task(const Params& p, const int layer, const int task, const int wid) {
  const int lane = opaque_lane();
  int g, hslot, b, r, tile, nq;
  if (!SAMPLE) {
    const int c = task & 63; int tmp = task >> 6; g = tmp % 3; tmp /= 3; hslot = tmp & 1; b = tmp >> 1;
    const int tpc = 64 >> (2 * g);
    r = c / tpc; tile = c % tpc; nq = 32;
  } else {
    b = task / 26; const int rem = task % 26; hslot = rem / 13; const int c = rem % 13;
    if (c == 0) { g = 0; r = 0; nq = 8; } else if (c < 5) { g = 1; r = c - 1; nq = 2; } else { g = 2; r = c - 5; nq = 1; }
    tile = 4;
  }
  const int dl = 1 << (2 * g);
  const int W = 128 << (2 * g);
  const int m0 = tile * 32;
  const int head = 2 * g + hslot;
  const u16* projb = SAMPLE ? p.proj + (size_t)(NP + b * 8) * IC : p.proj + (size_t)b * 2048 * IC;
  const int ropeb = SAMPLE ? 2048 : 0;
  const float* cache = SAMPLE ? ((g == 0) ? p.kv_in[0] : (g == 1) ? p.kv_in[1] : p.kv_in[2]) + (size_t)(layer * 32 + b) * W * 256 + hslot * 64 : nullptr;
  const int qi = lane & 31, h = lane >> 5;
  int tq;
  if (SAMPLE) tq = r + dl * (qi < nq ? qi : 0); else tq = (m0 + qi) * dl + r;
  bf16x8 qf[4];
  load_qk(projb + (size_t)tq * IC + C_Q + head * 64, p.rope + (ropeb + tq) * 16, p.q_norm_g + layer * 64, 0.125f, qf, h);
  const int kt_lo = SAMPLE ? 0 : max(0, 4 - tile);
  f32x16 sacc[5];
#pragma unroll
  for (int kt = 0; kt < 5; ++kt) {
#pragma unroll
    for (int i = 0; i < 16; ++i) sacc[kt][i] = 0.f;
    if (kt >= kt_lo) {
      bf16x8 kf[4];
      if (SAMPLE && kt < 4) {
        const float* kp = cache + (size_t)(r + dl * (32 * kt + qi)) * 256 + 8 * h;
#pragma unroll
        for (int s = 0; s < 4; ++s) {
          const float4 x0 = *(const float4*)(kp + 16 * s), x1 = *(const float4*)(kp + 16 * s + 4);
          kf[s] = pack8(x0.x, x0.y, x0.z, x0.w, x1.x, x1.y, x1.z, x1.w);
        }
      } else {
        int tk;
        if (SAMPLE) tk = r + dl * (qi < nq ? qi : 0); else tk = (m0 - 128 + 32 * kt + qi) * dl + r;
        load_qk(projb + (size_t)tk * IC + C_K + head * 64, p.rope + (ropeb + tk) * 16, p.k_norm_g + layer * 64, 1.0f, kf, h);
      }
#pragma unroll
      for (int s = 0; s < 4; ++s) sacc[kt] = MFMA32(kf[s], qf[s], sacc[kt]);
    }
  }
  float mx = -1e30f;
#pragma unroll
  for (int kt = 0; kt < 5; ++kt)
#pragma unroll
    for (int rr = 0; rr < 16; ++rr) {
      const int keyrow = (rr & 3) + 8 * (rr >> 2) + 4 * h;
      const int dist = 128 - 32 * kt + qi - keyrow;
      const bool valid = (kt >= kt_lo) && dist >= 0 && dist <= 128;
      const float s = valid ? sacc[kt][rr] : -1e30f;
      sacc[kt][rr] = s;
      mx = fmaxf(mx, s);
    }
  mx = fmaxf(mx, __shfl_xor(mx, 32));
  float sum = 0.f;
#pragma unroll
  for (int kt = 0; kt < 5; ++kt)
#pragma unroll
    for (int rr = 0; rr < 16; ++rr) {
      const float s = sacc[kt][rr];
      const float ex = (s > -1e29f) ? __expf(s - mx) : 0.f;
      sacc[kt][rr] = ex;
      sum += ex;
    }
  sum += __shfl_xor(sum, 32);
  bf16x8 pfa[5][2];
#pragma unroll
  for (int kt = 0; kt < 5; ++kt)
#pragma unroll
    for (int s2 = 0; s2 < 2; ++s2)
      pfa[kt][s2] = pack8(sacc[kt][8 * s2], sacc[kt][8 * s2 + 1], sacc[kt][8 * s2 + 2], sacc[kt][8 * s2 + 3], sacc[kt][8 * s2 + 4], sacc[kt][8 * s2 + 5], sacc[kt][8 * s2 + 6], sacc[kt][8 * s2 + 7]);
  f32x16 oacc[2];
#pragma unroll
  for (int i = 0; i < 16; ++i) { oacc[0][i] = 0.f; oacc[1][i] = 0.f; }
  u16* vt = (u16*)(smem + wid * 16384);
  const int srow = lane >> 1, shf = (lane & 1) * 32;
#pragma unroll
  for (int kt = 0; kt < 5; ++kt) {
    if (kt >= kt_lo) {
      u16* vb = vt + (kt & 1) * (32 * 72);
      if (SAMPLE && kt < 4) {
        const float* vp = cache + (size_t)(r + dl * (32 * kt + srow)) * 256 + 128 + shf;
#pragma unroll
        for (int c = 0; c < 4; ++c) {
          const float4 x0 = *(const float4*)(vp + 8 * c), x1 = *(const float4*)(vp + 8 * c + 4);
          uint4 o; o.x = pack2(x0.x, x0.y); o.y = pack2(x0.z, x0.w); o.z = pack2(x1.x, x1.y); o.w = pack2(x1.z, x1.w);
          *(uint4*)(vb + srow * 72 + shf + 8 * c) = o;
        }
      } else {
        int tk;
        if (SAMPLE) tk = r + dl * (srow < nq ? srow : 0); else tk = (m0 - 128 + 32 * kt + srow) * dl + r;
        const u16* vp = projb + (size_t)tk * IC + C_V + head * 64 + shf;
#pragma unroll
        for (int c = 0; c < 4; ++c) *(uint4*)(vb + srow * 72 + shf + 8 * c) = *(const uint4*)(vp + 8 * c);
      }
#pragma unroll
      for (int s2 = 0; s2 < 2; ++s2) {
        bf16x8 v0, v1;
#pragma unroll
        for (int j = 0; j < 8; ++j) {
          const int kr = 16 * s2 + 8 * (j >> 2) + 4 * h + (j & 3);
          v0[j] = (short)vb[kr * 72 + qi]; v1[j] = (short)vb[kr * 72 + qi + 32];
        }
        oacc[0] = MFMA32(v0, pfa[kt][s2], oacc[0]);
        oacc[1] = MFMA32(v1, pfa[kt][s2], oacc[1]);
      }
    }
  }
  const float isum = 1.0f / sum;
  const size_t rowq = SAMPLE ? (size_t)NP + b * 8 + tq : (size_t)b * 2048 + tq;
  if (!SAMPLE || qi < nq) {
    float* op = p.opart + ((size_t)g * MT + rowq) * 128 + hslot * 64;
#pragma unroll
    for (int db = 0; db < 2; ++db)
#pragma unroll
      for (int i4 = 0; i4 < 4; ++i4) {
        float4 o; o.x = oacc[db][4 * i4] * isum; o.y = oacc[db][4 * i4 + 1] * isum; o.z = oacc[db][4 * i4 + 2] * isum; o.w = oacc[db][4 * i4 + 3] * isum;
        *(float4*)(op + db * 32 + 8 * i4 + 4 * h) = o;
      }
    if (h == 0) p.lse[((size_t)g * MT + rowq) * 2 + hslot] = mx + __logf(sum);
  }
}

__device__ __forceinline__ void kv_row_task(const Params& p, const int l, const int row, const int lane, const bf16x8 kr, const bf16x8 vr) {
  const int hl = lane < 48 ? lane : 47;
  const int head = hl >> 3, c8 = hl & 7;
  int b, t, ridx;
  const bool prompt = row < NP;
  if (prompt) { b = row >> 11; t = row & 2047; ridx = t; } else { b = (row - NP) >> 3; t = (row - NP) & 7; ridx = 2048 + t; }
  float f[8]; float ss = 0.f;
#pragma unroll
  for (int j = 0; j < 8; ++j) { f[j] = bfs2f(kr[j]); ss += f[j] * f[j]; }
  ss += __shfl_xor(ss, 1); ss += __shfl_xor(ss, 2); ss += __shfl_xor(ss, 4);
  const float inv = rsqrtf(ss * (1.0f / 64.0f) + EPS);
  const float* gk = p.k_norm_g + l * 64 + c8 * 8;
#pragma unroll
  for (int j = 0; j < 8; ++j) f[j] *= inv * gk[j];
  const float* rp = p.rope + ridx * 16;
#pragma unroll
  for (int j = 0; j < 8; ++j) {
    const float other = __shfl_xor(f[j], 1);
    const float cs = rp[j], sn = rp[8 + j];
    if (c8 == 0) f[j] = f[j] * cs - other * sn;
    else if (c8 == 1) f[j] = f[j] * cs + other * sn;
  }
  const int g = head >> 1, hh = head & 1;
  const int W = 128 << (2 * g);
  float* dst = nullptr;
  if (prompt) {
    const int r = t - (2048 - W);
    const size_t base = (g == 0) ? O_KV128P : (g == 1) ? O_KV512P : O_KV2048P;
    if (r >= 0) dst = p.out + base + ((size_t)(l * 8 + b) * W + r) * 256 + hh * 64 + c8 * 8;
  } else {
    const int r = W - 8 + t;
    const size_t base = (g == 0) ? O_KV128S : (g == 1) ? O_KV512S : O_KV2048S;
    dst = p.out + base + ((size_t)(l * 32 + b) * W + r) * 256 + hh * 64 + c8 * 8;
  }
  if (dst && lane < 48) {
    *(float4*)(dst) = make_float4(f[0], f[1], f[2], f[3]);
    *(float4*)(dst + 4) = make_float4(f[4], f[5], f[6], f[7]);
    *(float4*)(dst + 128) = make_float4(bfs2f(vr[0]), bfs2f(vr[1]), bfs2f(vr[2]), bfs2f(vr[3]));
    *(float4*)(dst + 132) = make_float4(bfs2f(vr[4]), bfs2f(vr[5]), bfs2f(vr[6]), bfs2f(vr[7]));
  }
}

__device__ __forceinline__ void phaseA(const Params& p, const int l, const int wave_s) {
  const int tid = opaque_tid(wave_s);
  const int lane = tid & 63, wid = tid >> 6;
  const int gw = blockIdx.x * 8 + wid, nw = gridDim.x * 8;
  for (int task = gw; task < 832 + 3072; task += nw) { if (task < 832) attn_task<true>(p, l, task, wid); else attn_task<false>(p, l, task - 832, wid); }
  for (int row0 = nw - 1 - gw; row0 < MT; row0 += 4 * nw) {
    const int hl = lane < 48 ? lane : 47;
    bf16x8 kr[4], vr[4];
#pragma unroll
    for (int u = 0; u < 4; ++u) {
      const int rc = min(row0 + u * nw, MT - 1);
      const u16* pr = p.proj + (size_t)rc * IC;
      kr[u] = *(const bf16x8*)(pr + C_K + hl * 8);
      vr[u] = *(const bf16x8*)(pr + C_V + hl * 8);
    }
#pragma unroll
    for (int u = 0; u < 4; ++u) if (row0 + u * nw < MT) kv_row_task(p, l, row0 + u * nw, lane, kr[u], vr[u]);
  }
}

template <int GRP>
__device__ __forceinline__ void pool_task(const Params& p, const int l, const int task, const int lane) {
  const int tile = task >> 2; constexpr int grp = GRP;
  const int qi = lane & 31, h = lane >> 5;
  const int row = tile * 32 + qi;
  constexpr int w = 2 << GRP;
  const bool prompt = row < NP;
  int n, t; float cnt;
  if (prompt) { n = row >> 11; t = row & 2047; cnt = (float)min(t + 1, w); } else { n = (row - NP) >> 3; t = (row - NP) & 7; cnt = (float)w; }
  const float icnt = 1.0f / cnt;
  f32x16 acc[2];
#pragma unroll
  for (int i = 0; i < 16; ++i) { acc[0][i] = 0.f; acc[1][i] = 0.f; }
  const u16* pw = p.pwT + (size_t)(l * 4 + grp) * 4096;
#pragma unroll
  for (int s = 0; s < 4; ++s) {
    const int c0 = grp * 64 + 16 * s + 8 * h;
    float sum[8], own[8];
#pragma unroll
    for (int j = 0; j < 8; ++j) { sum[j] = 0.f; own[j] = 0.f; }
#pragma unroll
    for (int i = 0; i < w; ++i) {
      const int tt = t - i;
      float v[8];
      if (tt >= 0) {
        const bf16x8 raw = *(const bf16x8*)(p.proj + (size_t)(row - i) * IC + C_U + c0);
#pragma unroll
        for (int j = 0; j < 8; ++j) v[j] = bfs2f(raw[j]);
      } else if (!prompt) {
        const float* sp = p.state_pool + ((size_t)(l * 32 + n) * 15 + 15 + tt) * 256 + c0;
        const float4 a = *(const float4*)sp, bb = *(const float4*)(sp + 4);
        v[0] = a.x; v[1] = a.y; v[2] = a.z; v[3] = a.w; v[4] = bb.x; v[5] = bb.y; v[6] = bb.z; v[7] = bb.w;
      } else {
#pragma unroll
        for (int j = 0; j < 8; ++j) v[j] = 0.f;
      }
#pragma unroll
      for (int j = 0; j < 8; ++j) sum[j] += v[j];
      if (i == 0) {
#pragma unroll
        for (int j = 0; j < 8; ++j) own[j] = v[j];
      }
    }
    const bf16x8 df = pack8(sum[0] * icnt - own[0], sum[1] * icnt - own[1], sum[2] * icnt - own[2], sum[3] * icnt - own[3],
                            sum[4] * icnt - own[4], sum[5] * icnt - own[5], sum[6] * icnt - own[6], sum[7] * icnt - own[7]);
    const bf16x8 a0 = *(const bf16x8*)(pw + (size_t)qi * 64 + 16 * s + 8 * h);
    const bf16x8 a1 = *(const bf16x8*)(pw + (size_t)(qi + 32) * 64 + 16 * s + 8 * h);
    acc[0] = MFMA32(a0, df, acc[0]);
    acc[1] = MFMA32(a1, df, acc[1]);
  }
  const float* ps = p.pool_scale + l * 256 + grp * 64;
  u16* mp = p.mixed + (size_t)row * MC + grp * 64;
#pragma unroll
  for (int db = 0; db < 2; ++db)
#pragma unroll
    for (int i4 = 0; i4 < 4; ++i4) {
      const int dd0 = db * 32 + 8 * i4 + 4 * h;
      const float4 sc = *(const float4*)(ps + dd0);
      uint2 o; o.x = pack2(acc[db][4 * i4] * sc.x, acc[db][4 * i4 + 1] * sc.y); o.y = pack2(acc[db][4 * i4 + 2] * sc.z, acc[db][4 * i4 + 3] * sc.w);
      *(uint2*)(mp + dd0) = o;
    }
}

__device__ __forceinline__ void phaseB(const Params& p, const int l, const int wave_s) {
  const int tid = opaque_tid(wave_s), lane = tid & 63, wid = tid >> 6;
  const int gw = blockIdx.x * 8 + wid, nw = gridDim.x * 8;
  const size_t gt = (size_t)blockIdx.x * 512 + tid, ntd = (size_t)gridDim.x * 512;
  {
    const bool spread = (nw == 2048);
    const int nit = spread ? 2 : (2080 + nw - 1) / nw;
    for (int it = 0; it < nit; ++it) {
      int task = gw + it * nw;
      if (spread && it == 1) task = ((gw & 63) == 0) ? 2048 + (gw >> 6) : 2080;
      if (task >= 2080) break;
      switch (task & 3) { case 0: pool_task<0>(p, l, task, lane); break; case 1: pool_task<1>(p, l, task, lane); break;
                          case 2: pool_task<2>(p, l, task, lane); break; default: pool_task<3>(p, l, task, lane); break; }
    }
  }
  for (size_t idx = gt; idx < (size_t)(MT / 4) * 48; idx += ntd) {
    const int row0 = (int)(idx / 48) * 4, ch = (int)(idx % 48) * 8;
    const bool prompt = row0 < NP;
    int n, t0;
    if (prompt) { n = row0 >> 11; t0 = row0 & 2047; } else { n = (row0 - NP) >> 3; t0 = (row0 - NP) & 7; }
    float z[6][8];
#pragma unroll
    for (int i = 0; i < 6; ++i) {
      const int tt = t0 - 2 + i;
      if (tt >= 0) {
        const u16* pr = p.proj + (size_t)(row0 - 2 + i) * IC;
        const bf16x8 gc = *(const bf16x8*)(pr + C_GC + ch), gh = *(const bf16x8*)(pr + C_GH + ch);
#pragma unroll
        for (int j = 0; j < 8; ++j) z[i][j] = bfs2f(gc[j]) * bfs2f(gh[j]);
      } else if (!prompt) {
        const float* sp = p.state_conv + ((size_t)(l * 32 + n) * 2 + 2 + tt) * 384 + ch;
        const float4 a = *(const float4*)sp, bb = *(const float4*)(sp + 4);
        z[i][0] = a.x; z[i][1] = a.y; z[i][2] = a.z; z[i][3] = a.w; z[i][4] = bb.x; z[i][5] = bb.y; z[i][6] = bb.z; z[i][7] = bb.w;
      } else {
#pragma unroll
        for (int j = 0; j < 8; ++j) z[i][j] = 0.f;
      }
    }
    const float* cw = p.conv_w + (size_t)l * 3 * 384 + ch;
    float c0[8], c1[8], c2[8];
#pragma unroll
    for (int j = 0; j < 8; ++j) { c0[j] = cw[j]; c1[j] = cw[384 + j]; c2[j] = cw[768 + j]; }
#pragma unroll
    for (int u = 0; u < 4; ++u) {
      const int row = row0 + u, t = t0 + u;
      const bf16x8 gb = *(const bf16x8*)(p.proj + (size_t)row * IC + C_GB + ch);
      float y[8];
#pragma unroll
      for (int j = 0; j < 8; ++j) y[j] = bfs2f(gb[j]) * (c0[j] * z[u][j] + c1[j] * z[u + 1][j] + c2[j] * z[u + 2][j]);
      uint4 o; o.x = pack2(y[0], y[1]); o.y = pack2(y[2], y[3]); o.z = pack2(y[4], y[5]); o.w = pack2(y[6], y[7]);
      *(uint4*)(p.mixed + (size_t)row * MC + 384 + ch) = o;
      float* so = nullptr;
      if (prompt) { if (t >= 2046) so = p.out + O_CONVP + ((size_t)(l * 8 + n) * 2 + (t - 2046)) * 384 + ch; }
      else { if (t >= 6) so = p.out + O_CONVS + ((size_t)(l * 32 + n) * 2 + (t - 6)) * 384 + ch; }
      if (so) { *(float4*)so = make_float4(z[u + 2][0], z[u + 2][1], z[u + 2][2], z[u + 2][3]); *(float4*)(so + 4) = make_float4(z[u + 2][4], z[u + 2][5], z[u + 2][6], z[u + 2][7]); }
    }
  }
  for (size_t idx0 = gt; idx0 < (size_t)MT * 16; idx0 += 2 * ntd) {
    float lg[2][3]; float4 pa[2][3], pb[2][3];
#pragma unroll
    for (int u = 0; u < 2; ++u) {
      const size_t idx = idx0 + u * ntd < (size_t)MT * 16 ? idx0 + u * ntd : idx0;
      const int row = (int)(idx >> 4), chunk = (int)(idx & 15);
      const int hslot = chunk >> 3, d0 = (chunk & 7) * 8;
#pragma unroll
      for (int g = 0; g < 3; ++g) {
        lg[u][g] = p.lse[((size_t)g * MT + row) * 2 + hslot];
        const float* op = p.opart + ((size_t)g * MT + row) * 128 + hslot * 64 + d0;
        pa[u][g] = *(const float4*)op; pb[u][g] = *(const float4*)(op + 4);
      }
    }
#pragma unroll
    for (int u = 0; u < 2; ++u) {
      const size_t idx = idx0 + u * ntd;
      if (idx < (size_t)MT * 16) {
        const int row = (int)(idx >> 4), chunk = (int)(idx & 15);
        const int hslot = chunk >> 3, d0 = (chunk & 7) * 8;
        const float m = fmaxf(lg[u][0], fmaxf(lg[u][1], lg[u][2]));
        float wg[3]; wg[0] = __expf(lg[u][0] - m); wg[1] = __expf(lg[u][1] - m); wg[2] = __expf(lg[u][2] - m);
        const float iw = 1.0f / (wg[0] + wg[1] + wg[2]);
        float y[8];
#pragma unroll
        for (int j = 0; j < 8; ++j) y[j] = 0.f;
#pragma unroll
        for (int g = 0; g < 3; ++g) {
          const float4 a = pa[u][g], bb = pb[u][g];
          const float ww = wg[g] * iw;
          y[0] += ww * a.x; y[1] += ww * a.y; y[2] += ww * a.z; y[3] += ww * a.w; y[4] += ww * bb.x; y[5] += ww * bb.y; y[6] += ww * bb.z; y[7] += ww * bb.w;
        }
        uint4 o; o.x = pack2(y[0], y[1]); o.y = pack2(y[2], y[3]); o.z = pack2(y[4], y[5]); o.w = pack2(y[6], y[7]);
        *(uint4*)(p.mixed + (size_t)row * MC + 256 + hslot * 64 + d0) = o;
      }
    }
  }
  for (size_t idx = gt; idx < (size_t)8 * 15 * 256; idx += ntd) {
    const int c = (int)(idx & 255); const int bi = (int)(idx >> 8); const int i = bi % 15, b = bi / 15;
    p.out[O_POOLP + (size_t)l * 8 * 15 * 256 + idx] = bf2f(p.proj[((size_t)b * 2048 + 2033 + i) * IC + C_U + c]);
  }
  for (size_t idx = gt; idx < (size_t)32 * 15 * 256; idx += ntd) {
    const int c = (int)(idx & 255); const int bi = (int)(idx >> 8); const int i = bi % 15, n = bi / 15;
    float v;
    if (i < 7) v = p.state_pool[((size_t)(l * 32 + n) * 15 + 8 + i) * 256 + c];
    else v = bf2f(p.proj[((size_t)NP + n * 8 + (i - 7)) * IC + C_U + c]);
    p.out[O_POOLS + (size_t)l * 32 * 15 * 256 + idx] = v;
  }
}

#ifndef PROBEV
#define PROBEV 0
#endif
#ifndef REPM
#define REPM 0
#endif
#define NREP(k) (1 + ((REPM >> (k)) & 1))
typedef const __attribute__((address_space(4))) Params* CP;
#if defined(__HIP_DEVICE_COMPILE__)
#define LOAD_PARAMS() CP pp_ = (CP)__builtin_amdgcn_kernarg_segment_ptr(); asm volatile("" : "+s"(pp_)); const Params p = *pp_
#else
#define LOAD_PARAMS() const Params& p = p_unused
#endif
__global__ void __launch_bounds__(512, 2) mega(const Params p_unused, const int ph_lo, const int ph_hi) {
  const int wave_s = __builtin_amdgcn_readfirstlane((int)(threadIdx.x >> 6));
  if (ph_hi == -12345) cg::this_grid().sync();
  {
    LOAD_PARAMS();
    if (opaque_tid(wave_s) == 0) {
      volatile __attribute__((address_space(3))) unsigned* st = (volatile __attribute__((address_space(3))) unsigned*)(smem + BAR_LDS_OFF);
      st[0] = 0u; st[1] = 0u;
      (void)xb_add(&p.bar[XB_XCNT(xb_xcc_id())], 1u);
    }
    __syncthreads();
  }
  int ph = 0;
#define IN_PH() (ph_lo <= ph && ph < ph_hi)
#define SEAM() do { if (ph_lo <= ph && ph + 1 < ph_hi) { LOAD_PARAMS(); grid_bar(p.bar, wave_s); } ++ph; } while (0)
  if (IN_PH()) for (int rep = 0; rep < NREP(0); ++rep) { LOAD_PARAMS(); phase0(p, wave_s); }
  SEAM();
#pragma unroll 1
  for (int l = 0; l < 2; ++l) {
    if (IN_PH()) for (int rep = 0; rep < NREP(1); ++rep) {
      LOAD_PARAMS();
      GemmEpi e{}; e.sumsq_in = p.sumsq + (size_t)(2 * l) * MT; e.out_bf = p.proj; e.ldo = IC;
      gemm_phase<1>(p.xg, p.wt_in + (size_t)l * IC * D, NP, IC, D, e, wave_s);
      { const int G = gridDim.x, first = (64 * (IC / 256)) % G;
        const int b0 = first ? first : 0, nb = G - b0;
        kv_shift_copy(p, l, b0, nb, opaque_tid(wave_s));
        sample_gemm64<1>(p.xg, p.wt_in + (size_t)l * IC * D, IC, D, e, wave_s, true); }
    }
    SEAM();
    if (IN_PH()) for (int rep = 0; rep < NREP(2); ++rep) { LOAD_PARAMS(); phaseA(p, l, wave_s); }
    SEAM();
    if (IN_PH()) for (int rep = 0; rep < NREP(3); ++rep) { LOAD_PARAMS(); phaseB(p, l, wave_s); }
    SEAM();
    if (IN_PH()) for (int rep = 0; rep < NREP(4); ++rep) {
      LOAD_PARAMS();
      GemmEpi e{};
      const bool last = (rep == NREP(4) - 1);
      e.xh = p.xg; e.xh_out = last ? p.xg : p.scr16; e.out_f = nullptr; e.sumsq_out = last ? p.sumsq + (size_t)(2 * l + 1) * MT : p.scrss;
      gemm_phase<2>(p.mixed, p.wt_out + (size_t)l * D * MC, NP, D, MC, e, wave_s, 0);
      sample_gemm<2>(p.mixed, p.wt_out + (size_t)l * D * MC, D, MC, e, wave_s, 0, gridDim.x);
    }
    SEAM();
    if (IN_PH()) for (int rep = 0; rep < NREP(5); ++rep) {
      LOAD_PARAMS();
      GemmEpi e{}; e.sumsq_in = p.sumsq + (size_t)(2 * l + 1) * MT; e.out_bf = p.hf; e.ldo = FF;
      gemm_phase<3>(p.xg, p.wt_up + (size_t)l * FF * D, NP, FF, D, e, wave_s, (rep && (PROBEV & 1)) ? 1 : 0);
      if (!(rep && (PROBEV & 2))) sample_gemm64<3>(p.xg, p.wt_up + (size_t)l * FF * D, FF, D, e, wave_s, false);
    }
    SEAM();
    if (IN_PH()) for (int rep = 0; rep < NREP(6); ++rep) {
      LOAD_PARAMS();
      GemmEpi e{};
      const bool last = (rep == NREP(6) - 1);
      e.xh = p.xg; e.xh_out = last ? p.xg : p.scr16;
      if (l == 0) { e.out_f = nullptr; e.sumsq_out = last ? p.sumsq + (size_t)2 * MT : p.scrss; } else { e.out_f = last ? p.out : p.scrf; e.sumsq_out = nullptr; }
      gemm_phase<2>(p.hf, p.wt_down + (size_t)l * D * FF, NP, D, FF, e, wave_s, 0);
      sample_gemm<2>(p.hf, p.wt_down + (size_t)l * D * FF, D, FF, e, wave_s, 0, gridDim.x);
    }
    SEAM();
  }
}

extern "C" void kernel_launch(void* const* d_in, const int* in_sizes, int n_in, void* d_out, int out_size, void* d_ws, size_t ws_size, hipStream_t stream) {
  static int grid_blocks = 0;
  if (!grid_blocks) {
    int dev = 0, cus = 0, per_cu = 0;
    hipGetDevice(&dev);
    hipDeviceGetAttribute(&cus, hipDeviceAttributeMultiprocessorCount, dev);
    hipFuncSetAttribute((const void*)mega, hipFuncAttributeMaxDynamicSharedMemorySize, GEMM_LDS);
    hipOccupancyMaxActiveBlocksPerMultiprocessor(&per_cu, (const void*)mega, 512, GEMM_LDS);
    if (per_cu < 1) { fprintf(stderr, "occupancy query returned %d\n", per_cu); per_cu = 1; }
    grid_blocks = cus * 1;
  }
  Params p{};
  p.x_prompt = (const float*)d_in[0]; p.x_sample = (const float*)d_in[1]; p.state_pool = (const float*)d_in[2]; p.state_conv = (const float*)d_in[3];
  p.kv_in[0] = (const float*)d_in[4]; p.kv_in[1] = (const float*)d_in[5]; p.kv_in[2] = (const float*)d_in[6];
  p.norm1_g = (const float*)d_in[7]; p.w_in = (const float*)d_in[8]; p.q_norm_g = (const float*)d_in[9]; p.k_norm_g = (const float*)d_in[10];
  p.pool_w = (const float*)d_in[11]; p.pool_scale = (const float*)d_in[12]; p.conv_w = (const float*)d_in[13]; p.w_out = (const float*)d_in[14];
  p.norm2_g = (const float*)d_in[15]; p.w_up = (const float*)d_in[16]; p.w_down = (const float*)d_in[17];
  p.out = (float*)d_out;
  unsigned char* w = (unsigned char*)d_ws; size_t off = 0;
  auto carve = [&](size_t bytes) { unsigned char* r = w + off; off += (bytes + 255) & ~(size_t)255; return r; };
  p.bar = (unsigned*)carve(XCD_BAR_WORDS * 4);
  p.wt_in = (u16*)carve((size_t)2 * IC * D * 2);
  p.wt_out = (u16*)carve((size_t)2 * D * MC * 2);
  p.wt_up = (u16*)carve((size_t)2 * FF * D * 2);
  p.wt_down = (u16*)carve((size_t)2 * D * FF * 2);
  p.pwT = (u16*)carve((size_t)2 * 4 * 4096 * 2);
  p.xg = (u16*)carve((size_t)MT * D * 2);
  p.mixed = (u16*)carve((size_t)MT * MC * 2);
  p.sumsq = (float*)carve((size_t)4 * MT * 4);
  p.lse = (float*)carve((size_t)3 * MT * 2 * 4);
  p.rope = (float*)carve((size_t)2056 * 16 * 4);
  p.scr16 = (u16*)carve((size_t)MT * D * 2); p.scrss = (float*)carve((size_t)MT * 4); p.scrf = (float*)carve((size_t)MT * D * 4);
  p.hf = (u16*)carve((size_t)MT * FF * 2);
  p.proj = p.hf;
  p.opart = (float*)((unsigned char*)p.hf + (((size_t)MT * IC * 2 + 255) & ~(size_t)255));
  if (off > ws_size) { fprintf(stderr, "workspace too small: need %zu have %zu\n", off, ws_size); return; }
  (void)hipMemsetAsync(p.bar, 0, XCD_BAR_WORDS * 4, stream);
  int lo = 0, hi = 13;
  void* args[] = {(void*)&p, (void*)&lo, (void*)&hi};
  hipError_t e = hipLaunchCooperativeKernel((const void*)mega, dim3(grid_blocks), dim3(512), args, GEMM_LDS, stream);
  if (e != hipSuccess) fprintf(stderr, "cooperative launch failed: %s (grid %d)\n", hipGetErrorString(e), grid_blocks);
}
```

```cpp
#include <hip/hip_runtime.h>
#include <hip/hip_cooperative_groups.h>
#include <cstdio>
namespace cg = cooperative_groups;

typedef unsigned short u16;
using bf16x8 = __attribute__((ext_vector_type(8))) short;
using f32x4 = __attribute__((ext_vector_type(4))) float;
using f32x16 = __attribute__((ext_vector_type(16))) float;

constexpr int NP = 16384, NS = 256, MT = NP + NS;
constexpr int D = 1024, IC = 2560, MC = 768, FF = 4096;
constexpr float EPS = 1e-6f;
constexpr int C_U = 0, C_Q = 256, C_K = 640, C_V = 1024, C_GB = 1408, C_GC = 1792, C_GH = 2176;
constexpr size_t O_YP = 0;
constexpr size_t O_YS = O_YP + (size_t)NP * D;
constexpr size_t O_POOLP = O_YS + (size_t)NS * D;
constexpr size_t O_CONVP = O_POOLP + 2 * 8 * 15 * 256;
constexpr size_t O_KV128P = O_CONVP + 2 * 8 * 2 * 384;
constexpr size_t O_KV512P = O_KV128P + (size_t)2 * 8 * 128 * 256;
constexpr size_t O_KV2048P = O_KV512P + (size_t)2 * 8 * 512 * 256;
constexpr size_t O_POOLS = O_KV2048P + (size_t)2 * 8 * 2048 * 256;
constexpr size_t O_CONVS = O_POOLS + 2 * 32 * 15 * 256;
constexpr size_t O_KV128S = O_CONVS + 2 * 32 * 2 * 384;
constexpr size_t O_KV512S = O_KV128S + (size_t)2 * 32 * 128 * 256;
constexpr size_t O_KV2048S = O_KV512S + (size_t)2 * 32 * 512 * 256;

struct Params {
  const float *x_prompt, *x_sample, *state_pool, *state_conv, *kv_in[3];
  const float *norm1_g, *w_in, *q_norm_g, *k_norm_g, *pool_w, *pool_scale, *conv_w, *w_out, *norm2_g, *w_up, *w_down;
  float* out;
  u16 *wt_in, *wt_out, *wt_up, *wt_down, *pwT;
  u16 *xg, *proj, *mixed, *hf;
  float *sumsq, *opart, *lse, *rope;
  unsigned* bar;
  u16* scr16; float* scrss; float* scrf;
};

extern __shared__ __attribute__((aligned(16))) unsigned char smem[];
typedef __attribute__((address_space(3))) void* LDSP;

typedef __bf16 bf16x2_t __attribute__((ext_vector_type(2)));
typedef float f32x2_t __attribute__((ext_vector_type(2)));
__device__ __forceinline__ unsigned pack2(float a, float b) { f32x2_t v = {a, b}; bf16x2_t r = __builtin_convertvector(v, bf16x2_t); return __builtin_bit_cast(unsigned, r); }
__device__ __forceinline__ u16 f2bf(float f) { return (u16)(pack2(f, 0.f) & 0xffffu); }
typedef unsigned u32x4_t __attribute__((ext_vector_type(4)));
__device__ __forceinline__ bf16x8 pack8(float a, float b, float c, float d, float e, float f, float g, float h) {
  u32x4_t t = {pack2(a, b), pack2(c, d), pack2(e, f), pack2(g, h)}; return __builtin_bit_cast(bf16x8, t); }
__device__ __forceinline__ float bf2f(u16 h) { return __uint_as_float(((unsigned)h) << 16); }
__device__ __forceinline__ float bfs2f(short h) { return __uint_as_float(((unsigned)(u16)h) << 16); }
__device__ __forceinline__ int opaque_tid(const int wave_s) {
  int l; asm volatile("v_mbcnt_lo_u32_b32 %0, -1, 0\n\tv_mbcnt_hi_u32_b32 %0, -1, %0" : "=v"(l));
  return wave_s * 64 + l;
}
__device__ __forceinline__ int opaque_lane() {
  int l; asm volatile("v_mbcnt_lo_u32_b32 %0, -1, 0\n\tv_mbcnt_hi_u32_b32 %0, -1, %0" : "=v"(l));
  return l;
}
#define XB_TMO      128
#define XB_XCNT(j)  (256  + 64 * (j))
#define XB_XSUB(j)  (1280 + 64 * (j))
#define XB_XGEN(j)  (2304 + 64 * (j))
#define XB_TOP      3328
#define XB_TOPGEN   3392
#define XCD_BAR_WORDS 3456
#define XB_SPIN_CAP (1u << 18)
constexpr int BAR_LDS_OFF = 131072;
__device__ __forceinline__ unsigned xb_ld(unsigned* p)              { return __hip_atomic_load(p, __ATOMIC_RELAXED, __HIP_MEMORY_SCOPE_AGENT); }
__device__ __forceinline__ unsigned xb_add(unsigned* p, unsigned v) { return __hip_atomic_fetch_add(p, v, __ATOMIC_RELAXED, __HIP_MEMORY_SCOPE_AGENT); }
__device__ __forceinline__ unsigned xb_xcc_id() { return (unsigned)__builtin_amdgcn_s_getreg((3 << 11) | 20) & 0xFu; }
#define XB_SPIN(cond, bar) do { unsigned _sp = 0; while (cond) { __builtin_amdgcn_s_sleep(1); \
    if ((++_sp & 255u) == 0u) { if (xb_ld(&(bar)[XB_TMO])) break; if (_sp > XB_SPIN_CAP) { atomicAdd(&(bar)[XB_TMO], 1u); break; } } } } while (0)
__device__ __forceinline__ void xcd_barrier_complete(unsigned* bar, unsigned x, unsigned& nloc, unsigned& nx) {
  const unsigned G = gridDim.x;
  unsigned sum, cnt, mine, sp = 0u;
  for (;;) {
    sum = 0u; cnt = 0u; mine = 0u;
#pragma unroll
    for (unsigned j = 0; j < 16; ++j) { const unsigned c = xb_ld(&bar[XB_XCNT(j)]); sum += c; cnt += (c > 0u) ? 1u : 0u; mine = (j == x) ? c : mine; }
    if (sum == G) break;
    __builtin_amdgcn_s_sleep(1);
    if ((++sp & 255u) == 0u) { if (xb_ld(&bar[XB_TMO])) break; if (sp > XB_SPIN_CAP) { atomicAdd(&bar[XB_TMO], 1u); break; } }
  }
  nloc = mine > 0u ? mine : 1u; nx = cnt > 0u ? cnt : 1u;
}
__device__ __forceinline__ void grid_bar(unsigned* bar, const int wave_s) {
  asm volatile("s_waitcnt vmcnt(0)" ::: "memory");
  __syncthreads();
  if (opaque_tid(wave_s) == 0) {
    volatile __attribute__((address_space(3))) unsigned* st = (volatile __attribute__((address_space(3))) unsigned*)(smem + BAR_LDS_OFF);
    const unsigned x = xb_xcc_id();
    __builtin_amdgcn_s_waitcnt(0);
    unsigned nloc = st[0], nx = st[1];
    if (nloc == 0u) { xcd_barrier_complete(bar, x, nloc, nx); st[0] = nloc; st[1] = nx; }
    const unsigned old = xb_add(&bar[XB_XSUB(x)], 1u);
    const unsigned gen = old / nloc;
    if (old + 1u == (gen + 1u) * nloc) {
      __builtin_amdgcn_fence(__ATOMIC_RELEASE, "agent");
      asm volatile("s_waitcnt vmcnt(0)" ::: "memory");
      const unsigned og = xb_add(&bar[XB_TOP], 1u);
      const unsigned tg = og / nx;
      if (og + 1u == (tg + 1u) * nx) xb_add(&bar[XB_TOPGEN], 1u);
      else XB_SPIN(xb_ld(&bar[XB_TOPGEN]) == tg, bar);
      __builtin_amdgcn_fence(__ATOMIC_ACQUIRE, "agent");
      xb_add(&bar[XB_XGEN(x)], 1u);
      asm volatile("s_waitcnt vmcnt(0)" ::: "memory");
    } else {
      XB_SPIN(xb_ld(&bar[XB_XGEN(x)]) == gen, bar);
      __builtin_amdgcn_fence(__ATOMIC_ACQUIRE, "agent");
      asm volatile("s_waitcnt vmcnt(0)" ::: "memory");
    }
  }
  __syncthreads();
}
__device__ __forceinline__ float wave_sum(float v) { for (int o = 32; o; o >>= 1) v += __shfl_xor(v, o); return v; }
__device__ __forceinline__ float wave_max(float v) { for (int o = 32; o; o >>= 1) v = fmaxf(v, __shfl_xor(v, o)); return v; }

constexpr int BM = 256, BK = 64, HALF = 128, NXCD = 8, WGM = 8, HT = HALF * BK;
constexpr int GEMM_LDS = 8 * HT * 2 + 16;

__device__ __forceinline__ int lds_byte(int r, int c) {
  int st = (r >> 4) * 2 + (c >> 5), rr = r & 15, cc = c & 31, ob = rr * 64 + cc * 2;
  return st * 1024 + (ob ^ (((ob >> 9) & 1) << 5));
}
__device__ __forceinline__ int perm32(int rho) { const int n = rho >> 4, i = rho & 15; return 8 * (i >> 2) + 4 * n + (i & 3); }
__device__ __forceinline__ void stage_rc(int b, int& R, int& C) {
  int st = b / 1024, sb = b % 1024, swz = sb ^ (((sb >> 9) & 1) << 5);
  R = (st >> 1) * 16 + swz / 64; C = (st & 1) * 32 + (swz % 64) / 2;
}

struct GemmEpi {
  const float* sumsq_in;
  u16* out_bf; int ldo;
  u16* xh;
  u16* xh_out;
  float* out_f;
  float* sumsq_out;
};

template <int MODE, bool ADD_RESID>
__device__ __forceinline__ void epi4(const GemmEpi& e, const f32x4 a, const float rs, const size_t grow, const int col0, float& ssq) {
  if (MODE == 1 || MODE == 3) {
    float v0 = a[0] * rs, v1 = a[1] * rs, v2 = a[2] * rs, v3 = a[3] * rs;
    if (MODE == 3) { v0 = fmaxf(v0, 0.f); v1 = fmaxf(v1, 0.f); v2 = fmaxf(v2, 0.f); v3 = fmaxf(v3, 0.f); v0 *= v0; v1 *= v1; v2 *= v2; v3 *= v3; }
    uint2 o; o.x = pack2(v0, v1); o.y = pack2(v2, v3);
    *(uint2*)(e.out_bf + grow * e.ldo + col0) = o;
  } else {
    float4 x; x.x = a[0]; x.y = a[1]; x.z = a[2]; x.w = a[3];
    if (ADD_RESID) {
      const uint2 r = *(const uint2*)(e.xh + grow * D + col0);
      x.x += __uint_as_float(r.x << 16); x.y += __uint_as_float(r.x & 0xffff0000u); x.z += __uint_as_float(r.y << 16); x.w += __uint_as_float(r.y & 0xffff0000u);
    }
    if (e.out_f) *(float4*)(e.out_f + grow * D + col0) = x;
    else { uint2 ob; ob.x = pack2(x.x, x.y); ob.y = pack2(x.z, x.w); *(uint2*)(e.xh_out + grow * D + col0) = ob; }
    ssq += x.x * x.x + x.y * x.y + x.z * x.z + x.w * x.w;
  }
}

template <int MODE>
__device__ __forceinline__ void epi8(const GemmEpi& e, const f32x4 a0, const f32x4 a1, const float rs, const size_t grow, const int col8, float& ssq) {
  float v[8] = {a0[0], a0[1], a0[2], a0[3], a1[0], a1[1], a1[2], a1[3]};
  if (MODE == 1 || MODE == 3) {
#pragma unroll
    for (int i = 0; i < 8; ++i) { v[i] *= rs; if (MODE == 3) { v[i] = fmaxf(v[i], 0.f); v[i] *= v[i]; } }
    uint4 o; o.x = pack2(v[0], v[1]); o.y = pack2(v[2], v[3]); o.z = pack2(v[4], v[5]); o.w = pack2(v[6], v[7]);
    *(uint4*)(e.out_bf + grow * e.ldo + col8) = o;
  } else {
    if (e.out_f) { *(float4*)(e.out_f + grow * D + col8) = make_float4(v[0], v[1], v[2], v[3]); *(float4*)(e.out_f + grow * D + col8 + 4) = make_float4(v[4], v[5], v[6], v[7]); }
    else { uint4 o; o.x = pack2(v[0], v[1]); o.y = pack2(v[2], v[3]); o.z = pack2(v[4], v[5]); o.w = pack2(v[6], v[7]); *(uint4*)(e.xh_out + grow * D + col8) = o; }
#pragma unroll
    for (int i = 0; i < 8; ++i) ssq += v[i] * v[i];
  }
}

template <int MODE>
__device__ __forceinline__ void gemm_phase(const u16* __restrict__ A, const u16* __restrict__ Bt, const int M, const int N, const int K, const GemmEpi e, const int wave_s, const int dry = 0) {
  u16* shm = (u16*)smem;
#define SA(b, h) (shm + ((b) * 2 + (h)) * HT)
#define SB(b, h) (shm + (4 + (b) * 2 + (h)) * HT)
#define STAGE_(P, RS, br, kt, o0, o1) do { const unsigned _so = (unsigned)(((br) * K + (kt) * BK) * 2); \
    __builtin_amdgcn_raw_ptr_buffer_load_lds(RS, (LDSP)((char*)(P) + tid0 * 16), 16, o0, _so, 0, 0); \
    __builtin_amdgcn_raw_ptr_buffer_load_lds(RS, (LDSP)((char*)(P) + tid0 * 16 + 8192), 16, o1, _so, 0, 0); } while (0)
#define STAGE(P, RS, br, kt) STAGE_(P, RS, br, kt, toff0, toff1)
#define STAGEB(P, RS, br, kt) STAGE_(P, RS, br, kt, toffb0, toffb1)
#define LDA(dst, b, h) for (int m = 0; m < 4; ++m) for (int k = 0; k < 2; ++k) \
    dst[m][k] = *reinterpret_cast<const bf16x8*>((char*)SA(b, h) + lds_byte(wr * 64 + m * 16 + fr, k * 32 + fq * 8))
#define LDB(dst, b, h) for (int n = 0; n < 2; ++n) for (int k = 0; k < 2; ++k) \
    dst[n][k] = *reinterpret_cast<const bf16x8*>((char*)SB(b, h) + lds_byte(wc * 32 + n * 16 + fr, k * 32 + fq * 8))
#define MMA(ai, bj, At, Bt_) do { __builtin_amdgcn_s_setprio(1); \
    for (int m = 0; m < 4; ++m) for (int n = 0; n < 2; ++n) for (int k = 0; k < 2; ++k) \
      acc[ai][bj][m][n] = __builtin_amdgcn_mfma_f32_16x16x32_bf16(Bt_[n][k], At[m][k], acc[ai][bj][m][n], 0, 0, 0); \
    __builtin_amdgcn_s_setprio(0); } while (0)
#define WAIT_V(n) asm volatile("s_waitcnt vmcnt(" #n ")" ::: "memory")
#define WAIT_L(n) asm volatile("s_waitcnt lgkmcnt(" #n ")" ::: "memory")
#define BAR __builtin_amdgcn_s_barrier()
#define SCHED __builtin_amdgcn_sched_barrier(0)
#define DECODE(tt_, brow_, bcol_) do { int wgid = (tt_); \
    { int q = nwg / NXCD, r = nwg % NXCD, xcd = wgid % NXCD, off = wgid / NXCD; \
      wgid = (xcd < r ? xcd * (q + 1) : r * (q + 1) + (xcd - r) * q) + off; } \
    int nig = WGM * nN, gid = wgid / nig, fm = gid * WGM, gsz = min(nM - fm, WGM); \
    brow_ = (fm + ((wgid % nig) % gsz)) * BM; bcol_ = ((wgid % nig) / gsz) * BM; } while (0)
#define STAGE7(brow_, bcol_) do { \
    STAGEB(SB(0, 0), rsB, bcol_, 0); STAGE(SA(0, 0), rsA, brow_, 0); \
    STAGEB(SB(0, 1), rsB, bcol_ + HALF, 0); STAGE(SA(0, 1), rsA, brow_ + HALF, 0); \
    STAGEB(SB(1, 0), rsB, bcol_, 1); STAGE(SA(1, 0), rsA, brow_, 1); STAGEB(SB(1, 1), rsB, bcol_ + HALF, 1); } while (0)

  const int nM = M / BM, nN = N / BM, nwg = nM * nN;
  const int nt = K / BK;
  unsigned toff0, toff1;
  const int tid0 = opaque_tid(wave_s);
  const int wr = (tid0 >> 6) >> 2, wc = (tid0 >> 6) & 3, fr = tid0 & 15, fq = (tid0 & 63) >> 4;
  unsigned toffb0, toffb1;
  { int r_, c_; stage_rc(tid0 * 16, r_, c_); toff0 = (unsigned)(r_ * K + c_) * 2u; toffb0 = (unsigned)(((r_ & ~31) | perm32(r_ & 31)) * K + c_) * 2u;
    stage_rc(tid0 * 16 + 8192, r_, c_); toff1 = (unsigned)(r_ * K + c_) * 2u; toffb1 = (unsigned)(((r_ & ~31) | perm32(r_ & 31)) * K + c_) * 2u; }
  const __amdgpu_buffer_rsrc_t rsA = __builtin_amdgcn_make_buffer_rsrc((void*)A, 0, -1, 0x00020000);
  const __amdgpu_buffer_rsrc_t rsB = __builtin_amdgcn_make_buffer_rsrc((void*)Bt, 0, -1, 0x00020000);
  int tt = blockIdx.x;
  int brow = 0, bcol = 0;
  if (tt < nwg) { DECODE(tt, brow, bcol); STAGE7(brow, bcol); WAIT_V(0); }
  f32x4 acc[2][2][4][2];
#define ACC_INIT(brow_, bcol_) do { \
    if (MODE == 2) { \
      const int t2 = opaque_tid(wave_s); const int wr_ = (t2 >> 6) >> 2, wc_ = (t2 >> 6) & 3, fr_ = t2 & 15, fq_ = (t2 & 63) >> 4; \
      const u16* rp_ = e.xh + (size_t)(brow_ + wr_ * 64 + fr_) * D + bcol_ + wc_ * 32 + fq_ * 8; \
      _Pragma("unroll") for (int ai = 0; ai < 2; ++ai) _Pragma("unroll") for (int bj = 0; bj < 2; ++bj) \
      _Pragma("unroll") for (int m = 0; m < 4; ++m) { \
        const uint4 x0 = *(const uint4*)(rp_ + (size_t)(ai * HALF + m * 16) * D + bj * HALF); \
        acc[ai][bj][m][0][0] = __uint_as_float(x0.x << 16); acc[ai][bj][m][0][1] = __uint_as_float(x0.x & 0xffff0000u); \
        acc[ai][bj][m][0][2] = __uint_as_float(x0.y << 16); acc[ai][bj][m][0][3] = __uint_as_float(x0.y & 0xffff0000u); \
        acc[ai][bj][m][1][0] = __uint_as_float(x0.z << 16); acc[ai][bj][m][1][1] = __uint_as_float(x0.z & 0xffff0000u); \
        acc[ai][bj][m][1][2] = __uint_as_float(x0.w << 16); acc[ai][bj][m][1][3] = __uint_as_float(x0.w & 0xffff0000u); } \
    } else { \
      _Pragma("unroll") for (int ai = 0; ai < 2; ++ai) _Pragma("unroll") for (int bj = 0; bj < 2; ++bj) \
      _Pragma("unroll") for (int m = 0; m < 4; ++m) _Pragma("unroll") for (int n = 0; n < 2; ++n) \
        acc[ai][bj][m][n] = (f32x4){0.f, 0.f, 0.f, 0.f}; \
    } } while (0)
  if (tt < nwg) ACC_INIT(brow, bcol);
  while (tt < nwg) {
    bf16x8 At[4][2], B0[2][2], B1[2][2];
    if (wr == 1) BAR;
    BAR;
    for (int t = 0; t < nt - 2; t += 2) {
      LDB(B0, 0, 0); SCHED; LDA(At, 0, 0); STAGE(SA(1, 1), rsA, brow + HALF, t + 1);
      WAIT_L(8); BAR; WAIT_L(0); MMA(0, 0, At, B0); BAR; SCHED;
      LDB(B1, 0, 1); STAGEB(SB(0, 0), rsB, bcol, t + 2);
      BAR; WAIT_L(0); MMA(0, 1, At, B1); BAR;
      LDA(At, 0, 1); STAGE(SA(0, 0), rsA, brow, t + 2);
      BAR; WAIT_L(0); MMA(1, 0, At, B0); BAR; SCHED;
      STAGEB(SB(0, 1), rsB, bcol + HALF, t + 2);
      WAIT_V(6); BAR; MMA(1, 1, At, B1); BAR;
      LDB(B0, 1, 0); SCHED; LDA(At, 1, 0); STAGE(SA(0, 1), rsA, brow + HALF, t + 2);
      WAIT_L(8); BAR; WAIT_L(0); MMA(0, 0, At, B0); BAR; SCHED;
      LDB(B1, 1, 1); STAGEB(SB(1, 0), rsB, bcol, t + 3);
      BAR; WAIT_L(0); MMA(0, 1, At, B1); BAR;
      LDA(At, 1, 1); STAGE(SA(1, 0), rsA, brow, t + 3);
      BAR; WAIT_L(0); MMA(1, 0, At, B0); BAR; SCHED;
      STAGEB(SB(1, 1), rsB, bcol + HALF, t + 3);
      WAIT_V(6); BAR; MMA(1, 1, At, B1); BAR;
    }
    { LDB(B0, 0, 0); LDA(At, 0, 0); STAGE(SA(1, 1), rsA, brow + HALF, nt - 1);
      BAR; WAIT_L(0); MMA(0, 0, At, B0); BAR;
      LDB(B1, 0, 1); BAR; WAIT_L(0); MMA(0, 1, At, B1); BAR;
      LDA(At, 0, 1); WAIT_V(4); BAR; WAIT_L(0); MMA(1, 0, At, B0); MMA(1, 1, At, B1); BAR; }
    { LDB(B0, 1, 0); LDA(At, 1, 0); WAIT_V(2); BAR; WAIT_L(0); MMA(0, 0, At, B0); BAR;
      LDB(B1, 1, 1); WAIT_V(0); BAR; WAIT_L(0); MMA(0, 1, At, B1); BAR;
      LDA(At, 1, 1); BAR; WAIT_L(0); MMA(1, 0, At, B0); MMA(1, 1, At, B1); BAR; }
    if (wr == 0) BAR;
    const int erow = brow, ecol = bcol;
    tt += gridDim.x;
    if (tt < nwg) { DECODE(tt, brow, bcol); STAGE7(brow, bcol); }
    SCHED;
    if (!dry) {
      const int tid1 = opaque_tid(wave_s);
      const int wr = (tid1 >> 6) >> 2, wc = (tid1 >> 6) & 3, fr = tid1 & 15, fq = (tid1 & 63) >> 4;
      float rsv[2][4];
#pragma unroll
      for (int ai = 0; ai < 2; ++ai)
#pragma unroll
        for (int m = 0; m < 4; ++m) {
          rsv[ai][m] = 0.f;
          if (MODE == 1 || MODE == 3) rsv[ai][m] = e.sumsq_in[(size_t)erow + ai * HALF + wr * 64 + m * 16 + fr];
        }
#pragma unroll
      for (int ai = 0; ai < 2; ++ai)
#pragma unroll
        for (int m = 0; m < 4; ++m) {
          const int lrow = ai * HALF + wr * 64 + m * 16 + fr;
          const size_t grow = (size_t)erow + lrow;
          float rs = 0.f, ssq = 0.f;
          if (MODE == 1 || MODE == 3) rs = rsqrtf(rsv[ai][m] * (1.0f / 1024.0f) + EPS);
#pragma unroll
          for (int bj = 0; bj < 2; ++bj)
            epi8<MODE>(e, acc[ai][bj][m][0], acc[ai][bj][m][1], rs, grow, ecol + bj * HALF + wc * 32 + fq * 8, ssq);
          if (MODE == 2 && e.sumsq_out) {
            ssq += __shfl_xor(ssq, 16); ssq += __shfl_xor(ssq, 32);
            if (fq == 0) atomicAdd(e.sumsq_out + grow, ssq);
          }
          SCHED;
        }
    }
    if (tt < nwg) ACC_INIT(brow, bcol);
    if (dry) WAIT_V(0); else WAIT_V(16);
  }
  WAIT_V(0);
#undef SA
#undef SB
#undef STAGE
#undef STAGEB
#undef STAGE_
#undef LDA
#undef LDB
#undef MMA
}

#define MFMA32(a, b, c) __builtin_amdgcn_mfma_f32_32x32x16_bf16((a), (b), (c), 0, 0, 0)

template <int MODE>
__device__ __forceinline__ void sample_gemm(const u16* __restrict__ A, const u16* __restrict__ Bt, const int N, const int K, const GemmEpi e, const int wave_s, const int b0, const int nb) {
  const int bi = (int)blockIdx.x - b0;
  if (bi < 0 || bi >= nb) return;
  const int tid = opaque_tid(wave_s);
  const int lane = tid & 63, wid = tid >> 6;
  const int i = lane & 31, h = lane >> 5;
  const int ntask = 8 * (N / 32);
  const int ks = K / 8;
  float* red = (float*)smem;
  for (int id = bi; id < ntask; id += nb) {
    const int r0 = (id & 7) * 32, c0 = (id >> 3) * 32;
    const u16* ap = A + (size_t)(NP + r0 + i) * K + wid * ks + 8 * h;
    const u16* bp = Bt + (size_t)(c0 + i) * K + wid * ks + 8 * h;
    f32x16 acc;
#pragma unroll
    for (int q = 0; q < 16; ++q) acc[q] = 0.f;
#pragma unroll 16
    for (int k = 0; k < ks; k += 16) {
      const bf16x8 a = *(const bf16x8*)(ap + k);
      const bf16x8 b = *(const bf16x8*)(bp + k);
      acc = MFMA32(b, a, acc);
    }
#pragma unroll
    for (int q = 0; q < 4; ++q)
      *(float4*)(red + (wid * 32 + i) * 36 + 8 * q + 4 * h) = make_float4(acc[4 * q], acc[4 * q + 1], acc[4 * q + 2], acc[4 * q + 3]);
    __syncthreads();
    if (tid < 256) {
      const int row = tid >> 3, c4 = (tid & 7) * 4;
      f32x4 s4; s4[0] = 0.f; s4[1] = 0.f; s4[2] = 0.f; s4[3] = 0.f;
#pragma unroll
      for (int w = 0; w < 8; ++w) {
        const float4 v = *(const float4*)(red + (w * 32 + row) * 36 + c4);
        s4[0] += v.x; s4[1] += v.y; s4[2] += v.z; s4[3] += v.w;
      }
      const int srow = r0 + row, col0 = c0 + c4;
      const size_t grow = (size_t)NP + srow;
      float rs = 0.f, ssq = 0.f;
      if (MODE == 1 || MODE == 3) rs = rsqrtf(e.sumsq_in[grow] * (1.0f / 1024.0f) + EPS);
      epi4<MODE, true>(e, s4, rs, grow, col0, ssq);
      if (MODE == 2 && e.sumsq_out) {
        ssq += __shfl_xor(ssq, 1); ssq += __shfl_xor(ssq, 2); ssq += __shfl_xor(ssq, 4);
        if ((tid & 7) == 0) atomicAdd(e.sumsq_out + grow, ssq);
      }
    }
    __syncthreads();
  }
}

template <int MODE>
__device__ __forceinline__ void sample_gemm64(const u16* __restrict__ A, const u16* __restrict__ Bt, const int N, const int K, const GemmEpi e, const int wave_s, const bool reverse) {
  const int tid = opaque_tid(wave_s);
  const int lane = tid & 63, wid = tid >> 6;
  const int i = lane & 31, h = lane >> 5;
  const int ri = wid & 1, ci = (wid >> 1) & 1, kh = wid >> 2;
  const int ntask = 4 * (N / 64);
  const int kspan = K / 2;
  float* red = (float*)smem;
  const int G = gridDim.x;
  for (int id = reverse ? G - 1 - (int)blockIdx.x : (int)blockIdx.x; id < ntask; id += G) {
    const int r0 = (id & 3) * 64 + ri * 32, c0 = (id >> 2) * 64 + ci * 32;
    const u16* ap = A + (size_t)(NP + r0 + i) * K + kh * kspan + 8 * h;
    const u16* bp = Bt + (size_t)(c0 + i) * K + kh * kspan + 8 * h;
    f32x16 acc;
#pragma unroll
    for (int q = 0; q < 16; ++q) acc[q] = 0.f;
#pragma unroll 16
    for (int k = 0; k < kspan; k += 16) {
      const bf16x8 a = *(const bf16x8*)(ap + k);
      const bf16x8 b = *(const bf16x8*)(bp + k);
      acc = MFMA32(b, a, acc);
    }
    float* rb = red + ((wid & 3) * 32 + i) * 36 + 4 * h;
    if (kh == 1) {
#pragma unroll
      for (int q = 0; q < 4; ++q) *(float4*)(rb + 8 * q) = make_float4(acc[4 * q], acc[4 * q + 1], acc[4 * q + 2], acc[4 * q + 3]);
    }
    __syncthreads();
    if (kh == 0) {
      const size_t grow = (size_t)NP + r0 + i;
      const float rs = rsqrtf(e.sumsq_in[grow] * (1.0f / 1024.0f) + EPS);
      float ssq = 0.f;
#pragma unroll
      for (int q = 0; q < 4; ++q) {
        const float4 o = *(const float4*)(rb + 8 * q);
        f32x4 a4; a4[0] = acc[4 * q] + o.x; a4[1] = acc[4 * q + 1] + o.y; a4[2] = acc[4 * q + 2] + o.z; a4[3] = acc[4 * q + 3] + o.w;
        epi4<MODE, false>(e, a4, rs, grow, c0 + 8 * q + 4 * h, ssq);
      }
    }
    __syncthreads();
  }
}

__device__ __forceinline__ void kv_shift_copy(const Params& p, const int l, const int b0, const int nb, const int tid) {
  const int bi = (int)blockIdx.x - b0;
  if (bi < 0 || bi >= nb) return;
  const size_t gt = (size_t)bi * 512 + tid, ntd = (size_t)nb * 512;
#pragma unroll
  for (int g = 0; g < 3; ++g) {
    const int W = 128 << (2 * g);
    const size_t n4 = (size_t)32 * W * 64;
    const size_t oo = (g == 0) ? O_KV128S : (g == 1) ? O_KV512S : O_KV2048S;
    const f32x4* src = (const f32x4*)p.kv_in[g] + (size_t)l * n4;
    f32x4* dst = (f32x4*)(p.out + oo) + (size_t)l * n4;
    const unsigned per = (unsigned)W * 64u, lim = (unsigned)(W - 8) * 64u;
    for (size_t i0 = gt; i0 < n4; i0 += ntd * 8) {
      f32x4 v[8];
#pragma unroll
      for (int k = 0; k < 8; ++k) {
        const size_t i = i0 + (size_t)k * ntd;
        v[k] = (f32x4){0.f, 0.f, 0.f, 0.f};
        if (i < n4 && ((unsigned)i % per) < lim) v[k] = __builtin_nontemporal_load(src + i + 512);
      }
#pragma unroll
      for (int k = 0; k < 8; ++k) {
        const size_t i = i0 + (size_t)k * ntd;
        if (i < n4 && ((unsigned)i % per) < lim) __builtin_nontemporal_store(v[k], dst + i);
      }
    }
  }
}

__device__ __forceinline__ void tr_tile(const float* __restrict__ src, u16* __restrict__ dst, int K, int N, int k0, int n0, const int tid, const float* __restrict__ gain) {
  float* lt = (float*)smem;
  { const int kk = tid >> 4, n4 = tid & 15;
#pragma unroll
    for (int i = 0; i < 2; ++i) {
      const int k = kk + i * 32;
      const float4 v = *(const float4*)(src + (size_t)(k0 + k) * N + n0 + n4 * 4);
      float* d = lt + k * 65 + n4 * 4;
      d[0] = v.x; d[1] = v.y; d[2] = v.z; d[3] = v.w;
    } }
  __syncthreads();
  { const int n = tid >> 3, k8 = tid & 7;
    float f[8];
#pragma unroll
    for (int i = 0; i < 8; ++i) f[i] = lt[(k8 * 8 + i) * 65 + n] * (gain ? gain[k0 + k8 * 8 + i] : 1.0f);
    uint4 o; o.x = pack2(f[0], f[1]); o.y = pack2(f[2], f[3]); o.z = pack2(f[4], f[5]); o.w = pack2(f[6], f[7]);
    *(uint4*)(dst + (size_t)(n0 + n) * K + k0 + k8 * 8) = o; }
  __syncthreads();
}

__device__ __forceinline__ void phase0(const Params& p, const int wave_s) {
  const int tid = opaque_tid(wave_s), lane = tid & 63, wid = tid >> 6;
  const int gw = blockIdx.x * 8 + wid, nw = gridDim.x * 8;
  const size_t gt = (size_t)blockIdx.x * 512 + tid, ntd = (size_t)gridDim.x * 512;
  for (int row0 = gw; row0 < MT; row0 += 2 * nw) {
    float4 v[2][4];
#pragma unroll
    for (int u = 0; u < 2; ++u) {
      const int row = min(row0 + u * nw, MT - 1);
      const float4* xr = (const float4*)(row < NP ? p.x_prompt + (size_t)row * D : p.x_sample + (size_t)(row - NP) * D);
#pragma unroll
      for (int i = 0; i < 4; ++i) v[u][i] = xr[lane + 64 * i];
    }
#pragma unroll
    for (int u = 0; u < 2; ++u) {
      const int row = row0 + u * nw;
      if (row < MT) {
        float ss = 0.f;
#pragma unroll
        for (int i = 0; i < 4; ++i) {
          const float4 x = v[u][i];
          ss += x.x * x.x + x.y * x.y + x.z * x.z + x.w * x.w;
          uint2 o; o.x = pack2(x.x, x.y); o.y = pack2(x.z, x.w);
          *(uint2*)(p.xg + (size_t)row * D + (lane + 64 * i) * 4) = o;
        }
        ss = wave_sum(ss);
        if (lane == 0) p.sumsq[row] = ss;
      }
    }
  }
  for (size_t i = gt; i < (size_t)3 * MT; i += ntd) p.sumsq[MT + i] = 0.f;
  for (size_t i = gt; i < (size_t)2056 * 8; i += ntd) {
    const int pi = (int)(i >> 3), fi = (int)(i & 7);
    const int pos = pi < 2048 ? pi : 8192 + (pi - 2048);
    float inv;
    switch (fi) { case 0: inv = 1.0f; break; case 1: inv = 0.1939227432012558f; break; case 2: inv = 0.03760603070259094f; break;
      case 3: inv = 0.007292664609849453f; break; case 4: inv = 0.0014142135623842478f; break; case 5: inv = 0.00027424818836152554f; break;
      case 6: inv = 5.318296098266728e-05f; break; default: inv = 1.0313386155758053e-05f; break; }
    const float ang = (float)pos * inv;
    p.rope[pi * 16 + fi] = cosf(ang);
    p.rope[pi * 16 + 8 + fi] = sinf(ang);
  }
  {
    float* lt = (float*)smem;
    constexpr int QL = (640 + 192 + 1024 + 1024) / 4;
    for (int t = blockIdx.x; t < 2 * QL; t += gridDim.x) {
      const int l = t / QL; int r = t % QL;
      const float* src; u16* dst; int K, N; const float* gain = nullptr;
      if (r < 160) { src = p.w_in + (size_t)l * D * IC; dst = p.wt_in + (size_t)l * IC * D; K = D; N = IC; gain = p.norm1_g + l * D; }
      else if (r < 208) { r -= 160; src = p.w_out + (size_t)l * MC * D; dst = p.wt_out + (size_t)l * D * MC; K = MC; N = D; }
      else if (r < 464) { r -= 208; src = p.w_up + (size_t)l * D * FF; dst = p.wt_up + (size_t)l * FF * D; K = D; N = FF; gain = p.norm2_g + l * D; }
      else { r -= 464; src = p.w_down + (size_t)l * FF * D; dst = p.wt_down + (size_t)l * D * FF; K = FF; N = D; }
      const int nq = N / 256;
      const int k0 = (r / nq) * 64, n0 = (r % nq) * 256;
      { const int kk = tid >> 6, n4 = tid & 63;
        float4 v[8];
#pragma unroll
        for (int i = 0; i < 8; ++i) v[i] = *(const float4*)(src + (size_t)(k0 + kk + 8 * i) * N + n0 + n4 * 4);
#pragma unroll
        for (int i = 0; i < 8; ++i) {
          const float gg = gain ? gain[k0 + kk + 8 * i] : 1.0f;
          *(float4*)(lt + (kk + 8 * i) * 260 + n4 * 4) = make_float4(v[i].x * gg, v[i].y * gg, v[i].z * gg, v[i].w * gg);
        } }
      __syncthreads();
      { const int n = tid >> 1, kh = (tid & 1) * 32;
        u16* dp = dst + (size_t)(n0 + n) * K + k0 + kh;
#pragma unroll
        for (int c = 0; c < 4; ++c) {
          float f[8];
#pragma unroll
          for (int i = 0; i < 8; ++i) f[i] = lt[(kh + c * 8 + i) * 260 + n];
          uint4 o; o.x = pack2(f[0], f[1]); o.y = pack2(f[2], f[3]); o.z = pack2(f[4], f[5]); o.w = pack2(f[6], f[7]);
          *(uint4*)(dp + c * 8) = o;
        } }
      __syncthreads();
    }
    for (int t = blockIdx.x; t < 8; t += gridDim.x)
      tr_tile(p.pool_w + (size_t)t * 4096, p.pwT + (size_t)t * 4096, 64, 64, 0, 0, tid, nullptr);
  }
}


__device__ __forceinline__ void qk_raw(const u16* __restrict__ rowp, bf16x8 raw[4], const int h) {
#pragma unroll
  for (int s = 0; s < 4; ++s) raw[s] = *(const bf16x8*)(rowp + 16 * s + 8 * h);
}
__device__ __forceinline__ void qk_finish(const bf16x8 raw[4], const float* __restrict__ ropep, const float* __restrict__ gain,
                                          const float scale, bf16x8 out[4], const int h) {
  float f[4][8];
  float ss = 0.f;
#pragma unroll
  for (int s = 0; s < 4; ++s) {
#pragma unroll
    for (int j = 0; j < 8; ++j) { f[s][j] = bfs2f(raw[s][j]); ss += f[s][j] * f[s][j]; }
  }
  ss += __shfl_xor(ss, 32);
  const float inv = rsqrtf(ss * (1.0f / 64.0f) + EPS);
#pragma unroll
  for (int s = 0; s < 4; ++s) {
    const float4 g0 = *(const float4*)(gain + 16 * s + 8 * h), g1 = *(const float4*)(gain + 16 * s + 8 * h + 4);
    f[s][0] *= inv * g0.x; f[s][1] *= inv * g0.y; f[s][2] *= inv * g0.z; f[s][3] *= inv * g0.w;
    f[s][4] *= inv * g1.x; f[s][5] *= inv * g1.y; f[s][6] *= inv * g1.z; f[s][7] *= inv * g1.w;
  }
  {
    const float4 c0 = *(const float4*)(ropep), c1 = *(const float4*)(ropep + 4), s0 = *(const float4*)(ropep + 8), s1 = *(const float4*)(ropep + 12);
    const float cs[8] = {c0.x, c0.y, c0.z, c0.w, c1.x, c1.y, c1.z, c1.w};
    const float sn[8] = {s0.x, s0.y, s0.z, s0.w, s1.x, s1.y, s1.z, s1.w};
#pragma unroll
    for (int j = 0; j < 8; ++j) {
      const float other = __shfl_xor(f[0][j], 32);
      f[0][j] = (h == 0) ? (f[0][j] * cs[j] - other * sn[j]) : (f[0][j] * cs[j] + other * sn[j]);
    }
  }
#pragma unroll
  for (int s = 0; s < 4; ++s)
    out[s] = pack8(f[s][0] * scale, f[s][1] * scale, f[s][2] * scale, f[s][3] * scale, f[s][4] * scale, f[s][5] * scale, f[s][6] * scale, f[s][7] * scale);
}

template <bool SAMPLE>
__device__ __forceinline__ void attn_task(const Params& p, const int layer, const int task, const int wid) {
  const int lane = opaque_lane();
  int g, hslot, b, r, tile, nq;
  if (!SAMPLE) {
    const int c = task & 63; int tmp = task >> 6; g = tmp % 3; tmp /= 3; hslot = tmp & 1; b = tmp >> 1;
    const int tpc = 64 >> (2 * g);
    r = c / tpc; tile = c % tpc; nq = 32;
  } else {
    b = task / 26; const int rem = task % 26; hslot = rem / 13; const int c = rem % 13;
    if (c == 0) { g = 0; r = 0; nq = 8; } else if (c < 5) { g = 1; r = c - 1; nq = 2; } else { g = 2; r = c - 5; nq = 1; }
    tile = 4;
  }
  const int dl = 1 << (2 * g);
  const int W = 128 << (2 * g);
  const int m0 = tile * 32;
  const int head = 2 * g + hslot;
  const u16* projb = SAMPLE ? p.proj + (size_t)(NP + b * 8) * IC : p.proj + (size_t)b * 2048 * IC;
  const int ropeb = SAMPLE ? 2048 : 0;
  const float* cache = SAMPLE ? ((g == 0) ? p.kv_in[0] : (g == 1) ? p.kv_in[1] : p.kv_in[2]) + (size_t)(layer * 32 + b) * W * 256 + hslot * 64 : nullptr;
  const int qi = lane & 31, h = lane >> 5;
  int tq;
  if (SAMPLE) tq = r + dl * (qi < nq ? qi : 0); else tq = (m0 + qi) * dl + r;
  const int kt_lo = SAMPLE ? 0 : max(0, 4 - tile);
  bf16x8 qraw[4], kraw[5][4];
  qk_raw(projb + (size_t)tq * IC + C_Q + head * 64, qraw, h);
#pragma unroll
  for (int kt = 0; kt < 5; ++kt) {
    if (kt >= kt_lo && !(SAMPLE && kt < 4)) {
      int tk;
      if (SAMPLE) tk = r + dl * (qi < nq ? qi : 0); else tk = (m0 - 128 + 32 * kt + qi) * dl + r;
      qk_raw(projb + (size_t)tk * IC + C_K + head * 64, kraw[kt], h);
    } else {
#pragma unroll
      for (int s = 0; s < 4; ++s) kraw[kt][s] = (bf16x8){0, 0, 0, 0, 0, 0, 0, 0};
    }
  }
  bf16x8 qf[4];
  qk_finish(qraw, p.rope + (ropeb + tq) * 16, p.q_norm_g + layer * 64, 0.125f, qf, h);
  f32x16 sacc[5];
#pragma unroll
  for (int kt = 0; kt < 5; ++kt) {
#pragma unroll
    for (int i = 0; i < 16; ++i) sacc[kt][i] = 0.f;
    if (kt >= kt_lo) {
      bf16x8 kf[4];
      if (SAMPLE && kt < 4) {
        const float* kp = cache + (size_t)(r + dl * (32 * kt + qi)) * 256 + 8 * h;
#pragma unroll
        for (int s = 0; s < 4; ++s) {
          const float4 x0 = *(const float4*)(kp + 16 * s), x1 = *(const float4*)(kp + 16 * s + 4);
          kf[s] = pack8(x0.x, x0.y, x0.z, x0.w, x1.x, x1.y, x1.z, x1.w);
        }
      } else {
        int tk;
        if (SAMPLE) tk = r + dl * (qi < nq ? qi : 0); else tk = (m0 - 128 + 32 * kt + qi) * dl + r;
        qk_finish(kraw[kt], p.rope + (ropeb + tk) * 16, p.k_norm_g + layer * 64, 1.0f, kf, h);
      }
#pragma unroll
      for (int s = 0; s < 4; ++s) sacc[kt] = MFMA32(kf[s], qf[s], sacc[kt]);
    }
  }
  const int srow = lane >> 1, shf = (lane & 1) * 32;
  uint4 vraw[5][4];
#pragma unroll
  for (int kt = 0; kt < 5; ++kt) {
    if (kt >= kt_lo && !(SAMPLE && kt < 4)) {
      int tk;
      if (SAMPLE) tk = r + dl * (srow < nq ? srow : 0); else tk = (m0 - 128 + 32 * kt + srow) * dl + r;
      const u16* vp = projb + (size_t)tk * IC + C_V + head * 64 + shf;
#pragma unroll
      for (int c = 0; c < 4; ++c) vraw[kt][c] = *(const uint4*)(vp + 8 * c);
    } else {
#pragma unroll
      for (int c = 0; c < 4; ++c) vraw[kt][c] = make_uint4(0u, 0u, 0u, 0u);
    }
  }
  float mx = -1e30f;
#pragma unroll
  for (int kt = 0; kt < 5; ++kt)
#pragma unroll
    for (int rr = 0; rr < 16; ++rr) {
      const int keyrow = (rr & 3) + 8 * (rr >> 2) + 4 * h;
      const int dist = 128 - 32 * kt + qi - keyrow;
      const bool valid = (kt >= kt_lo) && dist >= 0 && dist <= 128;
      const float s = valid ? sacc[kt][rr] : -1e30f;
      sacc[kt][rr] = s;
      mx = fmaxf(mx, s);
    }
  mx = fmaxf(mx, __shfl_xor(mx, 32));
  float sum = 0.f;
#pragma unroll
  for (int kt = 0; kt < 5; ++kt)
#pragma unroll
    for (int rr = 0; rr < 16; ++rr) {
      const float s = sacc[kt][rr];
      const float ex = (s > -1e29f) ? __expf(s - mx) : 0.f;
      sacc[kt][rr] = ex;
      sum += ex;
    }
  sum += __shfl_xor(sum, 32);
  bf16x8 pfa[5][2];
#pragma unroll
  for (int kt = 0; kt < 5; ++kt)
#pragma unroll
    for (int s2 = 0; s2 < 2; ++s2)
      pfa[kt][s2] = pack8(sacc[kt][8 * s2], sacc[kt][8 * s2 + 1], sacc[kt][8 * s2 + 2], sacc[kt][8 * s2 + 3], sacc[kt][8 * s2 + 4], sacc[kt][8 * s2 + 5], sacc[kt][8 * s2 + 6], sacc[kt][8 * s2 + 7]);
  f32x16 oacc[2];
#pragma unroll
  for (int i = 0; i < 16; ++i) { oacc[0][i] = 0.f; oacc[1][i] = 0.f; }
  u16* vt = (u16*)(smem + wid * 16384);
#pragma unroll
  for (int kt = 0; kt < 5; ++kt) {
    if (kt >= kt_lo) {
      u16* vb = vt + (kt & 1) * (32 * 72);
      if (SAMPLE && kt < 4) {
        const float* vp = cache + (size_t)(r + dl * (32 * kt + srow)) * 256 + 128 + shf;
#pragma unroll
        for (int c = 0; c < 4; ++c) {
          const float4 x0 = *(const float4*)(vp + 8 * c), x1 = *(const float4*)(vp + 8 * c + 4);
          uint4 o; o.x = pack2(x0.x, x0.y); o.y = pack2(x0.z, x0.w); o.z = pack2(x1.x, x1.y); o.w = pack2(x1.z, x1.w);
          *(uint4*)(vb + srow * 72 + shf + 8 * c) = o;
        }
      } else {
#pragma unroll
        for (int c = 0; c < 4; ++c) *(uint4*)(vb + srow * 72 + shf + 8 * c) = vraw[kt][c];
      }
#pragma unroll
      for (int s2 = 0; s2 < 2; ++s2) {
        bf16x8 v0, v1;
#pragma unroll
        for (int j = 0; j < 8; ++j) {
          const int kr = 16 * s2 + 8 * (j >> 2) + 4 * h + (j & 3);
          v0[j] = (short)vb[kr * 72 + qi]; v1[j] = (short)vb[kr * 72 + qi + 32];
        }
        oacc[0] = MFMA32(v0, pfa[kt][s2], oacc[0]);
        oacc[1] = MFMA32(v1, pfa[kt][s2], oacc[1]);
      }
    }
  }
  const float isum = 1.0f / sum;
  const size_t rowq = SAMPLE ? (size_t)NP + b * 8 + tq : (size_t)b * 2048 + tq;
  if (!SAMPLE || qi < nq) {
    float* op = p.opart + ((size_t)g * MT + rowq) * 128 + hslot * 64;
#pragma unroll
    for (int db = 0; db < 2; ++db)
#pragma unroll
      for (int i4 = 0; i4 < 4; ++i4) {
        float4 o; o.x = oacc[db][4 * i4] * isum; o.y = oacc[db][4 * i4 + 1] * isum; o.z = oacc[db][4 * i4 + 2] * isum; o.w = oacc[db][4 * i4 + 3] * isum;
        *(float4*)(op + db * 32 + 8 * i4 + 4 * h) = o;
      }
    if (h == 0) p.lse[((size_t)g * MT + rowq) * 2 + hslot] = mx + __logf(sum);
  }
}

__device__ __forceinline__ void kv_row_task(const Params& p, const int l, const int row, const int lane, const bf16x8 kr, const bf16x8 vr) {
  const int hl = lane < 48 ? lane : 47;
  const int head = hl >> 3, c8 = hl & 7;
  int b, t, ridx;
  const bool prompt = row < NP;
  if (prompt) { b = row >> 11; t = row & 2047; ridx = t; } else { b = (row - NP) >> 3; t = (row - NP) & 7; ridx = 2048 + t; }
  float f[8]; float ss = 0.f;
#pragma unroll
  for (int j = 0; j < 8; ++j) { f[j] = bfs2f(kr[j]); ss += f[j] * f[j]; }
  ss += __shfl_xor(ss, 1); ss += __shfl_xor(ss, 2); ss += __shfl_xor(ss, 4);
  const float inv = rsqrtf(ss * (1.0f / 64.0f) + EPS);
  const float* gk = p.k_norm_g + l * 64 + c8 * 8;
#pragma unroll
  for (int j = 0; j < 8; ++j) f[j] *= inv * gk[j];
  const float* rp = p.rope + ridx * 16;
#pragma unroll
  for (int j = 0; j < 8; ++j) {
    const float other = __shfl_xor(f[j], 1);
    const float cs = rp[j], sn = rp[8 + j];
    if (c8 == 0) f[j] = f[j] * cs - other * sn;
    else if (c8 == 1) f[j] = f[j] * cs + other * sn;
  }
  const int g = head >> 1, hh = head & 1;
  const int W = 128 << (2 * g);
  float* dst = nullptr;
  if (prompt) {
    const int r = t - (2048 - W);
    const size_t base = (g == 0) ? O_KV128P : (g == 1) ? O_KV512P : O_KV2048P;
    if (r >= 0) dst = p.out + base + ((size_t)(l * 8 + b) * W + r) * 256 + hh * 64 + c8 * 8;
  } else {
    const int r = W - 8 + t;
    const size_t base = (g == 0) ? O_KV128S : (g == 1) ? O_KV512S : O_KV2048S;
    dst = p.out + base + ((size_t)(l * 32 + b) * W + r) * 256 + hh * 64 + c8 * 8;
  }
  if (dst && lane < 48) {
    *(float4*)(dst) = make_float4(f[0], f[1], f[2], f[3]);
    *(float4*)(dst + 4) = make_float4(f[4], f[5], f[6], f[7]);
    *(float4*)(dst + 128) = make_float4(bfs2f(vr[0]), bfs2f(vr[1]), bfs2f(vr[2]), bfs2f(vr[3]));
    *(float4*)(dst + 132) = make_float4(bfs2f(vr[4]), bfs2f(vr[5]), bfs2f(vr[6]), bfs2f(vr[7]));
  }
}

__device__ __forceinline__ void phaseA(const Params& p, const int l, const int wave_s) {
  const int tid = opaque_tid(wave_s);
  const int lane = tid & 63, wid = tid >> 6;
  const int gw = blockIdx.x * 8 + wid, nw = gridDim.x * 8;
  for (int task = gw; task < 832 + 3072; task += nw) { if (task < 832) attn_task<true>(p, l, task, wid); else attn_task<false>(p, l, task - 832, wid); }
  for (int row0 = nw - 1 - gw; row0 < MT; row0 += 4 * nw) {
    const int hl = lane < 48 ? lane : 47;
    bf16x8 kr[4], vr[4];
#pragma unroll
    for (int u = 0; u < 4; ++u) {
      const int rc = min(row0 + u * nw, MT - 1);
      const u16* pr = p.proj + (size_t)rc * IC;
      kr[u] = *(const bf16x8*)(pr + C_K + hl * 8);
      vr[u] = *(const bf16x8*)(pr + C_V + hl * 8);
    }
#pragma unroll
    for (int u = 0; u < 4; ++u) if (row0 + u * nw < MT) kv_row_task(p, l, row0 + u * nw, lane, kr[u], vr[u]);
  }
}

template <int GRP>
__device__ __forceinline__ void pool_task(const Params& p, const int l, const int task, const int lane) {
  const int tile = task >> 2; constexpr int grp = GRP;
  const int qi = lane & 31, h = lane >> 5;
  const int row = tile * 32 + qi;
  constexpr int w = 2 << GRP;
  const bool prompt = row < NP;
  int n, t; float cnt;
  if (prompt) { n = row >> 11; t = row & 2047; cnt = (float)min(t + 1, w); } else { n = (row - NP) >> 3; t = (row - NP) & 7; cnt = (float)w; }
  const float icnt = 1.0f / cnt;
  f32x16 acc[2];
#pragma unroll
  for (int i = 0; i < 16; ++i) { acc[0][i] = 0.f; acc[1][i] = 0.f; }
  const u16* pw = p.pwT + (size_t)(l * 4 + grp) * 4096;
#pragma unroll
  for (int s = 0; s < 4; ++s) {
    const int c0 = grp * 64 + 16 * s + 8 * h;
    float sum[8], own[8];
#pragma unroll
    for (int j = 0; j < 8; ++j) { sum[j] = 0.f; own[j] = 0.f; }
#pragma unroll
    for (int i = 0; i < w; ++i) {
      const int tt = t - i;
      float v[8];
      if (tt >= 0) {
        const bf16x8 raw = *(const bf16x8*)(p.proj + (size_t)(row - i) * IC + C_U + c0);
#pragma unroll
        for (int j = 0; j < 8; ++j) v[j] = bfs2f(raw[j]);
      } else if (!prompt) {
        const float* sp = p.state_pool + ((size_t)(l * 32 + n) * 15 + 15 + tt) * 256 + c0;
        const float4 a = *(const float4*)sp, bb = *(const float4*)(sp + 4);
        v[0] = a.x; v[1] = a.y; v[2] = a.z; v[3] = a.w; v[4] = bb.x; v[5] = bb.y; v[6] = bb.z; v[7] = bb.w;
      } else {
#pragma unroll
        for (int j = 0; j < 8; ++j) v[j] = 0.f;
      }
#pragma unroll
      for (int j = 0; j < 8; ++j) sum[j] += v[j];
      if (i == 0) {
#pragma unroll
        for (int j = 0; j < 8; ++j) own[j] = v[j];
      }
    }
    const bf16x8 df = pack8(sum[0] * icnt - own[0], sum[1] * icnt - own[1], sum[2] * icnt - own[2], sum[3] * icnt - own[3],
                            sum[4] * icnt - own[4], sum[5] * icnt - own[5], sum[6] * icnt - own[6], sum[7] * icnt - own[7]);
    const bf16x8 a0 = *(const bf16x8*)(pw + (size_t)qi * 64 + 16 * s + 8 * h);
    const bf16x8 a1 = *(const bf16x8*)(pw + (size_t)(qi + 32) * 64 + 16 * s + 8 * h);
    acc[0] = MFMA32(a0, df, acc[0]);
    acc[1] = MFMA32(a1, df, acc[1]);
  }
  const float* ps = p.pool_scale + l * 256 + grp * 64;
  u16* mp = p.mixed + (size_t)row * MC + grp * 64;
#pragma unroll
  for (int db = 0; db < 2; ++db)
#pragma unroll
    for (int i4 = 0; i4 < 4; ++i4) {
      const int dd0 = db * 32 + 8 * i4 + 4 * h;
      const float4 sc = *(const float4*)(ps + dd0);
      uint2 o; o.x = pack2(acc[db][4 * i4] * sc.x, acc[db][4 * i4 + 1] * sc.y); o.y = pack2(acc[db][4 * i4 + 2] * sc.z, acc[db][4 * i4 + 3] * sc.w);
      *(uint2*)(mp + dd0) = o;
    }
}

__device__ __forceinline__ void phaseB(const Params& p, const int l, const int wave_s) {
  const int tid = opaque_tid(wave_s), lane = tid & 63, wid = tid >> 6;
  const int gw = blockIdx.x * 8 + wid, nw = gridDim.x * 8;
  const size_t gt = (size_t)blockIdx.x * 512 + tid, ntd = (size_t)gridDim.x * 512;
  {
    const bool spread = (nw == 2048);
    const int nit = spread ? 2 : (2080 + nw - 1) / nw;
    for (int it = 0; it < nit; ++it) {
      int task = gw + it * nw;
      if (spread && it == 1) task = ((gw & 63) == 0) ? 2048 + (gw >> 6) : 2080;
      if (task >= 2080) break;
      switch (task & 3) { case 0: pool_task<0>(p, l, task, lane); break; case 1: pool_task<1>(p, l, task, lane); break;
                          case 2: pool_task<2>(p, l, task, lane); break; default: pool_task<3>(p, l, task, lane); break; }
    }
  }
  for (size_t idx = gt; idx < (size_t)(MT / 4) * 48; idx += ntd) {
    const int row0 = (int)(idx / 48) * 4, ch = (int)(idx % 48) * 8;
    const bool prompt = row0 < NP;
    int n, t0;
    if (prompt) { n = row0 >> 11; t0 = row0 & 2047; } else { n = (row0 - NP) >> 3; t0 = (row0 - NP) & 7; }
    float z[6][8];
#pragma unroll
    for (int i = 0; i < 6; ++i) {
      const int tt = t0 - 2 + i;
      if (tt >= 0) {
        const u16* pr = p.proj + (size_t)(row0 - 2 + i) * IC;
        const bf16x8 gc = *(const bf16x8*)(pr + C_GC + ch), gh = *(const bf16x8*)(pr + C_GH + ch);
#pragma unroll
        for (int j = 0; j < 8; ++j) z[i][j] = bfs2f(gc[j]) * bfs2f(gh[j]);
      } else if (!prompt) {
        const float* sp = p.state_conv + ((size_t)(l * 32 + n) * 2 + 2 + tt) * 384 + ch;
        const float4 a = *(const float4*)sp, bb = *(const float4*)(sp + 4);
        z[i][0] = a.x; z[i][1] = a.y; z[i][2] = a.z; z[i][3] = a.w; z[i][4] = bb.x; z[i][5] = bb.y; z[i][6] = bb.z; z[i][7] = bb.w;
      } else {
#pragma unroll
        for (int j = 0; j < 8; ++j) z[i][j] = 0.f;
      }
    }
    const float* cw = p.conv_w + (size_t)l * 3 * 384 + ch;
    float c0[8], c1[8], c2[8];
#pragma unroll
    for (int j = 0; j < 8; ++j) { c0[j] = cw[j]; c1[j] = cw[384 + j]; c2[j] = cw[768 + j]; }
#pragma unroll
    for (int u = 0; u < 4; ++u) {
      const int row = row0 + u, t = t0 + u;
      const bf16x8 gb = *(const bf16x8*)(p.proj + (size_t)row * IC + C_GB + ch);
      float y[8];
#pragma unroll
      for (int j = 0; j < 8; ++j) y[j] = bfs2f(gb[j]) * (c0[j] * z[u][j] + c1[j] * z[u + 1][j] + c2[j] * z[u + 2][j]);
      uint4 o; o.x = pack2(y[0], y[1]); o.y = pack2(y[2], y[3]); o.z = pack2(y[4], y[5]); o.w = pack2(y[6], y[7]);
      *(uint4*)(p.mixed + (size_t)row * MC + 384 + ch) = o;
      float* so = nullptr;
      if (prompt) { if (t >= 2046) so = p.out + O_CONVP + ((size_t)(l * 8 + n) * 2 + (t - 2046)) * 384 + ch; }
      else { if (t >= 6) so = p.out + O_CONVS + ((size_t)(l * 32 + n) * 2 + (t - 6)) * 384 + ch; }
      if (so) { *(float4*)so = make_float4(z[u + 2][0], z[u + 2][1], z[u + 2][2], z[u + 2][3]); *(float4*)(so + 4) = make_float4(z[u + 2][4], z[u + 2][5], z[u + 2][6], z[u + 2][7]); }
    }
  }
  for (size_t idx0 = gt; idx0 < (size_t)MT * 16; idx0 += 2 * ntd) {
    float lg[2][3]; float4 pa[2][3], pb[2][3];
#pragma unroll
    for (int u = 0; u < 2; ++u) {
      const size_t idx = idx0 + u * ntd < (size_t)MT * 16 ? idx0 + u * ntd : idx0;
      const int row = (int)(idx >> 4), chunk = (int)(idx & 15);
      const int hslot = chunk >> 3, d0 = (chunk & 7) * 8;
#pragma unroll
      for (int g = 0; g < 3; ++g) {
        lg[u][g] = p.lse[((size_t)g * MT + row) * 2 + hslot];
        const float* op = p.opart + ((size_t)g * MT + row) * 128 + hslot * 64 + d0;
        pa[u][g] = *(const float4*)op; pb[u][g] = *(const float4*)(op + 4);
      }
    }
#pragma unroll
    for (int u = 0; u < 2; ++u) {
      const size_t idx = idx0 + u * ntd;
      if (idx < (size_t)MT * 16) {
        const int row = (int)(idx >> 4), chunk = (int)(idx & 15);
        const int hslot = chunk >> 3, d0 = (chunk & 7) * 8;
        const float m = fmaxf(lg[u][0], fmaxf(lg[u][1], lg[u][2]));
        float wg[3]; wg[0] = __expf(lg[u][0] - m); wg[1] = __expf(lg[u][1] - m); wg[2] = __expf(lg[u][2] - m);
        const float iw = 1.0f / (wg[0] + wg[1] + wg[2]);
        float y[8];
#pragma unroll
        for (int j = 0; j < 8; ++j) y[j] = 0.f;
#pragma unroll
        for (int g = 0; g < 3; ++g) {
          const float4 a = pa[u][g], bb = pb[u][g];
          const float ww = wg[g] * iw;
          y[0] += ww * a.x; y[1] += ww * a.y; y[2] += ww * a.z; y[3] += ww * a.w; y[4] += ww * bb.x; y[5] += ww * bb.y; y[6] += ww * bb.z; y[7] += ww * bb.w;
        }
        uint4 o; o.x = pack2(y[0], y[1]); o.y = pack2(y[2], y[3]); o.z = pack2(y[4], y[5]); o.w = pack2(y[6], y[7]);
        *(uint4*)(p.mixed + (size_t)row * MC + 256 + hslot * 64 + d0) = o;
      }
    }
  }
  for (size_t idx = gt; idx < (size_t)8 * 15 * 256; idx += ntd) {
    const int c = (int)(idx & 255); const int bi = (int)(idx >> 8); const int i = bi % 15, b = bi / 15;
    p.out[O_POOLP + (size_t)l * 8 * 15 * 256 + idx] = bf2f(p.proj[((size_t)b * 2048 + 2033 + i) * IC + C_U + c]);
  }
  for (size_t idx = gt; idx < (size_t)32 * 15 * 256; idx += ntd) {
    const int c = (int)(idx & 255); const int bi = (int)(idx >> 8); const int i = bi % 15, n = bi / 15;
    float v;
    if (i < 7) v = p.state_pool[((size_t)(l * 32 + n) * 15 + 8 + i) * 256 + c];
    else v = bf2f(p.proj[((size_t)NP + n * 8 + (i - 7)) * IC + C_U + c]);
    p.out[O_POOLS + (size_t)l * 32 * 15 * 256 + idx] = v;
  }
}

#ifndef PROBEV
#define PROBEV 0
#endif
#ifndef REPM
#define REPM 0
#endif
#define NREP(k) (1 + ((REPM >> (k)) & 1))
typedef const __attribute__((address_space(4))) Params* CP;
#if defined(__HIP_DEVICE_COMPILE__)
#define LOAD_PARAMS() CP pp_ = (CP)__builtin_amdgcn_kernarg_segment_ptr(); asm volatile("" : "+s"(pp_)); const Params p = *pp_
#else
#define LOAD_PARAMS() const Params& p = p_unused
#endif
__global__ void __launch_bounds__(512, 2) mega(const Params p_unused, const int ph_lo, const int ph_hi) {
  const int wave_s = __builtin_amdgcn_readfirstlane((int)(threadIdx.x >> 6));
  if (ph_hi == -12345) cg::this_grid().sync();
  {
    LOAD_PARAMS();
    if (opaque_tid(wave_s) == 0) {
      volatile __attribute__((address_space(3))) unsigned* st = (volatile __attribute__((address_space(3))) unsigned*)(smem + BAR_LDS_OFF);
      st[0] = 0u; st[1] = 0u;
      (void)xb_add(&p.bar[XB_XCNT(xb_xcc_id())], 1u);
    }
    __syncthreads();
  }
  int ph = 0;
#define IN_PH() (ph_lo <= ph && ph < ph_hi)
#define SEAM() do { if (ph_lo <= ph && ph + 1 < ph_hi) { LOAD_PARAMS(); grid_bar(p.bar, wave_s); } ++ph; } while (0)
  if (IN_PH()) for (int rep = 0; rep < NREP(0); ++rep) { LOAD_PARAMS(); phase0(p, wave_s); }
  SEAM();
#pragma unroll 1
  for (int l = 0; l < 2; ++l) {
    if (IN_PH()) for (int rep = 0; rep < NREP(1); ++rep) {
      LOAD_PARAMS();
      GemmEpi e{}; e.sumsq_in = p.sumsq + (size_t)(2 * l) * MT; e.out_bf = p.proj; e.ldo = IC;
      gemm_phase<1>(p.xg, p.wt_in + (size_t)l * IC * D, NP, IC, D, e, wave_s);
      { const int G = gridDim.x, first = (64 * (IC / 256)) % G;
        const int b0 = first ? first : 0, nb = G - b0;
        kv_shift_copy(p, l, b0, nb, opaque_tid(wave_s));
        sample_gemm64<1>(p.xg, p.wt_in + (size_t)l * IC * D, IC, D, e, wave_s, true); }
    }
    SEAM();
    if (IN_PH()) for (int rep = 0; rep < NREP(2); ++rep) { LOAD_PARAMS(); phaseA(p, l, wave_s); }
    SEAM();
    if (IN_PH()) for (int rep = 0; rep < NREP(3); ++rep) { LOAD_PARAMS(); phaseB(p, l, wave_s); }
    SEAM();
    if (IN_PH()) for (int rep = 0; rep < NREP(4); ++rep) {
      LOAD_PARAMS();
      GemmEpi e{};
      const bool last = (rep == NREP(4) - 1);
      e.xh = p.xg; e.xh_out = last ? p.xg : p.scr16; e.out_f = nullptr; e.sumsq_out = last ? p.sumsq + (size_t)(2 * l + 1) * MT : p.scrss;
      gemm_phase<2>(p.mixed, p.wt_out + (size_t)l * D * MC, NP, D, MC, e, wave_s, 0);
      sample_gemm<2>(p.mixed, p.wt_out + (size_t)l * D * MC, D, MC, e, wave_s, 0, gridDim.x);
    }
    SEAM();
    if (IN_PH()) for (int rep = 0; rep < NREP(5); ++rep) {
      LOAD_PARAMS();
      GemmEpi e{}; e.sumsq_in = p.sumsq + (size_t)(2 * l + 1) * MT; e.out_bf = p.hf; e.ldo = FF;
      gemm_phase<3>(p.xg, p.wt_up + (size_t)l * FF * D, NP, FF, D, e, wave_s, (rep && (PROBEV & 1)) ? 1 : 0);
      if (!(rep && (PROBEV & 2))) sample_gemm64<3>(p.xg, p.wt_up + (size_t)l * FF * D, FF, D, e, wave_s, false);
    }
    SEAM();
    if (IN_PH()) for (int rep = 0; rep < NREP(6); ++rep) {
      LOAD_PARAMS();
      GemmEpi e{};
      const bool last = (rep == NREP(6) - 1);
      e.xh = p.xg; e.xh_out = last ? p.xg : p.scr16;
      if (l == 0) { e.out_f = nullptr; e.sumsq_out = last ? p.sumsq + (size_t)2 * MT : p.scrss; } else { e.out_f = last ? p.out : p.scrf; e.sumsq_out = nullptr; }
      gemm_phase<2>(p.hf, p.wt_down + (size_t)l * D * FF, NP, D, FF, e, wave_s, 0);
      sample_gemm<2>(p.hf, p.wt_down + (size_t)l * D * FF, D, FF, e, wave_s, 0, gridDim.x);
    }
    SEAM();
  }
}

extern "C" void kernel_launch(void* const* d_in, const int* in_sizes, int n_in, void* d_out, int out_size, void* d_ws, size_t ws_size, hipStream_t stream) {
  static int grid_blocks = 0;
  if (!grid_blocks) {
    int dev = 0, cus = 0, per_cu = 0;
    hipGetDevice(&dev);
    hipDeviceGetAttribute(&cus, hipDeviceAttributeMultiprocessorCount, dev);
    hipFuncSetAttribute((const void*)mega, hipFuncAttributeMaxDynamicSharedMemorySize, GEMM_LDS);
    hipOccupancyMaxActiveBlocksPerMultiprocessor(&per_cu, (const void*)mega, 512, GEMM_LDS);
    if (per_cu < 1) { fprintf(stderr, "occupancy query returned %d\n", per_cu); per_cu = 1; }
    grid_blocks = cus * 1;
  }
  Params p{};
  p.x_prompt = (const float*)d_in[0]; p.x_sample = (const float*)d_in[1]; p.state_pool = (const float*)d_in[2]; p.state_conv = (const float*)d_in[3];
  p.kv_in[0] = (const float*)d_in[4]; p.kv_in[1] = (const float*)d_in[5]; p.kv_in[2] = (const float*)d_in[6];
  p.norm1_g = (const float*)d_in[7]; p.w_in = (const float*)d_in[8]; p.q_norm_g = (const float*)d_in[9]; p.k_norm_g = (const float*)d_in[10];
  p.pool_w = (const float*)d_in[11]; p.pool_scale = (const float*)d_in[12]; p.conv_w = (const float*)d_in[13]; p.w_out = (const float*)d_in[14];
  p.norm2_g = (const float*)d_in[15]; p.w_up = (const float*)d_in[16]; p.w_down = (const float*)d_in[17];
  p.out = (float*)d_out;
  unsigned char* w = (unsigned char*)d_ws; size_t off = 0;
  auto carve = [&](size_t bytes) { unsigned char* r = w + off; off += (bytes + 255) & ~(size_t)255; return r; };
  p.bar = (unsigned*)carve(XCD_BAR_WORDS * 4);
  p.wt_in = (u16*)carve((size_t)2 * IC * D * 2);
  p.wt_out = (u16*)carve((size_t)2 * D * MC * 2);
  p.wt_up = (u16*)carve((size_t)2 * FF * D * 2);
  p.wt_down = (u16*)carve((size_t)2 * D * FF * 2);
  p.pwT = (u16*)carve((size_t)2 * 4 * 4096 * 2);
  p.xg = (u16*)carve((size_t)MT * D * 2);
  p.mixed = (u16*)carve((size_t)MT * MC * 2);
  p.sumsq = (float*)carve((size_t)4 * MT * 4);
  p.lse = (float*)carve((size_t)3 * MT * 2 * 4);
  p.rope = (float*)carve((size_t)2056 * 16 * 4);
  p.scr16 = (u16*)carve((size_t)MT * D * 2); p.scrss = (float*)carve((size_t)MT * 4); p.scrf = (float*)carve((size_t)MT * D * 4);
  p.hf = (u16*)carve((size_t)MT * FF * 2);
  p.proj = p.hf;
  p.opart = (float*)((unsigned char*)p.hf + (((size_t)MT * IC * 2 + 255) & ~(size_t)255));
  if (off > ws_size) { fprintf(stderr, "workspace too small: need %zu have %zu\n", off, ws_size); return; }
  (void)hipMemsetAsync(p.bar, 0, XCD_BAR_WORDS * 4, stream);
  int lo = 0, hi = 13;
  void* args[] = {(void*)&p, (void*)&lo, (void*)&hi};
  hipError_t e = hipLaunchCooperativeKernel((const void*)mega, dim3(grid_blocks), dim3(512), args, GEMM_LDS, stream);
  if (e != hipSuccess) fprintf(stderr, "cooperative launch failed: %s (grid %d)\n", hipGetErrorString(e), grid_blocks);
}
```

```cpp
#include <hip/hip_runtime.h>
#include <hip/hip_cooperative_groups.h>
#include <cstdio>
namespace cg = cooperative_groups;

typedef unsigned short u16;
using bf16x8 = __attribute__((ext_vector_type(8))) short;
using f32x4 = __attribute__((ext_vector_type(4))) float;
using f32x16 = __attribute__((ext_vector_type(16))) float;

constexpr int NP = 16384, NS = 256, MT = NP + NS;
constexpr int D = 1024, IC = 2560, MC = 768, FF = 4096;
constexpr float EPS = 1e-6f;
constexpr int C_U = 0, C_Q = 256, C_K = 640, C_V = 1024, C_GB = 1408, C_GC = 1792, C_GH = 2176;
constexpr size_t O_YP = 0;
constexpr size_t O_YS = O_YP + (size_t)NP * D;
constexpr size_t O_POOLP = O_YS + (size_t)NS * D;
constexpr size_t O_CONVP = O_POOLP + 2 * 8 * 15 * 256;
constexpr size_t O_KV128P = O_CONVP + 2 * 8 * 2 * 384;
constexpr size_t O_KV512P = O_KV128P + (size_t)2 * 8 * 128 * 256;
constexpr size_t O_KV2048P = O_KV512P + (size_t)2 * 8 * 512 * 256;
constexpr size_t O_POOLS = O_KV2048P + (size_t)2 * 8 * 2048 * 256;
constexpr size_t O_CONVS = O_POOLS + 2 * 32 * 15 * 256;
constexpr size_t O_KV128S = O_CONVS + 2 * 32 * 2 * 384;
constexpr size_t O_KV512S = O_KV128S + (size_t)2 * 32 * 128 * 256;
constexpr size_t O_KV2048S = O_KV512S + (size_t)2 * 32 * 512 * 256;

struct Params {
  const float *x_prompt, *x_sample, *state_pool, *state_conv, *kv_in[3];
  const float *norm1_g, *w_in, *q_norm_g, *k_norm_g, *pool_w, *pool_scale, *conv_w, *w_out, *norm2_g, *w_up, *w_down;
  float* out;
  u16 *wt_in, *wt_out, *wt_up, *wt_down, *pwT;
  u16 *xg, *proj, *mixed, *hf;
  float *sumsq, *opart, *lse, *rope;
  unsigned* bar;
  u16* scr16; float* scrss; float* scrf;
};

extern __shared__ __attribute__((aligned(16))) unsigned char smem[];
typedef __attribute__((address_space(3))) void* LDSP;

typedef __bf16 bf16x2_t __attribute__((ext_vector_type(2)));
typedef float f32x2_t __attribute__((ext_vector_type(2)));
__device__ __forceinline__ unsigned pack2(float a, float b) { f32x2_t v = {a, b}; bf16x2_t r = __builtin_convertvector(v, bf16x2_t); return __builtin_bit_cast(unsigned, r); }
__device__ __forceinline__ u16 f2bf(float f) { return (u16)(pack2(f, 0.f) & 0xffffu); }
typedef unsigned u32x4_t __attribute__((ext_vector_type(4)));
__device__ __forceinline__ bf16x8 pack8(float a, float b, float c, float d, float e, float f, float g, float h) {
  u32x4_t t = {pack2(a, b), pack2(c, d), pack2(e, f), pack2(g, h)}; return __builtin_bit_cast(bf16x8, t); }
__device__ __forceinline__ float bf2f(u16 h) { return __uint_as_float(((unsigned)h) << 16); }
__device__ __forceinline__ float bfs2f(short h) { return __uint_as_float(((unsigned)(u16)h) << 16); }
__device__ __forceinline__ int opaque_tid(const int wave_s) {
  int l; asm volatile("v_mbcnt_lo_u32_b32 %0, -1, 0\n\tv_mbcnt_hi_u32_b32 %0, -1, %0" : "=v"(l));
  return wave_s * 64 + l;
}
__device__ __forceinline__ int opaque_lane() {
  int l; asm volatile("v_mbcnt_lo_u32_b32 %0, -1, 0\n\tv_mbcnt_hi_u32_b32 %0, -1, %0" : "=v"(l));
  return l;
}
#define XB_TMO      128
#define XB_XCNT(j)  (256  + 64 * (j))
#define XB_XSUB(j)  (1280 + 64 * (j))
#define XB_XGEN(j)  (2304 + 64 * (j))
#define XB_TOP      3328
#define XB_TOPGEN   3392
#define XCD_BAR_WORDS 3456
#define XB_SPIN_CAP (1u << 18)
constexpr int BAR_LDS_OFF = 131072;
__device__ __forceinline__ unsigned xb_ld(unsigned* p)              { return __hip_atomic_load(p, __ATOMIC_RELAXED, __HIP_MEMORY_SCOPE_AGENT); }
__device__ __forceinline__ unsigned xb_add(unsigned* p, unsigned v) { return __hip_atomic_fetch_add(p, v, __ATOMIC_RELAXED, __HIP_MEMORY_SCOPE_AGENT); }
__device__ __forceinline__ unsigned xb_xcc_id() { return (unsigned)__builtin_amdgcn_s_getreg((3 << 11) | 20) & 0xFu; }
#define XB_SPIN(cond, bar) do { unsigned _sp = 0; while (cond) { __builtin_amdgcn_s_sleep(1); \
    if ((++_sp & 255u) == 0u) { if (xb_ld(&(bar)[XB_TMO])) break; if (_sp > XB_SPIN_CAP) { atomicAdd(&(bar)[XB_TMO], 1u); break; } } } } while (0)
__device__ __forceinline__ void xcd_barrier_complete(unsigned* bar, unsigned x, unsigned& nloc, unsigned& nx) {
  const unsigned G = gridDim.x;
  unsigned sum, cnt, mine, sp = 0u;
  for (;;) {
    sum = 0u; cnt = 0u; mine = 0u;
#pragma unroll
    for (unsigned j = 0; j < 16; ++j) { const unsigned c = xb_ld(&bar[XB_XCNT(j)]); sum += c; cnt += (c > 0u) ? 1u : 0u; mine = (j == x) ? c : mine; }
    if (sum == G) break;
    __builtin_amdgcn_s_sleep(1);
    if ((++sp & 255u) == 0u) { if (xb_ld(&bar[XB_TMO])) break; if (sp > XB_SPIN_CAP) { atomicAdd(&bar[XB_TMO], 1u); break; } }
  }
  nloc = mine > 0u ? mine : 1u; nx = cnt > 0u ? cnt : 1u;
}
__device__ __forceinline__ void grid_bar(unsigned* bar, const int wave_s) {
  asm volatile("s_waitcnt vmcnt(0)" ::: "memory");
  __syncthreads();
  if (opaque_tid(wave_s) == 0) {
    volatile __attribute__((address_space(3))) unsigned* st = (volatile __attribute__((address_space(3))) unsigned*)(smem + BAR_LDS_OFF);
    const unsigned x = xb_xcc_id();
    __builtin_amdgcn_s_waitcnt(0);
    unsigned nloc = st[0], nx = st[1];
    if (nloc == 0u) { xcd_barrier_complete(bar, x, nloc, nx); st[0] = nloc; st[1] = nx; }
    const unsigned old = xb_add(&bar[XB_XSUB(x)], 1u);
    const unsigned gen = old / nloc;
    if (old + 1u == (gen + 1u) * nloc) {
      __builtin_amdgcn_fence(__ATOMIC_RELEASE, "agent");
      asm volatile("s_waitcnt vmcnt(0)" ::: "memory");
      const unsigned og = xb_add(&bar[XB_TOP], 1u);
      const unsigned tg = og / nx;
      if (og + 1u == (tg + 1u) * nx) xb_add(&bar[XB_TOPGEN], 1u);
      else XB_SPIN(xb_ld(&bar[XB_TOPGEN]) == tg, bar);
      __builtin_amdgcn_fence(__ATOMIC_ACQUIRE, "agent");
      xb_add(&bar[XB_XGEN(x)], 1u);
      asm volatile("s_waitcnt vmcnt(0)" ::: "memory");
    } else {
      XB_SPIN(xb_ld(&bar[XB_XGEN(x)]) == gen, bar);
      __builtin_amdgcn_fence(__ATOMIC_ACQUIRE, "agent");
      asm volatile("s_waitcnt vmcnt(0)" ::: "memory");
    }
  }
  __syncthreads();
}
__device__ __forceinline__ float wave_sum(float v) { for (int o = 32; o; o >>= 1) v += __shfl_xor(v, o); return v; }
__device__ __forceinline__ float wave_max(float v) { for (int o = 32; o; o >>= 1) v = fmaxf(v, __shfl_xor(v, o)); return v; }

constexpr int BM = 256, BK = 64, HALF = 128, NXCD = 8, WGM = 4, HT = HALF * BK;
constexpr int GEMM_LDS = 8 * HT * 2 + 16;

__device__ __forceinline__ int lds_byte(int r, int c) {
  int st = (r >> 4) * 2 + (c >> 5), rr = r & 15, cc = c & 31, ob = rr * 64 + cc * 2;
  return st * 1024 + (ob ^ (((ob >> 9) & 1) << 5));
}
__device__ __forceinline__ int perm32(int rho) { const int n = rho >> 4, i = rho & 15; return 8 * (i >> 2) + 4 * n + (i & 3); }
__device__ __forceinline__ void stage_rc(int b, int& R, int& C) {
  int st = b / 1024, sb = b % 1024, swz = sb ^ (((sb >> 9) & 1) << 5);
  R = (st >> 1) * 16 + swz / 64; C = (st & 1) * 32 + (swz % 64) / 2;
}

struct GemmEpi {
  const float* sumsq_in;
  u16* out_bf; int ldo;
  u16* xh;
  u16* xh_out;
  float* out_f;
  float* sumsq_out;
};

template <int MODE, bool ADD_RESID>
__device__ __forceinline__ void epi4(const GemmEpi& e, const f32x4 a, const float rs, const size_t grow, const int col0, float& ssq) {
  if (MODE == 1 || MODE == 3) {
    float v0 = a[0] * rs, v1 = a[1] * rs, v2 = a[2] * rs, v3 = a[3] * rs;
    if (MODE == 3) { v0 = fmaxf(v0, 0.f); v1 = fmaxf(v1, 0.f); v2 = fmaxf(v2, 0.f); v3 = fmaxf(v3, 0.f); v0 *= v0; v1 *= v1; v2 *= v2; v3 *= v3; }
    uint2 o; o.x = pack2(v0, v1); o.y = pack2(v2, v3);
    *(uint2*)(e.out_bf + grow * e.ldo + col0) = o;
  } else {
    float4 x; x.x = a[0]; x.y = a[1]; x.z = a[2]; x.w = a[3];
    if (ADD_RESID) {
      const uint2 r = *(const uint2*)(e.xh + grow * D + col0);
      x.x += __uint_as_float(r.x << 16); x.y += __uint_as_float(r.x & 0xffff0000u); x.z += __uint_as_float(r.y << 16); x.w += __uint_as_float(r.y & 0xffff0000u);
    }
    if (e.out_f) *(float4*)(e.out_f + grow * D + col0) = x;
    else { uint2 ob; ob.x = pack2(x.x, x.y); ob.y = pack2(x.z, x.w); *(uint2*)(e.xh_out + grow * D + col0) = ob; }
    ssq += x.x * x.x + x.y * x.y + x.z * x.z + x.w * x.w;
  }
}

template <int MODE>
__device__ __forceinline__ void epi8(const GemmEpi& e, const f32x4 a0, const f32x4 a1, const float rs, const size_t grow, const int col8, float& ssq) {
  float v[8] = {a0[0], a0[1], a0[2], a0[3], a1[0], a1[1], a1[2], a1[3]};
  if (MODE == 1 || MODE == 3) {
#pragma unroll
    for (int i = 0; i < 8; ++i) { v[i] *= rs; if (MODE == 3) { v[i] = fmaxf(v[i], 0.f); v[i] *= v[i]; } }
    uint4 o; o.x = pack2(v[0], v[1]); o.y = pack2(v[2], v[3]); o.z = pack2(v[4], v[5]); o.w = pack2(v[6], v[7]);
    *(uint4*)(e.out_bf + grow * e.ldo + col8) = o;
  } else {
    if (e.out_f) { *(float4*)(e.out_f + grow * D + col8) = make_float4(v[0], v[1], v[2], v[3]); *(float4*)(e.out_f + grow * D + col8 + 4) = make_float4(v[4], v[5], v[6], v[7]); }
    else { uint4 o; o.x = pack2(v[0], v[1]); o.y = pack2(v[2], v[3]); o.z = pack2(v[4], v[5]); o.w = pack2(v[6], v[7]); *(uint4*)(e.xh_out + grow * D + col8) = o; }
#pragma unroll
    for (int i = 0; i < 8; ++i) ssq += v[i] * v[i];
  }
}

template <int MODE>
__device__ __forceinline__ void gemm_phase(const u16* __restrict__ A, const u16* __restrict__ Bt, const int M, const int N, const int K, const GemmEpi e, const int wave_s, const int dry = 0) {
  u16* shm = (u16*)smem;
#define SA(b, h) (shm + ((b) * 2 + (h)) * HT)
#define SB(b, h) (shm + (4 + (b) * 2 + (h)) * HT)
#define STAGE_(P, RS, br, kt, o0, o1) do { const unsigned _so = (unsigned)(((br) * K + (kt) * BK) * 2); \
    __builtin_amdgcn_raw_ptr_buffer_load_lds(RS, (LDSP)((char*)(P) + tid0 * 16), 16, o0, _so, 0, 0); \
    __builtin_amdgcn_raw_ptr_buffer_load_lds(RS, (LDSP)((char*)(P) + tid0 * 16 + 8192), 16, o1, _so, 0, 0); } while (0)
#define STAGE(P, RS, br, kt) STAGE_(P, RS, br, kt, toff0, toff1)
#define STAGEB(P, RS, br, kt) STAGE_(P, RS, br, kt, toffb0, toffb1)
#define LDA(dst, b, h) for (int m = 0; m < 4; ++m) for (int k = 0; k < 2; ++k) \
    dst[m][k] = *reinterpret_cast<const bf16x8*>((char*)SA(b, h) + lds_byte(wr * 64 + m * 16 + fr, k * 32 + fq * 8))
#define LDB(dst, b, h) for (int n = 0; n < 2; ++n) for (int k = 0; k < 2; ++k) \
    dst[n][k] = *reinterpret_cast<const bf16x8*>((char*)SB(b, h) + lds_byte(wc * 32 + n * 16 + fr, k * 32 + fq * 8))
#define MMA(ai, bj, At, Bt_) do { __builtin_amdgcn_s_setprio(1); \
    for (int m = 0; m < 4; ++m) for (int n = 0; n < 2; ++n) for (int k = 0; k < 2; ++k) \
      acc[ai][bj][m][n] = __builtin_amdgcn_mfma_f32_16x16x32_bf16(Bt_[n][k], At[m][k], acc[ai][bj][m][n], 0, 0, 0); \
    __builtin_amdgcn_s_setprio(0); } while (0)
#define WAIT_V(n) asm volatile("s_waitcnt vmcnt(" #n ")" ::: "memory")
#define WAIT_L(n) asm volatile("s_waitcnt lgkmcnt(" #n ")" ::: "memory")
#define BAR __builtin_amdgcn_s_barrier()
#define SCHED __builtin_amdgcn_sched_barrier(0)
#define DECODE(tt_, brow_, bcol_) do { int wgid = (tt_); \
    { int q = nwg / NXCD, r = nwg % NXCD, xcd = wgid % NXCD, off = wgid / NXCD; \
      wgid = (xcd < r ? xcd * (q + 1) : r * (q + 1) + (xcd - r) * q) + off; } \
    int nig = WGM * nN, gid = wgid / nig, fm = gid * WGM, gsz = min(nM - fm, WGM); \
    brow_ = (fm + ((wgid % nig) % gsz)) * BM; bcol_ = ((wgid % nig) / gsz) * BM; } while (0)
#define STAGE7(brow_, bcol_) do { \
    STAGEB(SB(0, 0), rsB, bcol_, 0); STAGE(SA(0, 0), rsA, brow_, 0); \
    STAGEB(SB(0, 1), rsB, bcol_ + HALF, 0); STAGE(SA(0, 1), rsA, brow_ + HALF, 0); \
    STAGEB(SB(1, 0), rsB, bcol_, 1); STAGE(SA(1, 0), rsA, brow_, 1); STAGEB(SB(1, 1), rsB, bcol_ + HALF, 1); } while (0)

  const int nM = M / BM, nN = N / BM, nwg = nM * nN;
  const int nt = K / BK;
  unsigned toff0, toff1;
  const int tid0 = opaque_tid(wave_s);
  const int wr = (tid0 >> 6) >> 2, wc = (tid0 >> 6) & 3, fr = tid0 & 15, fq = (tid0 & 63) >> 4;
  unsigned toffb0, toffb1;
  { int r_, c_; stage_rc(tid0 * 16, r_, c_); toff0 = (unsigned)(r_ * K + c_) * 2u; toffb0 = (unsigned)(((r_ & ~31) | perm32(r_ & 31)) * K + c_) * 2u;
    stage_rc(tid0 * 16 + 8192, r_, c_); toff1 = (unsigned)(r_ * K + c_) * 2u; toffb1 = (unsigned)(((r_ & ~31) | perm32(r_ & 31)) * K + c_) * 2u; }
  const __amdgpu_buffer_rsrc_t rsA = __builtin_amdgcn_make_buffer_rsrc((void*)A, 0, -1, 0x00020000);
  const __amdgpu_buffer_rsrc_t rsB = __builtin_amdgcn_make_buffer_rsrc((void*)Bt, 0, -1, 0x00020000);
  int tt = blockIdx.x;
  int brow = 0, bcol = 0;
  if (tt < nwg) { DECODE(tt, brow, bcol); STAGE7(brow, bcol); WAIT_V(0); }
  f32x4 acc[2][2][4][2];
#define ACC_INIT(brow_, bcol_) do { \
    if (MODE == 2) { \
      const int t2 = opaque_tid(wave_s); const int wr_ = (t2 >> 6) >> 2, wc_ = (t2 >> 6) & 3, fr_ = t2 & 15, fq_ = (t2 & 63) >> 4; \
      const u16* rp_ = e.xh + (size_t)(brow_ + wr_ * 64 + fr_) * D + bcol_ + wc_ * 32 + fq_ * 8; \
      _Pragma("unroll") for (int ai = 0; ai < 2; ++ai) _Pragma("unroll") for (int bj = 0; bj < 2; ++bj) \
      _Pragma("unroll") for (int m = 0; m < 4; ++m) { \
        const uint4 x0 = *(const uint4*)(rp_ + (size_t)(ai * HALF + m * 16) * D + bj * HALF); \
        acc[ai][bj][m][0][0] = __uint_as_float(x0.x << 16); acc[ai][bj][m][0][1] = __uint_as_float(x0.x & 0xffff0000u); \
        acc[ai][bj][m][0][2] = __uint_as_float(x0.y << 16); acc[ai][bj][m][0][3] = __uint_as_float(x0.y & 0xffff0000u); \
        acc[ai][bj][m][1][0] = __uint_as_float(x0.z << 16); acc[ai][bj][m][1][1] = __uint_as_float(x0.z & 0xffff0000u); \
        acc[ai][bj][m][1][2] = __uint_as_float(x0.w << 16); acc[ai][bj][m][1][3] = __uint_as_float(x0.w & 0xffff0000u); } \
    } else { \
      _Pragma("unroll") for (int ai = 0; ai < 2; ++ai) _Pragma("unroll") for (int bj = 0; bj < 2; ++bj) \
      _Pragma("unroll") for (int m = 0; m < 4; ++m) _Pragma("unroll") for (int n = 0; n < 2; ++n) \
        acc[ai][bj][m][n] = (f32x4){0.f, 0.f, 0.f, 0.f}; \
    } } while (0)
  if (tt < nwg) ACC_INIT(brow, bcol);
  while (tt < nwg) {
    bf16x8 At[4][2], B0[2][2], B1[2][2];
    if (wr == 1) BAR;
    BAR;
    for (int t = 0; t < nt - 2; t += 2) {
      LDB(B0, 0, 0); SCHED; LDA(At, 0, 0); STAGE(SA(1, 1), rsA, brow + HALF, t + 1);
      WAIT_L(8); BAR; WAIT_L(0); MMA(0, 0, At, B0); BAR; SCHED;
      LDB(B1, 0, 1); STAGEB(SB(0, 0), rsB, bcol, t + 2);
      BAR; WAIT_L(0); MMA(0, 1, At, B1); BAR;
      LDA(At, 0, 1); STAGE(SA(0, 0), rsA, brow, t + 2);
      BAR; WAIT_L(0); MMA(1, 0, At, B0); BAR; SCHED;
      STAGEB(SB(0, 1), rsB, bcol + HALF, t + 2);
      WAIT_V(6); BAR; MMA(1, 1, At, B1); BAR;
      LDB(B0, 1, 0); SCHED; LDA(At, 1, 0); STAGE(SA(0, 1), rsA, brow + HALF, t + 2);
      WAIT_L(8); BAR; WAIT_L(0); MMA(0, 0, At, B0); BAR; SCHED;
      LDB(B1, 1, 1); STAGEB(SB(1, 0), rsB, bcol, t + 3);
      BAR; WAIT_L(0); MMA(0, 1, At, B1); BAR;
      LDA(At, 1, 1); STAGE(SA(1, 0), rsA, brow, t + 3);
      BAR; WAIT_L(0); MMA(1, 0, At, B0); BAR; SCHED;
      STAGEB(SB(1, 1), rsB, bcol + HALF, t + 3);
      WAIT_V(6); BAR; MMA(1, 1, At, B1); BAR;
    }
    { LDB(B0, 0, 0); LDA(At, 0, 0); STAGE(SA(1, 1), rsA, brow + HALF, nt - 1);
      BAR; WAIT_L(0); MMA(0, 0, At, B0); BAR;
      LDB(B1, 0, 1); BAR; WAIT_L(0); MMA(0, 1, At, B1); BAR;
      LDA(At, 0, 1); WAIT_V(4); BAR; WAIT_L(0); MMA(1, 0, At, B0); MMA(1, 1, At, B1); BAR; }
    { LDB(B0, 1, 0); LDA(At, 1, 0); WAIT_V(2); BAR; WAIT_L(0); MMA(0, 0, At, B0); BAR;
      LDB(B1, 1, 1); WAIT_V(0); BAR; WAIT_L(0); MMA(0, 1, At, B1); BAR;
      LDA(At, 1, 1); BAR; WAIT_L(0); MMA(1, 0, At, B0); MMA(1, 1, At, B1); BAR; }
    if (wr == 0) BAR;
    const int erow = brow, ecol = bcol;
    tt += gridDim.x;
    if (tt < nwg) { DECODE(tt, brow, bcol); STAGE7(brow, bcol); }
    SCHED;
    if (!dry) {
      const int tid1 = opaque_tid(wave_s);
      const int wr = (tid1 >> 6) >> 2, wc = (tid1 >> 6) & 3, fr = tid1 & 15, fq = (tid1 & 63) >> 4;
      float rsv[2][4];
#pragma unroll
      for (int ai = 0; ai < 2; ++ai)
#pragma unroll
        for (int m = 0; m < 4; ++m) {
          rsv[ai][m] = 0.f;
          if (MODE == 1 || MODE == 3) rsv[ai][m] = e.sumsq_in[(size_t)erow + ai * HALF + wr * 64 + m * 16 + fr];
        }
#pragma unroll
      for (int ai = 0; ai < 2; ++ai)
#pragma unroll
        for (int m = 0; m < 4; ++m) {
          const int lrow = ai * HALF + wr * 64 + m * 16 + fr;
          const size_t grow = (size_t)erow + lrow;
          float rs = 0.f, ssq = 0.f;
          if (MODE == 1 || MODE == 3) rs = rsqrtf(rsv[ai][m] * (1.0f / 1024.0f) + EPS);
#pragma unroll
          for (int bj = 0; bj < 2; ++bj)
            epi8<MODE>(e, acc[ai][bj][m][0], acc[ai][bj][m][1], rs, grow, ecol + bj * HALF + wc * 32 + fq * 8, ssq);
          if (MODE == 2 && e.sumsq_out) {
            ssq += __shfl_xor(ssq, 16); ssq += __shfl_xor(ssq, 32);
            if (fq == 0) atomicAdd(e.sumsq_out + grow, ssq);
          }
          SCHED;
        }
    }
    if (tt < nwg) ACC_INIT(brow, bcol);
    if (dry) WAIT_V(0); else WAIT_V(16);
  }
  WAIT_V(0);
#undef SA
#undef SB
#undef STAGE
#undef STAGEB
#undef STAGE_
#undef LDA
#undef LDB
#undef MMA
}

#define MFMA32(a, b, c) __builtin_amdgcn_mfma_f32_32x32x16_bf16((a), (b), (c), 0, 0, 0)

template <int MODE>
__device__ __forceinline__ void sample_gemm(const u16* __restrict__ A, const u16* __restrict__ Bt, const int N, const int K, const GemmEpi e, const int wave_s, const int b0, const int nb) {
  const int bi = (int)blockIdx.x - b0;
  if (bi < 0 || bi >= nb) return;
  const int tid = opaque_tid(wave_s);
  const int lane = tid & 63, wid = tid >> 6;
  const int i = lane & 31, h = lane >> 5;
  const int ntask = 8 * (N / 32);
  const int ks = K / 8;
  float* red = (float*)smem;
  for (int id = bi; id < ntask; id += nb) {
    const int r0 = (id & 7) * 32, c0 = (id >> 3) * 32;
    const u16* ap = A + (size_t)(NP + r0 + i) * K + wid * ks + 8 * h;
    const u16* bp = Bt + (size_t)(c0 + i) * K + wid * ks + 8 * h;
    f32x16 acc;
#pragma unroll
    for (int q = 0; q < 16; ++q) acc[q] = 0.f;
#pragma unroll 16
    for (int k = 0; k < ks; k += 16) {
      const bf16x8 a = *(const bf16x8*)(ap + k);
      const bf16x8 b = *(const bf16x8*)(bp + k);
      acc = MFMA32(b, a, acc);
    }
#pragma unroll
    for (int q = 0; q < 4; ++q)
      *(float4*)(red + (wid * 32 + i) * 36 + 8 * q + 4 * h) = make_float4(acc[4 * q], acc[4 * q + 1], acc[4 * q + 2], acc[4 * q + 3]);
    __syncthreads();
    if (tid < 256) {
      const int row = tid >> 3, c4 = (tid & 7) * 4;
      f32x4 s4; s4[0] = 0.f; s4[1] = 0.f; s4[2] = 0.f; s4[3] = 0.f;
#pragma unroll
      for (int w = 0; w < 8; ++w) {
        const float4 v = *(const float4*)(red + (w * 32 + row) * 36 + c4);
        s4[0] += v.x; s4[1] += v.y; s4[2] += v.z; s4[3] += v.w;
      }
      const int srow = r0 + row, col0 = c0 + c4;
      const size_t grow = (size_t)NP + srow;
      float rs = 0.f, ssq = 0.f;
      if (MODE == 1 || MODE == 3) rs = rsqrtf(e.sumsq_in[grow] * (1.0f / 1024.0f) + EPS);
      epi4<MODE, true>(e, s4, rs, grow, col0, ssq);
      if (MODE == 2 && e.sumsq_out) {
        ssq += __shfl_xor(ssq, 1); ssq += __shfl_xor(ssq, 2); ssq += __shfl_xor(ssq, 4);
        if ((tid & 7) == 0) atomicAdd(e.sumsq_out + grow, ssq);
      }
    }
    __syncthreads();
  }
}

template <int MODE>
__device__ __forceinline__ void sample_gemm64(const u16* __restrict__ A, const u16* __restrict__ Bt, const int N, const int K, const GemmEpi e, const int wave_s, const bool reverse) {
  const int tid = opaque_tid(wave_s);
  const int lane = tid & 63, wid = tid >> 6;
  const int i = lane & 31, h = lane >> 5;
  const int ri = wid & 1, ci = (wid >> 1) & 1, kh = wid >> 2;
  const int ntask = 4 * (N / 64);
  const int kspan = K / 2;
  float* red = (float*)smem;
  const int G = gridDim.x;
  for (int id = reverse ? G - 1 - (int)blockIdx.x : (int)blockIdx.x; id < ntask; id += G) {
    const int r0 = (id & 3) * 64 + ri * 32, c0 = (id >> 2) * 64 + ci * 32;
    const u16* ap = A + (size_t)(NP + r0 + i) * K + kh * kspan + 8 * h;
    const u16* bp = Bt + (size_t)(c0 + i) * K + kh * kspan + 8 * h;
    f32x16 acc;
#pragma unroll
    for (int q = 0; q < 16; ++q) acc[q] = 0.f;
#pragma unroll 16
    for (int k = 0; k < kspan; k += 16) {
      const bf16x8 a = *(const bf16x8*)(ap + k);
      const bf16x8 b = *(const bf16x8*)(bp + k);
      acc = MFMA32(b, a, acc);
    }
    float* rb = red + ((wid & 3) * 32 + i) * 36 + 4 * h;
    if (kh == 1) {
#pragma unroll
      for (int q = 0; q < 4; ++q) *(float4*)(rb + 8 * q) = make_float4(acc[4 * q], acc[4 * q + 1], acc[4 * q + 2], acc[4 * q + 3]);
    }
    __syncthreads();
    if (kh == 0) {
      const size_t grow = (size_t)NP + r0 + i;
      const float rs = rsqrtf(e.sumsq_in[grow] * (1.0f / 1024.0f) + EPS);
      float ssq = 0.f;
#pragma unroll
      for (int q = 0; q < 4; ++q) {
        const float4 o = *(const float4*)(rb + 8 * q);
        f32x4 a4; a4[0] = acc[4 * q] + o.x; a4[1] = acc[4 * q + 1] + o.y; a4[2] = acc[4 * q + 2] + o.z; a4[3] = acc[4 * q + 3] + o.w;
        epi4<MODE, false>(e, a4, rs, grow, c0 + 8 * q + 4 * h, ssq);
      }
    }
    __syncthreads();
  }
}

__device__ __forceinline__ void kv_shift_copy(const Params& p, const int l, const int b0, const int nb, const int tid) {
  const int bi = (int)blockIdx.x - b0;
  if (bi < 0 || bi >= nb) return;
  const size_t gt = (size_t)bi * 512 + tid, ntd = (size_t)nb * 512;
#pragma unroll
  for (int g = 0; g < 3; ++g) {
    const int W = 128 << (2 * g);
    const size_t n4 = (size_t)32 * W * 64;
    const size_t oo = (g == 0) ? O_KV128S : (g == 1) ? O_KV512S : O_KV2048S;
    const f32x4* src = (const f32x4*)p.kv_in[g] + (size_t)l * n4;
    f32x4* dst = (f32x4*)(p.out + oo) + (size_t)l * n4;
    const unsigned per = (unsigned)W * 64u, lim = (unsigned)(W - 8) * 64u;
    for (size_t i0 = gt; i0 < n4; i0 += ntd * 8) {
      f32x4 v[8];
#pragma unroll
      for (int k = 0; k < 8; ++k) {
        const size_t i = i0 + (size_t)k * ntd;
        v[k] = (f32x4){0.f, 0.f, 0.f, 0.f};
        if (i < n4 && ((unsigned)i % per) < lim) v[k] = __builtin_nontemporal_load(src + i + 512);
      }
#pragma unroll
      for (int k = 0; k < 8; ++k) {
        const size_t i = i0 + (size_t)k * ntd;
        if (i < n4 && ((unsigned)i % per) < lim) __builtin_nontemporal_store(v[k], dst + i);
      }
    }
  }
}

__device__ __forceinline__ void tr_tile(const float* __restrict__ src, u16* __restrict__ dst, int K, int N, int k0, int n0, const int tid, const float* __restrict__ gain) {
  float* lt = (float*)smem;
  { const int kk = tid >> 4, n4 = tid & 15;
#pragma unroll
    for (int i = 0; i < 2; ++i) {
      const int k = kk + i * 32;
      const float4 v = *(const float4*)(src + (size_t)(k0 + k) * N + n0 + n4 * 4);
      float* d = lt + k * 65 + n4 * 4;
      d[0] = v.x; d[1] = v.y; d[2] = v.z; d[3] = v.w;
    } }
  __syncthreads();
  { const int n = tid >> 3, k8 = tid & 7;
    float f[8];
#pragma unroll
    for (int i = 0; i < 8; ++i) f[i] = lt[(k8 * 8 + i) * 65 + n] * (gain ? gain[k0 + k8 * 8 + i] : 1.0f);
    uint4 o; o.x = pack2(f[0], f[1]); o.y = pack2(f[2], f[3]); o.z = pack2(f[4], f[5]); o.w = pack2(f[6], f[7]);
    *(uint4*)(dst + (size_t)(n0 + n) * K + k0 + k8 * 8) = o; }
  __syncthreads();
}

__device__ __forceinline__ void phase0(const Params& p, const int wave_s) {
  const int tid = opaque_tid(wave_s), lane = tid & 63, wid = tid >> 6;
  const int gw = blockIdx.x * 8 + wid, nw = gridDim.x * 8;
  const size_t gt = (size_t)blockIdx.x * 512 + tid, ntd = (size_t)gridDim.x * 512;
  for (int row0 = gw; row0 < MT; row0 += 2 * nw) {
    float4 v[2][4];
#pragma unroll
    for (int u = 0; u < 2; ++u) {
      const int row = min(row0 + u * nw, MT - 1);
      const float4* xr = (const float4*)(row < NP ? p.x_prompt + (size_t)row * D : p.x_sample + (size_t)(row - NP) * D);
#pragma unroll
      for (int i = 0; i < 4; ++i) v[u][i] = xr[lane + 64 * i];
    }
#pragma unroll
    for (int u = 0; u < 2; ++u) {
      const int row = row0 + u * nw;
      if (row < MT) {
        float ss = 0.f;
#pragma unroll
        for (int i = 0; i < 4; ++i) {
          const float4 x = v[u][i];
          ss += x.x * x.x + x.y * x.y + x.z * x.z + x.w * x.w;
          uint2 o; o.x = pack2(x.x, x.y); o.y = pack2(x.z, x.w);
          *(uint2*)(p.xg + (size_t)row * D + (lane + 64 * i) * 4) = o;
        }
        ss = wave_sum(ss);
        if (lane == 0) p.sumsq[row] = ss;
      }
    }
  }
  for (size_t i = gt; i < (size_t)3 * MT; i += ntd) p.sumsq[MT + i] = 0.f;
  for (size_t i = gt; i < (size_t)2056 * 8; i += ntd) {
    const int pi = (int)(i >> 3), fi = (int)(i & 7);
    const int pos = pi < 2048 ? pi : 8192 + (pi - 2048);
    float inv;
    switch (fi) { case 0: inv = 1.0f; break; case 1: inv = 0.1939227432012558f; break; case 2: inv = 0.03760603070259094f; break;
      case 3: inv = 0.007292664609849453f; break; case 4: inv = 0.0014142135623842478f; break; case 5: inv = 0.00027424818836152554f; break;
      case 6: inv = 5.318296098266728e-05f; break; default: inv = 1.0313386155758053e-05f; break; }
    const float ang = (float)pos * inv;
    p.rope[pi * 16 + fi] = cosf(ang);
    p.rope[pi * 16 + 8 + fi] = sinf(ang);
  }
  {
    float* lt = (float*)smem;
    constexpr int QL = (640 + 192 + 1024 + 1024) / 4;
    for (int t = blockIdx.x; t < 2 * QL; t += gridDim.x) {
      const int l = t / QL; int r = t % QL;
      const float* src; u16* dst; int K, N; const float* gain = nullptr;
      if (r < 160) { src = p.w_in + (size_t)l * D * IC; dst = p.wt_in + (size_t)l * IC * D; K = D; N = IC; gain = p.norm1_g + l * D; }
      else if (r < 208) { r -= 160; src = p.w_out + (size_t)l * MC * D; dst = p.wt_out + (size_t)l * D * MC; K = MC; N = D; }
      else if (r < 464) { r -= 208; src = p.w_up + (size_t)l * D * FF; dst = p.wt_up + (size_t)l * FF * D; K = D; N = FF; gain = p.norm2_g + l * D; }
      else { r -= 464; src = p.w_down + (size_t)l * FF * D; dst = p.wt_down + (size_t)l * D * FF; K = FF; N = D; }
      const int nq = N / 256;
      const int k0 = (r / nq) * 64, n0 = (r % nq) * 256;
      { const int kk = tid >> 6, n4 = tid & 63;
        float4 v[8];
#pragma unroll
        for (int i = 0; i < 8; ++i) v[i] = *(const float4*)(src + (size_t)(k0 + kk + 8 * i) * N + n0 + n4 * 4);
#pragma unroll
        for (int i = 0; i < 8; ++i) {
          const float gg = gain ? gain[k0 + kk + 8 * i] : 1.0f;
          *(float4*)(lt + (kk + 8 * i) * 260 + n4 * 4) = make_float4(v[i].x * gg, v[i].y * gg, v[i].z * gg, v[i].w * gg);
        } }
      __syncthreads();
      { const int n = tid >> 1, kh = (tid & 1) * 32;
        u16* dp = dst + (size_t)(n0 + n) * K + k0 + kh;
#pragma unroll
        for (int c = 0; c < 4; ++c) {
          float f[8];
#pragma unroll
          for (int i = 0; i < 8; ++i) f[i] = lt[(kh + c * 8 + i) * 260 + n];
          uint4 o; o.x = pack2(f[0], f[1]); o.y = pack2(f[2], f[3]); o.z = pack2(f[4], f[5]); o.w = pack2(f[6], f[7]);
          *(uint4*)(dp + c * 8) = o;
        } }
      __syncthreads();
    }
    for (int t = blockIdx.x; t < 8; t += gridDim.x)
      tr_tile(p.pool_w + (size_t)t * 4096, p.pwT + (size_t)t * 4096, 64, 64, 0, 0, tid, nullptr);
  }
}


__device__ __forceinline__ void qk_raw(const u16* __restrict__ rowp, bf16x8 raw[4], const int h) {
#pragma unroll
  for (int s = 0; s < 4; ++s) raw[s] = *(const bf16x8*)(rowp + 16 * s + 8 * h);
}
__device__ __forceinline__ void qk_finish(const bf16x8 raw[4], const float* __restrict__ ropep, const float* __restrict__ gain,
                                          const float scale, bf16x8 out[4], const int h) {
  float f[4][8];
  float ss = 0.f;
#pragma unroll
  for (int s = 0; s < 4; ++s) {
#pragma unroll
    for (int j = 0; j < 8; ++j) { f[s][j] = bfs2f(raw[s][j]); ss += f[s][j] * f[s][j]; }
  }
  ss += __shfl_xor(ss, 32);
  const float inv = rsqrtf(ss * (1.0f / 64.0f) + EPS);
#pragma unroll
  for (int s = 0; s < 4; ++s) {
    const float4 g0 = *(const float4*)(gain + 16 * s + 8 * h), g1 = *(const float4*)(gain + 16 * s + 8 * h + 4);
    f[s][0] *= inv * g0.x; f[s][1] *= inv * g0.y; f[s][2] *= inv * g0.z; f[s][3] *= inv * g0.w;
    f[s][4] *= inv * g1.x; f[s][5] *= inv * g1.y; f[s][6] *= inv * g1.z; f[s][7] *= inv * g1.w;
  }
  {
    const float4 c0 = *(const float4*)(ropep), c1 = *(const float4*)(ropep + 4), s0 = *(const float4*)(ropep + 8), s1 = *(const float4*)(ropep + 12);
    const float cs[8] = {c0.x, c0.y, c0.z, c0.w, c1.x, c1.y, c1.z, c1.w};
    const float sn[8] = {s0.x, s0.y, s0.z, s0.w, s1.x, s1.y, s1.z, s1.w};
#pragma unroll
    for (int j = 0; j < 8; ++j) {
      const float other = __shfl_xor(f[0][j], 32);
      f[0][j] = (h == 0) ? (f[0][j] * cs[j] - other * sn[j]) : (f[0][j] * cs[j] + other * sn[j]);
    }
  }
#pragma unroll
  for (int s = 0; s < 4; ++s)
    out[s] = pack8(f[s][0] * scale, f[s][1] * scale, f[s][2] * scale, f[s][3] * scale, f[s][4] * scale, f[s][5] * scale, f[s][6] * scale, f[s][7] * scale);
}

template <bool SAMPLE>
__device__ __forceinline__ void attn_task(const Params& p, const int layer, const int task, const int wid) {
  const int lane = opaque_lane();
  int g, hslot, b, r, tile, nq;
  if (!SAMPLE) {
    const int c = task & 63; int tmp = task >> 6; g = tmp % 3; tmp /= 3; hslot = tmp & 1; b = tmp >> 1;
    const int tpc = 64 >> (2 * g);
    r = c / tpc; tile = c % tpc; nq = 32;
  } else {
    b = task / 26; const int rem = task % 26; hslot = rem / 13; const int c = rem % 13;
    if (c == 0) { g = 0; r = 0; nq = 8; } else if (c < 5) { g = 1; r = c - 1; nq = 2; } else { g = 2; r = c - 5; nq = 1; }
    tile = 4;
  }
  const int dl = 1 << (2 * g);
  const int W = 128 << (2 * g);
  const int m0 = tile * 32;
  const int head = 2 * g + hslot;
  const u16* projb = SAMPLE ? p.proj + (size_t)(NP + b * 8) * IC : p.proj + (size_t)b * 2048 * IC;
  const int ropeb = SAMPLE ? 2048 : 0;
  const float* cache = SAMPLE ? ((g == 0) ? p.kv_in[0] : (g == 1) ? p.kv_in[1] : p.kv_in[2]) + (size_t)(layer * 32 + b) * W * 256 + hslot * 64 : nullptr;
  const int qi = lane & 31, h = lane >> 5;
  int tq;
  if (SAMPLE) tq = r + dl * (qi < nq ? qi : 0); else tq = (m0 + qi) * dl + r;
  const int kt_lo = SAMPLE ? 0 : max(0, 4 - tile);
  bf16x8 qraw[4], kraw[5][4];
  qk_raw(projb + (size_t)tq * IC + C_Q + head * 64, qraw, h);
#pragma unroll
  for (int kt = 0; kt < 5; ++kt) {
    if (kt >= kt_lo && !(SAMPLE && kt < 4)) {
      int tk;
      if (SAMPLE) tk = r + dl * (qi < nq ? qi : 0); else tk = (m0 - 128 + 32 * kt + qi) * dl + r;
      qk_raw(projb + (size_t)tk * IC + C_K + head * 64, kraw[kt], h);
    } else {
#pragma unroll
      for (int s = 0; s < 4; ++s) kraw[kt][s] = (bf16x8){0, 0, 0, 0, 0, 0, 0, 0};
    }
  }
  bf16x8 qf[4];
  qk_finish(qraw, p.rope + (ropeb + tq) * 16, p.q_norm_g + layer * 64, 0.125f, qf, h);
  f32x16 sacc[5];
#pragma unroll
  for (int kt = 0; kt < 5; ++kt) {
#pragma unroll
    for (int i = 0; i < 16; ++i) sacc[kt][i] = 0.f;
    if (kt >= kt_lo) {
      bf16x8 kf[4];
      if (SAMPLE && kt < 4) {
        const float* kp = cache + (size_t)(r + dl * (32 * kt + qi)) * 256 + 8 * h;
#pragma unroll
        for (int s = 0; s < 4; ++s) {
          const float4 x0 = *(const float4*)(kp + 16 * s), x1 = *(const float4*)(kp + 16 * s + 4);
          kf[s] = pack8(x0.x, x0.y, x0.z, x0.w, x1.x, x1.y, x1.z, x1.w);
        }
      } else {
        int tk;
        if (SAMPLE) tk = r + dl * (qi < nq ? qi : 0); else tk = (m0 - 128 + 32 * kt + qi) * dl + r;
        qk_finish(kraw[kt], p.rope + (ropeb + tk) * 16, p.k_norm_g + layer * 64, 1.0f, kf, h);
      }
#pragma unroll
      for (int s = 0; s < 4; ++s) sacc[kt] = MFMA32(kf[s], qf[s], sacc[kt]);
    }
  }
  const int srow = lane >> 1, shf = (lane & 1) * 32;
  uint4 vraw[5][4];
#pragma unroll
  for (int kt = 0; kt < 5; ++kt) {
    if (kt >= kt_lo && !(SAMPLE && kt < 4)) {
      int tk;
      if (SAMPLE) tk = r + dl * (srow < nq ? srow : 0); else tk = (m0 - 128 + 32 * kt + srow) * dl + r;
      const u16* vp = projb + (size_t)tk * IC + C_V + head * 64 + shf;
#pragma unroll
      for (int c = 0; c < 4; ++c) vraw[kt][c] = *(const uint4*)(vp + 8 * c);
    } else {
#pragma unroll
      for (int c = 0; c < 4; ++c) vraw[kt][c] = make_uint4(0u, 0u, 0u, 0u);
    }
  }
  float mx = -1e30f;
#pragma unroll
  for (int kt = 0; kt < 5; ++kt)
#pragma unroll
    for (int rr = 0; rr < 16; ++rr) {
      const int keyrow = (rr & 3) + 8 * (rr >> 2) + 4 * h;
      const int dist = 128 - 32 * kt + qi - keyrow;
      const bool valid = (kt >= kt_lo) && dist >= 0 && dist <= 128;
      const float s = valid ? sacc[kt][rr] : -1e30f;
      sacc[kt][rr] = s;
      mx = fmaxf(mx, s);
    }
  mx = fmaxf(mx, __shfl_xor(mx, 32));
  float sum = 0.f;
#pragma unroll
  for (int kt = 0; kt < 5; ++kt)
#pragma unroll
    for (int rr = 0; rr < 16; ++rr) {
      const float s = sacc[kt][rr];
      const float ex = (s > -1e29f) ? __expf(s - mx) : 0.f;
      sacc[kt][rr] = ex;
      sum += ex;
    }
  sum += __shfl_xor(sum, 32);
  bf16x8 pfa[5][2];
#pragma unroll
  for (int kt = 0; kt < 5; ++kt)
#pragma unroll
    for (int s2 = 0; s2 < 2; ++s2)
      pfa[kt][s2] = pack8(sacc[kt][8 * s2], sacc[kt][8 * s2 + 1], sacc[kt][8 * s2 + 2], sacc[kt][8 * s2 + 3], sacc[kt][8 * s2 + 4], sacc[kt][8 * s2 + 5], sacc[kt][8 * s2 + 6], sacc[kt][8 * s2 + 7]);
  f32x16 oacc[2];
#pragma unroll
  for (int i = 0; i < 16; ++i) { oacc[0][i] = 0.f; oacc[1][i] = 0.f; }
  u16* vt = (u16*)(smem + wid * 16384);
#pragma unroll
  for (int kt = 0; kt < 5; ++kt) {
    if (kt >= kt_lo) {
      u16* vb = vt + (kt & 1) * (32 * 72);
      if (SAMPLE && kt < 4) {
        const float* vp = cache + (size_t)(r + dl * (32 * kt + srow)) * 256 + 128 + shf;
#pragma unroll
        for (int c = 0; c < 4; ++c) {
          const float4 x0 = *(const float4*)(vp + 8 * c), x1 = *(const float4*)(vp + 8 * c + 4);
          uint4 o; o.x = pack2(x0.x, x0.y); o.y = pack2(x0.z, x0.w); o.z = pack2(x1.x, x1.y); o.w = pack2(x1.z, x1.w);
          *(uint4*)(vb + srow * 72 + shf + 8 * c) = o;
        }
      } else {
#pragma unroll
        for (int c = 0; c < 4; ++c) *(uint4*)(vb + srow * 72 + shf + 8 * c) = vraw[kt][c];
      }
#pragma unroll
      for (int s2 = 0; s2 < 2; ++s2) {
        bf16x8 v0, v1;
#pragma unroll
        for (int j = 0; j < 8; ++j) {
          const int kr = 16 * s2 + 8 * (j >> 2) + 4 * h + (j & 3);
          v0[j] = (short)vb[kr * 72 + qi]; v1[j] = (short)vb[kr * 72 + qi + 32];
        }
        oacc[0] = MFMA32(v0, pfa[kt][s2], oacc[0]);
        oacc[1] = MFMA32(v1, pfa[kt][s2], oacc[1]);
      }
    }
  }
  const float isum = 1.0f / sum;
  const size_t rowq = SAMPLE ? (size_t)NP + b * 8 + tq : (size_t)b * 2048 + tq;
  if (!SAMPLE || qi < nq) {
    float* op = p.opart + ((size_t)g * MT + rowq) * 128 + hslot * 64;
#pragma unroll
    for (int db = 0; db < 2; ++db)
#pragma unroll
      for (int i4 = 0; i4 < 4; ++i4) {
        float4 o; o.x = oacc[db][4 * i4] * isum; o.y = oacc[db][4 * i4 + 1] * isum; o.z = oacc[db][4 * i4 + 2] * isum; o.w = oacc[db][4 * i4 + 3] * isum;
        *(float4*)(op + db * 32 + 8 * i4 + 4 * h) = o;
      }
    if (h == 0) p.lse[((size_t)g * MT + rowq) * 2 + hslot] = mx + __logf(sum);
  }
}

__device__ __forceinline__ void kv_row_task(const Params& p, const int l, const int row, const int lane, const bf16x8 kr, const bf16x8 vr) {
  const int hl = lane < 48 ? lane : 47;
  const int head = hl >> 3, c8 = hl & 7;
  int b, t, ridx;
  const bool prompt = row < NP;
  if (prompt) { b = row >> 11; t = row & 2047; ridx = t; } else { b = (row - NP) >> 3; t = (row - NP) & 7; ridx = 2048 + t; }
  float f[8]; float ss = 0.f;
#pragma unroll
  for (int j = 0; j < 8; ++j) { f[j] = bfs2f(kr[j]); ss += f[j] * f[j]; }
  ss += __shfl_xor(ss, 1); ss += __shfl_xor(ss, 2); ss += __shfl_xor(ss, 4);
  const float inv = rsqrtf(ss * (1.0f / 64.0f) + EPS);
  const float* gk = p.k_norm_g + l * 64 + c8 * 8;
#pragma unroll
  for (int j = 0; j < 8; ++j) f[j] *= inv * gk[j];
  const float* rp = p.rope + ridx * 16;
#pragma unroll
  for (int j = 0; j < 8; ++j) {
    const float other = __shfl_xor(f[j], 1);
    const float cs = rp[j], sn = rp[8 + j];
    if (c8 == 0) f[j] = f[j] * cs - other * sn;
    else if (c8 == 1) f[j] = f[j] * cs + other * sn;
  }
  const int g = head >> 1, hh = head & 1;
  const int W = 128 << (2 * g);
  float* dst = nullptr;
  if (prompt) {
    const int r = t - (2048 - W);
    const size_t base = (g == 0) ? O_KV128P : (g == 1) ? O_KV512P : O_KV2048P;
    if (r >= 0) dst = p.out + base + ((size_t)(l * 8 + b) * W + r) * 256 + hh * 64 + c8 * 8;
  } else {
    const int r = W - 8 + t;
    const size_t base = (g == 0) ? O_KV128S : (g == 1) ? O_KV512S : O_KV2048S;
    dst = p.out + base + ((size_t)(l * 32 + b) * W + r) * 256 + hh * 64 + c8 * 8;
  }
  if (dst && lane < 48) {
    *(float4*)(dst) = make_float4(f[0], f[1], f[2], f[3]);
    *(float4*)(dst + 4) = make_float4(f[4], f[5], f[6], f[7]);
    *(float4*)(dst + 128) = make_float4(bfs2f(vr[0]), bfs2f(vr[1]), bfs2f(vr[2]), bfs2f(vr[3]));
    *(float4*)(dst + 132) = make_float4(bfs2f(vr[4]), bfs2f(vr[5]), bfs2f(vr[6]), bfs2f(vr[7]));
  }
}

__device__ __forceinline__ void phaseA(const Params& p, const int l, const int wave_s) {
  const int tid = opaque_tid(wave_s);
  const int lane = tid & 63, wid = tid >> 6;
  const int gw = blockIdx.x * 8 + wid, nw = gridDim.x * 8;
  for (int task = gw; task < 832 + 3072; task += nw) { if (task < 832) attn_task<true>(p, l, task, wid); else attn_task<false>(p, l, task - 832, wid); }
  for (int row0 = nw - 1 - gw; row0 < MT; row0 += 4 * nw) {
    const int hl = lane < 48 ? lane : 47;
    bf16x8 kr[4], vr[4];
#pragma unroll
    for (int u = 0; u < 4; ++u) {
      const int rc = min(row0 + u * nw, MT - 1);
      const u16* pr = p.proj + (size_t)rc * IC;
      kr[u] = *(const bf16x8*)(pr + C_K + hl * 8);
      vr[u] = *(const bf16x8*)(pr + C_V + hl * 8);
    }
#pragma unroll
    for (int u = 0; u < 4; ++u) if (row0 + u * nw < MT) kv_row_task(p, l, row0 + u * nw, lane, kr[u], vr[u]);
  }
}

template <int GRP>
__device__ __forceinline__ void pool_task(const Params& p, const int l, const int task, const int lane) {
  const int tile = task >> 2; constexpr int grp = GRP;
  const int qi = lane & 31, h = lane >> 5;
  const int row = tile * 32 + qi;
  constexpr int w = 2 << GRP;
  const bool prompt = row < NP;
  int n, t; float cnt;
  if (prompt) { n = row >> 11; t = row & 2047; cnt = (float)min(t + 1, w); } else { n = (row - NP) >> 3; t = (row - NP) & 7; cnt = (float)w; }
  const float icnt = 1.0f / cnt;
  f32x16 acc[2];
#pragma unroll
  for (int i = 0; i < 16; ++i) { acc[0][i] = 0.f; acc[1][i] = 0.f; }
  const u16* pw = p.pwT + (size_t)(l * 4 + grp) * 4096;
#pragma unroll
  for (int s = 0; s < 4; ++s) {
    const int c0 = grp * 64 + 16 * s + 8 * h;
    float sum[8], own[8];
#pragma unroll
    for (int j = 0; j < 8; ++j) { sum[j] = 0.f; own[j] = 0.f; }
#pragma unroll
    for (int i = 0; i < w; ++i) {
      const int tt = t - i;
      float v[8];
      if (tt >= 0) {
        const bf16x8 raw = *(const bf16x8*)(p.proj + (size_t)(row - i) * IC + C_U + c0);
#pragma unroll
        for (int j = 0; j < 8; ++j) v[j] = bfs2f(raw[j]);
      } else if (!prompt) {
        const float* sp = p.state_pool + ((size_t)(l * 32 + n) * 15 + 15 + tt) * 256 + c0;
        const float4 a = *(const float4*)sp, bb = *(const float4*)(sp + 4);
        v[0] = a.x; v[1] = a.y; v[2] = a.z; v[3] = a.w; v[4] = bb.x; v[5] = bb.y; v[6] = bb.z; v[7] = bb.w;
      } else {
#pragma unroll
        for (int j = 0; j < 8; ++j) v[j] = 0.f;
      }
#pragma unroll
      for (int j = 0; j < 8; ++j) sum[j] += v[j];
      if (i == 0) {
#pragma unroll
        for (int j = 0; j < 8; ++j) own[j] = v[j];
      }
    }
    const bf16x8 df = pack8(sum[0] * icnt - own[0], sum[1] * icnt - own[1], sum[2] * icnt - own[2], sum[3] * icnt - own[3],
                            sum[4] * icnt - own[4], sum[5] * icnt - own[5], sum[6] * icnt - own[6], sum[7] * icnt - own[7]);
    const bf16x8 a0 = *(const bf16x8*)(pw + (size_t)qi * 64 + 16 * s + 8 * h);
    const bf16x8 a1 = *(const bf16x8*)(pw + (size_t)(qi + 32) * 64 + 16 * s + 8 * h);
    acc[0] = MFMA32(a0, df, acc[0]);
    acc[1] = MFMA32(a1, df, acc[1]);
  }
  const float* ps = p.pool_scale + l * 256 + grp * 64;
  u16* mp = p.mixed + (size_t)row * MC + grp * 64;
#pragma unroll
  for (int db = 0; db < 2; ++db)
#pragma unroll
    for (int i4 = 0; i4 < 4; ++i4) {
      const int dd0 = db * 32 + 8 * i4 + 4 * h;
      const float4 sc = *(const float4*)(ps + dd0);
      uint2 o; o.x = pack2(acc[db][4 * i4] * sc.x, acc[db][4 * i4 + 1] * sc.y); o.y = pack2(acc[db][4 * i4 + 2] * sc.z, acc[db][4 * i4 + 3] * sc.w);
      *(uint2*)(mp + dd0) = o;
    }
}

__device__ __forceinline__ void phaseB(const Params& p, const int l, const int wave_s) {
  const int tid = opaque_tid(wave_s), lane = tid & 63, wid = tid >> 6;
  const int gw = blockIdx.x * 8 + wid, nw = gridDim.x * 8;
  const size_t gt = (size_t)blockIdx.x * 512 + tid, ntd = (size_t)gridDim.x * 512;
  {
    const bool spread = (nw == 2048);
    const int nit = spread ? 2 : (2080 + nw - 1) / nw;
    for (int it = 0; it < nit; ++it) {
      int task = gw + it * nw;
      if (spread && it == 1) task = ((gw & 63) == 0) ? 2048 + (gw >> 6) : 2080;
      if (task >= 2080) break;
      switch (task & 3) { case 0: pool_task<0>(p, l, task, lane); break; case 1: pool_task<1>(p, l, task, lane); break;
                          case 2: pool_task<2>(p, l, task, lane); break; default: pool_task<3>(p, l, task, lane); break; }
    }
  }
  for (size_t idx = gt; idx < (size_t)(MT / 4) * 48; idx += ntd) {
    const int row0 = (int)(idx / 48) * 4, ch = (int)(idx % 48) * 8;
    const bool prompt = row0 < NP;
    int n, t0;
    if (prompt) { n = row0 >> 11; t0 = row0 & 2047; } else { n = (row0 - NP) >> 3; t0 = (row0 - NP) & 7; }
    float z[6][8];
#pragma unroll
    for (int i = 0; i < 6; ++i) {
      const int tt = t0 - 2 + i;
      if (tt >= 0) {
        const u16* pr = p.proj + (size_t)(row0 - 2 + i) * IC;
        const bf16x8 gc = *(const bf16x8*)(pr + C_GC + ch), gh = *(const bf16x8*)(pr + C_GH + ch);
#pragma unroll
        for (int j = 0; j < 8; ++j) z[i][j] = bfs2f(gc[j]) * bfs2f(gh[j]);
      } else if (!prompt) {
        const float* sp = p.state_conv + ((size_t)(l * 32 + n) * 2 + 2 + tt) * 384 + ch;
        const float4 a = *(const float4*)sp, bb = *(const float4*)(sp + 4);
        z[i][0] = a.x; z[i][1] = a.y; z[i][2] = a.z; z[i][3] = a.w; z[i][4] = bb.x; z[i][5] = bb.y; z[i][6] = bb.z; z[i][7] = bb.w;
      } else {
#pragma unroll
        for (int j = 0; j < 8; ++j) z[i][j] = 0.f;
      }
    }
    const float* cw = p.conv_w + (size_t)l * 3 * 384 + ch;
    float c0[8], c1[8], c2[8];
#pragma unroll
    for (int j = 0; j < 8; ++j) { c0[j] = cw[j]; c1[j] = cw[384 + j]; c2[j] = cw[768 + j]; }
#pragma unroll
    for (int u = 0; u < 4; ++u) {
      const int row = row0 + u, t = t0 + u;
      const bf16x8 gb = *(const bf16x8*)(p.proj + (size_t)row * IC + C_GB + ch);
      float y[8];
#pragma unroll
      for (int j = 0; j < 8; ++j) y[j] = bfs2f(gb[j]) * (c0[j] * z[u][j] + c1[j] * z[u + 1][j] + c2[j] * z[u + 2][j]);
      uint4 o; o.x = pack2(y[0], y[1]); o.y = pack2(y[2], y[3]); o.z = pack2(y[4], y[5]); o.w = pack2(y[6], y[7]);
      *(uint4*)(p.mixed + (size_t)row * MC + 384 + ch) = o;
      float* so = nullptr;
      if (prompt) { if (t >= 2046) so = p.out + O_CONVP + ((size_t)(l * 8 + n) * 2 + (t - 2046)) * 384 + ch; }
      else { if (t >= 6) so = p.out + O_CONVS + ((size_t)(l * 32 + n) * 2 + (t - 6)) * 384 + ch; }
      if (so) { *(float4*)so = make_float4(z[u + 2][0], z[u + 2][1], z[u + 2][2], z[u + 2][3]); *(float4*)(so + 4) = make_float4(z[u + 2][4], z[u + 2][5], z[u + 2][6], z[u + 2][7]); }
    }
  }
  for (size_t idx0 = gt; idx0 < (size_t)MT * 16; idx0 += 2 * ntd) {
    float lg[2][3]; float4 pa[2][3], pb[2][3];
#pragma unroll
    for (int u = 0; u < 2; ++u) {
      const size_t idx = idx0 + u * ntd < (size_t)MT * 16 ? idx0 + u * ntd : idx0;
      const int row = (int)(idx >> 4), chunk = (int)(idx & 15);
      const int hslot = chunk >> 3, d0 = (chunk & 7) * 8;
#pragma unroll
      for (int g = 0; g < 3; ++g) {
        lg[u][g] = p.lse[((size_t)g * MT + row) * 2 + hslot];
        const float* op = p.opart + ((size_t)g * MT + row) * 128 + hslot * 64 + d0;
        pa[u][g] = *(const float4*)op; pb[u][g] = *(const float4*)(op + 4);
      }
    }
#pragma unroll
    for (int u = 0; u < 2; ++u) {
      const size_t idx = idx0 + u * ntd;
      if (idx < (size_t)MT * 16) {
        const int row = (int)(idx >> 4), chunk = (int)(idx & 15);
        const int hslot = chunk >> 3, d0 = (chunk & 7) * 8;
        const float m = fmaxf(lg[u][0], fmaxf(lg[u][1], lg[u][2]));
        float wg[3]; wg[0] = __expf(lg[u][0] - m); wg[1] = __expf(lg[u][1] - m); wg[2] = __expf(lg[u][2] - m);
        const float iw = 1.0f / (wg[0] + wg[1] + wg[2]);
        float y[8];
#pragma unroll
        for (int j = 0; j < 8; ++j) y[j] = 0.f;
#pragma unroll
        for (int g = 0; g < 3; ++g) {
          const float4 a = pa[u][g], bb = pb[u][g];
          const float ww = wg[g] * iw;
          y[0] += ww * a.x; y[1] += ww * a.y; y[2] += ww * a.z; y[3] += ww * a.w; y[4] += ww * bb.x; y[5] += ww * bb.y; y[6] += ww * bb.z; y[7] += ww * bb.w;
        }
        uint4 o; o.x = pack2(y[0], y[1]); o.y = pack2(y[2], y[3]); o.z = pack2(y[4], y[5]); o.w = pack2(y[6], y[7]);
        *(uint4*)(p.mixed + (size_t)row * MC + 256 + hslot * 64 + d0) = o;
      }
    }
  }
  for (size_t idx = gt; idx < (size_t)8 * 15 * 256; idx += ntd) {
    const int c = (int)(idx & 255); const int bi = (int)(idx >> 8); const int i = bi % 15, b = bi / 15;
    p.out[O_POOLP + (size_t)l * 8 * 15 * 256 + idx] = bf2f(p.proj[((size_t)b * 2048 + 2033 + i) * IC + C_U + c]);
  }
  for (size_t idx = gt; idx < (size_t)32 * 15 * 256; idx += ntd) {
    const int c = (int)(idx & 255); const int bi = (int)(idx >> 8); const int i = bi % 15, n = bi / 15;
    float v;
    if (i < 7) v = p.state_pool[((size_t)(l * 32 + n) * 15 + 8 + i) * 256 + c];
    else v = bf2f(p.proj[((size_t)NP + n * 8 + (i - 7)) * IC + C_U + c]);
    p.out[O_POOLS + (size_t)l * 32 * 15 * 256 + idx] = v;
  }
}

#ifndef PROBEV
#define PROBEV 0
#endif
#ifndef REPM
#define REPM 0
#endif
#define NREP(k) (1 + ((REPM >> (k)) & 1))
typedef const __attribute__((address_space(4))) Params* CP;
#if defined(__HIP_DEVICE_COMPILE__)
#define LOAD_PARAMS() CP pp_ = (CP)__builtin_amdgcn_kernarg_segment_ptr(); asm volatile("" : "+s"(pp_)); const Params p = *pp_
#else
#define LOAD_PARAMS() const Params& p = p_unused
#endif
__global__ void __launch_bounds__(512, 2) mega(const Params p_unused, const int ph_lo, const int ph_hi) {
  const int wave_s = __builtin_amdgcn_readfirstlane((int)(threadIdx.x >> 6));
  if (ph_hi == -12345) cg::this_grid().sync();
  {
    LOAD_PARAMS();
    if (opaque_tid(wave_s) == 0) {
      volatile __attribute__((address_space(3))) unsigned* st = (volatile __attribute__((address_space(3))) unsigned*)(smem + BAR_LDS_OFF);
      st[0] = 0u; st[1] = 0u;
      (void)xb_add(&p.bar[XB_XCNT(xb_xcc_id())], 1u);
    }
    __syncthreads();
  }
  int ph = 0;
#define IN_PH() (ph_lo <= ph && ph < ph_hi)
#define SEAM() do { if (ph_lo <= ph && ph + 1 < ph_hi) { LOAD_PARAMS(); grid_bar(p.bar, wave_s); } ++ph; } while (0)
  if (IN_PH()) for (int rep = 0; rep < NREP(0); ++rep) { LOAD_PARAMS(); phase0(p, wave_s); }
  SEAM();
#pragma unroll 1
  for (int l = 0; l < 2; ++l) {
    if (IN_PH()) for (int rep = 0; rep < NREP(1); ++rep) {
      LOAD_PARAMS();
      GemmEpi e{}; e.sumsq_in = p.sumsq + (size_t)(2 * l) * MT; e.out_bf = p.proj; e.ldo = IC;
      gemm_phase<1>(p.xg, p.wt_in + (size_t)l * IC * D, NP, IC, D, e, wave_s);
      { const int G = gridDim.x, first = (64 * (IC / 256)) % G;
        const int b0 = first ? first : 0, nb = G - b0;
        kv_shift_copy(p, l, b0, nb, opaque_tid(wave_s));
        sample_gemm64<1>(p.xg, p.wt_in + (size_t)l * IC * D, IC, D, e, wave_s, true); }
    }
    SEAM();
    if (IN_PH()) for (int rep = 0; rep < NREP(2); ++rep) { LOAD_PARAMS(); phaseA(p, l, wave_s); }
    SEAM();
    if (IN_PH()) for (int rep = 0; rep < NREP(3); ++rep) { LOAD_PARAMS(); phaseB(p, l, wave_s); }
    SEAM();
    if (IN_PH()) for (int rep = 0; rep < NREP(4); ++rep) {
      LOAD_PARAMS();
      GemmEpi e{};
      const bool last = (rep == NREP(4) - 1);
      e.xh = p.xg; e.xh_out = last ? p.xg : p.scr16; e.out_f = nullptr; e.sumsq_out = last ? p.sumsq + (size_t)(2 * l + 1) * MT : p.scrss;
      gemm_phase<2>(p.mixed, p.wt_out + (size_t)l * D * MC, NP, D, MC, e, wave_s, 0);
      sample_gemm<2>(p.mixed, p.wt_out + (size_t)l * D * MC, D, MC, e, wave_s, 0, gridDim.x);
    }
    SEAM();
    if (IN_PH()) for (int rep = 0; rep < NREP(5); ++rep) {
      LOAD_PARAMS();
      GemmEpi e{}; e.sumsq_in = p.sumsq + (size_t)(2 * l + 1) * MT; e.out_bf = p.hf; e.ldo = FF;
      gemm_phase<3>(p.xg, p.wt_up + (size_t)l * FF * D, NP, FF, D, e, wave_s, (rep && (PROBEV & 1)) ? 1 : 0);
      if (!(rep && (PROBEV & 2))) sample_gemm64<3>(p.xg, p.wt_up + (size_t)l * FF * D, FF, D, e, wave_s, false);
    }
    SEAM();
    if (IN_PH()) for (int rep = 0; rep < NREP(6); ++rep) {
      LOAD_PARAMS();
      GemmEpi e{};
      const bool last = (rep == NREP(6) - 1);
      e.xh = p.xg; e.xh_out = last ? p.xg : p.scr16;
      if (l == 0) { e.out_f = nullptr; e.sumsq_out = last ? p.sumsq + (size_t)2 * MT : p.scrss; } else { e.out_f = last ? p.out : p.scrf; e.sumsq_out = nullptr; }
      gemm_phase<2>(p.hf, p.wt_down + (size_t)l * D * FF, NP, D, FF, e, wave_s, 0);
      sample_gemm<2>(p.hf, p.wt_down + (size_t)l * D * FF, D, FF, e, wave_s, 0, gridDim.x);
    }
    SEAM();
  }
}

extern "C" void kernel_launch(void* const* d_in, const int* in_sizes, int n_in, void* d_out, int out_size, void* d_ws, size_t ws_size, hipStream_t stream) {
  static int grid_blocks = 0;
  if (!grid_blocks) {
    int dev = 0, cus = 0, per_cu = 0;
    hipGetDevice(&dev);
    hipDeviceGetAttribute(&cus, hipDeviceAttributeMultiprocessorCount, dev);
    hipFuncSetAttribute((const void*)mega, hipFuncAttributeMaxDynamicSharedMemorySize, GEMM_LDS);
    hipOccupancyMaxActiveBlocksPerMultiprocessor(&per_cu, (const void*)mega, 512, GEMM_LDS);
    if (per_cu < 1) { fprintf(stderr, "occupancy query returned %d\n", per_cu); per_cu = 1; }
    grid_blocks = cus * 1;
  }
  Params p{};
  p.x_prompt = (const float*)d_in[0]; p.x_sample = (const float*)d_in[1]; p.state_pool = (const float*)d_in[2]; p.state_conv = (const float*)d_in[3];
  p.kv_in[0] = (const float*)d_in[4]; p.kv_in[1] = (const float*)d_in[5]; p.kv_in[2] = (const float*)d_in[6];
  p.norm1_g = (const float*)d_in[7]; p.w_in = (const float*)d_in[8]; p.q_norm_g = (const float*)d_in[9]; p.k_norm_g = (const float*)d_in[10];
  p.pool_w = (const float*)d_in[11]; p.pool_scale = (const float*)d_in[12]; p.conv_w = (const float*)d_in[13]; p.w_out = (const float*)d_in[14];
  p.norm2_g = (const float*)d_in[15]; p.w_up = (const float*)d_in[16]; p.w_down = (const float*)d_in[17];
  p.out = (float*)d_out;
  unsigned char* w = (unsigned char*)d_ws; size_t off = 0;
  auto carve = [&](size_t bytes) { unsigned char* r = w + off; off += (bytes + 255) & ~(size_t)255; return r; };
  p.bar = (unsigned*)carve(XCD_BAR_WORDS * 4);
  p.wt_in = (u16*)carve((size_t)2 * IC * D * 2);
  p.wt_out = (u16*)carve((size_t)2 * D * MC * 2);
  p.wt_up = (u16*)carve((size_t)2 * FF * D * 2);
  p.wt_down = (u16*)carve((size_t)2 * D * FF * 2);
  p.pwT = (u16*)carve((size_t)2 * 4 * 4096 * 2);
  p.xg = (u16*)carve((size_t)MT * D * 2);
  p.mixed = (u16*)carve((size_t)MT * MC * 2);
  p.sumsq = (float*)carve((size_t)4 * MT * 4);
  p.lse = (float*)carve((size_t)3 * MT * 2 * 4);
  p.rope = (float*)carve((size_t)2056 * 16 * 4);
  p.scr16 = (u16*)carve((size_t)MT * D * 2); p.scrss = (float*)carve((size_t)MT * 4); p.scrf = (float*)carve((size_t)MT * D * 4);
  p.hf = (u16*)carve((size_t)MT * FF * 2);
  p.proj = p.hf;
  p.opart = (float*)((unsigned char*)p.hf + (((size_t)MT * IC * 2 + 255) & ~(size_t)255));
  if (off > ws_size) { fprintf(stderr, "workspace too small: need %zu have %zu\n", off, ws_size); return; }
  (void)hipMemsetAsync(p.bar, 0, XCD_BAR_WORDS * 4, stream);
  int lo = 0, hi = 13;
  void* args[] = {(void*)&p, (void*)&lo, (void*)&hi};
  hipError_t e = hipLaunchCooperativeKernel((const void*)mega, dim3(grid_blocks), dim3(512), args, GEMM_LDS, stream);
  if (e != hipSuccess) fprintf(stderr, "cooperative launch failed: %s (grid %d)\n", hipGetErrorString(e), grid_blocks);
}
```

```cpp
#include <hip/hip_runtime.h>
#include <hip/hip_cooperative_groups.h>
#include <cstdio>
namespace cg = cooperative_groups;

typedef unsigned short u16;
using bf16x8 = __attribute__((ext_vector_type(8))) short;
using f32x4 = __attribute__((ext_vector_type(4))) float;
using f32x16 = __attribute__((ext_vector_type(16))) float;

constexpr int NP = 16384, NS = 256, MT = NP + NS;
constexpr int D = 1024, IC = 2560, MC = 768, FF = 4096;
constexpr float EPS = 1e-6f;
constexpr int C_U = 0, C_Q = 256, C_K = 640, C_V = 1024, C_GB = 1408, C_GC = 1792, C_GH = 2176;
constexpr size_t O_YP = 0;
constexpr size_t O_YS = O_YP + (size_t)NP * D;
constexpr size_t O_POOLP = O_YS + (size_t)NS * D;
constexpr size_t O_CONVP = O_POOLP + 2 * 8 * 15 * 256;
constexpr size_t O_KV128P = O_CONVP + 2 * 8 * 2 * 384;
constexpr size_t O_KV512P = O_KV128P + (size_t)2 * 8 * 128 * 256;
constexpr size_t O_KV2048P = O_KV512P + (size_t)2 * 8 * 512 * 256;
constexpr size_t O_POOLS = O_KV2048P + (size_t)2 * 8 * 2048 * 256;
constexpr size_t O_CONVS = O_POOLS + 2 * 32 * 15 * 256;
constexpr size_t O_KV128S = O_CONVS + 2 * 32 * 2 * 384;
constexpr size_t O_KV512S = O_KV128S + (size_t)2 * 32 * 128 * 256;
constexpr size_t O_KV2048S = O_KV512S + (size_t)2 * 32 * 512 * 256;

struct Params {
  const float *x_prompt, *x_sample, *state_pool, *state_conv, *kv_in[3];
  const float *norm1_g, *w_in, *q_norm_g, *k_norm_g, *pool_w, *pool_scale, *conv_w, *w_out, *norm2_g, *w_up, *w_down;
  float* out;
  u16 *wt_in, *wt_out, *wt_up, *wt_down, *pwT;
  u16 *xg, *proj, *mixed, *hf;
  float *sumsq, *lse, *rope;
  u16* opart;
  unsigned* bar;
  u16* scr16; float* scrss; float* scrf;
};

extern __shared__ __attribute__((aligned(16))) unsigned char smem[];
typedef __attribute__((address_space(3))) void* LDSP;

typedef __bf16 bf16x2_t __attribute__((ext_vector_type(2)));
typedef float f32x2_t __attribute__((ext_vector_type(2)));
__device__ __forceinline__ unsigned pack2(float a, float b) { f32x2_t v = {a, b}; bf16x2_t r = __builtin_convertvector(v, bf16x2_t); return __builtin_bit_cast(unsigned, r); }
__device__ __forceinline__ u16 f2bf(float f) { return (u16)(pack2(f, 0.f) & 0xffffu); }
typedef unsigned u32x4_t __attribute__((ext_vector_type(4)));
__device__ __forceinline__ bf16x8 pack8(float a, float b, float c, float d, float e, float f, float g, float h) {
  u32x4_t t = {pack2(a, b), pack2(c, d), pack2(e, f), pack2(g, h)}; return __builtin_bit_cast(bf16x8, t); }
__device__ __forceinline__ float bf2f(u16 h) { return __uint_as_float(((unsigned)h) << 16); }
__device__ __forceinline__ float bfs2f(short h) { return __uint_as_float(((unsigned)(u16)h) << 16); }
__device__ __forceinline__ int opaque_tid(const int wave_s) {
  int l; asm volatile("v_mbcnt_lo_u32_b32 %0, -1, 0\n\tv_mbcnt_hi_u32_b32 %0, -1, %0" : "=v"(l));
  return wave_s * 64 + l;
}
__device__ __forceinline__ int opaque_lane() {
  int l; asm volatile("v_mbcnt_lo_u32_b32 %0, -1, 0\n\tv_mbcnt_hi_u32_b32 %0, -1, %0" : "=v"(l));
  return l;
}
#define XB_TMO      128
#define XB_XCNT(j)  (256  + 64 * (j))
#define XB_XSUB(j)  (1280 + 64 * (j))
#define XB_XGEN(j)  (2304 + 64 * (j))
#define XB_TOP      3328
#define XB_TOPGEN   3392
#define XCD_BAR_WORDS 3456
#define XB_SPIN_CAP (1u << 18)
constexpr int BAR_LDS_OFF = 131072;
__device__ __forceinline__ unsigned xb_ld(unsigned* p)              { return __hip_atomic_load(p, __ATOMIC_RELAXED, __HIP_MEMORY_SCOPE_AGENT); }
__device__ __forceinline__ unsigned xb_add(unsigned* p, unsigned v) { return __hip_atomic_fetch_add(p, v, __ATOMIC_RELAXED, __HIP_MEMORY_SCOPE_AGENT); }
__device__ __forceinline__ unsigned xb_xcc_id() { return (unsigned)__builtin_amdgcn_s_getreg((3 << 11) | 20) & 0xFu; }
#define XB_SPIN(cond, bar) do { unsigned _sp = 0; while (cond) { __builtin_amdgcn_s_sleep(1); \
    if ((++_sp & 255u) == 0u) { if (xb_ld(&(bar)[XB_TMO])) break; if (_sp > XB_SPIN_CAP) { atomicAdd(&(bar)[XB_TMO], 1u); break; } } } } while (0)
__device__ __forceinline__ void xcd_barrier_complete(unsigned* bar, unsigned x, unsigned& nloc, unsigned& nx) {
  const unsigned G = gridDim.x;
  unsigned sum, cnt, mine, sp = 0u;
  for (;;) {
    sum = 0u; cnt = 0u; mine = 0u;
#pragma unroll
    for (unsigned j = 0; j < 16; ++j) { const unsigned c = xb_ld(&bar[XB_XCNT(j)]); sum += c; cnt += (c > 0u) ? 1u : 0u; mine = (j == x) ? c : mine; }
    if (sum == G) break;
    __builtin_amdgcn_s_sleep(1);
    if ((++sp & 255u) == 0u) { if (xb_ld(&bar[XB_TMO])) break; if (sp > XB_SPIN_CAP) { atomicAdd(&bar[XB_TMO], 1u); break; } }
  }
  nloc = mine > 0u ? mine : 1u; nx = cnt > 0u ? cnt : 1u;
}
__device__ __forceinline__ void grid_bar(unsigned* bar, const int wave_s) {
  asm volatile("s_waitcnt vmcnt(0)" ::: "memory");
  __syncthreads();
  if (opaque_tid(wave_s) == 0) {
    volatile __attribute__((address_space(3))) unsigned* st = (volatile __attribute__((address_space(3))) unsigned*)(smem + BAR_LDS_OFF);
    const unsigned x = xb_xcc_id();
    __builtin_amdgcn_s_waitcnt(0);
    unsigned nloc = st[0], nx = st[1];
    if (nloc == 0u) { xcd_barrier_complete(bar, x, nloc, nx); st[0] = nloc; st[1] = nx; }
    const unsigned old = xb_add(&bar[XB_XSUB(x)], 1u);
    const unsigned gen = old / nloc;
    if (old + 1u == (gen + 1u) * nloc) {
      __builtin_amdgcn_fence(__ATOMIC_RELEASE, "agent");
      asm volatile("s_waitcnt vmcnt(0)" ::: "memory");
      const unsigned og = xb_add(&bar[XB_TOP], 1u);
      const unsigned tg = og / nx;
      if (og + 1u == (tg + 1u) * nx) xb_add(&bar[XB_TOPGEN], 1u);
      else XB_SPIN(xb_ld(&bar[XB_TOPGEN]) == tg, bar);
      __builtin_amdgcn_fence(__ATOMIC_ACQUIRE, "agent");
      xb_add(&bar[XB_XGEN(x)], 1u);
      asm volatile("s_waitcnt vmcnt(0)" ::: "memory");
    } else {
      XB_SPIN(xb_ld(&bar[XB_XGEN(x)]) == gen, bar);
      __builtin_amdgcn_fence(__ATOMIC_ACQUIRE, "agent");
      asm volatile("s_waitcnt vmcnt(0)" ::: "memory");
    }
  }
  __syncthreads();
}
__device__ __forceinline__ float wave_sum(float v) { for (int o = 32; o; o >>= 1) v += __shfl_xor(v, o); return v; }
__device__ __forceinline__ float wave_max(float v) { for (int o = 32; o; o >>= 1) v = fmaxf(v, __shfl_xor(v, o)); return v; }

constexpr int BM = 256, BK = 64, HALF = 128, NXCD = 8, WGM = 4, HT = HALF * BK;
constexpr int GEMM_LDS = 8 * HT * 2 + 16;

__device__ __forceinline__ int lds_byte(int r, int c) {
  int st = (r >> 4) * 2 + (c >> 5), rr = r & 15, cc = c & 31, ob = rr * 64 + cc * 2;
  return st * 1024 + (ob ^ (((ob >> 9) & 1) << 5));
}
__device__ __forceinline__ int perm32(int rho) { const int n = rho >> 4, i = rho & 15; return 8 * (i >> 2) + 4 * n + (i & 3); }
__device__ __forceinline__ void stage_rc(int b, int& R, int& C) {
  int st = b / 1024, sb = b % 1024, swz = sb ^ (((sb >> 9) & 1) << 5);
  R = (st >> 1) * 16 + swz / 64; C = (st & 1) * 32 + (swz % 64) / 2;
}

struct GemmEpi {
  const float* sumsq_in;
  u16* out_bf; int ldo;
  u16* xh;
  u16* xh_out;
  float* out_f;
  float* sumsq_out;
};

template <int MODE, bool ADD_RESID>
__device__ __forceinline__ void epi4(const GemmEpi& e, const f32x4 a, const float rs, const size_t grow, const int col0, float& ssq) {
  if (MODE == 1 || MODE == 3) {
    float v0 = a[0] * rs, v1 = a[1] * rs, v2 = a[2] * rs, v3 = a[3] * rs;
    if (MODE == 3) { v0 = fmaxf(v0, 0.f); v1 = fmaxf(v1, 0.f); v2 = fmaxf(v2, 0.f); v3 = fmaxf(v3, 0.f); v0 *= v0; v1 *= v1; v2 *= v2; v3 *= v3; }
    uint2 o; o.x = pack2(v0, v1); o.y = pack2(v2, v3);
    *(uint2*)(e.out_bf + grow * e.ldo + col0) = o;
  } else {
    float4 x; x.x = a[0]; x.y = a[1]; x.z = a[2]; x.w = a[3];
    if (ADD_RESID) {
      const uint2 r = *(const uint2*)(e.xh + grow * D + col0);
      x.x += __uint_as_float(r.x << 16); x.y += __uint_as_float(r.x & 0xffff0000u); x.z += __uint_as_float(r.y << 16); x.w += __uint_as_float(r.y & 0xffff0000u);
    }
    if (e.out_f) *(float4*)(e.out_f + grow * D + col0) = x;
    else { uint2 ob; ob.x = pack2(x.x, x.y); ob.y = pack2(x.z, x.w); *(uint2*)(e.xh_out + grow * D + col0) = ob; }
    ssq += x.x * x.x + x.y * x.y + x.z * x.z + x.w * x.w;
  }
}

template <int MODE>
__device__ __forceinline__ void epi8(const GemmEpi& e, const f32x4 a0, const f32x4 a1, const float rs, const size_t grow, const int col8, float& ssq) {
  float v[8] = {a0[0], a0[1], a0[2], a0[3], a1[0], a1[1], a1[2], a1[3]};
  if (MODE == 1 || MODE == 3) {
#pragma unroll
    for (int i = 0; i < 8; ++i) { v[i] *= rs; if (MODE == 3) { v[i] = fmaxf(v[i], 0.f); v[i] *= v[i]; } }
    uint4 o; o.x = pack2(v[0], v[1]); o.y = pack2(v[2], v[3]); o.z = pack2(v[4], v[5]); o.w = pack2(v[6], v[7]);
    *(uint4*)(e.out_bf + grow * e.ldo + col8) = o;
  } else {
    if (e.out_f) { *(float4*)(e.out_f + grow * D + col8) = make_float4(v[0], v[1], v[2], v[3]); *(float4*)(e.out_f + grow * D + col8 + 4) = make_float4(v[4], v[5], v[6], v[7]); }
    else { uint4 o; o.x = pack2(v[0], v[1]); o.y = pack2(v[2], v[3]); o.z = pack2(v[4], v[5]); o.w = pack2(v[6], v[7]); *(uint4*)(e.xh_out + grow * D + col8) = o; }
#pragma unroll
    for (int i = 0; i < 8; ++i) ssq += v[i] * v[i];
  }
}

template <int MODE>
__device__ __forceinline__ void gemm_phase(const u16* __restrict__ A, const u16* __restrict__ Bt, const int M, const int N, const int K, const GemmEpi e, const int wave_s, const int dry = 0) {
  u16* shm = (u16*)smem;
#define SA(b, h) (shm + ((b) * 2 + (h)) * HT)
#define SB(b, h) (shm + (4 + (b) * 2 + (h)) * HT)
#define STAGE_(P, RS, br, kt, o0, o1) do { const unsigned _so = (unsigned)(((br) * K + (kt) * BK) * 2); \
    __builtin_amdgcn_raw_ptr_buffer_load_lds(RS, (LDSP)((char*)(P) + tid0 * 16), 16, o0, _so, 0, 0); \
    __builtin_amdgcn_raw_ptr_buffer_load_lds(RS, (LDSP)((char*)(P) + tid0 * 16 + 8192), 16, o1, _so, 0, 0); } while (0)
#define STAGE(P, RS, br, kt) STAGE_(P, RS, br, kt, toff0, toff1)
#define STAGEB(P, RS, br, kt) STAGE_(P, RS, br, kt, toffb0, toffb1)
#define LDA(dst, b, h) for (int m = 0; m < 4; ++m) for (int k = 0; k < 2; ++k) \
    dst[m][k] = *reinterpret_cast<const bf16x8*>((char*)SA(b, h) + lds_byte(wr * 64 + m * 16 + fr, k * 32 + fq * 8))
#define LDB(dst, b, h) for (int n = 0; n < 2; ++n) for (int k = 0; k < 2; ++k) \
    dst[n][k] = *reinterpret_cast<const bf16x8*>((char*)SB(b, h) + lds_byte(wc * 32 + n * 16 + fr, k * 32 + fq * 8))
#define MMA(ai, bj, At, Bt_) do { __builtin_amdgcn_s_setprio(1); \
    for (int m = 0; m < 4; ++m) for (int n = 0; n < 2; ++n) for (int k = 0; k < 2; ++k) \
      acc[ai][bj][m][n] = __builtin_amdgcn_mfma_f32_16x16x32_bf16(Bt_[n][k], At[m][k], acc[ai][bj][m][n], 0, 0, 0); \
    __builtin_amdgcn_s_setprio(0); } while (0)
#define WAIT_V(n) asm volatile("s_waitcnt vmcnt(" #n ")" ::: "memory")
#define WAIT_L(n) asm volatile("s_waitcnt lgkmcnt(" #n ")" ::: "memory")
#define BAR __builtin_amdgcn_s_barrier()
#define SCHED __builtin_amdgcn_sched_barrier(0)
#define DECODE(tt_, brow_, bcol_) do { int wgid = (tt_); \
    { int q = nwg / NXCD, r = nwg % NXCD, xcd = wgid % NXCD, off = wgid / NXCD; \
      wgid = (xcd < r ? xcd * (q + 1) : r * (q + 1) + (xcd - r) * q) + off; } \
    int nig = WGM * nN, gid = wgid / nig, fm = gid * WGM, gsz = min(nM - fm, WGM); \
    brow_ = (fm + ((wgid % nig) % gsz)) * BM; bcol_ = ((wgid % nig) / gsz) * BM; } while (0)
#define STAGE7(brow_, bcol_) do { \
    STAGEB(SB(0, 0), rsB, bcol_, 0); STAGE(SA(0, 0), rsA, brow_, 0); \
    STAGEB(SB(0, 1), rsB, bcol_ + HALF, 0); STAGE(SA(0, 1), rsA, brow_ + HALF, 0); \
    STAGEB(SB(1, 0), rsB, bcol_, 1); STAGE(SA(1, 0), rsA, brow_, 1); STAGEB(SB(1, 1), rsB, bcol_ + HALF, 1); } while (0)

  const int nM = M / BM, nN = N / BM, nwg = nM * nN;
  const int nt = K / BK;
  unsigned toff0, toff1;
  const int tid0 = opaque_tid(wave_s);
  const int wr = (tid0 >> 6) >> 2, wc = (tid0 >> 6) & 3, fr = tid0 & 15, fq = (tid0 & 63) >> 4;
  unsigned toffb0, toffb1;
  { int r_, c_; stage_rc(tid0 * 16, r_, c_); toff0 = (unsigned)(r_ * K + c_) * 2u; toffb0 = (unsigned)(((r_ & ~31) | perm32(r_ & 31)) * K + c_) * 2u;
    stage_rc(tid0 * 16 + 8192, r_, c_); toff1 = (unsigned)(r_ * K + c_) * 2u; toffb1 = (unsigned)(((r_ & ~31) | perm32(r_ & 31)) * K + c_) * 2u; }
  const __amdgpu_buffer_rsrc_t rsA = __builtin_amdgcn_make_buffer_rsrc((void*)A, 0, -1, 0x00020000);
  const __amdgpu_buffer_rsrc_t rsB = __builtin_amdgcn_make_buffer_rsrc((void*)Bt, 0, -1, 0x00020000);
  int tt = blockIdx.x;
  int brow = 0, bcol = 0;
  if (tt < nwg) { DECODE(tt, brow, bcol); STAGE7(brow, bcol); WAIT_V(0); }
  f32x4 acc[2][2][4][2];
#define ACC_INIT(brow_, bcol_) do { \
    if (MODE == 2) { \
      const int t2 = opaque_tid(wave_s); const int wr_ = (t2 >> 6) >> 2, wc_ = (t2 >> 6) & 3, fr_ = t2 & 15, fq_ = (t2 & 63) >> 4; \
      const u16* rp_ = e.xh + (size_t)(brow_ + wr_ * 64 + fr_) * D + bcol_ + wc_ * 32 + fq_ * 8; \
      _Pragma("unroll") for (int ai = 0; ai < 2; ++ai) _Pragma("unroll") for (int bj = 0; bj < 2; ++bj) \
      _Pragma("unroll") for (int m = 0; m < 4; ++m) { \
        const uint4 x0 = *(const uint4*)(rp_ + (size_t)(ai * HALF + m * 16) * D + bj * HALF); \
        acc[ai][bj][m][0][0] = __uint_as_float(x0.x << 16); acc[ai][bj][m][0][1] = __uint_as_float(x0.x & 0xffff0000u); \
        acc[ai][bj][m][0][2] = __uint_as_float(x0.y << 16); acc[ai][bj][m][0][3] = __uint_as_float(x0.y & 0xffff0000u); \
        acc[ai][bj][m][1][0] = __uint_as_float(x0.z << 16); acc[ai][bj][m][1][1] = __uint_as_float(x0.z & 0xffff0000u); \
        acc[ai][bj][m][1][2] = __uint_as_float(x0.w << 16); acc[ai][bj][m][1][3] = __uint_as_float(x0.w & 0xffff0000u); } \
    } else { \
      _Pragma("unroll") for (int ai = 0; ai < 2; ++ai) _Pragma("unroll") for (int bj = 0; bj < 2; ++bj) \
      _Pragma("unroll") for (int m = 0; m < 4; ++m) _Pragma("unroll") for (int n = 0; n < 2; ++n) \
        acc[ai][bj][m][n] = (f32x4){0.f, 0.f, 0.f, 0.f}; \
    } } while (0)
  if (tt < nwg) ACC_INIT(brow, bcol);
  while (tt < nwg) {
    bf16x8 At[4][2], B0[2][2], B1[2][2];
    if (wr == 1) BAR;
    BAR;
    for (int t = 0; t < nt - 2; t += 2) {
      LDB(B0, 0, 0); SCHED; LDA(At, 0, 0); STAGE(SA(1, 1), rsA, brow + HALF, t + 1);
      WAIT_L(8); BAR; WAIT_L(0); MMA(0, 0, At, B0); BAR; SCHED;
      LDB(B1, 0, 1); STAGEB(SB(0, 0), rsB, bcol, t + 2);
      BAR; WAIT_L(0); MMA(0, 1, At, B1); BAR;
      LDA(At, 0, 1); STAGE(SA(0, 0), rsA, brow, t + 2);
      BAR; WAIT_L(0); MMA(1, 0, At, B0); BAR; SCHED;
      STAGEB(SB(0, 1), rsB, bcol + HALF, t + 2);
      WAIT_V(6); BAR; MMA(1, 1, At, B1); BAR;
      LDB(B0, 1, 0); SCHED; LDA(At, 1, 0); STAGE(SA(0, 1), rsA, brow + HALF, t + 2);
      WAIT_L(8); BAR; WAIT_L(0); MMA(0, 0, At, B0); BAR; SCHED;
      LDB(B1, 1, 1); STAGEB(SB(1, 0), rsB, bcol, t + 3);
      BAR; WAIT_L(0); MMA(0, 1, At, B1); BAR;
      LDA(At, 1, 1); STAGE(SA(1, 0), rsA, brow, t + 3);
      BAR; WAIT_L(0); MMA(1, 0, At, B0); BAR; SCHED;
      STAGEB(SB(1, 1), rsB, bcol + HALF, t + 3);
      WAIT_V(6); BAR; MMA(1, 1, At, B1); BAR;
    }
    { LDB(B0, 0, 0); LDA(At, 0, 0); STAGE(SA(1, 1), rsA, brow + HALF, nt - 1);
      BAR; WAIT_L(0); MMA(0, 0, At, B0); BAR;
      LDB(B1, 0, 1); BAR; WAIT_L(0); MMA(0, 1, At, B1); BAR;
      LDA(At, 0, 1); WAIT_V(4); BAR; WAIT_L(0); MMA(1, 0, At, B0); MMA(1, 1, At, B1); BAR; }
    { LDB(B0, 1, 0); LDA(At, 1, 0); WAIT_V(2); BAR; WAIT_L(0); MMA(0, 0, At, B0); BAR;
      LDB(B1, 1, 1); WAIT_V(0); BAR; WAIT_L(0); MMA(0, 1, At, B1); BAR;
      LDA(At, 1, 1); BAR; WAIT_L(0); MMA(1, 0, At, B0); MMA(1, 1, At, B1); BAR; }
    if (wr == 0) BAR;
    const int erow = brow, ecol = bcol;
    tt += gridDim.x;
    if (tt < nwg) { DECODE(tt, brow, bcol); STAGE7(brow, bcol); }
    SCHED;
    if (!dry) {
      const int tid1 = opaque_tid(wave_s);
      const int wr = (tid1 >> 6) >> 2, wc = (tid1 >> 6) & 3, fr = tid1 & 15, fq = (tid1 & 63) >> 4;
      float rsv[2][4];
#pragma unroll
      for (int ai = 0; ai < 2; ++ai)
#pragma unroll
        for (int m = 0; m < 4; ++m) {
          rsv[ai][m] = 0.f;
          if (MODE == 1 || MODE == 3) rsv[ai][m] = e.sumsq_in[(size_t)erow + ai * HALF + wr * 64 + m * 16 + fr];
        }
#pragma unroll
      for (int ai = 0; ai < 2; ++ai)
#pragma unroll
        for (int m = 0; m < 4; ++m) {
          const int lrow = ai * HALF + wr * 64 + m * 16 + fr;
          const size_t grow = (size_t)erow + lrow;
          float rs = 0.f, ssq = 0.f;
          if (MODE == 1 || MODE == 3) rs = rsqrtf(rsv[ai][m] * (1.0f / 1024.0f) + EPS);
#pragma unroll
          for (int bj = 0; bj < 2; ++bj)
            epi8<MODE>(e, acc[ai][bj][m][0], acc[ai][bj][m][1], rs, grow, ecol + bj * HALF + wc * 32 + fq * 8, ssq);
          if (MODE == 2 && e.sumsq_out) {
            ssq += __shfl_xor(ssq, 16); ssq += __shfl_xor(ssq, 32);
            if (fq == 0) atomicAdd(e.sumsq_out + grow, ssq);
          }
          SCHED;
        }
    }
    if (tt < nwg) ACC_INIT(brow, bcol);
    if (dry) WAIT_V(0); else WAIT_V(16);
  }
  WAIT_V(0);
#undef SA
#undef SB
#undef STAGE
#undef STAGEB
#undef STAGE_
#undef LDA
#undef LDB
#undef MMA
}

#define MFMA32(a, b, c) __builtin_amdgcn_mfma_f32_32x32x16_bf16((a), (b), (c), 0, 0, 0)

template <int MODE>
__device__ __forceinline__ void sample_gemm(const u16* __restrict__ A, const u16* __restrict__ Bt, const int N, const int K, const GemmEpi e, const int wave_s, const int b0, const int nb) {
  const int bi = (int)blockIdx.x - b0;
  if (bi < 0 || bi >= nb) return;
  const int tid = opaque_tid(wave_s);
  const int lane = tid & 63, wid = tid >> 6;
  const int i = lane & 31, h = lane >> 5;
  const int ntask = 8 * (N / 32);
  const int ks = K / 8;
  float* red = (float*)smem;
  for (int id = bi; id < ntask; id += nb) {
    const int r0 = (id & 7) * 32, c0 = (id >> 3) * 32;
    const u16* ap = A + (size_t)(NP + r0 + i) * K + wid * ks + 8 * h;
    const u16* bp = Bt + (size_t)(c0 + i) * K + wid * ks + 8 * h;
    f32x16 acc;
#pragma unroll
    for (int q = 0; q < 16; ++q) acc[q] = 0.f;
#pragma unroll 16
    for (int k = 0; k < ks; k += 16) {
      const bf16x8 a = *(const bf16x8*)(ap + k);
      const bf16x8 b = *(const bf16x8*)(bp + k);
      acc = MFMA32(b, a, acc);
    }
#pragma unroll
    for (int q = 0; q < 4; ++q)
      *(float4*)(red + (wid * 32 + i) * 36 + 8 * q + 4 * h) = make_float4(acc[4 * q], acc[4 * q + 1], acc[4 * q + 2], acc[4 * q + 3]);
    __syncthreads();
    if (tid < 256) {
      const int row = tid >> 3, c4 = (tid & 7) * 4;
      f32x4 s4; s4[0] = 0.f; s4[1] = 0.f; s4[2] = 0.f; s4[3] = 0.f;
#pragma unroll
      for (int w = 0; w < 8; ++w) {
        const float4 v = *(const float4*)(red + (w * 32 + row) * 36 + c4);
        s4[0] += v.x; s4[1] += v.y; s4[2] += v.z; s4[3] += v.w;
      }
      const int srow = r0 + row, col0 = c0 + c4;
      const size_t grow = (size_t)NP + srow;
      float rs = 0.f, ssq = 0.f;
      if (MODE == 1 || MODE == 3) rs = rsqrtf(e.sumsq_in[grow] * (1.0f / 1024.0f) + EPS);
      epi4<MODE, true>(e, s4, rs, grow, col0, ssq);
      if (MODE == 2 && e.sumsq_out) {
        ssq += __shfl_xor(ssq, 1); ssq += __shfl_xor(ssq, 2); ssq += __shfl_xor(ssq, 4);
        if ((tid & 7) == 0) atomicAdd(e.sumsq_out + grow, ssq);
      }
    }
    __syncthreads();
  }
}

template <int MODE>
__device__ __forceinline__ void sample_gemm64(const u16* __restrict__ A, const u16* __restrict__ Bt, const int N, const int K, const GemmEpi e, const int wave_s, const bool reverse) {
  const int tid = opaque_tid(wave_s);
  const int lane = tid & 63, wid = tid >> 6;
  const int i = lane & 31, h = lane >> 5;
  const int ri = wid & 1, ci = (wid >> 1) & 1, kh = wid >> 2;
  const int ntask = 4 * (N / 64);
  const int kspan = K / 2;
  float* red = (float*)smem;
  const int G = gridDim.x;
  for (int id = reverse ? G - 1 - (int)blockIdx.x : (int)blockIdx.x; id < ntask; id += G) {
    const int r0 = (id & 3) * 64 + ri * 32, c0 = (id >> 2) * 64 + ci * 32;
    const u16* ap = A + (size_t)(NP + r0 + i) * K + kh * kspan + 8 * h;
    const u16* bp = Bt + (size_t)(c0 + i) * K + kh * kspan + 8 * h;
    f32x16 acc;
#pragma unroll
    for (int q = 0; q < 16; ++q) acc[q] = 0.f;
#pragma unroll 16
    for (int k = 0; k < kspan; k += 16) {
      const bf16x8 a = *(const bf16x8*)(ap + k);
      const bf16x8 b = *(const bf16x8*)(bp + k);
      acc = MFMA32(b, a, acc);
    }
    float* rb = red + ((wid & 3) * 32 + i) * 36 + 4 * h;
    if (kh == 1) {
#pragma unroll
      for (int q = 0; q < 4; ++q) *(float4*)(rb + 8 * q) = make_float4(acc[4 * q], acc[4 * q + 1], acc[4 * q + 2], acc[4 * q + 3]);
    }
    __syncthreads();
    if (kh == 0) {
      const size_t grow = (size_t)NP + r0 + i;
      const float rs = rsqrtf(e.sumsq_in[grow] * (1.0f / 1024.0f) + EPS);
      float ssq = 0.f;
#pragma unroll
      for (int q = 0; q < 4; ++q) {
        const float4 o = *(const float4*)(rb + 8 * q);
        f32x4 a4; a4[0] = acc[4 * q] + o.x; a4[1] = acc[4 * q + 1] + o.y; a4[2] = acc[4 * q + 2] + o.z; a4[3] = acc[4 * q + 3] + o.w;
        epi4<MODE, false>(e, a4, rs, grow, c0 + 8 * q + 4 * h, ssq);
      }
    }
    __syncthreads();
  }
}

__device__ __forceinline__ void kv_shift_copy(const Params& p, const int l, const int b0, const int nb, const int tid) {
  const int bi = (int)blockIdx.x - b0;
  if (bi < 0 || bi >= nb) return;
  const size_t gt = (size_t)bi * 512 + tid, ntd = (size_t)nb * 512;
#pragma unroll
  for (int g = 0; g < 3; ++g) {
    const int W = 128 << (2 * g);
    const size_t n4 = (size_t)32 * W * 64;
    const size_t oo = (g == 0) ? O_KV128S : (g == 1) ? O_KV512S : O_KV2048S;
    const f32x4* src = (const f32x4*)p.kv_in[g] + (size_t)l * n4;
    f32x4* dst = (f32x4*)(p.out + oo) + (size_t)l * n4;
    const unsigned per = (unsigned)W * 64u, lim = (unsigned)(W - 8) * 64u;
    for (size_t i0 = gt; i0 < n4; i0 += ntd * 8) {
      f32x4 v[8];
#pragma unroll
      for (int k = 0; k < 8; ++k) {
        const size_t i = i0 + (size_t)k * ntd;
        v[k] = (f32x4){0.f, 0.f, 0.f, 0.f};
        if (i < n4 && ((unsigned)i % per) < lim) v[k] = __builtin_nontemporal_load(src + i + 512);
      }
#pragma unroll
      for (int k = 0; k < 8; ++k) {
        const size_t i = i0 + (size_t)k * ntd;
        if (i < n4 && ((unsigned)i % per) < lim) __builtin_nontemporal_store(v[k], dst + i);
      }
    }
  }
}

__device__ __forceinline__ void tr_tile(const float* __restrict__ src, u16* __restrict__ dst, int K, int N, int k0, int n0, const int tid, const float* __restrict__ gain) {
  float* lt = (float*)smem;
  { const int kk = tid >> 4, n4 = tid & 15;
#pragma unroll
    for (int i = 0; i < 2; ++i) {
      const int k = kk + i * 32;
      const float4 v = *(const float4*)(src + (size_t)(k0 + k) * N + n0 + n4 * 4);
      float* d = lt + k * 65 + n4 * 4;
      d[0] = v.x; d[1] = v.y; d[2] = v.z; d[3] = v.w;
    } }
  __syncthreads();
  { const int n = tid >> 3, k8 = tid & 7;
    float f[8];
#pragma unroll
    for (int i = 0; i < 8; ++i) f[i] = lt[(k8 * 8 + i) * 65 + n] * (gain ? gain[k0 + k8 * 8 + i] : 1.0f);
    uint4 o; o.x = pack2(f[0], f[1]); o.y = pack2(f[2], f[3]); o.z = pack2(f[4], f[5]); o.w = pack2(f[6], f[7]);
    *(uint4*)(dst + (size_t)(n0 + n) * K + k0 + k8 * 8) = o; }
  __syncthreads();
}

__device__ __forceinline__ void phase0(const Params& p, const int wave_s) {
  const int tid = opaque_tid(wave_s), lane = tid & 63, wid = tid >> 6;
  const int gw = blockIdx.x * 8 + wid, nw = gridDim.x * 8;
  const size_t gt = (size_t)blockIdx.x * 512 + tid, ntd = (size_t)gridDim.x * 512;
  for (int row0 = gw; row0 < MT; row0 += 2 * nw) {
    float4 v[2][4];
#pragma unroll
    for (int u = 0; u < 2; ++u) {
      const int row = min(row0 + u * nw, MT - 1);
      const float4* xr = (const float4*)(row < NP ? p.x_prompt + (size_t)row * D : p.x_sample + (size_t)(row - NP) * D);
#pragma unroll
      for (int i = 0; i < 4; ++i) v[u][i] = xr[lane + 64 * i];
    }
#pragma unroll
    for (int u = 0; u < 2; ++u) {
      const int row = row0 + u * nw;
      if (row < MT) {
        float ss = 0.f;
#pragma unroll
        for (int i = 0; i < 4; ++i) {
          const float4 x = v[u][i];
          ss += x.x * x.x + x.y * x.y + x.z * x.z + x.w * x.w;
          uint2 o; o.x = pack2(x.x, x.y); o.y = pack2(x.z, x.w);
          *(uint2*)(p.xg + (size_t)row * D + (lane + 64 * i) * 4) = o;
        }
        ss = wave_sum(ss);
        if (lane == 0) p.sumsq[row] = ss;
      }
    }
  }
  for (size_t i = gt; i < (size_t)3 * MT; i += ntd) p.sumsq[MT + i] = 0.f;
  for (size_t i = gt; i < (size_t)2056 * 8; i += ntd) {
    const int pi = (int)(i >> 3), fi = (int)(i & 7);
    const int pos = pi < 2048 ? pi : 8192 + (pi - 2048);
    float inv;
    switch (fi) { case 0: inv = 1.0f; break; case 1: inv = 0.1939227432012558f; break; case 2: inv = 0.03760603070259094f; break;
      case 3: inv = 0.007292664609849453f; break; case 4: inv = 0.0014142135623842478f; break; case 5: inv = 0.00027424818836152554f; break;
      case 6: inv = 5.318296098266728e-05f; break; default: inv = 1.0313386155758053e-05f; break; }
    const float ang = (float)pos * inv;
    p.rope[pi * 16 + fi] = cosf(ang);
    p.rope[pi * 16 + 8 + fi] = sinf(ang);
  }
  {
    float* lt = (float*)smem;
    constexpr int QL = (640 + 192 + 1024 + 1024) / 4;
    for (int t = blockIdx.x; t < 2 * QL; t += gridDim.x) {
      const int l = t / QL; int r = t % QL;
      const float* src; u16* dst; int K, N; const float* gain = nullptr;
      if (r < 160) { src = p.w_in + (size_t)l * D * IC; dst = p.wt_in + (size_t)l * IC * D; K = D; N = IC; gain = p.norm1_g + l * D; }
      else if (r < 208) { r -= 160; src = p.w_out + (size_t)l * MC * D; dst = p.wt_out + (size_t)l * D * MC; K = MC; N = D; }
      else if (r < 464) { r -= 208; src = p.w_up + (size_t)l * D * FF; dst = p.wt_up + (size_t)l * FF * D; K = D; N = FF; gain = p.norm2_g + l * D; }
      else { r -= 464; src = p.w_down + (size_t)l * FF * D; dst = p.wt_down + (size_t)l * D * FF; K = FF; N = D; }
      const int nq = N / 256;
      const int k0 = (r / nq) * 64, n0 = (r % nq) * 256;
      { const int kk = tid >> 6, n4 = tid & 63;
        float4 v[8];
#pragma unroll
        for (int i = 0; i < 8; ++i) v[i] = *(const float4*)(src + (size_t)(k0 + kk + 8 * i) * N + n0 + n4 * 4);
#pragma unroll
        for (int i = 0; i < 8; ++i) {
          const float gg = gain ? gain[k0 + kk + 8 * i] : 1.0f;
          *(float4*)(lt + (kk + 8 * i) * 260 + n4 * 4) = make_float4(v[i].x * gg, v[i].y * gg, v[i].z * gg, v[i].w * gg);
        } }
      __syncthreads();
      { const int n = tid >> 1, kh = (tid & 1) * 32;
        u16* dp = dst + (size_t)(n0 + n) * K + k0 + kh;
#pragma unroll
        for (int c = 0; c < 4; ++c) {
          float f[8];
#pragma unroll
          for (int i = 0; i < 8; ++i) f[i] = lt[(kh + c * 8 + i) * 260 + n];
          uint4 o; o.x = pack2(f[0], f[1]); o.y = pack2(f[2], f[3]); o.z = pack2(f[4], f[5]); o.w = pack2(f[6], f[7]);
          *(uint4*)(dp + c * 8) = o;
        } }
      __syncthreads();
    }
    for (int t = blockIdx.x; t < 8; t += gridDim.x)
      tr_tile(p.pool_w + (size_t)t * 4096, p.pwT + (size_t)t * 4096, 64, 64, 0, 0, tid, nullptr);
  }
}


__device__ __forceinline__ void qk_raw(const u16* __restrict__ rowp, bf16x8 raw[4], const int h) {
#pragma unroll
  for (int s = 0; s < 4; ++s) raw[s] = *(const bf16x8*)(rowp + 16 * s + 8 * h);
}
__device__ __forceinline__ void qk_finish(const bf16x8 raw[4], const float* __restrict__ ropep, const float* __restrict__ gain,
                                          const float scale, bf16x8 out[4], const int h) {
  float f[4][8];
  float ss = 0.f;
#pragma unroll
  for (int s = 0; s < 4; ++s) {
#pragma unroll
    for (int j = 0; j < 8; ++j) { f[s][j] = bfs2f(raw[s][j]); ss += f[s][j] * f[s][j]; }
  }
  ss += __shfl_xor(ss, 32);
  const float inv = rsqrtf(ss * (1.0f / 64.0f) + EPS);
#pragma unroll
  for (int s = 0; s < 4; ++s) {
    const float4 g0 = *(const float4*)(gain + 16 * s + 8 * h), g1 = *(const float4*)(gain + 16 * s + 8 * h + 4);
    f[s][0] *= inv * g0.x; f[s][1] *= inv * g0.y; f[s][2] *= inv * g0.z; f[s][3] *= inv * g0.w;
    f[s][4] *= inv * g1.x; f[s][5] *= inv * g1.y; f[s][6] *= inv * g1.z; f[s][7] *= inv * g1.w;
  }
  {
    const float4 c0 = *(const float4*)(ropep), c1 = *(const float4*)(ropep + 4), s0 = *(const float4*)(ropep + 8), s1 = *(const float4*)(ropep + 12);
    const float cs[8] = {c0.x, c0.y, c0.z, c0.w, c1.x, c1.y, c1.z, c1.w};
    const float sn[8] = {s0.x, s0.y, s0.z, s0.w, s1.x, s1.y, s1.z, s1.w};
#pragma unroll
    for (int j = 0; j < 8; ++j) {
      const float other = __shfl_xor(f[0][j], 32);
      f[0][j] = (h == 0) ? (f[0][j] * cs[j] - other * sn[j]) : (f[0][j] * cs[j] + other * sn[j]);
    }
  }
#pragma unroll
  for (int s = 0; s < 4; ++s)
    out[s] = pack8(f[s][0] * scale, f[s][1] * scale, f[s][2] * scale, f[s][3] * scale, f[s][4] * scale, f[s][5] * scale, f[s][6] * scale, f[s][7] * scale);
}

template <bool SAMPLE>
__device__ __forceinline__ void attn_task(const Params& p, const int layer, const int task, const int wid) {
  const int lane = opaque_lane();
  int g, hslot, b, r, tile, nq;
  if (!SAMPLE) {
    const int c = task & 63; int tmp = task >> 6; g = tmp % 3; tmp /= 3; hslot = tmp & 1; b = tmp >> 1;
    const int tpc = 64 >> (2 * g);
    r = c / tpc; tile = c % tpc; nq = 32;
  } else {
    b = task / 26; const int rem = task % 26; hslot = rem / 13; const int c = rem % 13;
    if (c == 0) { g = 0; r = 0; nq = 8; } else if (c < 5) { g = 1; r = c - 1; nq = 2; } else { g = 2; r = c - 5; nq = 1; }
    tile = 4;
  }
  const int dl = 1 << (2 * g);
  const int W = 128 << (2 * g);
  const int m0 = tile * 32;
  const int head = 2 * g + hslot;
  const u16* projb = SAMPLE ? p.proj + (size_t)(NP + b * 8) * IC : p.proj + (size_t)b * 2048 * IC;
  const int ropeb = SAMPLE ? 2048 : 0;
  const float* cache = SAMPLE ? ((g == 0) ? p.kv_in[0] : (g == 1) ? p.kv_in[1] : p.kv_in[2]) + (size_t)(layer * 32 + b) * W * 256 + hslot * 64 : nullptr;
  const int qi = lane & 31, h = lane >> 5;
  int tq;
  if (SAMPLE) tq = r + dl * (qi < nq ? qi : 0); else tq = (m0 + qi) * dl + r;
  const int kt_lo = SAMPLE ? 0 : max(0, 4 - tile);
  bf16x8 qraw[4], kraw[5][4];
  qk_raw(projb + (size_t)tq * IC + C_Q + head * 64, qraw, h);
#pragma unroll
  for (int kt = 0; kt < 5; ++kt) {
    if (kt >= kt_lo && !(SAMPLE && kt < 4)) {
      int tk;
      if (SAMPLE) tk = r + dl * (qi < nq ? qi : 0); else tk = (m0 - 128 + 32 * kt + qi) * dl + r;
      qk_raw(projb + (size_t)tk * IC + C_K + head * 64, kraw[kt], h);
    } else {
#pragma unroll
      for (int s = 0; s < 4; ++s) kraw[kt][s] = (bf16x8){0, 0, 0, 0, 0, 0, 0, 0};
    }
  }
  bf16x8 qf[4];
  qk_finish(qraw, p.rope + (ropeb + tq) * 16, p.q_norm_g + layer * 64, 0.125f, qf, h);
  f32x16 sacc[5];
#pragma unroll
  for (int kt = 0; kt < 5; ++kt) {
#pragma unroll
    for (int i = 0; i < 16; ++i) sacc[kt][i] = 0.f;
    if (kt >= kt_lo) {
      bf16x8 kf[4];
      if (SAMPLE && kt < 4) {
        const float* kp = cache + (size_t)(r + dl * (32 * kt + qi)) * 256 + 8 * h;
#pragma unroll
        for (int s = 0; s < 4; ++s) {
          const float4 x0 = *(const float4*)(kp + 16 * s), x1 = *(const float4*)(kp + 16 * s + 4);
          kf[s] = pack8(x0.x, x0.y, x0.z, x0.w, x1.x, x1.y, x1.z, x1.w);
        }
      } else {
        int tk;
        if (SAMPLE) tk = r + dl * (qi < nq ? qi : 0); else tk = (m0 - 128 + 32 * kt + qi) * dl + r;
        qk_finish(kraw[kt], p.rope + (ropeb + tk) * 16, p.k_norm_g + layer * 64, 1.0f, kf, h);
      }
#pragma unroll
      for (int s = 0; s < 4; ++s) sacc[kt] = MFMA32(kf[s], qf[s], sacc[kt]);
    }
  }
  const int srow = lane >> 1, shf = (lane & 1) * 32;
  uint4 vraw[5][4];
#pragma unroll
  for (int kt = 0; kt < 5; ++kt) {
    if (kt >= kt_lo && !(SAMPLE && kt < 4)) {
      int tk;
      if (SAMPLE) tk = r + dl * (srow < nq ? srow : 0); else tk = (m0 - 128 + 32 * kt + srow) * dl + r;
      const u16* vp = projb + (size_t)tk * IC + C_V + head * 64 + shf;
#pragma unroll
      for (int c = 0; c < 4; ++c) vraw[kt][c] = *(const uint4*)(vp + 8 * c);
    } else {
#pragma unroll
      for (int c = 0; c < 4; ++c) vraw[kt][c] = make_uint4(0u, 0u, 0u, 0u);
    }
  }
  float mx = -1e30f;
#pragma unroll
  for (int kt = 0; kt < 5; ++kt)
#pragma unroll
    for (int rr = 0; rr < 16; ++rr) {
      const int keyrow = (rr & 3) + 8 * (rr >> 2) + 4 * h;
      const int dist = 128 - 32 * kt + qi - keyrow;
      const bool valid = (kt >= kt_lo) && dist >= 0 && dist <= 128;
      const float s = valid ? sacc[kt][rr] : -1e30f;
      sacc[kt][rr] = s;
      mx = fmaxf(mx, s);
    }
  mx = fmaxf(mx, __shfl_xor(mx, 32));
  float sum = 0.f;
#pragma unroll
  for (int kt = 0; kt < 5; ++kt)
#pragma unroll
    for (int rr = 0; rr < 16; ++rr) {
      const float s = sacc[kt][rr];
      const float ex = (s > -1e29f) ? __expf(s - mx) : 0.f;
      sacc[kt][rr] = ex;
      sum += ex;
    }
  sum += __shfl_xor(sum, 32);
  bf16x8 pfa[5][2];
#pragma unroll
  for (int kt = 0; kt < 5; ++kt)
#pragma unroll
    for (int s2 = 0; s2 < 2; ++s2)
      pfa[kt][s2] = pack8(sacc[kt][8 * s2], sacc[kt][8 * s2 + 1], sacc[kt][8 * s2 + 2], sacc[kt][8 * s2 + 3], sacc[kt][8 * s2 + 4], sacc[kt][8 * s2 + 5], sacc[kt][8 * s2 + 6], sacc[kt][8 * s2 + 7]);
  f32x16 oacc[2];
#pragma unroll
  for (int i = 0; i < 16; ++i) { oacc[0][i] = 0.f; oacc[1][i] = 0.f; }
  u16* vt = (u16*)(smem + wid * 16384);
#pragma unroll
  for (int kt = 0; kt < 5; ++kt) {
    if (kt >= kt_lo) {
      u16* vb = vt + (kt & 1) * (32 * 72);
      if (SAMPLE && kt < 4) {
        const float* vp = cache + (size_t)(r + dl * (32 * kt + srow)) * 256 + 128 + shf;
#pragma unroll
        for (int c = 0; c < 4; ++c) {
          const float4 x0 = *(const float4*)(vp + 8 * c), x1 = *(const float4*)(vp + 8 * c + 4);
          uint4 o; o.x = pack2(x0.x, x0.y); o.y = pack2(x0.z, x0.w); o.z = pack2(x1.x, x1.y); o.w = pack2(x1.z, x1.w);
          *(uint4*)(vb + srow * 72 + shf + 8 * c) = o;
        }
      } else {
#pragma unroll
        for (int c = 0; c < 4; ++c) *(uint4*)(vb + srow * 72 + shf + 8 * c) = vraw[kt][c];
      }
#pragma unroll
      for (int s2 = 0; s2 < 2; ++s2) {
        bf16x8 v0, v1;
#pragma unroll
        for (int j = 0; j < 8; ++j) {
          const int kr = 16 * s2 + 8 * (j >> 2) + 4 * h + (j & 3);
          v0[j] = (short)vb[kr * 72 + qi]; v1[j] = (short)vb[kr * 72 + qi + 32];
        }
        oacc[0] = MFMA32(v0, pfa[kt][s2], oacc[0]);
        oacc[1] = MFMA32(v1, pfa[kt][s2], oacc[1]);
      }
    }
  }
  const float isum = 1.0f / sum;
  const size_t rowq = SAMPLE ? (size_t)NP + b * 8 + tq : (size_t)b * 2048 + tq;
  if (!SAMPLE || qi < nq) {
    u16* op = p.opart + ((size_t)g * MT + rowq) * 128 + hslot * 64;
#pragma unroll
    for (int db = 0; db < 2; ++db)
#pragma unroll
      for (int i4 = 0; i4 < 4; ++i4) {
        uint2 o; o.x = pack2(oacc[db][4 * i4] * isum, oacc[db][4 * i4 + 1] * isum); o.y = pack2(oacc[db][4 * i4 + 2] * isum, oacc[db][4 * i4 + 3] * isum);
        *(uint2*)(op + db * 32 + 8 * i4 + 4 * h) = o;
      }
    if (h == 0) p.lse[((size_t)g * MT + rowq) * 2 + hslot] = mx + __logf(sum);
  }
}

__device__ __forceinline__ void kv_row_task(const Params& p, const int l, const int row, const int lane, const bf16x8 kr, const bf16x8 vr) {
  const int hl = lane < 48 ? lane : 47;
  const int head = hl >> 3, c8 = hl & 7;
  int b, t, ridx;
  const bool prompt = row < NP;
  if (prompt) { b = row >> 11; t = row & 2047; ridx = t; } else { b = (row - NP) >> 3; t = (row - NP) & 7; ridx = 2048 + t; }
  float f[8]; float ss = 0.f;
#pragma unroll
  for (int j = 0; j < 8; ++j) { f[j] = bfs2f(kr[j]); ss += f[j] * f[j]; }
  ss += __shfl_xor(ss, 1); ss += __shfl_xor(ss, 2); ss += __shfl_xor(ss, 4);
  const float inv = rsqrtf(ss * (1.0f / 64.0f) + EPS);
  const float* gk = p.k_norm_g + l * 64 + c8 * 8;
#pragma unroll
  for (int j = 0; j < 8; ++j) f[j] *= inv * gk[j];
  const float* rp = p.rope + ridx * 16;
#pragma unroll
  for (int j = 0; j < 8; ++j) {
    const float other = __shfl_xor(f[j], 1);
    const float cs = rp[j], sn = rp[8 + j];
    if (c8 == 0) f[j] = f[j] * cs - other * sn;
    else if (c8 == 1) f[j] = f[j] * cs + other * sn;
  }
  const int g = head >> 1, hh = head & 1;
  const int W = 128 << (2 * g);
  float* dst = nullptr;
  if (prompt) {
    const int r = t - (2048 - W);
    const size_t base = (g == 0) ? O_KV128P : (g == 1) ? O_KV512P : O_KV2048P;
    if (r >= 0) dst = p.out + base + ((size_t)(l * 8 + b) * W + r) * 256 + hh * 64 + c8 * 8;
  } else {
    const int r = W - 8 + t;
    const size_t base = (g == 0) ? O_KV128S : (g == 1) ? O_KV512S : O_KV2048S;
    dst = p.out + base + ((size_t)(l * 32 + b) * W + r) * 256 + hh * 64 + c8 * 8;
  }
  if (dst && lane < 48) {
    *(float4*)(dst) = make_float4(f[0], f[1], f[2], f[3]);
    *(float4*)(dst + 4) = make_float4(f[4], f[5], f[6], f[7]);
    *(float4*)(dst + 128) = make_float4(bfs2f(vr[0]), bfs2f(vr[1]), bfs2f(vr[2]), bfs2f(vr[3]));
    *(float4*)(dst + 132) = make_float4(bfs2f(vr[4]), bfs2f(vr[5]), bfs2f(vr[6]), bfs2f(vr[7]));
  }
}

__device__ __forceinline__ void phaseA(const Params& p, const int l, const int wave_s) {
  const int tid = opaque_tid(wave_s);
  const int lane = tid & 63, wid = tid >> 6;
  const int gw = blockIdx.x * 8 + wid, nw = gridDim.x * 8;
  for (int task = gw; task < 832 + 3072; task += nw) { if (task < 832) attn_task<true>(p, l, task, wid); else attn_task<false>(p, l, task - 832, wid); }
  for (int row0 = nw - 1 - gw; row0 < MT; row0 += 4 * nw) {
    const int hl = lane < 48 ? lane : 47;
    bf16x8 kr[4], vr[4];
#pragma unroll
    for (int u = 0; u < 4; ++u) {
      const int rc = min(row0 + u * nw, MT - 1);
      const u16* pr = p.proj + (size_t)rc * IC;
      kr[u] = *(const bf16x8*)(pr + C_K + hl * 8);
      vr[u] = *(const bf16x8*)(pr + C_V + hl * 8);
    }
#pragma unroll
    for (int u = 0; u < 4; ++u) if (row0 + u * nw < MT) kv_row_task(p, l, row0 + u * nw, lane, kr[u], vr[u]);
  }
}

template <int GRP>
__device__ __forceinline__ void pool_task(const Params& p, const int l, const int task, const int lane) {
  const int tile = task >> 2; constexpr int grp = GRP;
  const int qi = lane & 31, h = lane >> 5;
  const int row = tile * 32 + qi;
  constexpr int w = 2 << GRP;
  const bool prompt = row < NP;
  int n, t; float cnt;
  if (prompt) { n = row >> 11; t = row & 2047; cnt = (float)min(t + 1, w); } else { n = (row - NP) >> 3; t = (row - NP) & 7; cnt = (float)w; }
  const float icnt = 1.0f / cnt;
  f32x16 acc[2];
#pragma unroll
  for (int i = 0; i < 16; ++i) { acc[0][i] = 0.f; acc[1][i] = 0.f; }
  const u16* pw = p.pwT + (size_t)(l * 4 + grp) * 4096;
#pragma unroll
  for (int s = 0; s < 4; ++s) {
    const int c0 = grp * 64 + 16 * s + 8 * h;
    float sum[8], own[8];
#pragma unroll
    for (int j = 0; j < 8; ++j) { sum[j] = 0.f; own[j] = 0.f; }
#pragma unroll
    for (int i = 0; i < w; ++i) {
      const int tt = t - i;
      float v[8];
      if (tt >= 0) {
        const bf16x8 raw = *(const bf16x8*)(p.proj + (size_t)(row - i) * IC + C_U + c0);
#pragma unroll
        for (int j = 0; j < 8; ++j) v[j] = bfs2f(raw[j]);
      } else if (!prompt) {
        const float* sp = p.state_pool + ((size_t)(l * 32 + n) * 15 + 15 + tt) * 256 + c0;
        const float4 a = *(const float4*)sp, bb = *(const float4*)(sp + 4);
        v[0] = a.x; v[1] = a.y; v[2] = a.z; v[3] = a.w; v[4] = bb.x; v[5] = bb.y; v[6] = bb.z; v[7] = bb.w;
      } else {
#pragma unroll
        for (int j = 0; j < 8; ++j) v[j] = 0.f;
      }
#pragma unroll
      for (int j = 0; j < 8; ++j) sum[j] += v[j];
      if (i == 0) {
#pragma unroll
        for (int j = 0; j < 8; ++j) own[j] = v[j];
      }
    }
    const bf16x8 df = pack8(sum[0] * icnt - own[0], sum[1] * icnt - own[1], sum[2] * icnt - own[2], sum[3] * icnt - own[3],
                            sum[4] * icnt - own[4], sum[5] * icnt - own[5], sum[6] * icnt - own[6], sum[7] * icnt - own[7]);
    const bf16x8 a0 = *(const bf16x8*)(pw + (size_t)qi * 64 + 16 * s + 8 * h);
    const bf16x8 a1 = *(const bf16x8*)(pw + (size_t)(qi + 32) * 64 + 16 * s + 8 * h);
    acc[0] = MFMA32(a0, df, acc[0]);
    acc[1] = MFMA32(a1, df, acc[1]);
  }
  const float* ps = p.pool_scale + l * 256 + grp * 64;
  u16* mp = p.mixed + (size_t)row * MC + grp * 64;
#pragma unroll
  for (int db = 0; db < 2; ++db)
#pragma unroll
    for (int i4 = 0; i4 < 4; ++i4) {
      const int dd0 = db * 32 + 8 * i4 + 4 * h;
      const float4 sc = *(const float4*)(ps + dd0);
      uint2 o; o.x = pack2(acc[db][4 * i4] * sc.x, acc[db][4 * i4 + 1] * sc.y); o.y = pack2(acc[db][4 * i4 + 2] * sc.z, acc[db][4 * i4 + 3] * sc.w);
      *(uint2*)(mp + dd0) = o;
    }
}

__device__ __forceinline__ void phaseB(const Params& p, const int l, const int wave_s) {
  const int tid = opaque_tid(wave_s), lane = tid & 63, wid = tid >> 6;
  const int gw = blockIdx.x * 8 + wid, nw = gridDim.x * 8;
  const size_t gt = (size_t)blockIdx.x * 512 + tid, ntd = (size_t)gridDim.x * 512;
  {
    const bool spread = (nw == 2048);
    const int nit = spread ? 2 : (2080 + nw - 1) / nw;
    for (int it = 0; it < nit; ++it) {
      int task = gw + it * nw;
      if (spread && it == 1) task = ((gw & 63) == 0) ? 2048 + (gw >> 6) : 2080;
      if (task >= 2080) break;
      switch (task & 3) { case 0: pool_task<0>(p, l, task, lane); break; case 1: pool_task<1>(p, l, task, lane); break;
                          case 2: pool_task<2>(p, l, task, lane); break; default: pool_task<3>(p, l, task, lane); break; }
    }
  }
  for (size_t idx = gt; idx < (size_t)(MT / 4) * 48; idx += ntd) {
    const int row0 = (int)(idx / 48) * 4, ch = (int)(idx % 48) * 8;
    const bool prompt = row0 < NP;
    int n, t0;
    if (prompt) { n = row0 >> 11; t0 = row0 & 2047; } else { n = (row0 - NP) >> 3; t0 = (row0 - NP) & 7; }
    float z[6][8];
#pragma unroll
    for (int i = 0; i < 6; ++i) {
      const int tt = t0 - 2 + i;
      if (tt >= 0) {
        const u16* pr = p.proj + (size_t)(row0 - 2 + i) * IC;
        const bf16x8 gc = *(const bf16x8*)(pr + C_GC + ch), gh = *(const bf16x8*)(pr + C_GH + ch);
#pragma unroll
        for (int j = 0; j < 8; ++j) z[i][j] = bfs2f(gc[j]) * bfs2f(gh[j]);
      } else if (!prompt) {
        const float* sp = p.state_conv + ((size_t)(l * 32 + n) * 2 + 2 + tt) * 384 + ch;
        const float4 a = *(const float4*)sp, bb = *(const float4*)(sp + 4);
        z[i][0] = a.x; z[i][1] = a.y; z[i][2] = a.z; z[i][3] = a.w; z[i][4] = bb.x; z[i][5] = bb.y; z[i][6] = bb.z; z[i][7] = bb.w;
      } else {
#pragma unroll
        for (int j = 0; j < 8; ++j) z[i][j] = 0.f;
      }
    }
    const float* cw = p.conv_w + (size_t)l * 3 * 384 + ch;
    float c0[8], c1[8], c2[8];
#pragma unroll
    for (int j = 0; j < 8; ++j) { c0[j] = cw[j]; c1[j] = cw[384 + j]; c2[j] = cw[768 + j]; }
#pragma unroll
    for (int u = 0; u < 4; ++u) {
      const int row = row0 + u, t = t0 + u;
      const bf16x8 gb = *(const bf16x8*)(p.proj + (size_t)row * IC + C_GB + ch);
      float y[8];
#pragma unroll
      for (int j = 0; j < 8; ++j) y[j] = bfs2f(gb[j]) * (c0[j] * z[u][j] + c1[j] * z[u + 1][j] + c2[j] * z[u + 2][j]);
      uint4 o; o.x = pack2(y[0], y[1]); o.y = pack2(y[2], y[3]); o.z = pack2(y[4], y[5]); o.w = pack2(y[6], y[7]);
      *(uint4*)(p.mixed + (size_t)row * MC + 384 + ch) = o;
      float* so = nullptr;
      if (prompt) { if (t >= 2046) so = p.out + O_CONVP + ((size_t)(l * 8 + n) * 2 + (t - 2046)) * 384 + ch; }
      else { if (t >= 6) so = p.out + O_CONVS + ((size_t)(l * 32 + n) * 2 + (t - 6)) * 384 + ch; }
      if (so) { *(float4*)so = make_float4(z[u + 2][0], z[u + 2][1], z[u + 2][2], z[u + 2][3]); *(float4*)(so + 4) = make_float4(z[u + 2][4], z[u + 2][5], z[u + 2][6], z[u + 2][7]); }
    }
  }
  for (size_t idx0 = gt; idx0 < (size_t)MT * 16; idx0 += 3 * ntd) {
    float lg[3][3]; uint4 pv[3][3];
#pragma unroll
    for (int u = 0; u < 3; ++u) {
      const size_t idx = idx0 + u * ntd < (size_t)MT * 16 ? idx0 + u * ntd : idx0;
      const int row = (int)(idx >> 4), chunk = (int)(idx & 15);
      const int hslot = chunk >> 3, d0 = (chunk & 7) * 8;
#pragma unroll
      for (int g = 0; g < 3; ++g) {
        lg[u][g] = p.lse[((size_t)g * MT + row) * 2 + hslot];
        pv[u][g] = *(const uint4*)(p.opart + ((size_t)g * MT + row) * 128 + hslot * 64 + d0);
      }
    }
#pragma unroll
    for (int u = 0; u < 3; ++u) {
      const size_t idx = idx0 + u * ntd;
      if (idx < (size_t)MT * 16) {
        const int row = (int)(idx >> 4), chunk = (int)(idx & 15);
        const int hslot = chunk >> 3, d0 = (chunk & 7) * 8;
        const float m = fmaxf(lg[u][0], fmaxf(lg[u][1], lg[u][2]));
        float wg[3]; wg[0] = __expf(lg[u][0] - m); wg[1] = __expf(lg[u][1] - m); wg[2] = __expf(lg[u][2] - m);
        const float iw = 1.0f / (wg[0] + wg[1] + wg[2]);
        float y[8];
#pragma unroll
        for (int j = 0; j < 8; ++j) y[j] = 0.f;
#pragma unroll
        for (int g = 0; g < 3; ++g) {
          const uint4 a = pv[u][g];
          const float ww = wg[g] * iw;
          y[0] += ww * __uint_as_float(a.x << 16); y[1] += ww * __uint_as_float(a.x & 0xffff0000u);
          y[2] += ww * __uint_as_float(a.y << 16); y[3] += ww * __uint_as_float(a.y & 0xffff0000u);
          y[4] += ww * __uint_as_float(a.z << 16); y[5] += ww * __uint_as_float(a.z & 0xffff0000u);
          y[6] += ww * __uint_as_float(a.w << 16); y[7] += ww * __uint_as_float(a.w & 0xffff0000u);
        }
        uint4 o; o.x = pack2(y[0], y[1]); o.y = pack2(y[2], y[3]); o.z = pack2(y[4], y[5]); o.w = pack2(y[6], y[7]);
        *(uint4*)(p.mixed + (size_t)row * MC + 256 + hslot * 64 + d0) = o;
      }
    }
  }
  for (size_t idx = gt; idx < (size_t)8 * 15 * 256; idx += ntd) {
    const int c = (int)(idx & 255); const int bi = (int)(idx >> 8); const int i = bi % 15, b = bi / 15;
    p.out[O_POOLP + (size_t)l * 8 * 15 * 256 + idx] = bf2f(p.proj[((size_t)b * 2048 + 2033 + i) * IC + C_U + c]);
  }
  for (size_t idx = gt; idx < (size_t)32 * 15 * 256; idx += ntd) {
    const int c = (int)(idx & 255); const int bi = (int)(idx >> 8); const int i = bi % 15, n = bi / 15;
    float v;
    if (i < 7) v = p.state_pool[((size_t)(l * 32 + n) * 15 + 8 + i) * 256 + c];
    else v = bf2f(p.proj[((size_t)NP + n * 8 + (i - 7)) * IC + C_U + c]);
    p.out[O_POOLS + (size_t)l * 32 * 15 * 256 + idx] = v;
  }
}

#ifndef PROBEV
#define PROBEV 0
#endif
#ifndef REPM
#define REPM 0
#endif
#define NREP(k) (1 + ((REPM >> (k)) & 1))
typedef const __attribute__((address_space(4))) Params* CP;
#if defined(__HIP_DEVICE_COMPILE__)
#define LOAD_PARAMS() CP pp_ = (CP)__builtin_amdgcn_kernarg_segment_ptr(); asm volatile("" : "+s"(pp_)); const Params p = *pp_
#else
#define LOAD_PARAMS() const Params& p = p_unused
#endif
__global__ void __launch_bounds__(512, 2) mega(const Params p_unused, const int ph_lo, const int ph_hi) {
  const int wave_s = __builtin_amdgcn_readfirstlane((int)(threadIdx.x >> 6));
  if (ph_hi == -12345) cg::this_grid().sync();
  {
    LOAD_PARAMS();
    if (opaque_tid(wave_s) == 0) {
      volatile __attribute__((address_space(3))) unsigned* st = (volatile __attribute__((address_space(3))) unsigned*)(smem + BAR_LDS_OFF);
      st[0] = 0u; st[1] = 0u;
      (void)xb_add(&p.bar[XB_XCNT(xb_xcc_id())], 1u);
    }
    __syncthreads();
  }
  int ph = 0;
#define IN_PH() (ph_lo <= ph && ph < ph_hi)
#define SEAM() do { if (ph_lo <= ph && ph + 1 < ph_hi) { LOAD_PARAMS(); grid_bar(p.bar, wave_s); } ++ph; } while (0)
  if (IN_PH()) for (int rep = 0; rep < NREP(0); ++rep) { LOAD_PARAMS(); phase0(p, wave_s); }
  SEAM();
#pragma unroll 1
  for (int l = 0; l < 2; ++l) {
    if (IN_PH()) for (int rep = 0; rep < NREP(1); ++rep) {
      LOAD_PARAMS();
      GemmEpi e{}; e.sumsq_in = p.sumsq + (size_t)(2 * l) * MT; e.out_bf = p.proj; e.ldo = IC;
      gemm_phase<1>(p.xg, p.wt_in + (size_t)l * IC * D, NP, IC, D, e, wave_s);
      { const int G = gridDim.x, first = (64 * (IC / 256)) % G;
        const int b0 = first ? first : 0, nb = G - b0;
        kv_shift_copy(p, l, b0, nb, opaque_tid(wave_s));
        sample_gemm64<1>(p.xg, p.wt_in + (size_t)l * IC * D, IC, D, e, wave_s, true); }
    }
    SEAM();
    if (IN_PH()) for (int rep = 0; rep < NREP(2); ++rep) { LOAD_PARAMS(); phaseA(p, l, wave_s); }
    SEAM();
    if (IN_PH()) for (int rep = 0; rep < NREP(3); ++rep) { LOAD_PARAMS(); phaseB(p, l, wave_s); }
    SEAM();
    if (IN_PH()) for (int rep = 0; rep < NREP(4); ++rep) {
      LOAD_PARAMS();
      GemmEpi e{};
      const bool last = (rep == NREP(4) - 1);
      e.xh = p.xg; e.xh_out = last ? p.xg : p.scr16; e.out_f = nullptr; e.sumsq_out = last ? p.sumsq + (size_t)(2 * l + 1) * MT : p.scrss;
      gemm_phase<2>(p.mixed, p.wt_out + (size_t)l * D * MC, NP, D, MC, e, wave_s, 0);
      sample_gemm<2>(p.mixed, p.wt_out + (size_t)l * D * MC, D, MC, e, wave_s, 0, gridDim.x);
    }
    SEAM();
    if (IN_PH()) for (int rep = 0; rep < NREP(5); ++rep) {
      LOAD_PARAMS();
      GemmEpi e{}; e.sumsq_in = p.sumsq + (size_t)(2 * l + 1) * MT; e.out_bf = p.hf; e.ldo = FF;
      gemm_phase<3>(p.xg, p.wt_up + (size_t)l * FF * D, NP, FF, D, e, wave_s, (rep && (PROBEV & 1)) ? 1 : 0);
      if (!(rep && (PROBEV & 2))) sample_gemm64<3>(p.xg, p.wt_up + (size_t)l * FF * D, FF, D, e, wave_s, false);
    }
    SEAM();
    if (IN_PH()) for (int rep = 0; rep < NREP(6); ++rep) {
      LOAD_PARAMS();
      GemmEpi e{};
      const bool last = (rep == NREP(6) - 1);
      e.xh = p.xg; e.xh_out = last ? p.xg : p.scr16;
      if (l == 0) { e.out_f = nullptr; e.sumsq_out = last ? p.sumsq + (size_t)2 * MT : p.scrss; } else { e.out_f = last ? p.out : p.scrf; e.sumsq_out = nullptr; }
      gemm_phase<2>(p.hf, p.wt_down + (size_t)l * D * FF, NP, D, FF, e, wave_s, 0);
      sample_gemm<2>(p.hf, p.wt_down + (size_t)l * D * FF, D, FF, e, wave_s, 0, gridDim.x);
    }
    SEAM();
  }
}

extern "C" void kernel_launch(void* const* d_in, const int* in_sizes, int n_in, void* d_out, int out_size, void* d_ws, size_t ws_size, hipStream_t stream) {
  static int grid_blocks = 0;
  if (!grid_blocks) {
    int dev = 0, cus = 0, per_cu = 0;
    hipGetDevice(&dev);
    hipDeviceGetAttribute(&cus, hipDeviceAttributeMultiprocessorCount, dev);
    hipFuncSetAttribute((const void*)mega, hipFuncAttributeMaxDynamicSharedMemorySize, GEMM_LDS);
    hipOccupancyMaxActiveBlocksPerMultiprocessor(&per_cu, (const void*)mega, 512, GEMM_LDS);
    if (per_cu < 1) { fprintf(stderr, "occupancy query returned %d\n", per_cu); per_cu = 1; }
    grid_blocks = cus * 1;
  }
  Params p{};
  p.x_prompt = (const float*)d_in[0]; p.x_sample = (const float*)d_in[1]; p.state_pool = (const float*)d_in[2]; p.state_conv = (const float*)d_in[3];
  p.kv_in[0] = (const float*)d_in[4]; p.kv_in[1] = (const float*)d_in[5]; p.kv_in[2] = (const float*)d_in[6];
  p.norm1_g = (const float*)d_in[7]; p.w_in = (const float*)d_in[8]; p.q_norm_g = (const float*)d_in[9]; p.k_norm_g = (const float*)d_in[10];
  p.pool_w = (const float*)d_in[11]; p.pool_scale = (const float*)d_in[12]; p.conv_w = (const float*)d_in[13]; p.w_out = (const float*)d_in[14];
  p.norm2_g = (const float*)d_in[15]; p.w_up = (const float*)d_in[16]; p.w_down = (const float*)d_in[17];
  p.out = (float*)d_out;
  unsigned char* w = (unsigned char*)d_ws; size_t off = 0;
  auto carve = [&](size_t bytes) { unsigned char* r = w + off; off += (bytes + 255) & ~(size_t)255; return r; };
  p.bar = (unsigned*)carve(XCD_BAR_WORDS * 4);
  p.wt_in = (u16*)carve((size_t)2 * IC * D * 2);
  p.wt_out = (u16*)carve((size_t)2 * D * MC * 2);
  p.wt_up = (u16*)carve((size_t)2 * FF * D * 2);
  p.wt_down = (u16*)carve((size_t)2 * D * FF * 2);
  p.pwT = (u16*)carve((size_t)2 * 4 * 4096 * 2);
  p.xg = (u16*)carve((size_t)MT * D * 2);
  p.mixed = (u16*)carve((size_t)MT * MC * 2);
  p.sumsq = (float*)carve((size_t)4 * MT * 4);
  p.lse = (float*)carve((size_t)3 * MT * 2 * 4);
  p.rope = (float*)carve((size_t)2056 * 16 * 4);
  p.scr16 = (u16*)carve((size_t)MT * D * 2); p.scrss = (float*)carve((size_t)MT * 4); p.scrf = (float*)carve((size_t)MT * D * 4);
  p.hf = (u16*)carve((size_t)MT * FF * 2);
  p.proj = p.hf;
  p.opart = (u16*)((unsigned char*)p.hf + (((size_t)MT * IC * 2 + 255) & ~(size_t)255));
  if (off > ws_size) { fprintf(stderr, "workspace too small: need %zu have %zu\n", off, ws_size); return; }
  (void)hipMemsetAsync(p.bar, 0, XCD_BAR_WORDS * 4, stream);
  int lo = 0, hi = 13;
  void* args[] = {(void*)&p, (void*)&lo, (void*)&hi};
  hipError_t e = hipLaunchCooperativeKernel((const void*)mega, dim3(grid_blocks), dim3(512), args, GEMM_LDS, stream);
  if (e != hipSuccess) fprintf(stderr, "cooperative launch failed: %s (grid %d)\n", hipGetErrorString(e), grid_blocks);
}
```

```cpp
#include <hip/hip_runtime.h>
#include <hip/hip_cooperative_groups.h>
#include <cstdio>
namespace cg = cooperative_groups;

typedef unsigned short u16;
using bf16x8 = __attribute__((ext_vector_type(8))) short;
using f32x4 = __attribute__((ext_vector_type(4))) float;
using f32x16 = __attribute__((ext_vector_type(16))) float;

constexpr int NP = 16384, NS = 256, MT = NP + NS;
constexpr int D = 1024, IC = 2560, MC = 768, FF = 4096;
constexpr float EPS = 1e-6f;
constexpr int C_U = 0, C_Q = 256, C_K = 640, C_V = 1024, C_GB = 1408, C_GC = 1792, C_GH = 2176;
constexpr size_t O_YP = 0;
constexpr size_t O_YS = O_YP + (size_t)NP * D;
constexpr size_t O_POOLP = O_YS + (size_t)NS * D;
constexpr size_t O_CONVP = O_POOLP + 2 * 8 * 15 * 256;
constexpr size_t O_KV128P = O_CONVP + 2 * 8 * 2 * 384;
constexpr size_t O_KV512P = O_KV128P + (size_t)2 * 8 * 128 * 256;
constexpr size_t O_KV2048P = O_KV512P + (size_t)2 * 8 * 512 * 256;
constexpr size_t O_POOLS = O_KV2048P + (size_t)2 * 8 * 2048 * 256;
constexpr size_t O_CONVS = O_POOLS + 2 * 32 * 15 * 256;
constexpr size_t O_KV128S = O_CONVS + 2 * 32 * 2 * 384;
constexpr size_t O_KV512S = O_KV128S + (size_t)2 * 32 * 128 * 256;
constexpr size_t O_KV2048S = O_KV512S + (size_t)2 * 32 * 512 * 256;

struct Params {
  const float *x_prompt, *x_sample, *state_pool, *state_conv, *kv_in[3];
  const float *norm1_g, *w_in, *q_norm_g, *k_norm_g, *pool_w, *pool_scale, *conv_w, *w_out, *norm2_g, *w_up, *w_down;
  float* out;
  u16 *wt_in, *wt_out, *wt_up, *wt_down, *pwT;
  u16 *xg, *proj, *mixed, *hf;
  float *sumsq, *lse, *rope;
  u16* opart;
  unsigned* bar;
  u16* scr16; float* scrss; float* scrf;
};

extern __shared__ __attribute__((aligned(16))) unsigned char smem[];
typedef __attribute__((address_space(3))) void* LDSP;

typedef __bf16 bf16x2_t __attribute__((ext_vector_type(2)));
typedef float f32x2_t __attribute__((ext_vector_type(2)));
__device__ __forceinline__ unsigned pack2(float a, float b) { f32x2_t v = {a, b}; bf16x2_t r = __builtin_convertvector(v, bf16x2_t); return __builtin_bit_cast(unsigned, r); }
__device__ __forceinline__ u16 f2bf(float f) { return (u16)(pack2(f, 0.f) & 0xffffu); }
typedef unsigned u32x4_t __attribute__((ext_vector_type(4)));
__device__ __forceinline__ bf16x8 pack8(float a, float b, float c, float d, float e, float f, float g, float h) {
  u32x4_t t = {pack2(a, b), pack2(c, d), pack2(e, f), pack2(g, h)}; return __builtin_bit_cast(bf16x8, t); }
__device__ __forceinline__ float bf2f(u16 h) { return __uint_as_float(((unsigned)h) << 16); }
__device__ __forceinline__ float bfs2f(short h) { return __uint_as_float(((unsigned)(u16)h) << 16); }
__device__ __forceinline__ int opaque_tid(const int wave_s) {
  int l; asm volatile("v_mbcnt_lo_u32_b32 %0, -1, 0\n\tv_mbcnt_hi_u32_b32 %0, -1, %0" : "=v"(l));
  return wave_s * 64 + l;
}
__device__ __forceinline__ int opaque_lane() {
  int l; asm volatile("v_mbcnt_lo_u32_b32 %0, -1, 0\n\tv_mbcnt_hi_u32_b32 %0, -1, %0" : "=v"(l));
  return l;
}
#define XB_TMO      128
#define XB_XCNT(j)  (256  + 64 * (j))
#define XB_XSUB(j)  (1280 + 64 * (j))
#define XB_XGEN(j)  (2304 + 64 * (j))
#define XB_TOP      3328
#define XB_TOPGEN   3392
#define XCD_BAR_WORDS 3456
#define XB_SPIN_CAP (1u << 18)
constexpr int BAR_LDS_OFF = 131072;
__device__ __forceinline__ unsigned xb_ld(unsigned* p)              { return __hip_atomic_load(p, __ATOMIC_RELAXED, __HIP_MEMORY_SCOPE_AGENT); }
__device__ __forceinline__ unsigned xb_add(unsigned* p, unsigned v) { return __hip_atomic_fetch_add(p, v, __ATOMIC_RELAXED, __HIP_MEMORY_SCOPE_AGENT); }
__device__ __forceinline__ unsigned xb_xcc_id() { return (unsigned)__builtin_amdgcn_s_getreg((3 << 11) | 20) & 0xFu; }
#define XB_SPIN(cond, bar) do { unsigned _sp = 0; while (cond) { __builtin_amdgcn_s_sleep(1); \
    if ((++_sp & 255u) == 0u) { if (xb_ld(&(bar)[XB_TMO])) break; if (_sp > XB_SPIN_CAP) { atomicAdd(&(bar)[XB_TMO], 1u); break; } } } } while (0)
__device__ __forceinline__ void xcd_barrier_complete(unsigned* bar, unsigned x, unsigned& nloc, unsigned& nx) {
  const unsigned G = gridDim.x;
  unsigned sum, cnt, mine, sp = 0u;
  for (;;) {
    sum = 0u; cnt = 0u; mine = 0u;
#pragma unroll
    for (unsigned j = 0; j < 16; ++j) { const unsigned c = xb_ld(&bar[XB_XCNT(j)]); sum += c; cnt += (c > 0u) ? 1u : 0u; mine = (j == x) ? c : mine; }
    if (sum == G) break;
    __builtin_amdgcn_s_sleep(1);
    if ((++sp & 255u) == 0u) { if (xb_ld(&bar[XB_TMO])) break; if (sp > XB_SPIN_CAP) { atomicAdd(&bar[XB_TMO], 1u); break; } }
  }
  nloc = mine > 0u ? mine : 1u; nx = cnt > 0u ? cnt : 1u;
}
__device__ __forceinline__ void grid_bar(unsigned* bar, const int wave_s) {
  asm volatile("s_waitcnt vmcnt(0)" ::: "memory");
  __syncthreads();
  if (opaque_tid(wave_s) == 0) {
    volatile __attribute__((address_space(3))) unsigned* st = (volatile __attribute__((address_space(3))) unsigned*)(smem + BAR_LDS_OFF);
    const unsigned x = xb_xcc_id();
    __builtin_amdgcn_s_waitcnt(0);
    unsigned nloc = st[0], nx = st[1];
    if (nloc == 0u) { xcd_barrier_complete(bar, x, nloc, nx); st[0] = nloc; st[1] = nx; }
    const unsigned old = xb_add(&bar[XB_XSUB(x)], 1u);
    const unsigned gen = old / nloc;
    if (old + 1u == (gen + 1u) * nloc) {
      __builtin_amdgcn_fence(__ATOMIC_RELEASE, "agent");
      asm volatile("s_waitcnt vmcnt(0)" ::: "memory");
      const unsigned og = xb_add(&bar[XB_TOP], 1u);
      const unsigned tg = og / nx;
      if (og + 1u == (tg + 1u) * nx) xb_add(&bar[XB_TOPGEN], 1u);
      else XB_SPIN(xb_ld(&bar[XB_TOPGEN]) == tg, bar);
      __builtin_amdgcn_fence(__ATOMIC_ACQUIRE, "agent");
      xb_add(&bar[XB_XGEN(x)], 1u);
      asm volatile("s_waitcnt vmcnt(0)" ::: "memory");
    } else {
      XB_SPIN(xb_ld(&bar[XB_XGEN(x)]) == gen, bar);
      __builtin_amdgcn_fence(__ATOMIC_ACQUIRE, "agent");
      asm volatile("s_waitcnt vmcnt(0)" ::: "memory");
    }
  }
  __syncthreads();
}
__device__ __forceinline__ float wave_sum(float v) { for (int o = 32; o; o >>= 1) v += __shfl_xor(v, o); return v; }
__device__ __forceinline__ float wave_max(float v) { for (int o = 32; o; o >>= 1) v = fmaxf(v, __shfl_xor(v, o)); return v; }

constexpr int BM = 256, BK = 64, HALF = 128, NXCD = 8, WGM = 4, HT = HALF * BK;
constexpr int GEMM_LDS = 8 * HT * 2 + 16;

__device__ __forceinline__ int lds_byte(int r, int c) {
  int st = (r >> 4) * 2 + (c >> 5), rr = r & 15, cc = c & 31, ob = rr * 64 + cc * 2;
  return st * 1024 + (ob ^ (((ob >> 9) & 1) << 5));
}
__device__ __forceinline__ int perm32(int rho) { const int n = rho >> 4, i = rho & 15; return 8 * (i >> 2) + 4 * n + (i & 3); }
__device__ __forceinline__ void stage_rc(int b, int& R, int& C) {
  int st = b / 1024, sb = b % 1024, swz = sb ^ (((sb >> 9) & 1) << 5);
  R = (st >> 1) * 16 + swz / 64; C = (st & 1) * 32 + (swz % 64) / 2;
}

struct GemmEpi {
  const float* sumsq_in;
  u16* out_bf; int ldo;
  u16* xh;
  u16* xh_out;
  float* out_f;
  float* sumsq_out;
};

template <int MODE, bool ADD_RESID>
__device__ __forceinline__ void epi4(const GemmEpi& e, const f32x4 a, const float rs, const size_t grow, const int col0, float& ssq) {
  if (MODE == 1 || MODE == 3) {
    float v0 = a[0] * rs, v1 = a[1] * rs, v2 = a[2] * rs, v3 = a[3] * rs;
    if (MODE == 3) { v0 = fmaxf(v0, 0.f); v1 = fmaxf(v1, 0.f); v2 = fmaxf(v2, 0.f); v3 = fmaxf(v3, 0.f); v0 *= v0; v1 *= v1; v2 *= v2; v3 *= v3; }
    uint2 o; o.x = pack2(v0, v1); o.y = pack2(v2, v3);
    *(uint2*)(e.out_bf + grow * e.ldo + col0) = o;
  } else {
    float4 x; x.x = a[0]; x.y = a[1]; x.z = a[2]; x.w = a[3];
    if (ADD_RESID) {
      const uint2 r = *(const uint2*)(e.xh + grow * D + col0);
      x.x += __uint_as_float(r.x << 16); x.y += __uint_as_float(r.x & 0xffff0000u); x.z += __uint_as_float(r.y << 16); x.w += __uint_as_float(r.y & 0xffff0000u);
    }
    if (e.out_f) *(float4*)(e.out_f + grow * D + col0) = x;
    else { uint2 ob; ob.x = pack2(x.x, x.y); ob.y = pack2(x.z, x.w); *(uint2*)(e.xh_out + grow * D + col0) = ob; }
    ssq += x.x * x.x + x.y * x.y + x.z * x.z + x.w * x.w;
  }
}

template <int MODE>
__device__ __forceinline__ void epi8(const GemmEpi& e, const f32x4 a0, const f32x4 a1, const float rs, const size_t grow, const int col8, float& ssq) {
  float v[8] = {a0[0], a0[1], a0[2], a0[3], a1[0], a1[1], a1[2], a1[3]};
  if (MODE == 1 || MODE == 3) {
#pragma unroll
    for (int i = 0; i < 8; ++i) { v[i] *= rs; if (MODE == 3) { v[i] = fmaxf(v[i], 0.f); v[i] *= v[i]; } }
    uint4 o; o.x = pack2(v[0], v[1]); o.y = pack2(v[2], v[3]); o.z = pack2(v[4], v[5]); o.w = pack2(v[6], v[7]);
    *(uint4*)(e.out_bf + grow * e.ldo + col8) = o;
  } else {
    if (e.out_f) { *(float4*)(e.out_f + grow * D + col8) = make_float4(v[0], v[1], v[2], v[3]); *(float4*)(e.out_f + grow * D + col8 + 4) = make_float4(v[4], v[5], v[6], v[7]); }
    else { uint4 o; o.x = pack2(v[0], v[1]); o.y = pack2(v[2], v[3]); o.z = pack2(v[4], v[5]); o.w = pack2(v[6], v[7]); *(uint4*)(e.xh_out + grow * D + col8) = o; }
#pragma unroll
    for (int i = 0; i < 8; ++i) ssq += v[i] * v[i];
  }
}

template <int MODE>
__device__ __forceinline__ void gemm_phase(const u16* __restrict__ A, const u16* __restrict__ Bt, const int M, const int N, const int K, const GemmEpi e, const int wave_s, const int dry = 0) {
  u16* shm = (u16*)smem;
#define SA(b, h) (shm + ((b) * 2 + (h)) * HT)
#define SB(b, h) (shm + (4 + (b) * 2 + (h)) * HT)
#define STAGE_(P, RS, br, kt, o0, o1) do { const unsigned _so = (unsigned)(((br) * K + (kt) * BK) * 2); \
    __builtin_amdgcn_raw_ptr_buffer_load_lds(RS, (LDSP)((char*)(P) + tid0 * 16), 16, o0, _so, 0, 0); \
    __builtin_amdgcn_raw_ptr_buffer_load_lds(RS, (LDSP)((char*)(P) + tid0 * 16 + 8192), 16, o1, _so, 0, 0); } while (0)
#define STAGE(P, RS, br, kt) STAGE_(P, RS, br, kt, toff0, toff1)
#define STAGEB(P, RS, br, kt) STAGE_(P, RS, br, kt, toffb0, toffb1)
#define LDA(dst, b, h) for (int m = 0; m < 4; ++m) for (int k = 0; k < 2; ++k) \
    dst[m][k] = *reinterpret_cast<const bf16x8*>((char*)SA(b, h) + lds_byte(wr * 64 + m * 16 + fr, k * 32 + fq * 8))
#define LDB(dst, b, h) for (int n = 0; n < 2; ++n) for (int k = 0; k < 2; ++k) \
    dst[n][k] = *reinterpret_cast<const bf16x8*>((char*)SB(b, h) + lds_byte(wc * 32 + n * 16 + fr, k * 32 + fq * 8))
#define MMA(ai, bj, At, Bt_) do { __builtin_amdgcn_s_setprio(1); \
    for (int m = 0; m < 4; ++m) for (int n = 0; n < 2; ++n) for (int k = 0; k < 2; ++k) \
      acc[ai][bj][m][n] = __builtin_amdgcn_mfma_f32_16x16x32_bf16(Bt_[n][k], At[m][k], acc[ai][bj][m][n], 0, 0, 0); \
    __builtin_amdgcn_s_setprio(0); } while (0)
#define WAIT_V(n) asm volatile("s_waitcnt vmcnt(" #n ")" ::: "memory")
#define WAIT_L(n) asm volatile("s_waitcnt lgkmcnt(" #n ")" ::: "memory")
#define BAR __builtin_amdgcn_s_barrier()
#define SCHED __builtin_amdgcn_sched_barrier(0)
#define DECODE(tt_, brow_, bcol_) do { int wgid = (tt_); \
    { int q = nwg / NXCD, r = nwg % NXCD, xcd = wgid % NXCD, off = wgid / NXCD; \
      wgid = (xcd < r ? xcd * (q + 1) : r * (q + 1) + (xcd - r) * q) + off; } \
    int nig = WGM * nN, gid = wgid / nig, fm = gid * WGM, gsz = min(nM - fm, WGM); \
    brow_ = (fm + ((wgid % nig) % gsz)) * BM; bcol_ = ((wgid % nig) / gsz) * BM; } while (0)
#define STAGE7(brow_, bcol_) do { \
    STAGEB(SB(0, 0), rsB, bcol_, 0); STAGE(SA(0, 0), rsA, brow_, 0); \
    STAGEB(SB(0, 1), rsB, bcol_ + HALF, 0); STAGE(SA(0, 1), rsA, brow_ + HALF, 0); \
    STAGEB(SB(1, 0), rsB, bcol_, 1); STAGE(SA(1, 0), rsA, brow_, 1); STAGEB(SB(1, 1), rsB, bcol_ + HALF, 1); } while (0)

  const int nM = M / BM, nN = N / BM, nwg = nM * nN;
  const int nt = K / BK;
  unsigned toff0, toff1;
  const int tid0 = opaque_tid(wave_s);
  const int wr = (tid0 >> 6) >> 2, wc = (tid0 >> 6) & 3, fr = tid0 & 15, fq = (tid0 & 63) >> 4;
  unsigned toffb0, toffb1;
  { int r_, c_; stage_rc(tid0 * 16, r_, c_); toff0 = (unsigned)(r_ * K + c_) * 2u; toffb0 = (unsigned)(((r_ & ~31) | perm32(r_ & 31)) * K + c_) * 2u;
    stage_rc(tid0 * 16 + 8192, r_, c_); toff1 = (unsigned)(r_ * K + c_) * 2u; toffb1 = (unsigned)(((r_ & ~31) | perm32(r_ & 31)) * K + c_) * 2u; }
  const __amdgpu_buffer_rsrc_t rsA = __builtin_amdgcn_make_buffer_rsrc((void*)A, 0, -1, 0x00020000);
  const __amdgpu_buffer_rsrc_t rsB = __builtin_amdgcn_make_buffer_rsrc((void*)Bt, 0, -1, 0x00020000);
  int tt = blockIdx.x;
  int brow = 0, bcol = 0;
  if (tt < nwg) { DECODE(tt, brow, bcol); STAGE7(brow, bcol); WAIT_V(0); }
  f32x4 acc[2][2][4][2];
#define ACC_INIT(brow_, bcol_) do { \
    if (MODE == 2) { \
      const int t2 = opaque_tid(wave_s); const int wr_ = (t2 >> 6) >> 2, wc_ = (t2 >> 6) & 3, fr_ = t2 & 15, fq_ = (t2 & 63) >> 4; \
      const u16* rp_ = e.xh + (size_t)(brow_ + wr_ * 64 + fr_) * D + bcol_ + wc_ * 32 + fq_ * 8; \
      _Pragma("unroll") for (int ai = 0; ai < 2; ++ai) _Pragma("unroll") for (int bj = 0; bj < 2; ++bj) \
      _Pragma("unroll") for (int m = 0; m < 4; ++m) { \
        const uint4 x0 = *(const uint4*)(rp_ + (size_t)(ai * HALF + m * 16) * D + bj * HALF); \
        acc[ai][bj][m][0][0] = __uint_as_float(x0.x << 16); acc[ai][bj][m][0][1] = __uint_as_float(x0.x & 0xffff0000u); \
        acc[ai][bj][m][0][2] = __uint_as_float(x0.y << 16); acc[ai][bj][m][0][3] = __uint_as_float(x0.y & 0xffff0000u); \
        acc[ai][bj][m][1][0] = __uint_as_float(x0.z << 16); acc[ai][bj][m][1][1] = __uint_as_float(x0.z & 0xffff0000u); \
        acc[ai][bj][m][1][2] = __uint_as_float(x0.w << 16); acc[ai][bj][m][1][3] = __uint_as_float(x0.w & 0xffff0000u); } \
    } else { \
      _Pragma("unroll") for (int ai = 0; ai < 2; ++ai) _Pragma("unroll") for (int bj = 0; bj < 2; ++bj) \
      _Pragma("unroll") for (int m = 0; m < 4; ++m) _Pragma("unroll") for (int n = 0; n < 2; ++n) \
        acc[ai][bj][m][n] = (f32x4){0.f, 0.f, 0.f, 0.f}; \
    } } while (0)
  if (tt < nwg) ACC_INIT(brow, bcol);
  while (tt < nwg) {
    bf16x8 At[4][2], B0[2][2], B1[2][2];
    if (wr == 1) BAR;
    BAR;
    for (int t = 0; t < nt - 2; t += 2) {
      LDB(B0, 0, 0); SCHED; LDA(At, 0, 0); STAGE(SA(1, 1), rsA, brow + HALF, t + 1);
      WAIT_L(8); BAR; WAIT_L(0); MMA(0, 0, At, B0); BAR; SCHED;
      LDB(B1, 0, 1); STAGEB(SB(0, 0), rsB, bcol, t + 2);
      BAR; WAIT_L(0); MMA(0, 1, At, B1); BAR;
      LDA(At, 0, 1); STAGE(SA(0, 0), rsA, brow, t + 2);
      BAR; WAIT_L(0); MMA(1, 0, At, B0); BAR; SCHED;
      STAGEB(SB(0, 1), rsB, bcol + HALF, t + 2);
      WAIT_V(6); BAR; MMA(1, 1, At, B1); BAR;
      LDB(B0, 1, 0); SCHED; LDA(At, 1, 0); STAGE(SA(0, 1), rsA, brow + HALF, t + 2);
      WAIT_L(8); BAR; WAIT_L(0); MMA(0, 0, At, B0); BAR; SCHED;
      LDB(B1, 1, 1); STAGEB(SB(1, 0), rsB, bcol, t + 3);
      BAR; WAIT_L(0); MMA(0, 1, At, B1); BAR;
      LDA(At, 1, 1); STAGE(SA(1, 0), rsA, brow, t + 3);
      BAR; WAIT_L(0); MMA(1, 0, At, B0); BAR; SCHED;
      STAGEB(SB(1, 1), rsB, bcol + HALF, t + 3);
      WAIT_V(6); BAR; MMA(1, 1, At, B1); BAR;
    }
    { LDB(B0, 0, 0); LDA(At, 0, 0); STAGE(SA(1, 1), rsA, brow + HALF, nt - 1);
      BAR; WAIT_L(0); MMA(0, 0, At, B0); BAR;
      LDB(B1, 0, 1); BAR; WAIT_L(0); MMA(0, 1, At, B1); BAR;
      LDA(At, 0, 1); WAIT_V(4); BAR; WAIT_L(0); MMA(1, 0, At, B0); MMA(1, 1, At, B1); BAR; }
    { LDB(B0, 1, 0); LDA(At, 1, 0); WAIT_V(2); BAR; WAIT_L(0); MMA(0, 0, At, B0); BAR;
      LDB(B1, 1, 1); WAIT_V(0); BAR; WAIT_L(0); MMA(0, 1, At, B1); BAR;
      LDA(At, 1, 1); BAR; WAIT_L(0); MMA(1, 0, At, B0); MMA(1, 1, At, B1); BAR; }
    if (wr == 0) BAR;
    const int erow = brow, ecol = bcol;
    tt += gridDim.x;
    if (tt < nwg) { DECODE(tt, brow, bcol); STAGE7(brow, bcol); }
    SCHED;
    if (!dry) {
      const int tid1 = opaque_tid(wave_s);
      const int wr = (tid1 >> 6) >> 2, wc = (tid1 >> 6) & 3, fr = tid1 & 15, fq = (tid1 & 63) >> 4;
      float rsv[2][4];
#pragma unroll
      for (int ai = 0; ai < 2; ++ai)
#pragma unroll
        for (int m = 0; m < 4; ++m) {
          rsv[ai][m] = 0.f;
          if (MODE == 1 || MODE == 3) rsv[ai][m] = e.sumsq_in[(size_t)erow + ai * HALF + wr * 64 + m * 16 + fr];
        }
#pragma unroll
      for (int ai = 0; ai < 2; ++ai)
#pragma unroll
        for (int m = 0; m < 4; ++m) {
          const int lrow = ai * HALF + wr * 64 + m * 16 + fr;
          const size_t grow = (size_t)erow + lrow;
          float rs = 0.f, ssq = 0.f;
          if (MODE == 1 || MODE == 3) rs = rsqrtf(rsv[ai][m] * (1.0f / 1024.0f) + EPS);
#pragma unroll
          for (int bj = 0; bj < 2; ++bj)
            epi8<MODE>(e, acc[ai][bj][m][0], acc[ai][bj][m][1], rs, grow, ecol + bj * HALF + wc * 32 + fq * 8, ssq);
          if (MODE == 2 && e.sumsq_out) {
            ssq += __shfl_xor(ssq, 16); ssq += __shfl_xor(ssq, 32);
            if (fq == 0) atomicAdd(e.sumsq_out + grow, ssq);
          }
          SCHED;
        }
    }
    if (tt < nwg) ACC_INIT(brow, bcol);
    if (dry) WAIT_V(0); else WAIT_V(16);
  }
  WAIT_V(0);
#undef SA
#undef SB
#undef STAGE
#undef STAGEB
#undef STAGE_
#undef LDA
#undef LDB
#undef MMA
}

#define MFMA32(a, b, c) __builtin_amdgcn_mfma_f32_32x32x16_bf16((a), (b), (c), 0, 0, 0)

template <int MODE>
__device__ __forceinline__ void sample_gemm(const u16* __restrict__ A, const u16* __restrict__ Bt, const int N, const int K, const GemmEpi e, const int wave_s, const int b0, const int nb) {
  const int bi = (int)blockIdx.x - b0;
  if (bi < 0 || bi >= nb) return;
  const int tid = opaque_tid(wave_s);
  const int lane = tid & 63, wid = tid >> 6;
  const int i = lane & 31, h = lane >> 5;
  const int ntask = 8 * (N / 32);
  const int ks = K / 8;
  float* red = (float*)smem;
  for (int id = bi; id < ntask; id += nb) {
    const int r0 = (id & 7) * 32, c0 = (id >> 3) * 32;
    const u16* ap = A + (size_t)(NP + r0 + i) * K + wid * ks + 8 * h;
    const u16* bp = Bt + (size_t)(c0 + i) * K + wid * ks + 8 * h;
    f32x16 acc;
#pragma unroll
    for (int q = 0; q < 16; ++q) acc[q] = 0.f;
#pragma unroll 16
    for (int k = 0; k < ks; k += 16) {
      const bf16x8 a = *(const bf16x8*)(ap + k);
      const bf16x8 b = *(const bf16x8*)(bp + k);
      acc = MFMA32(b, a, acc);
    }
#pragma unroll
    for (int q = 0; q < 4; ++q)
      *(float4*)(red + (wid * 32 + i) * 36 + 8 * q + 4 * h) = make_float4(acc[4 * q], acc[4 * q + 1], acc[4 * q + 2], acc[4 * q + 3]);
    __syncthreads();
    if (tid < 256) {
      const int row = tid >> 3, c4 = (tid & 7) * 4;
      f32x4 s4; s4[0] = 0.f; s4[1] = 0.f; s4[2] = 0.f; s4[3] = 0.f;
#pragma unroll
      for (int w = 0; w < 8; ++w) {
        const float4 v = *(const float4*)(red + (w * 32 + row) * 36 + c4);
        s4[0] += v.x; s4[1] += v.y; s4[2] += v.z; s4[3] += v.w;
      }
      const int srow = r0 + row, col0 = c0 + c4;
      const size_t grow = (size_t)NP + srow;
      float rs = 0.f, ssq = 0.f;
      if (MODE == 1 || MODE == 3) rs = rsqrtf(e.sumsq_in[grow] * (1.0f / 1024.0f) + EPS);
      epi4<MODE, true>(e, s4, rs, grow, col0, ssq);
      if (MODE == 2 && e.sumsq_out) {
        ssq += __shfl_xor(ssq, 1); ssq += __shfl_xor(ssq, 2); ssq += __shfl_xor(ssq, 4);
        if ((tid & 7) == 0) atomicAdd(e.sumsq_out + grow, ssq);
      }
    }
    __syncthreads();
  }
}

template <int MODE>
__device__ __forceinline__ void sample_gemm64(const u16* __restrict__ A, const u16* __restrict__ Bt, const int N, const int K, const GemmEpi e, const int wave_s, const bool reverse) {
  const int tid = opaque_tid(wave_s);
  const int lane = tid & 63, wid = tid >> 6;
  const int i = lane & 31, h = lane >> 5;
  const int ri = wid & 1, ci = (wid >> 1) & 1, kh = wid >> 2;
  const int ntask = 4 * (N / 64);
  const int kspan = K / 2;
  float* red = (float*)smem;
  const int G = gridDim.x;
  for (int id = reverse ? G - 1 - (int)blockIdx.x : (int)blockIdx.x; id < ntask; id += G) {
    const int r0 = (id & 3) * 64 + ri * 32, c0 = (id >> 2) * 64 + ci * 32;
    const u16* ap = A + (size_t)(NP + r0 + i) * K + kh * kspan + 8 * h;
    const u16* bp = Bt + (size_t)(c0 + i) * K + kh * kspan + 8 * h;
    f32x16 acc;
#pragma unroll
    for (int q = 0; q < 16; ++q) acc[q] = 0.f;
#pragma unroll 16
    for (int k = 0; k < kspan; k += 16) {
      const bf16x8 a = *(const bf16x8*)(ap + k);
      const bf16x8 b = *(const bf16x8*)(bp + k);
      acc = MFMA32(b, a, acc);
    }
    float* rb = red + ((wid & 3) * 32 + i) * 36 + 4 * h;
    if (kh == 1) {
#pragma unroll
      for (int q = 0; q < 4; ++q) *(float4*)(rb + 8 * q) = make_float4(acc[4 * q], acc[4 * q + 1], acc[4 * q + 2], acc[4 * q + 3]);
    }
    __syncthreads();
    if (kh == 0) {
      const size_t grow = (size_t)NP + r0 + i;
      const float rs = rsqrtf(e.sumsq_in[grow] * (1.0f / 1024.0f) + EPS);
      float ssq = 0.f;
#pragma unroll
      for (int q = 0; q < 4; ++q) {
        const float4 o = *(const float4*)(rb + 8 * q);
        f32x4 a4; a4[0] = acc[4 * q] + o.x; a4[1] = acc[4 * q + 1] + o.y; a4[2] = acc[4 * q + 2] + o.z; a4[3] = acc[4 * q + 3] + o.w;
        epi4<MODE, false>(e, a4, rs, grow, c0 + 8 * q + 4 * h, ssq);
      }
    }
    __syncthreads();
  }
}

__device__ __forceinline__ void kv_shift_copy(const Params& p, const int l, const int b0, const int nb, const int tid) {
  const int bi = (int)blockIdx.x - b0;
  if (bi < 0 || bi >= nb) return;
  const size_t gt = (size_t)bi * 512 + tid, ntd = (size_t)nb * 512;
#pragma unroll
  for (int g = 0; g < 3; ++g) {
    const int W = 128 << (2 * g);
    const size_t n4 = (size_t)32 * W * 64;
    const size_t oo = (g == 0) ? O_KV128S : (g == 1) ? O_KV512S : O_KV2048S;
    const f32x4* src = (const f32x4*)p.kv_in[g] + (size_t)l * n4;
    f32x4* dst = (f32x4*)(p.out + oo) + (size_t)l * n4;
    const unsigned per = (unsigned)W * 64u, lim = (unsigned)(W - 8) * 64u;
    for (size_t i0 = gt; i0 < n4; i0 += ntd * 8) {
      f32x4 v[8];
#pragma unroll
      for (int k = 0; k < 8; ++k) {
        const size_t i = i0 + (size_t)k * ntd;
        v[k] = (f32x4){0.f, 0.f, 0.f, 0.f};
        if (i < n4 && ((unsigned)i % per) < lim) v[k] = __builtin_nontemporal_load(src + i + 512);
      }
#pragma unroll
      for (int k = 0; k < 8; ++k) {
        const size_t i = i0 + (size_t)k * ntd;
        if (i < n4 && ((unsigned)i % per) < lim) __builtin_nontemporal_store(v[k], dst + i);
      }
    }
  }
}

__device__ __forceinline__ void tr_tile(const float* __restrict__ src, u16* __restrict__ dst, int K, int N, int k0, int n0, const int tid, const float* __restrict__ gain) {
  float* lt = (float*)smem;
  { const int kk = tid >> 4, n4 = tid & 15;
#pragma unroll
    for (int i = 0; i < 2; ++i) {
      const int k = kk + i * 32;
      const float4 v = *(const float4*)(src + (size_t)(k0 + k) * N + n0 + n4 * 4);
      float* d = lt + k * 65 + n4 * 4;
      d[0] = v.x; d[1] = v.y; d[2] = v.z; d[3] = v.w;
    } }
  __syncthreads();
  { const int n = tid >> 3, k8 = tid & 7;
    float f[8];
#pragma unroll
    for (int i = 0; i < 8; ++i) f[i] = lt[(k8 * 8 + i) * 65 + n] * (gain ? gain[k0 + k8 * 8 + i] : 1.0f);
    uint4 o; o.x = pack2(f[0], f[1]); o.y = pack2(f[2], f[3]); o.z = pack2(f[4], f[5]); o.w = pack2(f[6], f[7]);
    *(uint4*)(dst + (size_t)(n0 + n) * K + k0 + k8 * 8) = o; }
  __syncthreads();
}

__device__ __forceinline__ void phase0(const Params& p, const int wave_s) {
  const int tid = opaque_tid(wave_s), lane = tid & 63, wid = tid >> 6;
  const int gw = blockIdx.x * 8 + wid, nw = gridDim.x * 8;
  const size_t gt = (size_t)blockIdx.x * 512 + tid, ntd = (size_t)gridDim.x * 512;
  for (int row0 = gw; row0 < MT; row0 += 2 * nw) {
    float4 v[2][4];
#pragma unroll
    for (int u = 0; u < 2; ++u) {
      const int row = min(row0 + u * nw, MT - 1);
      const float4* xr = (const float4*)(row < NP ? p.x_prompt + (size_t)row * D : p.x_sample + (size_t)(row - NP) * D);
#pragma unroll
      for (int i = 0; i < 4; ++i) v[u][i] = xr[lane + 64 * i];
    }
#pragma unroll
    for (int u = 0; u < 2; ++u) {
      const int row = row0 + u * nw;
      if (row < MT) {
        float ss = 0.f;
#pragma unroll
        for (int i = 0; i < 4; ++i) {
          const float4 x = v[u][i];
          ss += x.x * x.x + x.y * x.y + x.z * x.z + x.w * x.w;
          uint2 o; o.x = pack2(x.x, x.y); o.y = pack2(x.z, x.w);
          *(uint2*)(p.xg + (size_t)row * D + (lane + 64 * i) * 4) = o;
        }
        ss = wave_sum(ss);
        if (lane == 0) p.sumsq[row] = ss;
      }
    }
  }
  for (size_t i = gt; i < (size_t)3 * MT; i += ntd) p.sumsq[MT + i] = 0.f;
  for (size_t i = gt; i < (size_t)2056 * 8; i += ntd) {
    const int pi = (int)(i >> 3), fi = (int)(i & 7);
    const int pos = pi < 2048 ? pi : 8192 + (pi - 2048);
    float inv;
    switch (fi) { case 0: inv = 1.0f; break; case 1: inv = 0.1939227432012558f; break; case 2: inv = 0.03760603070259094f; break;
      case 3: inv = 0.007292664609849453f; break; case 4: inv = 0.0014142135623842478f; break; case 5: inv = 0.00027424818836152554f; break;
      case 6: inv = 5.318296098266728e-05f; break; default: inv = 1.0313386155758053e-05f; break; }
    const float ang = (float)pos * inv;
    p.rope[pi * 16 + fi] = cosf(ang);
    p.rope[pi * 16 + 8 + fi] = sinf(ang);
  }
  {
    float* lt = (float*)smem;
    constexpr int QL = (640 + 192 + 1024 + 1024) / 4;
    for (int t = blockIdx.x; t < 2 * QL; t += gridDim.x) {
      const int l = t / QL; int r = t % QL;
      const float* src; u16* dst; int K, N; const float* gain = nullptr;
      if (r < 160) { src = p.w_in + (size_t)l * D * IC; dst = p.wt_in + (size_t)l * IC * D; K = D; N = IC; gain = p.norm1_g + l * D; }
      else if (r < 208) { r -= 160; src = p.w_out + (size_t)l * MC * D; dst = p.wt_out + (size_t)l * D * MC; K = MC; N = D; }
      else if (r < 464) { r -= 208; src = p.w_up + (size_t)l * D * FF; dst = p.wt_up + (size_t)l * FF * D; K = D; N = FF; gain = p.norm2_g + l * D; }
      else { r -= 464; src = p.w_down + (size_t)l * FF * D; dst = p.wt_down + (size_t)l * D * FF; K = FF; N = D; }
      const int nq = N / 256;
      const int k0 = (r / nq) * 64, n0 = (r % nq) * 256;
      { const int kk = tid >> 6, n4 = tid & 63;
        float4 v[8];
#pragma unroll
        for (int i = 0; i < 8; ++i) v[i] = *(const float4*)(src + (size_t)(k0 + kk + 8 * i) * N + n0 + n4 * 4);
#pragma unroll
        for (int i = 0; i < 8; ++i) {
          const float gg = gain ? gain[k0 + kk + 8 * i] : 1.0f;
          *(float4*)(lt + (kk + 8 * i) * 260 + n4 * 4) = make_float4(v[i].x * gg, v[i].y * gg, v[i].z * gg, v[i].w * gg);
        } }
      __syncthreads();
      { const int n = tid >> 1, kh = (tid & 1) * 32;
        u16* dp = dst + (size_t)(n0 + n) * K + k0 + kh;
#pragma unroll
        for (int c = 0; c < 4; ++c) {
          float f[8];
#pragma unroll
          for (int i = 0; i < 8; ++i) f[i] = lt[(kh + c * 8 + i) * 260 + n];
          uint4 o; o.x = pack2(f[0], f[1]); o.y = pack2(f[2], f[3]); o.z = pack2(f[4], f[5]); o.w = pack2(f[6], f[7]);
          *(uint4*)(dp + c * 8) = o;
        } }
      __syncthreads();
    }
    for (int t = blockIdx.x; t < 8; t += gridDim.x)
      tr_tile(p.pool_w + (size_t)t * 4096, p.pwT + (size_t)t * 4096, 64, 64, 0, 0, tid, nullptr);
  }
}


__device__ __forceinline__ void qk_raw(const u16* __restrict__ rowp, bf16x8 raw[4], const int h) {
#pragma unroll
  for (int s = 0; s < 4; ++s) raw[s] = *(const bf16x8*)(rowp + 16 * s + 8 * h);
}
__device__ __forceinline__ void qk_finish(const bf16x8 raw[4], const float* __restrict__ ropep, const float* __restrict__ gain,
                                          const float scale, bf16x8 out[4], const int h) {
  float f[4][8];
  float ss = 0.f;
#pragma unroll
  for (int s = 0; s < 4; ++s) {
#pragma unroll
    for (int j = 0; j < 8; ++j) { f[s][j] = bfs2f(raw[s][j]); ss += f[s][j] * f[s][j]; }
  }
  ss += __shfl_xor(ss, 32);
  const float inv = rsqrtf(ss * (1.0f / 64.0f) + EPS);
#pragma unroll
  for (int s = 0; s < 4; ++s) {
    const float4 g0 = *(const float4*)(gain + 16 * s + 8 * h), g1 = *(const float4*)(gain + 16 * s + 8 * h + 4);
    f[s][0] *= inv * g0.x; f[s][1] *= inv * g0.y; f[s][2] *= inv * g0.z; f[s][3] *= inv * g0.w;
    f[s][4] *= inv * g1.x; f[s][5] *= inv * g1.y; f[s][6] *= inv * g1.z; f[s][7] *= inv * g1.w;
  }
  {
    const float4 c0 = *(const float4*)(ropep), c1 = *(const float4*)(ropep + 4), s0 = *(const float4*)(ropep + 8), s1 = *(const float4*)(ropep + 12);
    const float cs[8] = {c0.x, c0.y, c0.z, c0.w, c1.x, c1.y, c1.z, c1.w};
    const float sn[8] = {s0.x, s0.y, s0.z, s0.w, s1.x, s1.y, s1.z, s1.w};
#pragma unroll
    for (int j = 0; j < 8; ++j) {
      const float other = __shfl_xor(f[0][j], 32);
      f[0][j] = (h == 0) ? (f[0][j] * cs[j] - other * sn[j]) : (f[0][j] * cs[j] + other * sn[j]);
    }
  }
#pragma unroll
  for (int s = 0; s < 4; ++s)
    out[s] = pack8(f[s][0] * scale, f[s][1] * scale, f[s][2] * scale, f[s][3] * scale, f[s][4] * scale, f[s][5] * scale, f[s][6] * scale, f[s][7] * scale);
}

template <bool SAMPLE>
__device__ __forceinline__ void attn_task(const Params& p, const int layer, const int task, const int wid) {
  const int lane = opaque_lane();
  int g, hslot, b, r, tile, nq;
  if (!SAMPLE) {
    const int c = task & 63; int tmp = task >> 6; g = tmp % 3; tmp /= 3; hslot = tmp & 1; b = tmp >> 1;
    const int tpc = 64 >> (2 * g);
    r = c / tpc; tile = c % tpc; nq = 32;
  } else {
    b = task / 26; const int rem = task % 26; hslot = rem / 13; const int c = rem % 13;
    if (c == 0) { g = 0; r = 0; nq = 8; } else if (c < 5) { g = 1; r = c - 1; nq = 2; } else { g = 2; r = c - 5; nq = 1; }
    tile = 4;
  }
  const int dl = 1 << (2 * g);
  const int W = 128 << (2 * g);
  const int m0 = tile * 32;
  const int head = 2 * g + hslot;
  const u16* projb = SAMPLE ? p.proj + (size_t)(NP + b * 8) * IC : p.proj + (size_t)b * 2048 * IC;
  const int ropeb = SAMPLE ? 2048 : 0;
  const float* cache = SAMPLE ? ((g == 0) ? p.kv_in[0] : (g == 1) ? p.kv_in[1] : p.kv_in[2]) + (size_t)(layer * 32 + b) * W * 256 + hslot * 64 : nullptr;
  const int qi = lane & 31, h = lane >> 5;
  int tq;
  if (SAMPLE) tq = r + dl * (qi < nq ? qi : 0); else tq = (m0 + qi) * dl + r;
  const int kt_lo = SAMPLE ? 0 : max(0, 4 - tile);
  bf16x8 qraw[4], kraw[5][4];
  qk_raw(projb + (size_t)tq * IC + C_Q + head * 64, qraw, h);
#pragma unroll
  for (int kt = 0; kt < 5; ++kt) {
    if (kt >= kt_lo && !(SAMPLE && kt < 4)) {
      int tk;
      if (SAMPLE) tk = r + dl * (qi < nq ? qi : 0); else tk = (m0 - 128 + 32 * kt + qi) * dl + r;
      qk_raw(projb + (size_t)tk * IC + C_K + head * 64, kraw[kt], h);
    } else {
#pragma unroll
      for (int s = 0; s < 4; ++s) kraw[kt][s] = (bf16x8){0, 0, 0, 0, 0, 0, 0, 0};
    }
  }
  bf16x8 qf[4];
  qk_finish(qraw, p.rope + (ropeb + tq) * 16, p.q_norm_g + layer * 64, 0.125f, qf, h);
  f32x16 sacc[5];
#pragma unroll
  for (int kt = 0; kt < 5; ++kt) {
#pragma unroll
    for (int i = 0; i < 16; ++i) sacc[kt][i] = 0.f;
    if (kt >= kt_lo) {
      bf16x8 kf[4];
      if (SAMPLE && kt < 4) {
        const float* kp = cache + (size_t)(r + dl * (32 * kt + qi)) * 256 + 8 * h;
#pragma unroll
        for (int s = 0; s < 4; ++s) {
          const float4 x0 = *(const float4*)(kp + 16 * s), x1 = *(const float4*)(kp + 16 * s + 4);
          kf[s] = pack8(x0.x, x0.y, x0.z, x0.w, x1.x, x1.y, x1.z, x1.w);
        }
      } else {
        int tk;
        if (SAMPLE) tk = r + dl * (qi < nq ? qi : 0); else tk = (m0 - 128 + 32 * kt + qi) * dl + r;
        qk_finish(kraw[kt], p.rope + (ropeb + tk) * 16, p.k_norm_g + layer * 64, 1.0f, kf, h);
      }
#pragma unroll
      for (int s = 0; s < 4; ++s) sacc[kt] = MFMA32(kf[s], qf[s], sacc[kt]);
    }
  }
  const int srow = lane >> 1, shf = (lane & 1) * 32;
  uint4 vraw[5][4];
#pragma unroll
  for (int kt = 0; kt < 5; ++kt) {
    if (kt >= kt_lo && !(SAMPLE && kt < 4)) {
      int tk;
      if (SAMPLE) tk = r + dl * (srow < nq ? srow : 0); else tk = (m0 - 128 + 32 * kt + srow) * dl + r;
      const u16* vp = projb + (size_t)tk * IC + C_V + head * 64 + shf;
#pragma unroll
      for (int c = 0; c < 4; ++c) vraw[kt][c] = *(const uint4*)(vp + 8 * c);
    } else {
#pragma unroll
      for (int c = 0; c < 4; ++c) vraw[kt][c] = make_uint4(0u, 0u, 0u, 0u);
    }
  }
  float mx = -1e30f;
#pragma unroll
  for (int kt = 0; kt < 5; ++kt)
#pragma unroll
    for (int rr = 0; rr < 16; ++rr) {
      const int keyrow = (rr & 3) + 8 * (rr >> 2) + 4 * h;
      const int dist = 128 - 32 * kt + qi - keyrow;
      const bool valid = (kt >= kt_lo) && dist >= 0 && dist <= 128;
      const float s = valid ? sacc[kt][rr] : -1e30f;
      sacc[kt][rr] = s;
      mx = fmaxf(mx, s);
    }
  mx = fmaxf(mx, __shfl_xor(mx, 32));
  float sum = 0.f;
#pragma unroll
  for (int kt = 0; kt < 5; ++kt)
#pragma unroll
    for (int rr = 0; rr < 16; ++rr) {
      const float s = sacc[kt][rr];
      const float ex = (s > -1e29f) ? __expf(s - mx) : 0.f;
      sacc[kt][rr] = ex;
      sum += ex;
    }
  sum += __shfl_xor(sum, 32);
  bf16x8 pfa[5][2];
#pragma unroll
  for (int kt = 0; kt < 5; ++kt)
#pragma unroll
    for (int s2 = 0; s2 < 2; ++s2)
      pfa[kt][s2] = pack8(sacc[kt][8 * s2], sacc[kt][8 * s2 + 1], sacc[kt][8 * s2 + 2], sacc[kt][8 * s2 + 3], sacc[kt][8 * s2 + 4], sacc[kt][8 * s2 + 5], sacc[kt][8 * s2 + 6], sacc[kt][8 * s2 + 7]);
  f32x16 oacc[2];
#pragma unroll
  for (int i = 0; i < 16; ++i) { oacc[0][i] = 0.f; oacc[1][i] = 0.f; }
  u16* vt = (u16*)(smem + wid * 16384);
#pragma unroll
  for (int kt = 0; kt < 5; ++kt) {
    if (kt >= kt_lo) {
      u16* vb = vt + (kt & 1) * (32 * 72);
      if (SAMPLE && kt < 4) {
        const float* vp = cache + (size_t)(r + dl * (32 * kt + srow)) * 256 + 128 + shf;
#pragma unroll
        for (int c = 0; c < 4; ++c) {
          const float4 x0 = *(const float4*)(vp + 8 * c), x1 = *(const float4*)(vp + 8 * c + 4);
          uint4 o; o.x = pack2(x0.x, x0.y); o.y = pack2(x0.z, x0.w); o.z = pack2(x1.x, x1.y); o.w = pack2(x1.z, x1.w);
          *(uint4*)(vb + srow * 72 + shf + 8 * c) = o;
        }
      } else {
#pragma unroll
        for (int c = 0; c < 4; ++c) *(uint4*)(vb + srow * 72 + shf + 8 * c) = vraw[kt][c];
      }
#pragma unroll
      for (int s2 = 0; s2 < 2; ++s2) {
        bf16x8 v0, v1;
#pragma unroll
        for (int j = 0; j < 8; ++j) {
          const int kr = 16 * s2 + 8 * (j >> 2) + 4 * h + (j & 3);
          v0[j] = (short)vb[kr * 72 + qi]; v1[j] = (short)vb[kr * 72 + qi + 32];
        }
        oacc[0] = MFMA32(v0, pfa[kt][s2], oacc[0]);
        oacc[1] = MFMA32(v1, pfa[kt][s2], oacc[1]);
      }
    }
  }
  const float isum = 1.0f / sum;
  const size_t rowq = SAMPLE ? (size_t)NP + b * 8 + tq : (size_t)b * 2048 + tq;
  if (!SAMPLE || qi < nq) {
    u16* op = p.opart + ((size_t)g * MT + rowq) * 128 + hslot * 64;
#pragma unroll
    for (int db = 0; db < 2; ++db)
#pragma unroll
      for (int i4 = 0; i4 < 4; ++i4) {
        uint2 o; o.x = pack2(oacc[db][4 * i4] * isum, oacc[db][4 * i4 + 1] * isum); o.y = pack2(oacc[db][4 * i4 + 2] * isum, oacc[db][4 * i4 + 3] * isum);
        *(uint2*)(op + db * 32 + 8 * i4 + 4 * h) = o;
      }
    if (h == 0) p.lse[((size_t)g * MT + rowq) * 2 + hslot] = mx + __logf(sum);
  }
}

__device__ __forceinline__ void kv_row_task(const Params& p, const int l, const int row, const int lane, const bf16x8 kr, const bf16x8 vr) {
  const int hl = lane < 48 ? lane : 47;
  const int head = hl >> 3, c8 = hl & 7;
  int b, t, ridx;
  const bool prompt = row < NP;
  if (prompt) { b = row >> 11; t = row & 2047; ridx = t; } else { b = (row - NP) >> 3; t = (row - NP) & 7; ridx = 2048 + t; }
  float f[8]; float ss = 0.f;
#pragma unroll
  for (int j = 0; j < 8; ++j) { f[j] = bfs2f(kr[j]); ss += f[j] * f[j]; }
  ss += __shfl_xor(ss, 1); ss += __shfl_xor(ss, 2); ss += __shfl_xor(ss, 4);
  const float inv = rsqrtf(ss * (1.0f / 64.0f) + EPS);
  const float* gk = p.k_norm_g + l * 64 + c8 * 8;
#pragma unroll
  for (int j = 0; j < 8; ++j) f[j] *= inv * gk[j];
  const float* rp = p.rope + ridx * 16;
#pragma unroll
  for (int j = 0; j < 8; ++j) {
    const float other = __shfl_xor(f[j], 1);
    const float cs = rp[j], sn = rp[8 + j];
    if (c8 == 0) f[j] = f[j] * cs - other * sn;
    else if (c8 == 1) f[j] = f[j] * cs + other * sn;
  }
  const int g = head >> 1, hh = head & 1;
  const int W = 128 << (2 * g);
  float* dst = nullptr;
  if (prompt) {
    const int r = t - (2048 - W);
    const size_t base = (g == 0) ? O_KV128P : (g == 1) ? O_KV512P : O_KV2048P;
    if (r >= 0) dst = p.out + base + ((size_t)(l * 8 + b) * W + r) * 256 + hh * 64 + c8 * 8;
  } else {
    const int r = W - 8 + t;
    const size_t base = (g == 0) ? O_KV128S : (g == 1) ? O_KV512S : O_KV2048S;
    dst = p.out + base + ((size_t)(l * 32 + b) * W + r) * 256 + hh * 64 + c8 * 8;
  }
  if (dst && lane < 48) {
    *(float4*)(dst) = make_float4(f[0], f[1], f[2], f[3]);
    *(float4*)(dst + 4) = make_float4(f[4], f[5], f[6], f[7]);
    *(float4*)(dst + 128) = make_float4(bfs2f(vr[0]), bfs2f(vr[1]), bfs2f(vr[2]), bfs2f(vr[3]));
    *(float4*)(dst + 132) = make_float4(bfs2f(vr[4]), bfs2f(vr[5]), bfs2f(vr[6]), bfs2f(vr[7]));
  }
}

__device__ __forceinline__ void phaseA(const Params& p, const int l, const int wave_s) {
  const int tid = opaque_tid(wave_s);
  const int lane = tid & 63, wid = tid >> 6;
  const int gw = blockIdx.x * 8 + wid, nw = gridDim.x * 8;
  for (int task = gw; task < 832 + 3072; task += nw) { if (task < 832) attn_task<true>(p, l, task, wid); else attn_task<false>(p, l, task - 832, wid); }
  for (int row0 = nw - 1 - gw; row0 < MT; row0 += 4 * nw) {
    const int hl = lane < 48 ? lane : 47;
    bf16x8 kr[4], vr[4];
#pragma unroll
    for (int u = 0; u < 4; ++u) {
      const int rc = min(row0 + u * nw, MT - 1);
      const u16* pr = p.proj + (size_t)rc * IC;
      kr[u] = *(const bf16x8*)(pr + C_K + hl * 8);
      vr[u] = *(const bf16x8*)(pr + C_V + hl * 8);
    }
#pragma unroll
    for (int u = 0; u < 4; ++u) if (row0 + u * nw < MT) kv_row_task(p, l, row0 + u * nw, lane, kr[u], vr[u]);
  }
}

template <int GRP>
__device__ __forceinline__ void pool_task(const Params& p, const int l, const int task, const int lane) {
  const int tile = task >> 2; constexpr int grp = GRP;
  const int qi = lane & 31, h = lane >> 5;
  const int row = tile * 32 + qi;
  constexpr int w = 2 << GRP;
  const bool prompt = row < NP;
  int n, t; float cnt;
  if (prompt) { n = row >> 11; t = row & 2047; cnt = (float)min(t + 1, w); } else { n = (row - NP) >> 3; t = (row - NP) & 7; cnt = (float)w; }
  const float icnt = 1.0f / cnt;
  f32x16 acc[2];
#pragma unroll
  for (int i = 0; i < 16; ++i) { acc[0][i] = 0.f; acc[1][i] = 0.f; }
  const u16* pw = p.pwT + (size_t)(l * 4 + grp) * 4096;
#pragma unroll
  for (int s = 0; s < 4; ++s) {
    const int c0 = grp * 64 + 16 * s + 8 * h;
    float sum[8], own[8];
#pragma unroll
    for (int j = 0; j < 8; ++j) { sum[j] = 0.f; own[j] = 0.f; }
#pragma unroll
    for (int i = 0; i < w; ++i) {
      const int tt = t - i;
      float v[8];
      if (tt >= 0) {
        const bf16x8 raw = *(const bf16x8*)(p.proj + (size_t)(row - i) * IC + C_U + c0);
#pragma unroll
        for (int j = 0; j < 8; ++j) v[j] = bfs2f(raw[j]);
      } else if (!prompt) {
        const float* sp = p.state_pool + ((size_t)(l * 32 + n) * 15 + 15 + tt) * 256 + c0;
        const float4 a = *(const float4*)sp, bb = *(const float4*)(sp + 4);
        v[0] = a.x; v[1] = a.y; v[2] = a.z; v[3] = a.w; v[4] = bb.x; v[5] = bb.y; v[6] = bb.z; v[7] = bb.w;
      } else {
#pragma unroll
        for (int j = 0; j < 8; ++j) v[j] = 0.f;
      }
#pragma unroll
      for (int j = 0; j < 8; ++j) sum[j] += v[j];
      if (i == 0) {
#pragma unroll
        for (int j = 0; j < 8; ++j) own[j] = v[j];
      }
    }
    const bf16x8 df = pack8(sum[0] * icnt - own[0], sum[1] * icnt - own[1], sum[2] * icnt - own[2], sum[3] * icnt - own[3],
                            sum[4] * icnt - own[4], sum[5] * icnt - own[5], sum[6] * icnt - own[6], sum[7] * icnt - own[7]);
    const bf16x8 a0 = *(const bf16x8*)(pw + (size_t)qi * 64 + 16 * s + 8 * h);
    const bf16x8 a1 = *(const bf16x8*)(pw + (size_t)(qi + 32) * 64 + 16 * s + 8 * h);
    acc[0] = MFMA32(a0, df, acc[0]);
    acc[1] = MFMA32(a1, df, acc[1]);
  }
  const float* ps = p.pool_scale + l * 256 + grp * 64;
  u16* mp = p.mixed + (size_t)row * MC + grp * 64;
#pragma unroll
  for (int db = 0; db < 2; ++db)
#pragma unroll
    for (int i4 = 0; i4 < 4; ++i4) {
      const int dd0 = db * 32 + 8 * i4 + 4 * h;
      const float4 sc = *(const float4*)(ps + dd0);
      uint2 o; o.x = pack2(acc[db][4 * i4] * sc.x, acc[db][4 * i4 + 1] * sc.y); o.y = pack2(acc[db][4 * i4 + 2] * sc.z, acc[db][4 * i4 + 3] * sc.w);
      *(uint2*)(mp + dd0) = o;
    }
}

__device__ __forceinline__ void phaseB(const Params& p, const int l, const int wave_s) {
  const int tid = opaque_tid(wave_s), lane = tid & 63, wid = tid >> 6;
  const int gw = blockIdx.x * 8 + wid, nw = gridDim.x * 8;
  const size_t gt = (size_t)blockIdx.x * 512 + tid, ntd = (size_t)gridDim.x * 512;
  {
    const bool spread = (nw == 2048);
    const int nit = spread ? 2 : (2080 + nw - 1) / nw;
    for (int it = 0; it < nit; ++it) {
      int task = gw + it * nw;
      if (spread && it == 1) task = ((gw & 63) == 0) ? 2048 + (gw >> 6) : 2080;
      if (task >= 2080) break;
      switch (task & 3) { case 0: pool_task<0>(p, l, task, lane); break; case 1: pool_task<1>(p, l, task, lane); break;
                          case 2: pool_task<2>(p, l, task, lane); break; default: pool_task<3>(p, l, task, lane); break; }
    }
  }
  for (size_t idx = gt; idx < (size_t)(MT / 8) * 48; idx += ntd) {
    const int row0 = (int)(idx / 48) * 8, ch = (int)(idx % 48) * 8;
    const bool prompt = row0 < NP;
    int n, t0;
    if (prompt) { n = row0 >> 11; t0 = row0 & 2047; } else { n = (row0 - NP) >> 3; t0 = (row0 - NP) & 7; }
    float z[10][8];
#pragma unroll
    for (int i = 0; i < 10; ++i) {
      const int tt = t0 - 2 + i;
      if (tt >= 0) {
        const u16* pr = p.proj + (size_t)(row0 - 2 + i) * IC;
        const bf16x8 gc = *(const bf16x8*)(pr + C_GC + ch), gh = *(const bf16x8*)(pr + C_GH + ch);
#pragma unroll
        for (int j = 0; j < 8; ++j) z[i][j] = bfs2f(gc[j]) * bfs2f(gh[j]);
      } else if (!prompt) {
        const float* sp = p.state_conv + ((size_t)(l * 32 + n) * 2 + 2 + tt) * 384 + ch;
        const float4 a = *(const float4*)sp, bb = *(const float4*)(sp + 4);
        z[i][0] = a.x; z[i][1] = a.y; z[i][2] = a.z; z[i][3] = a.w; z[i][4] = bb.x; z[i][5] = bb.y; z[i][6] = bb.z; z[i][7] = bb.w;
      } else {
#pragma unroll
        for (int j = 0; j < 8; ++j) z[i][j] = 0.f;
      }
    }
    const float* cw = p.conv_w + (size_t)l * 3 * 384 + ch;
    float c0[8], c1[8], c2[8];
#pragma unroll
    for (int j = 0; j < 8; ++j) { c0[j] = cw[j]; c1[j] = cw[384 + j]; c2[j] = cw[768 + j]; }
#pragma unroll
    for (int u = 0; u < 8; ++u) {
      const int row = row0 + u, t = t0 + u;
      const bf16x8 gb = *(const bf16x8*)(p.proj + (size_t)row * IC + C_GB + ch);
      float y[8];
#pragma unroll
      for (int j = 0; j < 8; ++j) y[j] = bfs2f(gb[j]) * (c0[j] * z[u][j] + c1[j] * z[u + 1][j] + c2[j] * z[u + 2][j]);
      uint4 o; o.x = pack2(y[0], y[1]); o.y = pack2(y[2], y[3]); o.z = pack2(y[4], y[5]); o.w = pack2(y[6], y[7]);
      *(uint4*)(p.mixed + (size_t)row * MC + 384 + ch) = o;
      float* so = nullptr;
      if (prompt) { if (t >= 2046) so = p.out + O_CONVP + ((size_t)(l * 8 + n) * 2 + (t - 2046)) * 384 + ch; }
      else { if (t >= 6) so = p.out + O_CONVS + ((size_t)(l * 32 + n) * 2 + (t - 6)) * 384 + ch; }
      if (so) { *(float4*)so = make_float4(z[u + 2][0], z[u + 2][1], z[u + 2][2], z[u + 2][3]); *(float4*)(so + 4) = make_float4(z[u + 2][4], z[u + 2][5], z[u + 2][6], z[u + 2][7]); }
    }
  }
  for (size_t idx0 = gt; idx0 < (size_t)MT * 16; idx0 += 3 * ntd) {
    float lg[3][3]; uint4 pv[3][3];
#pragma unroll
    for (int u = 0; u < 3; ++u) {
      const size_t idx = idx0 + u * ntd < (size_t)MT * 16 ? idx0 + u * ntd : idx0;
      const int row = (int)(idx >> 4), chunk = (int)(idx & 15);
      const int hslot = chunk >> 3, d0 = (chunk & 7) * 8;
#pragma unroll
      for (int g = 0; g < 3; ++g) {
        lg[u][g] = p.lse[((size_t)g * MT + row) * 2 + hslot];
        pv[u][g] = *(const uint4*)(p.opart + ((size_t)g * MT + row) * 128 + hslot * 64 + d0);
      }
    }
#pragma unroll
    for (int u = 0; u < 3; ++u) {
      const size_t idx = idx0 + u * ntd;
      if (idx < (size_t)MT * 16) {
        const int row = (int)(idx >> 4), chunk = (int)(idx & 15);
        const int hslot = chunk >> 3, d0 = (chunk & 7) * 8;
        const float m = fmaxf(lg[u][0], fmaxf(lg[u][1], lg[u][2]));
        float wg[3]; wg[0] = __expf(lg[u][0] - m); wg[1] = __expf(lg[u][1] - m); wg[2] = __expf(lg[u][2] - m);
        const float iw = 1.0f / (wg[0] + wg[1] + wg[2]);
        float y[8];
#pragma unroll
        for (int j = 0; j < 8; ++j) y[j] = 0.f;
#pragma unroll
        for (int g = 0; g < 3; ++g) {
          const uint4 a = pv[u][g];
          const float ww = wg[g] * iw;
          y[0] += ww * __uint_as_float(a.x << 16); y[1] += ww * __uint_as_float(a.x & 0xffff0000u);
          y[2] += ww * __uint_as_float(a.y << 16); y[3] += ww * __uint_as_float(a.y & 0xffff0000u);
          y[4] += ww * __uint_as_float(a.z << 16); y[5] += ww * __uint_as_float(a.z & 0xffff0000u);
          y[6] += ww * __uint_as_float(a.w << 16); y[7] += ww * __uint_as_float(a.w & 0xffff0000u);
        }
        uint4 o; o.x = pack2(y[0], y[1]); o.y = pack2(y[2], y[3]); o.z = pack2(y[4], y[5]); o.w = pack2(y[6], y[7]);
        *(uint4*)(p.mixed + (size_t)row * MC + 256 + hslot * 64 + d0) = o;
      }
    }
  }
  for (size_t idx = gt; idx < (size_t)8 * 15 * 256; idx += ntd) {
    const int c = (int)(idx & 255); const int bi = (int)(idx >> 8); const int i = bi % 15, b = bi / 15;
    p.out[O_POOLP + (size_t)l * 8 * 15 * 256 + idx] = bf2f(p.proj[((size_t)b * 2048 + 2033 + i) * IC + C_U + c]);
  }
  for (size_t idx = gt; idx < (size_t)32 * 15 * 256; idx += ntd) {
    const int c = (int)(idx & 255); const int bi = (int)(idx >> 8); const int i = bi % 15, n = bi / 15;
    float v;
    if (i < 7) v = p.state_pool[((size_t)(l * 32 + n) * 15 + 8 + i) * 256 + c];
    else v = bf2f(p.proj[((size_t)NP + n * 8 + (i - 7)) * IC + C_U + c]);
    p.out[O_POOLS + (size_t)l * 32 * 15 * 256 + idx] = v;
  }
}

#ifndef PROBEV
#define PROBEV 0
#endif
#ifndef REPM
#define REPM 0
#endif
#define NREP(k) (1 + ((REPM >> (k)) & 1))
typedef const __attribute__((address_space(4))) Params* CP;
#if defined(__HIP_DEVICE_COMPILE__)
#define LOAD_PARAMS() CP pp_ = (CP)__builtin_amdgcn_kernarg_segment_ptr(); asm volatile("" : "+s"(pp_)); const Params p = *pp_
#else
#define LOAD_PARAMS() const Params& p = p_unused
#endif
__global__ void __launch_bounds__(512, 2) mega(const Params p_unused, const int ph_lo, const int ph_hi) {
  const int wave_s = __builtin_amdgcn_readfirstlane((int)(threadIdx.x >> 6));
  if (ph_hi == -12345) cg::this_grid().sync();
  {
    LOAD_PARAMS();
    if (opaque_tid(wave_s) == 0) {
      volatile __attribute__((address_space(3))) unsigned* st = (volatile __attribute__((address_space(3))) unsigned*)(smem + BAR_LDS_OFF);
      st[0] = 0u; st[1] = 0u;
      (void)xb_add(&p.bar[XB_XCNT(xb_xcc_id())], 1u);
    }
    __syncthreads();
  }
  int ph = 0;
#define IN_PH() (ph_lo <= ph && ph < ph_hi)
#define SEAM() do { if (ph_lo <= ph && ph + 1 < ph_hi) { LOAD_PARAMS(); grid_bar(p.bar, wave_s); } ++ph; } while (0)
  if (IN_PH()) for (int rep = 0; rep < NREP(0); ++rep) { LOAD_PARAMS(); phase0(p, wave_s); }
  SEAM();
#pragma unroll 1
  for (int l = 0; l < 2; ++l) {
    if (IN_PH()) for (int rep = 0; rep < NREP(1); ++rep) {
      LOAD_PARAMS();
      GemmEpi e{}; e.sumsq_in = p.sumsq + (size_t)(2 * l) * MT; e.out_bf = p.proj; e.ldo = IC;
      gemm_phase<1>(p.xg, p.wt_in + (size_t)l * IC * D, NP, IC, D, e, wave_s);
      { const int G = gridDim.x, first = (64 * (IC / 256)) % G;
        const int b0 = first ? first : 0, nb = G - b0;
        kv_shift_copy(p, l, b0, nb, opaque_tid(wave_s));
        sample_gemm64<1>(p.xg, p.wt_in + (size_t)l * IC * D, IC, D, e, wave_s, true); }
    }
    SEAM();
    if (IN_PH()) for (int rep = 0; rep < NREP(2); ++rep) { LOAD_PARAMS(); phaseA(p, l, wave_s); }
    SEAM();
    if (IN_PH()) for (int rep = 0; rep < NREP(3); ++rep) { LOAD_PARAMS(); phaseB(p, l, wave_s); }
    SEAM();
    if (IN_PH()) for (int rep = 0; rep < NREP(4); ++rep) {
      LOAD_PARAMS();
      GemmEpi e{};
      const bool last = (rep == NREP(4) - 1);
      e.xh = p.xg; e.xh_out = last ? p.xg : p.scr16; e.out_f = nullptr; e.sumsq_out = last ? p.sumsq + (size_t)(2 * l + 1) * MT : p.scrss;
      gemm_phase<2>(p.mixed, p.wt_out + (size_t)l * D * MC, NP, D, MC, e, wave_s, 0);
      sample_gemm<2>(p.mixed, p.wt_out + (size_t)l * D * MC, D, MC, e, wave_s, 0, gridDim.x);
    }
    SEAM();
    if (IN_PH()) for (int rep = 0; rep < NREP(5); ++rep) {
      LOAD_PARAMS();
      GemmEpi e{}; e.sumsq_in = p.sumsq + (size_t)(2 * l + 1) * MT; e.out_bf = p.hf; e.ldo = FF;
      gemm_phase<3>(p.xg, p.wt_up + (size_t)l * FF * D, NP, FF, D, e, wave_s, (rep && (PROBEV & 1)) ? 1 : 0);
      if (!(rep && (PROBEV & 2))) sample_gemm64<3>(p.xg, p.wt_up + (size_t)l * FF * D, FF, D, e, wave_s, false);
    }
    SEAM();
    if (IN_PH()) for (int rep = 0; rep < NREP(6); ++rep) {
      LOAD_PARAMS();
      GemmEpi e{};
      const bool last = (rep == NREP(6) - 1);
      e.xh = p.xg; e.xh_out = last ? p.xg : p.scr16;
      if (l == 0) { e.out_f = nullptr; e.sumsq_out = last ? p.sumsq + (size_t)2 * MT : p.scrss; } else { e.out_f = last ? p.out : p.scrf; e.sumsq_out = nullptr; }
      gemm_phase<2>(p.hf, p.wt_down + (size_t)l * D * FF, NP, D, FF, e, wave_s, 0);
      sample_gemm<2>(p.hf, p.wt_down + (size_t)l * D * FF, D, FF, e, wave_s, 0, gridDim.x);
    }
    SEAM();
  }
}

extern "C" void kernel_launch(void* const* d_in, const int* in_sizes, int n_in, void* d_out, int out_size, void* d_ws, size_t ws_size, hipStream_t stream) {
  static int grid_blocks = 0;
  if (!grid_blocks) {
    int dev = 0, cus = 0, per_cu = 0;
    hipGetDevice(&dev);
    hipDeviceGetAttribute(&cus, hipDeviceAttributeMultiprocessorCount, dev);
    hipFuncSetAttribute((const void*)mega, hipFuncAttributeMaxDynamicSharedMemorySize, GEMM_LDS);
    hipOccupancyMaxActiveBlocksPerMultiprocessor(&per_cu, (const void*)mega, 512, GEMM_LDS);
    if (per_cu < 1) { fprintf(stderr, "occupancy query returned %d\n", per_cu); per_cu = 1; }
    grid_blocks = cus * 1;
  }
  Params p{};
  p.x_prompt = (const float*)d_in[0]; p.x_sample = (const float*)d_in[1]; p.state_pool = (const float*)d_in[2]; p.state_conv = (const float*)d_in[3];
  p.kv_in[0] = (const float*)d_in[4]; p.kv_in[1] = (const float*)d_in[5]; p.kv_in[2] = (const float*)d_in[6];
  p.norm1_g = (const float*)d_in[7]; p.w_in = (const float*)d_in[8]; p.q_norm_g = (const float*)d_in[9]; p.k_norm_g = (const float*)d_in[10];
  p.pool_w = (const float*)d_in[11]; p.pool_scale = (const float*)d_in[12]; p.conv_w = (const float*)d_in[13]; p.w_out = (const float*)d_in[14];
  p.norm2_g = (const float*)d_in[15]; p.w_up = (const float*)d_in[16]; p.w_down = (const float*)d_in[17];
  p.out = (float*)d_out;
  unsigned char* w = (unsigned char*)d_ws; size_t off = 0;
  auto carve = [&](size_t bytes) { unsigned char* r = w + off; off += (bytes + 255) & ~(size_t)255; return r; };
  p.bar = (unsigned*)carve(XCD_BAR_WORDS * 4);
  p.wt_in = (u16*)carve((size_t)2 * IC * D * 2);
  p.wt_out = (u16*)carve((size_t)2 * D * MC * 2);
  p.wt_up = (u16*)carve((size_t)2 * FF * D * 2);
  p.wt_down = (u16*)carve((size_t)2 * D * FF * 2);
  p.pwT = (u16*)carve((size_t)2 * 4 * 4096 * 2);
  p.xg = (u16*)carve((size_t)MT * D * 2);
  p.mixed = (u16*)carve((size_t)MT * MC * 2);
  p.sumsq = (float*)carve((size_t)4 * MT * 4);
  p.lse = (float*)carve((size_t)3 * MT * 2 * 4);
  p.rope = (float*)carve((size_t)2056 * 16 * 4);
  p.scr16 = (u16*)carve((size_t)MT * D * 2); p.scrss = (float*)carve((size_t)MT * 4); p.scrf = (float*)carve((size_t)MT * D * 4);
  p.hf = (u16*)carve((size_t)MT * FF * 2);
  p.proj = p.hf;
  p.opart = (u16*)((unsigned char*)p.hf + (((size_t)MT * IC * 2 + 255) & ~(size_t)255));
  if (off > ws_size) { fprintf(stderr, "workspace too small: need %zu have %zu\n", off, ws_size); return; }
  (void)hipMemsetAsync(p.bar, 0, XCD_BAR_WORDS * 4, stream);
  int lo = 0, hi = 13;
  void* args[] = {(void*)&p, (void*)&lo, (void*)&hi};
  hipError_t e = hipLaunchCooperativeKernel((const void*)mega, dim3(grid_blocks), dim3(512), args, GEMM_LDS, stream);
  if (e != hipSuccess) fprintf(stderr, "cooperative launch failed: %s (grid %d)\n", hipGetErrorString(e), grid_blocks);
}
```

```cpp
#include <hip/hip_runtime.h>
#include <hip/hip_cooperative_groups.h>
#include <cstdio>
namespace cg = cooperative_groups;

typedef unsigned short u16;
using bf16x8 = __attribute__((ext_vector_type(8))) short;
using f32x4 = __attribute__((ext_vector_type(4))) float;
using f32x16 = __attribute__((ext_vector_type(16))) float;

constexpr int NP = 16384, NS = 256, MT = NP + NS;
constexpr int D = 1024, IC = 2560, MC = 768, FF = 4096;
constexpr float EPS = 1e-6f;
constexpr int C_U = 0, C_Q = 256, C_K = 640, C_V = 1024, C_GB = 1408, C_GC = 1792, C_GH = 2176;
constexpr size_t O_YP = 0;
constexpr size_t O_YS = O_YP + (size_t)NP * D;
constexpr size_t O_POOLP = O_YS + (size_t)NS * D;
constexpr size_t O_CONVP = O_POOLP + 2 * 8 * 15 * 256;
constexpr size_t O_KV128P = O_CONVP + 2 * 8 * 2 * 384;
constexpr size_t O_KV512P = O_KV128P + (size_t)2 * 8 * 128 * 256;
constexpr size_t O_KV2048P = O_KV512P + (size_t)2 * 8 * 512 * 256;
constexpr size_t O_POOLS = O_KV2048P + (size_t)2 * 8 * 2048 * 256;
constexpr size_t O_CONVS = O_POOLS + 2 * 32 * 15 * 256;
constexpr size_t O_KV128S = O_CONVS + 2 * 32 * 2 * 384;
constexpr size_t O_KV512S = O_KV128S + (size_t)2 * 32 * 128 * 256;
constexpr size_t O_KV2048S = O_KV512S + (size_t)2 * 32 * 512 * 256;

struct Params {
  const float *x_prompt, *x_sample, *state_pool, *state_conv, *kv_in[3];
  const float *norm1_g, *w_in, *q_norm_g, *k_norm_g, *pool_w, *pool_scale, *conv_w, *w_out, *norm2_g, *w_up, *w_down;
  float* out;
  u16 *wt_in, *wt_out, *wt_up, *wt_down, *pwT;
  u16 *xg, *proj, *mixed, *hf;
  float *sumsq, *lse, *rope;
  u16* opart;
  unsigned* bar;
  u16* scr16; float* scrss; float* scrf;
};

extern __shared__ __attribute__((aligned(16))) unsigned char smem[];
typedef __attribute__((address_space(3))) void* LDSP;

typedef __bf16 bf16x2_t __attribute__((ext_vector_type(2)));
typedef float f32x2_t __attribute__((ext_vector_type(2)));
__device__ __forceinline__ unsigned pack2(float a, float b) { f32x2_t v = {a, b}; bf16x2_t r = __builtin_convertvector(v, bf16x2_t); return __builtin_bit_cast(unsigned, r); }
__device__ __forceinline__ u16 f2bf(float f) { return (u16)(pack2(f, 0.f) & 0xffffu); }
typedef unsigned u32x4_t __attribute__((ext_vector_type(4)));
__device__ __forceinline__ bf16x8 pack8(float a, float b, float c, float d, float e, float f, float g, float h) {
  u32x4_t t = {pack2(a, b), pack2(c, d), pack2(e, f), pack2(g, h)}; return __builtin_bit_cast(bf16x8, t); }
__device__ __forceinline__ float bf2f(u16 h) { return __uint_as_float(((unsigned)h) << 16); }
__device__ __forceinline__ float bfs2f(short h) { return __uint_as_float(((unsigned)(u16)h) << 16); }
__device__ __forceinline__ int opaque_tid(const int wave_s) {
  int l; asm volatile("v_mbcnt_lo_u32_b32 %0, -1, 0\n\tv_mbcnt_hi_u32_b32 %0, -1, %0" : "=v"(l));
  return wave_s * 64 + l;
}
__device__ __forceinline__ int opaque_lane() {
  int l; asm volatile("v_mbcnt_lo_u32_b32 %0, -1, 0\n\tv_mbcnt_hi_u32_b32 %0, -1, %0" : "=v"(l));
  return l;
}
#define XB_TMO      128
#define XB_XCNT(j)  (256  + 64 * (j))
#define XB_XSUB(j)  (1280 + 64 * (j))
#define XB_XGEN(j)  (2304 + 64 * (j))
#define XB_TOP      3328
#define XB_TOPGEN   3392
#define XCD_BAR_WORDS 3456
#define XB_SPIN_CAP (1u << 18)
constexpr int BAR_LDS_OFF = 131072;
__device__ __forceinline__ unsigned xb_ld(unsigned* p)              { return __hip_atomic_load(p, __ATOMIC_RELAXED, __HIP_MEMORY_SCOPE_AGENT); }
__device__ __forceinline__ unsigned xb_add(unsigned* p, unsigned v) { return __hip_atomic_fetch_add(p, v, __ATOMIC_RELAXED, __HIP_MEMORY_SCOPE_AGENT); }
__device__ __forceinline__ unsigned xb_xcc_id() { return (unsigned)__builtin_amdgcn_s_getreg((3 << 11) | 20) & 0xFu; }
#define XB_SPIN(cond, bar) do { unsigned _sp = 0; while (cond) { __builtin_amdgcn_s_sleep(1); \
    if ((++_sp & 255u) == 0u) { if (xb_ld(&(bar)[XB_TMO])) break; if (_sp > XB_SPIN_CAP) { atomicAdd(&(bar)[XB_TMO], 1u); break; } } } } while (0)
__device__ __forceinline__ void xcd_barrier_complete(unsigned* bar, unsigned x, unsigned& nloc, unsigned& nx) {
  const unsigned G = gridDim.x;
  unsigned sum, cnt, mine, sp = 0u;
  for (;;) {
    sum = 0u; cnt = 0u; mine = 0u;
#pragma unroll
    for (unsigned j = 0; j < 16; ++j) { const unsigned c = xb_ld(&bar[XB_XCNT(j)]); sum += c; cnt += (c > 0u) ? 1u : 0u; mine = (j == x) ? c : mine; }
    if (sum == G) break;
    __builtin_amdgcn_s_sleep(1);
    if ((++sp & 255u) == 0u) { if (xb_ld(&bar[XB_TMO])) break; if (sp > XB_SPIN_CAP) { atomicAdd(&bar[XB_TMO], 1u); break; } }
  }
  nloc = mine > 0u ? mine : 1u; nx = cnt > 0u ? cnt : 1u;
}
__device__ __forceinline__ void grid_bar(unsigned* bar, const int wave_s) {
  asm volatile("s_waitcnt vmcnt(0)" ::: "memory");
  __syncthreads();
  if (opaque_tid(wave_s) == 0) {
    volatile __attribute__((address_space(3))) unsigned* st = (volatile __attribute__((address_space(3))) unsigned*)(smem + BAR_LDS_OFF);
    const unsigned x = xb_xcc_id();
    __builtin_amdgcn_s_waitcnt(0);
    unsigned nloc = st[0], nx = st[1];
    if (nloc == 0u) { xcd_barrier_complete(bar, x, nloc, nx); st[0] = nloc; st[1] = nx; }
    const unsigned old = xb_add(&bar[XB_XSUB(x)], 1u);
    const unsigned gen = old / nloc;
    if (old + 1u == (gen + 1u) * nloc) {
      __builtin_amdgcn_fence(__ATOMIC_RELEASE, "agent");
      asm volatile("s_waitcnt vmcnt(0)" ::: "memory");
      const unsigned og = xb_add(&bar[XB_TOP], 1u);
      const unsigned tg = og / nx;
      if (og + 1u == (tg + 1u) * nx) xb_add(&bar[XB_TOPGEN], 1u);
      else XB_SPIN(xb_ld(&bar[XB_TOPGEN]) == tg, bar);
      __builtin_amdgcn_fence(__ATOMIC_ACQUIRE, "agent");
      xb_add(&bar[XB_XGEN(x)], 1u);
      asm volatile("s_waitcnt vmcnt(0)" ::: "memory");
    } else {
      XB_SPIN(xb_ld(&bar[XB_XGEN(x)]) == gen, bar);
      __builtin_amdgcn_fence(__ATOMIC_ACQUIRE, "agent");
      asm volatile("s_waitcnt vmcnt(0)" ::: "memory");
    }
  }
  __syncthreads();
}
__device__ __forceinline__ float wave_sum(float v) { for (int o = 32; o; o >>= 1) v += __shfl_xor(v, o); return v; }
__device__ __forceinline__ float wave_max(float v) { for (int o = 32; o; o >>= 1) v = fmaxf(v, __shfl_xor(v, o)); return v; }

constexpr int BM = 256, BK = 64, HALF = 128, NXCD = 8, WGM = 4, HT = HALF * BK;
constexpr int GEMM_LDS = 8 * HT * 2 + 16;

__device__ __forceinline__ int lds_byte(int r, int c) {
  int st = (r >> 4) * 2 + (c >> 5), rr = r & 15, cc = c & 31, ob = rr * 64 + cc * 2;
  return st * 1024 + (ob ^ (((ob >> 9) & 1) << 5));
}
__device__ __forceinline__ int perm32(int rho) { const int n = rho >> 4, i = rho & 15; return 8 * (i >> 2) + 4 * n + (i & 3); }
__device__ __forceinline__ void stage_rc(int b, int& R, int& C) {
  int st = b / 1024, sb = b % 1024, swz = sb ^ (((sb >> 9) & 1) << 5);
  R = (st >> 1) * 16 + swz / 64; C = (st & 1) * 32 + (swz % 64) / 2;
}

struct GemmEpi {
  const float* sumsq_in;
  u16* out_bf; int ldo;
  u16* xh;
  u16* xh_out;
  float* out_f;
  float* sumsq_out;
};

template <int MODE, bool ADD_RESID>
__device__ __forceinline__ void epi4(const GemmEpi& e, const f32x4 a, const float rs, const size_t grow, const int col0, float& ssq) {
  if (MODE == 1 || MODE == 3) {
    float v0 = a[0] * rs, v1 = a[1] * rs, v2 = a[2] * rs, v3 = a[3] * rs;
    if (MODE == 3) { v0 = fmaxf(v0, 0.f); v1 = fmaxf(v1, 0.f); v2 = fmaxf(v2, 0.f); v3 = fmaxf(v3, 0.f); v0 *= v0; v1 *= v1; v2 *= v2; v3 *= v3; }
    uint2 o; o.x = pack2(v0, v1); o.y = pack2(v2, v3);
    *(uint2*)(e.out_bf + grow * e.ldo + col0) = o;
  } else {
    float4 x; x.x = a[0]; x.y = a[1]; x.z = a[2]; x.w = a[3];
    if (ADD_RESID) {
      const uint2 r = *(const uint2*)(e.xh + grow * D + col0);
      x.x += __uint_as_float(r.x << 16); x.y += __uint_as_float(r.x & 0xffff0000u); x.z += __uint_as_float(r.y << 16); x.w += __uint_as_float(r.y & 0xffff0000u);
    }
    if (e.out_f) *(float4*)(e.out_f + grow * D + col0) = x;
    else { uint2 ob; ob.x = pack2(x.x, x.y); ob.y = pack2(x.z, x.w); *(uint2*)(e.xh_out + grow * D + col0) = ob; }
    ssq += x.x * x.x + x.y * x.y + x.z * x.z + x.w * x.w;
  }
}

template <int MODE>
__device__ __forceinline__ void epi8(const GemmEpi& e, const f32x4 a0, const f32x4 a1, const float rs, const size_t grow, const int col8, float& ssq) {
  float v[8] = {a0[0], a0[1], a0[2], a0[3], a1[0], a1[1], a1[2], a1[3]};
  if (MODE == 1 || MODE == 3) {
#pragma unroll
    for (int i = 0; i < 8; ++i) { v[i] *= rs; if (MODE == 3) { v[i] = fmaxf(v[i], 0.f); v[i] *= v[i]; } }
    uint4 o; o.x = pack2(v[0], v[1]); o.y = pack2(v[2], v[3]); o.z = pack2(v[4], v[5]); o.w = pack2(v[6], v[7]);
    *(uint4*)(e.out_bf + grow * e.ldo + col8) = o;
  } else {
    if (e.out_f) { *(float4*)(e.out_f + grow * D + col8) = make_float4(v[0], v[1], v[2], v[3]); *(float4*)(e.out_f + grow * D + col8 + 4) = make_float4(v[4], v[5], v[6], v[7]); }
    else { uint4 o; o.x = pack2(v[0], v[1]); o.y = pack2(v[2], v[3]); o.z = pack2(v[4], v[5]); o.w = pack2(v[6], v[7]); *(uint4*)(e.xh_out + grow * D + col8) = o; }
#pragma unroll
    for (int i = 0; i < 8; ++i) ssq += v[i] * v[i];
  }
}

template <int MODE>
__device__ __forceinline__ void gemm_phase(const u16* __restrict__ A, const u16* __restrict__ Bt, const int M, const int N, const int K, const GemmEpi e, const int wave_s, const int dry = 0) {
  u16* shm = (u16*)smem;
#define SA(b, h) (shm + ((b) * 2 + (h)) * HT)
#define SB(b, h) (shm + (4 + (b) * 2 + (h)) * HT)
#define STAGE_(P, RS, br, kt, o0, o1) do { const unsigned _so = (unsigned)(((br) * K + (kt) * BK) * 2); \
    __builtin_amdgcn_raw_ptr_buffer_load_lds(RS, (LDSP)((char*)(P) + tid0 * 16), 16, o0, _so, 0, 0); \
    __builtin_amdgcn_raw_ptr_buffer_load_lds(RS, (LDSP)((char*)(P) + tid0 * 16 + 8192), 16, o1, _so, 0, 0); } while (0)
#define STAGE(P, RS, br, kt) STAGE_(P, RS, br, kt, toff0, toff1)
#define STAGEB(P, RS, br, kt) STAGE_(P, RS, br, kt, toffb0, toffb1)
#define LDA(dst, b, h) for (int m = 0; m < 4; ++m) for (int k = 0; k < 2; ++k) \
    dst[m][k] = *reinterpret_cast<const bf16x8*>((char*)SA(b, h) + lds_byte(wr * 64 + m * 16 + fr, k * 32 + fq * 8))
#define LDB(dst, b, h) for (int n = 0; n < 2; ++n) for (int k = 0; k < 2; ++k) \
    dst[n][k] = *reinterpret_cast<const bf16x8*>((char*)SB(b, h) + lds_byte(wc * 32 + n * 16 + fr, k * 32 + fq * 8))
#define MMA(ai, bj, At, Bt_) do { __builtin_amdgcn_s_setprio(1); \
    for (int m = 0; m < 4; ++m) for (int n = 0; n < 2; ++n) for (int k = 0; k < 2; ++k) \
      acc[ai][bj][m][n] = __builtin_amdgcn_mfma_f32_16x16x32_bf16(Bt_[n][k], At[m][k], acc[ai][bj][m][n], 0, 0, 0); \
    __builtin_amdgcn_s_setprio(0); } while (0)
#define WAIT_V(n) asm volatile("s_waitcnt vmcnt(" #n ")" ::: "memory")
#define WAIT_L(n) asm volatile("s_waitcnt lgkmcnt(" #n ")" ::: "memory")
#define BAR __builtin_amdgcn_s_barrier()
#define SCHED __builtin_amdgcn_sched_barrier(0)
#define DECODE(tt_, brow_, bcol_) do { int wgid = (tt_); \
    { int q = nwg / NXCD, r = nwg % NXCD, xcd = wgid % NXCD, off = wgid / NXCD; \
      wgid = (xcd < r ? xcd * (q + 1) : r * (q + 1) + (xcd - r) * q) + off; } \
    int nig = WGM * nN, gid = wgid / nig, fm = gid * WGM, gsz = min(nM - fm, WGM); \
    brow_ = (fm + ((wgid % nig) % gsz)) * BM; bcol_ = ((wgid % nig) / gsz) * BM; } while (0)
#define STAGE7(brow_, bcol_) do { \
    STAGEB(SB(0, 0), rsB, bcol_, 0); STAGE(SA(0, 0), rsA, brow_, 0); \
    STAGEB(SB(0, 1), rsB, bcol_ + HALF, 0); STAGE(SA(0, 1), rsA, brow_ + HALF, 0); \
    STAGEB(SB(1, 0), rsB, bcol_, 1); STAGE(SA(1, 0), rsA, brow_, 1); STAGEB(SB(1, 1), rsB, bcol_ + HALF, 1); } while (0)

  const int nM = M / BM, nN = N / BM, nwg = nM * nN;
  const int nt = K / BK;
  unsigned toff0, toff1;
  const int tid0 = opaque_tid(wave_s);
  const int wr = (tid0 >> 6) >> 2, wc = (tid0 >> 6) & 3, fr = tid0 & 15, fq = (tid0 & 63) >> 4;
  unsigned toffb0, toffb1;
  { int r_, c_; stage_rc(tid0 * 16, r_, c_); toff0 = (unsigned)(r_ * K + c_) * 2u; toffb0 = (unsigned)(((r_ & ~31) | perm32(r_ & 31)) * K + c_) * 2u;
    stage_rc(tid0 * 16 + 8192, r_, c_); toff1 = (unsigned)(r_ * K + c_) * 2u; toffb1 = (unsigned)(((r_ & ~31) | perm32(r_ & 31)) * K + c_) * 2u; }
  const __amdgpu_buffer_rsrc_t rsA = __builtin_amdgcn_make_buffer_rsrc((void*)A, 0, -1, 0x00020000);
  const __amdgpu_buffer_rsrc_t rsB = __builtin_amdgcn_make_buffer_rsrc((void*)Bt, 0, -1, 0x00020000);
  int tt = blockIdx.x;
  int brow = 0, bcol = 0;
  if (tt < nwg) { DECODE(tt, brow, bcol); STAGE7(brow, bcol); WAIT_V(0); }
  f32x4 acc[2][2][4][2];
#define ACC_INIT(brow_, bcol_) do { \
    if (MODE == 2) { \
      const int t2 = opaque_tid(wave_s); const int wr_ = (t2 >> 6) >> 2, wc_ = (t2 >> 6) & 3, fr_ = t2 & 15, fq_ = (t2 & 63) >> 4; \
      const u16* rp_ = e.xh + (size_t)(brow_ + wr_ * 64 + fr_) * D + bcol_ + wc_ * 32 + fq_ * 8; \
      _Pragma("unroll") for (int ai = 0; ai < 2; ++ai) _Pragma("unroll") for (int bj = 0; bj < 2; ++bj) \
      _Pragma("unroll") for (int m = 0; m < 4; ++m) { \
        const uint4 x0 = *(const uint4*)(rp_ + (size_t)(ai * HALF + m * 16) * D + bj * HALF); \
        acc[ai][bj][m][0][0] = __uint_as_float(x0.x << 16); acc[ai][bj][m][0][1] = __uint_as_float(x0.x & 0xffff0000u); \
        acc[ai][bj][m][0][2] = __uint_as_float(x0.y << 16); acc[ai][bj][m][0][3] = __uint_as_float(x0.y & 0xffff0000u); \
        acc[ai][bj][m][1][0] = __uint_as_float(x0.z << 16); acc[ai][bj][m][1][1] = __uint_as_float(x0.z & 0xffff0000u); \
        acc[ai][bj][m][1][2] = __uint_as_float(x0.w << 16); acc[ai][bj][m][1][3] = __uint_as_float(x0.w & 0xffff0000u); } \
    } else { \
      _Pragma("unroll") for (int ai = 0; ai < 2; ++ai) _Pragma("unroll") for (int bj = 0; bj < 2; ++bj) \
      _Pragma("unroll") for (int m = 0; m < 4; ++m) _Pragma("unroll") for (int n = 0; n < 2; ++n) \
        acc[ai][bj][m][n] = (f32x4){0.f, 0.f, 0.f, 0.f}; \
    } } while (0)
  if (tt < nwg) ACC_INIT(brow, bcol);
  while (tt < nwg) {
    bf16x8 At[4][2], B0[2][2], B1[2][2];
    if (wr == 1) BAR;
    BAR;
    for (int t = 0; t < nt - 2; t += 2) {
      LDB(B0, 0, 0); SCHED; LDA(At, 0, 0); STAGE(SA(1, 1), rsA, brow + HALF, t + 1);
      WAIT_L(8); BAR; WAIT_L(0); MMA(0, 0, At, B0); BAR; SCHED;
      LDB(B1, 0, 1); STAGEB(SB(0, 0), rsB, bcol, t + 2);
      BAR; WAIT_L(0); MMA(0, 1, At, B1); BAR;
      LDA(At, 0, 1); STAGE(SA(0, 0), rsA, brow, t + 2);
      BAR; WAIT_L(0); MMA(1, 0, At, B0); BAR; SCHED;
      STAGEB(SB(0, 1), rsB, bcol + HALF, t + 2);
      WAIT_V(6); BAR; MMA(1, 1, At, B1); BAR;
      LDB(B0, 1, 0); SCHED; LDA(At, 1, 0); STAGE(SA(0, 1), rsA, brow + HALF, t + 2);
      WAIT_L(8); BAR; WAIT_L(0); MMA(0, 0, At, B0); BAR; SCHED;
      LDB(B1, 1, 1); STAGEB(SB(1, 0), rsB, bcol, t + 3);
      BAR; WAIT_L(0); MMA(0, 1, At, B1); BAR;
      LDA(At, 1, 1); STAGE(SA(1, 0), rsA, brow, t + 3);
      BAR; WAIT_L(0); MMA(1, 0, At, B0); BAR; SCHED;
      STAGEB(SB(1, 1), rsB, bcol + HALF, t + 3);
      WAIT_V(6); BAR; MMA(1, 1, At, B1); BAR;
    }
    { LDB(B0, 0, 0); LDA(At, 0, 0); STAGE(SA(1, 1), rsA, brow + HALF, nt - 1);
      BAR; WAIT_L(0); MMA(0, 0, At, B0); BAR;
      LDB(B1, 0, 1); BAR; WAIT_L(0); MMA(0, 1, At, B1); BAR;
      LDA(At, 0, 1); WAIT_V(4); BAR; WAIT_L(0); MMA(1, 0, At, B0); MMA(1, 1, At, B1); BAR; }
    { LDB(B0, 1, 0); LDA(At, 1, 0); WAIT_V(2); BAR; WAIT_L(0); MMA(0, 0, At, B0); BAR;
      LDB(B1, 1, 1); WAIT_V(0); BAR; WAIT_L(0); MMA(0, 1, At, B1); BAR;
      LDA(At, 1, 1); BAR; WAIT_L(0); MMA(1, 0, At, B0); MMA(1, 1, At, B1); BAR; }
    if (wr == 0) BAR;
    const int erow = brow, ecol = bcol;
    tt += gridDim.x;
    if (tt < nwg) { DECODE(tt, brow, bcol); STAGE7(brow, bcol); }
    SCHED;
    if (!dry) {
      const int tid1 = opaque_tid(wave_s);
      const int wr = (tid1 >> 6) >> 2, wc = (tid1 >> 6) & 3, fr = tid1 & 15, fq = (tid1 & 63) >> 4;
      float rsv[2][4];
#pragma unroll
      for (int ai = 0; ai < 2; ++ai)
#pragma unroll
        for (int m = 0; m < 4; ++m) {
          rsv[ai][m] = 0.f;
          if (MODE == 1 || MODE == 3) rsv[ai][m] = e.sumsq_in[(size_t)erow + ai * HALF + wr * 64 + m * 16 + fr];
        }
#pragma unroll
      for (int ai = 0; ai < 2; ++ai)
#pragma unroll
        for (int m = 0; m < 4; ++m) {
          const int lrow = ai * HALF + wr * 64 + m * 16 + fr;
          const size_t grow = (size_t)erow + lrow;
          float rs = 0.f, ssq = 0.f;
          if (MODE == 1 || MODE == 3) rs = rsqrtf(rsv[ai][m] * (1.0f / 1024.0f) + EPS);
#pragma unroll
          for (int bj = 0; bj < 2; ++bj)
            epi8<MODE>(e, acc[ai][bj][m][0], acc[ai][bj][m][1], rs, grow, ecol + bj * HALF + wc * 32 + fq * 8, ssq);
          if (MODE == 2 && e.sumsq_out) {
            ssq += __shfl_xor(ssq, 16); ssq += __shfl_xor(ssq, 32);
            if (fq == 0) atomicAdd(e.sumsq_out + grow, ssq);
          }
          SCHED;
        }
    }
    if (tt < nwg) ACC_INIT(brow, bcol);
    if (dry) WAIT_V(0); else WAIT_V(16);
  }
  WAIT_V(0);
#undef SA
#undef SB
#undef STAGE
#undef STAGEB
#undef STAGE_
#undef LDA
#undef LDB
#undef MMA
}

#define MFMA32(a, b, c) __builtin_amdgcn_mfma_f32_32x32x16_bf16((a), (b), (c), 0, 0, 0)

template <int MODE>
__device__ __forceinline__ void sample_gemm(const u16* __restrict__ A, const u16* __restrict__ Bt, const int N, const int K, const GemmEpi e, const int wave_s, const int b0, const int nb) {
  const int bi = (int)blockIdx.x - b0;
  if (bi < 0 || bi >= nb) return;
  const int tid = opaque_tid(wave_s);
  const int lane = tid & 63, wid = tid >> 6;
  const int i = lane & 31, h = lane >> 5;
  const int ntask = 8 * (N / 32);
  const int ks = K / 8;
  float* red = (float*)smem;
  for (int id = bi; id < ntask; id += nb) {
    const int r0 = (id & 7) * 32, c0 = (id >> 3) * 32;
    const u16* ap = A + (size_t)(NP + r0 + i) * K + wid * ks + 8 * h;
    const u16* bp = Bt + (size_t)(c0 + i) * K + wid * ks + 8 * h;
    f32x16 acc;
#pragma unroll
    for (int q = 0; q < 16; ++q) acc[q] = 0.f;
#pragma unroll 16
    for (int k = 0; k < ks; k += 16) {
      const bf16x8 a = *(const bf16x8*)(ap + k);
      const bf16x8 b = *(const bf16x8*)(bp + k);
      acc = MFMA32(b, a, acc);
    }
#pragma unroll
    for (int q = 0; q < 4; ++q)
      *(float4*)(red + (wid * 32 + i) * 36 + 8 * q + 4 * h) = make_float4(acc[4 * q], acc[4 * q + 1], acc[4 * q + 2], acc[4 * q + 3]);
    __syncthreads();
    if (tid < 256) {
      const int row = tid >> 3, c4 = (tid & 7) * 4;
      f32x4 s4; s4[0] = 0.f; s4[1] = 0.f; s4[2] = 0.f; s4[3] = 0.f;
#pragma unroll
      for (int w = 0; w < 8; ++w) {
        const float4 v = *(const float4*)(red + (w * 32 + row) * 36 + c4);
        s4[0] += v.x; s4[1] += v.y; s4[2] += v.z; s4[3] += v.w;
      }
      const int srow = r0 + row, col0 = c0 + c4;
      const size_t grow = (size_t)NP + srow;
      float rs = 0.f, ssq = 0.f;
      if (MODE == 1 || MODE == 3) rs = rsqrtf(e.sumsq_in[grow] * (1.0f / 1024.0f) + EPS);
      epi4<MODE, true>(e, s4, rs, grow, col0, ssq);
      if (MODE == 2 && e.sumsq_out) {
        ssq += __shfl_xor(ssq, 1); ssq += __shfl_xor(ssq, 2); ssq += __shfl_xor(ssq, 4);
        if ((tid & 7) == 0) atomicAdd(e.sumsq_out + grow, ssq);
      }
    }
    __syncthreads();
  }
}

template <int MODE>
__device__ __forceinline__ void sample_gemm64(const u16* __restrict__ A, const u16* __restrict__ Bt, const int N, const int K, const GemmEpi e, const int wave_s, const bool reverse) {
  const int tid = opaque_tid(wave_s);
  const int lane = tid & 63, wid = tid >> 6;
  const int i = lane & 31, h = lane >> 5;
  const int ri = wid & 1, ci = (wid >> 1) & 1, kh = wid >> 2;
  const int ntask = 4 * (N / 64);
  const int kspan = K / 2;
  float* red = (float*)smem;
  const int G = gridDim.x;
  for (int id = reverse ? G - 1 - (int)blockIdx.x : (int)blockIdx.x; id < ntask; id += G) {
    const int r0 = (id & 3) * 64 + ri * 32, c0 = (id >> 2) * 64 + ci * 32;
    const u16* ap = A + (size_t)(NP + r0 + i) * K + kh * kspan + 8 * h;
    const u16* bp = Bt + (size_t)(c0 + i) * K + kh * kspan + 8 * h;
    f32x16 acc;
#pragma unroll
    for (int q = 0; q < 16; ++q) acc[q] = 0.f;
#pragma unroll 16
    for (int k = 0; k < kspan; k += 16) {
      const bf16x8 a = *(const bf16x8*)(ap + k);
      const bf16x8 b = *(const bf16x8*)(bp + k);
      acc = MFMA32(b, a, acc);
    }
    float* rb = red + ((wid & 3) * 32 + i) * 36 + 4 * h;
    if (kh == 1) {
#pragma unroll
      for (int q = 0; q < 4; ++q) *(float4*)(rb + 8 * q) = make_float4(acc[4 * q], acc[4 * q + 1], acc[4 * q + 2], acc[4 * q + 3]);
    }
    __syncthreads();
    if (kh == 0) {
      const size_t grow = (size_t)NP + r0 + i;
      const float rs = rsqrtf(e.sumsq_in[grow] * (1.0f / 1024.0f) + EPS);
      float ssq = 0.f;
#pragma unroll
      for (int q = 0; q < 4; ++q) {
        const float4 o = *(const float4*)(rb + 8 * q);
        f32x4 a4; a4[0] = acc[4 * q] + o.x; a4[1] = acc[4 * q + 1] + o.y; a4[2] = acc[4 * q + 2] + o.z; a4[3] = acc[4 * q + 3] + o.w;
        epi4<MODE, false>(e, a4, rs, grow, c0 + 8 * q + 4 * h, ssq);
      }
    }
    __syncthreads();
  }
}

__device__ __forceinline__ void kv_shift_copy(const Params& p, const int l, const int b0, const int nb, const int tid) {
  const int bi = (int)blockIdx.x - b0;
  if (bi < 0 || bi >= nb) return;
  const size_t gt = (size_t)bi * 512 + tid, ntd = (size_t)nb * 512;
#pragma unroll
  for (int g = 0; g < 3; ++g) {
    const int W = 128 << (2 * g);
    const size_t n4 = (size_t)32 * W * 64;
    const size_t oo = (g == 0) ? O_KV128S : (g == 1) ? O_KV512S : O_KV2048S;
    const f32x4* src = (const f32x4*)p.kv_in[g] + (size_t)l * n4;
    f32x4* dst = (f32x4*)(p.out + oo) + (size_t)l * n4;
    const unsigned per = (unsigned)W * 64u, lim = (unsigned)(W - 8) * 64u;
    for (size_t i0 = gt; i0 < n4; i0 += ntd * 8) {
      f32x4 v[8];
#pragma unroll
      for (int k = 0; k < 8; ++k) {
        const size_t i = i0 + (size_t)k * ntd;
        v[k] = (f32x4){0.f, 0.f, 0.f, 0.f};
        if (i < n4 && ((unsigned)i % per) < lim) v[k] = __builtin_nontemporal_load(src + i + 512);
      }
#pragma unroll
      for (int k = 0; k < 8; ++k) {
        const size_t i = i0 + (size_t)k * ntd;
        if (i < n4 && ((unsigned)i % per) < lim) __builtin_nontemporal_store(v[k], dst + i);
      }
    }
  }
}

__device__ __forceinline__ void tr_tile(const float* __restrict__ src, u16* __restrict__ dst, int K, int N, int k0, int n0, const int tid, const float* __restrict__ gain) {
  float* lt = (float*)smem;
  { const int kk = tid >> 4, n4 = tid & 15;
#pragma unroll
    for (int i = 0; i < 2; ++i) {
      const int k = kk + i * 32;
      const float4 v = *(const float4*)(src + (size_t)(k0 + k) * N + n0 + n4 * 4);
      float* d = lt + k * 65 + n4 * 4;
      d[0] = v.x; d[1] = v.y; d[2] = v.z; d[3] = v.w;
    } }
  __syncthreads();
  { const int n = tid >> 3, k8 = tid & 7;
    float f[8];
#pragma unroll
    for (int i = 0; i < 8; ++i) f[i] = lt[(k8 * 8 + i) * 65 + n] * (gain ? gain[k0 + k8 * 8 + i] : 1.0f);
    uint4 o; o.x = pack2(f[0], f[1]); o.y = pack2(f[2], f[3]); o.z = pack2(f[4], f[5]); o.w = pack2(f[6], f[7]);
    *(uint4*)(dst + (size_t)(n0 + n) * K + k0 + k8 * 8) = o; }
  __syncthreads();
}

__device__ __forceinline__ void phase0(const Params& p, const int wave_s) {
  const int tid = opaque_tid(wave_s), lane = tid & 63, wid = tid >> 6;
  const int gw = blockIdx.x * 8 + wid, nw = gridDim.x * 8;
  const size_t gt = (size_t)blockIdx.x * 512 + tid, ntd = (size_t)gridDim.x * 512;
  for (int row0 = gw; row0 < MT; row0 += 3 * nw) {
    float4 v[3][4];
#pragma unroll
    for (int u = 0; u < 3; ++u) {
      const int row = min(row0 + u * nw, MT - 1);
      const float4* xr = (const float4*)(row < NP ? p.x_prompt + (size_t)row * D : p.x_sample + (size_t)(row - NP) * D);
#pragma unroll
      for (int i = 0; i < 4; ++i) v[u][i] = xr[lane + 64 * i];
    }
#pragma unroll
    for (int u = 0; u < 3; ++u) {
      const int row = row0 + u * nw;
      if (row < MT) {
        float ss = 0.f;
#pragma unroll
        for (int i = 0; i < 4; ++i) {
          const float4 x = v[u][i];
          ss += x.x * x.x + x.y * x.y + x.z * x.z + x.w * x.w;
          uint2 o; o.x = pack2(x.x, x.y); o.y = pack2(x.z, x.w);
          *(uint2*)(p.xg + (size_t)row * D + (lane + 64 * i) * 4) = o;
        }
        ss = wave_sum(ss);
        if (lane == 0) p.sumsq[row] = ss;
      }
    }
  }
  for (size_t i = gt; i < (size_t)3 * MT; i += ntd) p.sumsq[MT + i] = 0.f;
  for (size_t i = gt; i < (size_t)2056 * 8; i += ntd) {
    const int pi = (int)(i >> 3), fi = (int)(i & 7);
    const int pos = pi < 2048 ? pi : 8192 + (pi - 2048);
    float inv;
    switch (fi) { case 0: inv = 1.0f; break; case 1: inv = 0.1939227432012558f; break; case 2: inv = 0.03760603070259094f; break;
      case 3: inv = 0.007292664609849453f; break; case 4: inv = 0.0014142135623842478f; break; case 5: inv = 0.00027424818836152554f; break;
      case 6: inv = 5.318296098266728e-05f; break; default: inv = 1.0313386155758053e-05f; break; }
    const float ang = (float)pos * inv;
    p.rope[pi * 16 + fi] = cosf(ang);
    p.rope[pi * 16 + 8 + fi] = sinf(ang);
  }
  {
    float* lt = (float*)smem;
    constexpr int QL = (640 + 192 + 1024 + 1024) / 4;
    for (int t = blockIdx.x; t < 2 * QL; t += gridDim.x) {
      const int l = t / QL; int r = t % QL;
      const float* src; u16* dst; int K, N; const float* gain = nullptr;
      if (r < 160) { src = p.w_in + (size_t)l * D * IC; dst = p.wt_in + (size_t)l * IC * D; K = D; N = IC; gain = p.norm1_g + l * D; }
      else if (r < 208) { r -= 160; src = p.w_out + (size_t)l * MC * D; dst = p.wt_out + (size_t)l * D * MC; K = MC; N = D; }
      else if (r < 464) { r -= 208; src = p.w_up + (size_t)l * D * FF; dst = p.wt_up + (size_t)l * FF * D; K = D; N = FF; gain = p.norm2_g + l * D; }
      else { r -= 464; src = p.w_down + (size_t)l * FF * D; dst = p.wt_down + (size_t)l * D * FF; K = FF; N = D; }
      const int nq = N / 256;
      const int k0 = (r / nq) * 64, n0 = (r % nq) * 256;
      { const int kk = tid >> 6, n4 = tid & 63;
        float4 v[8];
#pragma unroll
        for (int i = 0; i < 8; ++i) v[i] = *(const float4*)(src + (size_t)(k0 + kk + 8 * i) * N + n0 + n4 * 4);
#pragma unroll
        for (int i = 0; i < 8; ++i) {
          const float gg = gain ? gain[k0 + kk + 8 * i] : 1.0f;
          *(float4*)(lt + (kk + 8 * i) * 260 + n4 * 4) = make_float4(v[i].x * gg, v[i].y * gg, v[i].z * gg, v[i].w * gg);
        } }
      __syncthreads();
      { const int n = tid >> 1, kh = (tid & 1) * 32;
        u16* dp = dst + (size_t)(n0 + n) * K + k0 + kh;
#pragma unroll
        for (int c = 0; c < 4; ++c) {
          float f[8];
#pragma unroll
          for (int i = 0; i < 8; ++i) f[i] = lt[(kh + c * 8 + i) * 260 + n];
          uint4 o; o.x = pack2(f[0], f[1]); o.y = pack2(f[2], f[3]); o.z = pack2(f[4], f[5]); o.w = pack2(f[6], f[7]);
          *(uint4*)(dp + c * 8) = o;
        } }
      __syncthreads();
    }
    for (int t = blockIdx.x; t < 8; t += gridDim.x)
      tr_tile(p.pool_w + (size_t)t * 4096, p.pwT + (size_t)t * 4096, 64, 64, 0, 0, tid, nullptr);
  }
}


__device__ __forceinline__ void qk_raw(const u16* __restrict__ rowp, bf16x8 raw[4], const int h) {
#pragma unroll
  for (int s = 0; s < 4; ++s) raw[s] = *(const bf16x8*)(rowp + 16 * s + 8 * h);
}
__device__ __forceinline__ void qk_finish(const bf16x8 raw[4], const float* __restrict__ ropep, const float* __restrict__ gain,
                                          const float scale, bf16x8 out[4], const int h) {
  float f[4][8];
  float ss = 0.f;
#pragma unroll
  for (int s = 0; s < 4; ++s) {
#pragma unroll
    for (int j = 0; j < 8; ++j) { f[s][j] = bfs2f(raw[s][j]); ss += f[s][j] * f[s][j]; }
  }
  ss += __shfl_xor(ss, 32);
  const float inv = rsqrtf(ss * (1.0f / 64.0f) + EPS);
#pragma unroll
  for (int s = 0; s < 4; ++s) {
    const float4 g0 = *(const float4*)(gain + 16 * s + 8 * h), g1 = *(const float4*)(gain + 16 * s + 8 * h + 4);
    f[s][0] *= inv * g0.x; f[s][1] *= inv * g0.y; f[s][2] *= inv * g0.z; f[s][3] *= inv * g0.w;
    f[s][4] *= inv * g1.x; f[s][5] *= inv * g1.y; f[s][6] *= inv * g1.z; f[s][7] *= inv * g1.w;
  }
  {
    const float4 c0 = *(const float4*)(ropep), c1 = *(const float4*)(ropep + 4), s0 = *(const float4*)(ropep + 8), s1 = *(const float4*)(ropep + 12);
    const float cs[8] = {c0.x, c0.y, c0.z, c0.w, c1.x, c1.y, c1.z, c1.w};
    const float sn[8] = {s0.x, s0.y, s0.z, s0.w, s1.x, s1.y, s1.z, s1.w};
#pragma unroll
    for (int j = 0; j < 8; ++j) {
      const float other = __shfl_xor(f[0][j], 32);
      f[0][j] = (h == 0) ? (f[0][j] * cs[j] - other * sn[j]) : (f[0][j] * cs[j] + other * sn[j]);
    }
  }
#pragma unroll
  for (int s = 0; s < 4; ++s)
    out[s] = pack8(f[s][0] * scale, f[s][1] * scale, f[s][2] * scale, f[s][3] * scale, f[s][4] * scale, f[s][5] * scale, f[s][6] * scale, f[s][7] * scale);
}

template <bool SAMPLE>
__device__ __forceinline__ void attn_task(const Params& p, const int layer, const int task, const int wid) {
  const int lane = opaque_lane();
  int g, hslot, b, r, tile, nq;
  if (!SAMPLE) {
    const int c = task & 63; int tmp = task >> 6; g = tmp % 3; tmp /= 3; hslot = tmp & 1; b = tmp >> 1;
    const int tpc = 64 >> (2 * g);
    r = c / tpc; tile = c % tpc; nq = 32;
  } else {
    b = task / 26; const int rem = task % 26; hslot = rem / 13; const int c = rem % 13;
    if (c == 0) { g = 0; r = 0; nq = 8; } else if (c < 5) { g = 1; r = c - 1; nq = 2; } else { g = 2; r = c - 5; nq = 1; }
    tile = 4;
  }
  const int dl = 1 << (2 * g);
  const int W = 128 << (2 * g);
  const int m0 = tile * 32;
  const int head = 2 * g + hslot;
  const u16* projb = SAMPLE ? p.proj + (size_t)(NP + b * 8) * IC : p.proj + (size_t)b * 2048 * IC;
  const int ropeb = SAMPLE ? 2048 : 0;
  const float* cache = SAMPLE ? ((g == 0) ? p.kv_in[0] : (g == 1) ? p.kv_in[1] : p.kv_in[2]) + (size_t)(layer * 32 + b) * W * 256 + hslot * 64 : nullptr;
  const int qi = lane & 31, h = lane >> 5;
  int tq;
  if (SAMPLE) tq = r + dl * (qi < nq ? qi : 0); else tq = (m0 + qi) * dl + r;
  const int kt_lo = SAMPLE ? 0 : max(0, 4 - tile);
  bf16x8 qraw[4], kraw[5][4];
  qk_raw(projb + (size_t)tq * IC + C_Q + head * 64, qraw, h);
#pragma unroll
  for (int kt = 0; kt < 5; ++kt) {
    if (kt >= kt_lo && !(SAMPLE && kt < 4)) {
      int tk;
      if (SAMPLE) tk = r + dl * (qi < nq ? qi : 0); else tk = (m0 - 128 + 32 * kt + qi) * dl + r;
      qk_raw(projb + (size_t)tk * IC + C_K + head * 64, kraw[kt], h);
    } else {
#pragma unroll
      for (int s = 0; s < 4; ++s) kraw[kt][s] = (bf16x8){0, 0, 0, 0, 0, 0, 0, 0};
    }
  }
  bf16x8 qf[4];
  qk_finish(qraw, p.rope + (ropeb + tq) * 16, p.q_norm_g + layer * 64, 0.125f, qf, h);
  f32x16 sacc[5];
#pragma unroll
  for (int kt = 0; kt < 5; ++kt) {
#pragma unroll
    for (int i = 0; i < 16; ++i) sacc[kt][i] = 0.f;
    if (kt >= kt_lo) {
      bf16x8 kf[4];
      if (SAMPLE && kt < 4) {
        const float* kp = cache + (size_t)(r + dl * (32 * kt + qi)) * 256 + 8 * h;
#pragma unroll
        for (int s = 0; s < 4; ++s) {
          const float4 x0 = *(const float4*)(kp + 16 * s), x1 = *(const float4*)(kp + 16 * s + 4);
          kf[s] = pack8(x0.x, x0.y, x0.z, x0.w, x1.x, x1.y, x1.z, x1.w);
        }
      } else {
        int tk;
        if (SAMPLE) tk = r + dl * (qi < nq ? qi : 0); else tk = (m0 - 128 + 32 * kt + qi) * dl + r;
        qk_finish(kraw[kt], p.rope + (ropeb + tk) * 16, p.k_norm_g + layer * 64, 1.0f, kf, h);
      }
#pragma unroll
      for (int s = 0; s < 4; ++s) sacc[kt] = MFMA32(kf[s], qf[s], sacc[kt]);
    }
  }
  const int srow = lane >> 1, shf = (lane & 1) * 32;
  uint4 vraw[5][4];
#pragma unroll
  for (int kt = 0; kt < 5; ++kt) {
    if (kt >= kt_lo && !(SAMPLE && kt < 4)) {
      int tk;
      if (SAMPLE) tk = r + dl * (srow < nq ? srow : 0); else tk = (m0 - 128 + 32 * kt + srow) * dl + r;
      const u16* vp = projb + (size_t)tk * IC + C_V + head * 64 + shf;
#pragma unroll
      for (int c = 0; c < 4; ++c) vraw[kt][c] = *(const uint4*)(vp + 8 * c);
    } else {
#pragma unroll
      for (int c = 0; c < 4; ++c) vraw[kt][c] = make_uint4(0u, 0u, 0u, 0u);
    }
  }
  float mx = -1e30f;
#pragma unroll
  for (int kt = 0; kt < 5; ++kt)
#pragma unroll
    for (int rr = 0; rr < 16; ++rr) {
      const int keyrow = (rr & 3) + 8 * (rr >> 2) + 4 * h;
      const int dist = 128 - 32 * kt + qi - keyrow;
      const bool valid = (kt >= kt_lo) && dist >= 0 && dist <= 128;
      const float s = valid ? sacc[kt][rr] : -1e30f;
      sacc[kt][rr] = s;
      mx = fmaxf(mx, s);
    }
  mx = fmaxf(mx, __shfl_xor(mx, 32));
  float sum = 0.f;
#pragma unroll
  for (int kt = 0; kt < 5; ++kt)
#pragma unroll
    for (int rr = 0; rr < 16; ++rr) {
      const float s = sacc[kt][rr];
      const float ex = (s > -1e29f) ? __expf(s - mx) : 0.f;
      sacc[kt][rr] = ex;
      sum += ex;
    }
  sum += __shfl_xor(sum, 32);
  bf16x8 pfa[5][2];
#pragma unroll
  for (int kt = 0; kt < 5; ++kt)
#pragma unroll
    for (int s2 = 0; s2 < 2; ++s2)
      pfa[kt][s2] = pack8(sacc[kt][8 * s2], sacc[kt][8 * s2 + 1], sacc[kt][8 * s2 + 2], sacc[kt][8 * s2 + 3], sacc[kt][8 * s2 + 4], sacc[kt][8 * s2 + 5], sacc[kt][8 * s2 + 6], sacc[kt][8 * s2 + 7]);
  f32x16 oacc[2];
#pragma unroll
  for (int i = 0; i < 16; ++i) { oacc[0][i] = 0.f; oacc[1][i] = 0.f; }
  u16* vt = (u16*)(smem + wid * 16384);
#pragma unroll
  for (int kt = 0; kt < 5; ++kt) {
    if (kt >= kt_lo) {
      u16* vb = vt + (kt & 1) * (32 * 72);
      if (SAMPLE && kt < 4) {
        const float* vp = cache + (size_t)(r + dl * (32 * kt + srow)) * 256 + 128 + shf;
#pragma unroll
        for (int c = 0; c < 4; ++c) {
          const float4 x0 = *(const float4*)(vp + 8 * c), x1 = *(const float4*)(vp + 8 * c + 4);
          uint4 o; o.x = pack2(x0.x, x0.y); o.y = pack2(x0.z, x0.w); o.z = pack2(x1.x, x1.y); o.w = pack2(x1.z, x1.w);
          *(uint4*)(vb + srow * 72 + shf + 8 * c) = o;
        }
      } else {
#pragma unroll
        for (int c = 0; c < 4; ++c) *(uint4*)(vb + srow * 72 + shf + 8 * c) = vraw[kt][c];
      }
#pragma unroll
      for (int s2 = 0; s2 < 2; ++s2) {
        bf16x8 v0, v1;
#pragma unroll
        for (int j = 0; j < 8; ++j) {
          const int kr = 16 * s2 + 8 * (j >> 2) + 4 * h + (j & 3);
          v0[j] = (short)vb[kr * 72 + qi]; v1[j] = (short)vb[kr * 72 + qi + 32];
        }
        oacc[0] = MFMA32(v0, pfa[kt][s2], oacc[0]);
        oacc[1] = MFMA32(v1, pfa[kt][s2], oacc[1]);
      }
    }
  }
  const float isum = 1.0f / sum;
  const size_t rowq = SAMPLE ? (size_t)NP + b * 8 + tq : (size_t)b * 2048 + tq;
  if (!SAMPLE || qi < nq) {
    u16* op = p.opart + ((size_t)g * MT + rowq) * 128 + hslot * 64;
#pragma unroll
    for (int db = 0; db < 2; ++db)
#pragma unroll
      for (int i4 = 0; i4 < 4; ++i4) {
        uint2 o; o.x = pack2(oacc[db][4 * i4] * isum, oacc[db][4 * i4 + 1] * isum); o.y = pack2(oacc[db][4 * i4 + 2] * isum, oacc[db][4 * i4 + 3] * isum);
        *(uint2*)(op + db * 32 + 8 * i4 + 4 * h) = o;
      }
    if (h == 0) p.lse[((size_t)g * MT + rowq) * 2 + hslot] = mx + __logf(sum);
  }
}

__device__ __forceinline__ void kv_row_task(const Params& p, const int l, const int row, const int lane, const bf16x8 kr, const bf16x8 vr) {
  const int hl = lane < 48 ? lane : 47;
  const int head = hl >> 3, c8 = hl & 7;
  int b, t, ridx;
  const bool prompt = row < NP;
  if (prompt) { b = row >> 11; t = row & 2047; ridx = t; } else { b = (row - NP) >> 3; t = (row - NP) & 7; ridx = 2048 + t; }
  float f[8]; float ss = 0.f;
#pragma unroll
  for (int j = 0; j < 8; ++j) { f[j] = bfs2f(kr[j]); ss += f[j] * f[j]; }
  ss += __shfl_xor(ss, 1); ss += __shfl_xor(ss, 2); ss += __shfl_xor(ss, 4);
  const float inv = rsqrtf(ss * (1.0f / 64.0f) + EPS);
  const float* gk = p.k_norm_g + l * 64 + c8 * 8;
#pragma unroll
  for (int j = 0; j < 8; ++j) f[j] *= inv * gk[j];
  const float* rp = p.rope + ridx * 16;
#pragma unroll
  for (int j = 0; j < 8; ++j) {
    const float other = __shfl_xor(f[j], 1);
    const float cs = rp[j], sn = rp[8 + j];
    if (c8 == 0) f[j] = f[j] * cs - other * sn;
    else if (c8 == 1) f[j] = f[j] * cs + other * sn;
  }
  const int g = head >> 1, hh = head & 1;
  const int W = 128 << (2 * g);
  float* dst = nullptr;
  if (prompt) {
    const int r = t - (2048 - W);
    const size_t base = (g == 0) ? O_KV128P : (g == 1) ? O_KV512P : O_KV2048P;
    if (r >= 0) dst = p.out + base + ((size_t)(l * 8 + b) * W + r) * 256 + hh * 64 + c8 * 8;
  } else {
    const int r = W - 8 + t;
    const size_t base = (g == 0) ? O_KV128S : (g == 1) ? O_KV512S : O_KV2048S;
    dst = p.out + base + ((size_t)(l * 32 + b) * W + r) * 256 + hh * 64 + c8 * 8;
  }
  if (dst && lane < 48) {
    *(float4*)(dst) = make_float4(f[0], f[1], f[2], f[3]);
    *(float4*)(dst + 4) = make_float4(f[4], f[5], f[6], f[7]);
    *(float4*)(dst + 128) = make_float4(bfs2f(vr[0]), bfs2f(vr[1]), bfs2f(vr[2]), bfs2f(vr[3]));
    *(float4*)(dst + 132) = make_float4(bfs2f(vr[4]), bfs2f(vr[5]), bfs2f(vr[6]), bfs2f(vr[7]));
  }
}

__device__ __forceinline__ void phaseA(const Params& p, const int l, const int wave_s) {
  const int tid = opaque_tid(wave_s);
  const int lane = tid & 63, wid = tid >> 6;
  const int gw = blockIdx.x * 8 + wid, nw = gridDim.x * 8;
  for (int task = gw; task < 832 + 3072; task += nw) { if (task < 832) attn_task<true>(p, l, task, wid); else attn_task<false>(p, l, task - 832, wid); }
  for (int row0 = nw - 1 - gw; row0 < MT; row0 += 5 * nw) {
    const int hl = lane < 48 ? lane : 47;
    bf16x8 kr[5], vr[5];
#pragma unroll
    for (int u = 0; u < 5; ++u) {
      const int rc = min(row0 + u * nw, MT - 1);
      const u16* pr = p.proj + (size_t)rc * IC;
      kr[u] = *(const bf16x8*)(pr + C_K + hl * 8);
      vr[u] = *(const bf16x8*)(pr + C_V + hl * 8);
    }
#pragma unroll
    for (int u = 0; u < 5; ++u) if (row0 + u * nw < MT) kv_row_task(p, l, row0 + u * nw, lane, kr[u], vr[u]);
  }
}

template <int GRP>
__device__ __forceinline__ void pool_task(const Params& p, const int l, const int task, const int lane) {
  const int tile = task >> 2; constexpr int grp = GRP;
  const int qi = lane & 31, h = lane >> 5;
  const int row = tile * 32 + qi;
  constexpr int w = 2 << GRP;
  const bool prompt = row < NP;
  int n, t; float cnt;
  if (prompt) { n = row >> 11; t = row & 2047; cnt = (float)min(t + 1, w); } else { n = (row - NP) >> 3; t = (row - NP) & 7; cnt = (float)w; }
  const float icnt = 1.0f / cnt;
  f32x16 acc[2];
#pragma unroll
  for (int i = 0; i < 16; ++i) { acc[0][i] = 0.f; acc[1][i] = 0.f; }
  const u16* pw = p.pwT + (size_t)(l * 4 + grp) * 4096;
#pragma unroll
  for (int s = 0; s < 4; ++s) {
    const int c0 = grp * 64 + 16 * s + 8 * h;
    float sum[8], own[8];
#pragma unroll
    for (int j = 0; j < 8; ++j) { sum[j] = 0.f; own[j] = 0.f; }
#pragma unroll
    for (int i = 0; i < w; ++i) {
      const int tt = t - i;
      float v[8];
      if (tt >= 0) {
        const bf16x8 raw = *(const bf16x8*)(p.proj + (size_t)(row - i) * IC + C_U + c0);
#pragma unroll
        for (int j = 0; j < 8; ++j) v[j] = bfs2f(raw[j]);
      } else if (!prompt) {
        const float* sp = p.state_pool + ((size_t)(l * 32 + n) * 15 + 15 + tt) * 256 + c0;
        const float4 a = *(const float4*)sp, bb = *(const float4*)(sp + 4);
        v[0] = a.x; v[1] = a.y; v[2] = a.z; v[3] = a.w; v[4] = bb.x; v[5] = bb.y; v[6] = bb.z; v[7] = bb.w;
      } else {
#pragma unroll
        for (int j = 0; j < 8; ++j) v[j] = 0.f;
      }
#pragma unroll
      for (int j = 0; j < 8; ++j) sum[j] += v[j];
      if (i == 0) {
#pragma unroll
        for (int j = 0; j < 8; ++j) own[j] = v[j];
      }
    }
    const bf16x8 df = pack8(sum[0] * icnt - own[0], sum[1] * icnt - own[1], sum[2] * icnt - own[2], sum[3] * icnt - own[3],
                            sum[4] * icnt - own[4], sum[5] * icnt - own[5], sum[6] * icnt - own[6], sum[7] * icnt - own[7]);
    const bf16x8 a0 = *(const bf16x8*)(pw + (size_t)qi * 64 + 16 * s + 8 * h);
    const bf16x8 a1 = *(const bf16x8*)(pw + (size_t)(qi + 32) * 64 + 16 * s + 8 * h);
    acc[0] = MFMA32(a0, df, acc[0]);
    acc[1] = MFMA32(a1, df, acc[1]);
  }
  const float* ps = p.pool_scale + l * 256 + grp * 64;
  u16* mp = p.mixed + (size_t)row * MC + grp * 64;
#pragma unroll
  for (int db = 0; db < 2; ++db)
#pragma unroll
    for (int i4 = 0; i4 < 4; ++i4) {
      const int dd0 = db * 32 + 8 * i4 + 4 * h;
      const float4 sc = *(const float4*)(ps + dd0);
      uint2 o; o.x = pack2(acc[db][4 * i4] * sc.x, acc[db][4 * i4 + 1] * sc.y); o.y = pack2(acc[db][4 * i4 + 2] * sc.z, acc[db][4 * i4 + 3] * sc.w);
      *(uint2*)(mp + dd0) = o;
    }
}

__device__ __forceinline__ void phaseB(const Params& p, const int l, const int wave_s) {
  const int tid = opaque_tid(wave_s), lane = tid & 63, wid = tid >> 6;
  const int gw = blockIdx.x * 8 + wid, nw = gridDim.x * 8;
  const size_t gt = (size_t)blockIdx.x * 512 + tid, ntd = (size_t)gridDim.x * 512;
  {
    const bool spread = (nw == 2048);
    const int nit = spread ? 2 : (2080 + nw - 1) / nw;
    for (int it = 0; it < nit; ++it) {
      int task = gw + it * nw;
      if (spread && it == 1) task = ((gw & 63) == 0) ? 2048 + (gw >> 6) : 2080;
      if (task >= 2080) break;
      switch (task & 3) { case 0: pool_task<0>(p, l, task, lane); break; case 1: pool_task<1>(p, l, task, lane); break;
                          case 2: pool_task<2>(p, l, task, lane); break; default: pool_task<3>(p, l, task, lane); break; }
    }
  }
  for (size_t idx = gt; idx < (size_t)(MT / 8) * 48; idx += ntd) {
    const int row0 = (int)(idx / 48) * 8, ch = (int)(idx % 48) * 8;
    const bool prompt = row0 < NP;
    int n, t0;
    if (prompt) { n = row0 >> 11; t0 = row0 & 2047; } else { n = (row0 - NP) >> 3; t0 = (row0 - NP) & 7; }
    float z[10][8];
#pragma unroll
    for (int i = 0; i < 10; ++i) {
      const int tt = t0 - 2 + i;
      if (tt >= 0) {
        const u16* pr = p.proj + (size_t)(row0 - 2 + i) * IC;
        const bf16x8 gc = *(const bf16x8*)(pr + C_GC + ch), gh = *(const bf16x8*)(pr + C_GH + ch);
#pragma unroll
        for (int j = 0; j < 8; ++j) z[i][j] = bfs2f(gc[j]) * bfs2f(gh[j]);
      } else if (!prompt) {
        const float* sp = p.state_conv + ((size_t)(l * 32 + n) * 2 + 2 + tt) * 384 + ch;
        const float4 a = *(const float4*)sp, bb = *(const float4*)(sp + 4);
        z[i][0] = a.x; z[i][1] = a.y; z[i][2] = a.z; z[i][3] = a.w; z[i][4] = bb.x; z[i][5] = bb.y; z[i][6] = bb.z; z[i][7] = bb.w;
      } else {
#pragma unroll
        for (int j = 0; j < 8; ++j) z[i][j] = 0.f;
      }
    }
    const float* cw = p.conv_w + (size_t)l * 3 * 384 + ch;
    float c0[8], c1[8], c2[8];
#pragma unroll
    for (int j = 0; j < 8; ++j) { c0[j] = cw[j]; c1[j] = cw[384 + j]; c2[j] = cw[768 + j]; }
#pragma unroll
    for (int u = 0; u < 8; ++u) {
      const int row = row0 + u, t = t0 + u;
      const bf16x8 gb = *(const bf16x8*)(p.proj + (size_t)row * IC + C_GB + ch);
      float y[8];
#pragma unroll
      for (int j = 0; j < 8; ++j) y[j] = bfs2f(gb[j]) * (c0[j] * z[u][j] + c1[j] * z[u + 1][j] + c2[j] * z[u + 2][j]);
      uint4 o; o.x = pack2(y[0], y[1]); o.y = pack2(y[2], y[3]); o.z = pack2(y[4], y[5]); o.w = pack2(y[6], y[7]);
      *(uint4*)(p.mixed + (size_t)row * MC + 384 + ch) = o;
      float* so = nullptr;
      if (prompt) { if (t >= 2046) so = p.out + O_CONVP + ((size_t)(l * 8 + n) * 2 + (t - 2046)) * 384 + ch; }
      else { if (t >= 6) so = p.out + O_CONVS + ((size_t)(l * 32 + n) * 2 + (t - 6)) * 384 + ch; }
      if (so) { *(float4*)so = make_float4(z[u + 2][0], z[u + 2][1], z[u + 2][2], z[u + 2][3]); *(float4*)(so + 4) = make_float4(z[u + 2][4], z[u + 2][5], z[u + 2][6], z[u + 2][7]); }
    }
  }
  for (size_t idx0 = gt; idx0 < (size_t)MT * 16; idx0 += 3 * ntd) {
    float lg[3][3]; uint4 pv[3][3];
#pragma unroll
    for (int u = 0; u < 3; ++u) {
      const size_t idx = idx0 + u * ntd < (size_t)MT * 16 ? idx0 + u * ntd : idx0;
      const int row = (int)(idx >> 4), chunk = (int)(idx & 15);
      const int hslot = chunk >> 3, d0 = (chunk & 7) * 8;
#pragma unroll
      for (int g = 0; g < 3; ++g) {
        lg[u][g] = p.lse[((size_t)g * MT + row) * 2 + hslot];
        pv[u][g] = *(const uint4*)(p.opart + ((size_t)g * MT + row) * 128 + hslot * 64 + d0);
      }
    }
#pragma unroll
    for (int u = 0; u < 3; ++u) {
      const size_t idx = idx0 + u * ntd;
      if (idx < (size_t)MT * 16) {
        const int row = (int)(idx >> 4), chunk = (int)(idx & 15);
        const int hslot = chunk >> 3, d0 = (chunk & 7) * 8;
        const float m = fmaxf(lg[u][0], fmaxf(lg[u][1], lg[u][2]));
        float wg[3]; wg[0] = __expf(lg[u][0] - m); wg[1] = __expf(lg[u][1] - m); wg[2] = __expf(lg[u][2] - m);
        const float iw = 1.0f / (wg[0] + wg[1] + wg[2]);
        float y[8];
#pragma unroll
        for (int j = 0; j < 8; ++j) y[j] = 0.f;
#pragma unroll
        for (int g = 0; g < 3; ++g) {
          const uint4 a = pv[u][g];
          const float ww = wg[g] * iw;
          y[0] += ww * __uint_as_float(a.x << 16); y[1] += ww * __uint_as_float(a.x & 0xffff0000u);
          y[2] += ww * __uint_as_float(a.y << 16); y[3] += ww * __uint_as_float(a.y & 0xffff0000u);
          y[4] += ww * __uint_as_float(a.z << 16); y[5] += ww * __uint_as_float(a.z & 0xffff0000u);
          y[6] += ww * __uint_as_float(a.w << 16); y[7] += ww * __uint_as_float(a.w & 0xffff0000u);
        }
        uint4 o; o.x = pack2(y[0], y[1]); o.y = pack2(y[2], y[3]); o.z = pack2(y[4], y[5]); o.w = pack2(y[6], y[7]);
        *(uint4*)(p.mixed + (size_t)row * MC + 256 + hslot * 64 + d0) = o;
      }
    }
  }
  for (size_t idx = gt; idx < (size_t)8 * 15 * 256; idx += ntd) {
    const int c = (int)(idx & 255); const int bi = (int)(idx >> 8); const int i = bi % 15, b = bi / 15;
    p.out[O_POOLP + (size_t)l * 8 * 15 * 256 + idx] = bf2f(p.proj[((size_t)b * 2048 + 2033 + i) * IC + C_U + c]);
  }
  for (size_t idx = gt; idx < (size_t)32 * 15 * 256; idx += ntd) {
    const int c = (int)(idx & 255); const int bi = (int)(idx >> 8); const int i = bi % 15, n = bi / 15;
    float v;
    if (i < 7) v = p.state_pool[((size_t)(l * 32 + n) * 15 + 8 + i) * 256 + c];
    else v = bf2f(p.proj[((size_t)NP + n * 8 + (i - 7)) * IC + C_U + c]);
    p.out[O_POOLS + (size_t)l * 32 * 15 * 256 + idx] = v;
  }
}

#ifndef PROBEV
#define PROBEV 0
#endif
#ifndef REPM
#define REPM 0
#endif
#define NREP(k) (1 + ((REPM >> (k)) & 1))
typedef const __attribute__((address_space(4))) Params* CP;
#if defined(__HIP_DEVICE_COMPILE__)
#define LOAD_PARAMS() CP pp_ = (CP)__builtin_amdgcn_kernarg_segment_ptr(); asm volatile("" : "+s"(pp_)); const Params p = *pp_
#else
#define LOAD_PARAMS() const Params& p = p_unused
#endif
__global__ void __launch_bounds__(512, 2) mega(const Params p_unused, const int ph_lo, const int ph_hi) {
  const int wave_s = __builtin_amdgcn_readfirstlane((int)(threadIdx.x >> 6));
  if (ph_hi == -12345) cg::this_grid().sync();
  {
    LOAD_PARAMS();
    if (opaque_tid(wave_s) == 0) {
      volatile __attribute__((address_space(3))) unsigned* st = (volatile __attribute__((address_space(3))) unsigned*)(smem + BAR_LDS_OFF);
      st[0] = 0u; st[1] = 0u;
      (void)xb_add(&p.bar[XB_XCNT(xb_xcc_id())], 1u);
    }
    __syncthreads();
  }
  int ph = 0;
#define IN_PH() (ph_lo <= ph && ph < ph_hi)
#define SEAM() do { if (ph_lo <= ph && ph + 1 < ph_hi) { LOAD_PARAMS(); grid_bar(p.bar, wave_s); } ++ph; } while (0)
  if (IN_PH()) for (int rep = 0; rep < NREP(0); ++rep) { LOAD_PARAMS(); phase0(p, wave_s); }
  SEAM();
#pragma unroll 1
  for (int l = 0; l < 2; ++l) {
    if (IN_PH()) for (int rep = 0; rep < NREP(1); ++rep) {
      LOAD_PARAMS();
      GemmEpi e{}; e.sumsq_in = p.sumsq + (size_t)(2 * l) * MT; e.out_bf = p.proj; e.ldo = IC;
      gemm_phase<1>(p.xg, p.wt_in + (size_t)l * IC * D, NP, IC, D, e, wave_s);
      { const int G = gridDim.x, first = (64 * (IC / 256)) % G;
        const int b0 = first ? first : 0, nb = G - b0;
        kv_shift_copy(p, l, b0, nb, opaque_tid(wave_s));
        sample_gemm64<1>(p.xg, p.wt_in + (size_t)l * IC * D, IC, D, e, wave_s, true); }
    }
    SEAM();
    if (IN_PH()) for (int rep = 0; rep < NREP(2); ++rep) { LOAD_PARAMS(); phaseA(p, l, wave_s); }
    SEAM();
    if (IN_PH()) for (int rep = 0; rep < NREP(3); ++rep) { LOAD_PARAMS(); phaseB(p, l, wave_s); }
    SEAM();
    if (IN_PH()) for (int rep = 0; rep < NREP(4); ++rep) {
      LOAD_PARAMS();
      GemmEpi e{};
      const bool last = (rep == NREP(4) - 1);
      e.xh = p.xg; e.xh_out = last ? p.xg : p.scr16; e.out_f = nullptr; e.sumsq_out = last ? p.sumsq + (size_t)(2 * l + 1) * MT : p.scrss;
      gemm_phase<2>(p.mixed, p.wt_out + (size_t)l * D * MC, NP, D, MC, e, wave_s, 0);
      sample_gemm<2>(p.mixed, p.wt_out + (size_t)l * D * MC, D, MC, e, wave_s, 0, gridDim.x);
    }
    SEAM();
    if (IN_PH()) for (int rep = 0; rep < NREP(5); ++rep) {
      LOAD_PARAMS();
      GemmEpi e{}; e.sumsq_in = p.sumsq + (size_t)(2 * l + 1) * MT; e.out_bf = p.hf; e.ldo = FF;
      gemm_phase<3>(p.xg, p.wt_up + (size_t)l * FF * D, NP, FF, D, e, wave_s, (rep && (PROBEV & 1)) ? 1 : 0);
      if (!(rep && (PROBEV & 2))) sample_gemm64<3>(p.xg, p.wt_up + (size_t)l * FF * D, FF, D, e, wave_s, false);
    }
    SEAM();
    if (IN_PH()) for (int rep = 0; rep < NREP(6); ++rep) {
      LOAD_PARAMS();
      GemmEpi e{};
      const bool last = (rep == NREP(6) - 1);
      e.xh = p.xg; e.xh_out = last ? p.xg : p.scr16;
      if (l == 0) { e.out_f = nullptr; e.sumsq_out = last ? p.sumsq + (size_t)2 * MT : p.scrss; } else { e.out_f = last ? p.out : p.scrf; e.sumsq_out = nullptr; }
      gemm_phase<2>(p.hf, p.wt_down + (size_t)l * D * FF, NP, D, FF, e, wave_s, 0);
      sample_gemm<2>(p.hf, p.wt_down + (size_t)l * D * FF, D, FF, e, wave_s, 0, gridDim.x);
    }
    SEAM();
  }
}

extern "C" void kernel_launch(void* const* d_in, const int* in_sizes, int n_in, void* d_out, int out_size, void* d_ws, size_t ws_size, hipStream_t stream) {
  static int grid_blocks = 0;
  if (!grid_blocks) {
    int dev = 0, cus = 0, per_cu = 0;
    hipGetDevice(&dev);
    hipDeviceGetAttribute(&cus, hipDeviceAttributeMultiprocessorCount, dev);
    hipFuncSetAttribute((const void*)mega, hipFuncAttributeMaxDynamicSharedMemorySize, GEMM_LDS);
    hipOccupancyMaxActiveBlocksPerMultiprocessor(&per_cu, (const void*)mega, 512, GEMM_LDS);
    if (per_cu < 1) { fprintf(stderr, "occupancy query returned %d\n", per_cu); per_cu = 1; }
    grid_blocks = cus * 1;
  }
  Params p{};
  p.x_prompt = (const float*)d_in[0]; p.x_sample = (const float*)d_in[1]; p.state_pool = (const float*)d_in[2]; p.state_conv = (const float*)d_in[3];
  p.kv_in[0] = (const float*)d_in[4]; p.kv_in[1] = (const float*)d_in[5]; p.kv_in[2] = (const float*)d_in[6];
  p.norm1_g = (const float*)d_in[7]; p.w_in = (const float*)d_in[8]; p.q_norm_g = (const float*)d_in[9]; p.k_norm_g = (const float*)d_in[10];
  p.pool_w = (const float*)d_in[11]; p.pool_scale = (const float*)d_in[12]; p.conv_w = (const float*)d_in[13]; p.w_out = (const float*)d_in[14];
  p.norm2_g = (const float*)d_in[15]; p.w_up = (const float*)d_in[16]; p.w_down = (const float*)d_in[17];
  p.out = (float*)d_out;
  unsigned char* w = (unsigned char*)d_ws; size_t off = 0;
  auto carve = [&](size_t bytes) { unsigned char* r = w + off; off += (bytes + 255) & ~(size_t)255; return r; };
  p.bar = (unsigned*)carve(XCD_BAR_WORDS * 4);
  p.wt_in = (u16*)carve((size_t)2 * IC * D * 2);
  p.wt_out = (u16*)carve((size_t)2 * D * MC * 2);
  p.wt_up = (u16*)carve((size_t)2 * FF * D * 2);
  p.wt_down = (u16*)carve((size_t)2 * D * FF * 2);
  p.pwT = (u16*)carve((size_t)2 * 4 * 4096 * 2);
  p.xg = (u16*)carve((size_t)MT * D * 2);
  p.mixed = (u16*)carve((size_t)MT * MC * 2);
  p.sumsq = (float*)carve((size_t)4 * MT * 4);
  p.lse = (float*)carve((size_t)3 * MT * 2 * 4);
  p.rope = (float*)carve((size_t)2056 * 16 * 4);
  p.scr16 = (u16*)carve((size_t)MT * D * 2); p.scrss = (float*)carve((size_t)MT * 4); p.scrf = (float*)carve((size_t)MT * D * 4);
  p.hf = (u16*)carve((size_t)MT * FF * 2);
  p.proj = p.hf;
  p.opart = (u16*)((unsigned char*)p.hf + (((size_t)MT * IC * 2 + 255) & ~(size_t)255));
  if (off > ws_size) { fprintf(stderr, "workspace too small: need %zu have %zu\n", off, ws_size); return; }
  (void)hipMemsetAsync(p.bar, 0, XCD_BAR_WORDS * 4, stream);
  int lo = 0, hi = 13;
  void* args[] = {(void*)&p, (void*)&lo, (void*)&hi};
  hipError_t e = hipLaunchCooperativeKernel((const void*)mega, dim3(grid_blocks), dim3(512), args, GEMM_LDS, stream);
  if (e != hipSuccess) fprintf(stderr, "cooperative launch failed: %s (grid %d)\n", hipGetErrorString(e), grid_blocks);
}
```
